# Optimizing an MI355X kernel written in HIP

```python
import math
import jax, jax.numpy as jnp
from jax import lax
import numpy as np

D_MODEL = 1024
BATCH = 2
SEQ = 16384
DEPTH = 1

HEAD_DIM = 64
DIL_WIDTH = D_MODEL // 2
N_HEADS_DIL = DIL_WIDTH // HEAD_DIM
DIL_PATTERNS = ((128, 1), (512, 4), (2048, 16))
DIFF_WIDTH = D_MODEL - DIL_WIDTH
N_HEADS_DIFF = DIFF_WIDTH // (2 * HEAD_DIM)
MIX_WIDTH = DIL_WIDTH + DIFF_WIDTH
Q_BLOCK = 128
N_EXPERTS = 32
TOP_K = 4
D_FF = D_MODEL
SWIGLU_ALPHA = 1.702
SWIGLU_LIMIT = 7.0
MOE_BLOCK = 256
DEEPNORM_ALPHA = (2.0 * DEPTH) ** 0.25
DEEPNORM_BETA = (8.0 * DEPTH) ** -0.25
LN_EPS = 1e-5
NEG_INF = -1e30

kernel_name = "hybrid_dilated_diffattn_moe_deepnorm"


def alibi_slopes(n):
    return jnp.asarray([2.0 ** (-8.0 * (i + 1) / n) for i in range(n)], jnp.float32)


def layer_norm(x, g, b):
    xf = x.astype(jnp.float32)
    mu = xf.mean(-1, keepdims=True)
    var = jnp.square(xf - mu).mean(-1, keepdims=True)
    return ((xf - mu) * lax.rsqrt(var + LN_EPS) * g + b).astype(x.dtype)


def dilated_pattern(q, k, v, window, dilation, slopes):
    B, H, S, Dh = q.shape
    n_side = (window // 2) // dilation
    L = S // dilation
    blk = n_side
    nb = -(-L // blk)
    Lp = nb * blk
    span = blk + 2 * n_side

    def to_res(a):
        return a.reshape(B, H, L, dilation, Dh).transpose(0, 1, 3, 2, 4)

    qr = jnp.pad(to_res(q), ((0, 0), (0, 0), (0, 0), (0, Lp - L), (0, 0)))
    kr = jnp.pad(to_res(k), ((0, 0), (0, 0), (0, 0), (n_side, n_side + Lp - L), (0, 0)))
    vr = jnp.pad(to_res(v), ((0, 0), (0, 0), (0, 0), (n_side, n_side + Lp - L), (0, 0)))
    kidx = (jnp.arange(nb) * blk)[:, None] + jnp.arange(span)[None, :]
    kb = kr[:, :, :, kidx]
    vb = vr[:, :, :, kidx].astype(jnp.float32)
    qb = qr.reshape(B, H, dilation, nb, blk, Dh)
    s = jnp.einsum('bhrnqd,bhrnkd->bhrnqk', qb, kb,
                   preferred_element_type=jnp.float32) * (HEAD_DIM ** -0.5)
    rel = jnp.arange(span)[None, :] - n_side - jnp.arange(blk)[:, None]
    key_m = kidx - n_side
    valid = (jnp.abs(rel) <= n_side)[None] & ((key_m >= 0) & (key_m < L))[:, None, :]
    bias = -(slopes * dilation)[:, None, None] * jnp.abs(rel).astype(jnp.float32)
    s = jnp.where(valid[None, None, None], s + bias[None, :, None, None], NEG_INF)
    m = s.max(-1)
    p = jnp.exp(s - m[..., None])
    l = p.sum(-1)
    acc = jnp.einsum('bhrnqk,bhrnkd->bhrnqd', p, vb)

    def from_res(a):
        tail = a.shape[5:]
        a = a.reshape(B, H, dilation, Lp, *tail)[:, :, :, :L]
        a = jnp.moveaxis(a, 2, 3)
        return a.reshape(B, H, S, *tail)

    return from_res(m), from_res(l), from_res(acc)


def dilated_attention(q, k, v, slopes):
    results = [dilated_pattern(q, k, v, w, d, slopes) for (w, d) in DIL_PATTERNS]
    ms = jnp.stack([r[0] for r in results])
    ls = jnp.stack([r[1] for r in results])
    accs = jnp.stack([r[2] for r in results])
    wts = jnp.exp(ms - ms.max(0, keepdims=True))
    num = (wts[..., None] * accs).sum(0)
    den = (wts * ls).sum(0)
    return num / den[..., None]


def diff_attention(q, k, v, slopes, lam):
    B, H, _, S, Dh = q.shape
    nq = S // Q_BLOCK
    qb = q.reshape(B, H, 2, nq, Q_BLOCK, Dh).transpose(3, 0, 1, 2, 4, 5)
    vf = v.astype(jnp.float32)
    key_pos = jnp.arange(S)

    def block(args):
        qblk, i = args
        s = jnp.einsum('bhcqd,bhckd->bhcqk', qblk, k,
                       preferred_element_type=jnp.float32) * (HEAD_DIM ** -0.5)
        qpos = i * Q_BLOCK + jnp.arange(Q_BLOCK)
        dist = jnp.abs(qpos[:, None] - key_pos[None, :]).astype(jnp.float32)
        s = s - (slopes[:, None, None] * dist)[None, :, None]
        p = jax.nn.softmax(s, axis=-1)
        a = p[:, :, 0] - lam * p[:, :, 1]
        return jnp.einsum('bhqk,bhkd->bhqd', a, vf)

    o = lax.map(block, (qb, jnp.arange(nq)))
    return o.transpose(1, 2, 0, 3, 4).reshape(B, H, S, 2 * Dh)


def token_mixers(h, w_in, w_out, lq1, lk1, lq2, lk2, g_sub, layer_idx):
    B, S, _ = h.shape
    proj = h @ w_in
    cuts = np.cumsum([DIL_WIDTH, DIL_WIDTH, DIL_WIDTH, DIFF_WIDTH, DIFF_WIDTH])
    qa, ka, va, qd, kd, vd = jnp.split(proj, [int(c) for c in cuts], axis=-1)

    def heads_a(t):
        return t.reshape(B, S, N_HEADS_DIL, HEAD_DIM).transpose(0, 2, 1, 3)

    oa = dilated_attention(heads_a(qa), heads_a(ka), heads_a(va), alibi_slopes(N_HEADS_DIL))
    oa = oa.transpose(0, 2, 1, 3).reshape(B, S, DIL_WIDTH)

    def heads_qk(t):
        return t.reshape(B, S, N_HEADS_DIFF, 2, HEAD_DIM).transpose(0, 2, 3, 1, 4)

    lam_init = 0.8 - 0.6 * math.exp(-0.3 * layer_idx)
    lam = (jnp.exp(jnp.sum(lq1.astype(jnp.float32) * lk1.astype(jnp.float32)))
           - jnp.exp(jnp.sum(lq2.astype(jnp.float32) * lk2.astype(jnp.float32))) + lam_init)
    vdh = vd.reshape(B, S, N_HEADS_DIFF, 2 * HEAD_DIM).transpose(0, 2, 1, 3)
    od = diff_attention(heads_qk(qd), heads_qk(kd), vdh, alibi_slopes(N_HEADS_DIFF), lam)
    od = od * lax.rsqrt(jnp.mean(od * od, -1, keepdims=True) + LN_EPS) * g_sub.astype(jnp.float32)
    od = (od * (1.0 - lam_init)).transpose(0, 2, 1, 3).reshape(B, S, DIFF_WIDTH)

    mixed = jnp.concatenate([oa, od], axis=-1).astype(h.dtype)
    return mixed @ w_out


def moe(h, w_router, b_router, w_up, b_up, w_down, b_down):
    B, S, D = h.shape
    T = B * S
    xf = h.reshape(T, D)
    logits = (xf @ w_router).astype(jnp.float32) + b_router.astype(jnp.float32)
    top_vals, top_idx = lax.top_k(logits, TOP_K)
    gates = jax.nn.softmax(top_vals, axis=-1)

    TK = T * TOP_K
    flat_e = top_idx.reshape(-1).astype(jnp.int32)
    flat_tok = jnp.arange(TK, dtype=jnp.int32) // TOP_K
    flat_gate = gates.reshape(-1)
    order = jnp.argsort(flat_e, stable=True)
    sorted_e = flat_e[order]
    counts = jnp.bincount(flat_e, length=N_EXPERTS)
    starts = jnp.cumsum(counts) - counts
    pcounts = ((counts + MOE_BLOCK - 1) // MOE_BLOCK) * MOE_BLOCK
    pends = jnp.cumsum(pcounts)
    pstarts = pends - pcounts
    dest = pstarts[sorted_e] + (jnp.arange(TK) - starts[sorted_e])

    n_rows = (-(-TK // MOE_BLOCK)) * MOE_BLOCK + N_EXPERTS * MOE_BLOCK
    nb = n_rows // MOE_BLOCK
    row_tok = jnp.full((n_rows,), T, jnp.int32).at[dest].set(flat_tok[order])
    row_gate = jnp.zeros((n_rows,), jnp.float32).at[dest].set(flat_gate[order])
    block_e = jnp.clip(jnp.searchsorted(pends, jnp.arange(nb) * MOE_BLOCK, side='right'),
                       0, N_EXPERTS - 1)
    x_pad = jnp.concatenate([xf, jnp.zeros((1, D), xf.dtype)], axis=0)

    def expert_block(args):
        tok, e = args
        hu = x_pad[tok] @ w_up[e] + b_up[e]
        g, u = hu[:, :D_FF], hu[:, D_FF:]
        g = jnp.minimum(g, SWIGLU_LIMIT)
        u = jnp.clip(u, -SWIGLU_LIMIT, SWIGLU_LIMIT)
        act = g * jax.nn.sigmoid(SWIGLU_ALPHA * g) * (u + 1.0)
        return act @ w_down[e] + b_down[e]

    y = lax.map(expert_block, (row_tok.reshape(nb, MOE_BLOCK), block_e)).reshape(n_rows, D)
    out = jnp.zeros((T + 1, D), jnp.float32).at[row_tok].add(y.astype(jnp.float32) * row_gate[:, None])
    return out[:T].reshape(B, S, D).astype(h.dtype)


def setup_inputs(seed: int = 0) -> dict:
    key = jax.random.key(seed)
    ks = jax.random.split(key, 20)
    n = lambda k, shape: jax.random.normal(k, shape, jnp.float32)
    return {
        "x": n(ks[0], (BATCH, SEQ, D_MODEL)),
        "w_in": n(ks[1], (DEPTH, D_MODEL, 3 * MIX_WIDTH)) * D_MODEL ** -0.5,
        "w_out": n(ks[2], (DEPTH, MIX_WIDTH, D_MODEL)) * MIX_WIDTH ** -0.5 * DEEPNORM_BETA,
        "lambda_q1": n(ks[3], (DEPTH, HEAD_DIM)) * 0.1,
        "lambda_k1": n(ks[4], (DEPTH, HEAD_DIM)) * 0.1,
        "lambda_q2": n(ks[5], (DEPTH, HEAD_DIM)) * 0.1,
        "lambda_k2": n(ks[6], (DEPTH, HEAD_DIM)) * 0.1,
        "diff_norm_g": 1.0 + 0.02 * n(ks[7], (DEPTH, 2 * HEAD_DIM)),
        "ln1_g": 1.0 + 0.02 * n(ks[8], (DEPTH, D_MODEL)),
        "ln1_b": 0.02 * n(ks[9], (DEPTH, D_MODEL)),
        "w_router": n(ks[10], (DEPTH, D_MODEL, N_EXPERTS)) * D_MODEL ** -0.5,
        "b_router": 0.01 * n(ks[11], (DEPTH, N_EXPERTS)),
        "w_up": n(ks[12], (DEPTH, N_EXPERTS, D_MODEL, 2 * D_FF)) * D_MODEL ** -0.5,
        "b_up": 0.01 * n(ks[13], (DEPTH, N_EXPERTS, 2 * D_FF)),
        "w_down": n(ks[14], (DEPTH, N_EXPERTS, D_FF, D_MODEL)) * D_FF ** -0.5 * DEEPNORM_BETA,
        "b_down": 0.01 * n(ks[15], (DEPTH, N_EXPERTS, D_MODEL)),
        "ln2_g": 1.0 + 0.02 * n(ks[16], (DEPTH, D_MODEL)),
        "ln2_b": 0.02 * n(ks[17], (DEPTH, D_MODEL)),
    }


def reference(x, w_in, w_out, lambda_q1, lambda_k1, lambda_q2, lambda_k2, diff_norm_g,
              ln1_g, ln1_b, w_router, b_router, w_up, b_up, w_down, b_down, ln2_g, ln2_b):
    for l in range(DEPTH):
        mix = token_mixers(x, w_in[l], w_out[l], lambda_q1[l], lambda_k1[l], lambda_q2[l],
                           lambda_k2[l], diff_norm_g[l], l)
        x = layer_norm(DEEPNORM_ALPHA * x + mix, ln1_g[l], ln1_b[l])
        ffn = moe(x, w_router[l], b_router[l], w_up[l], b_up[l], w_down[l], b_down[l])
        x = layer_norm(DEEPNORM_ALPHA * x + ffn, ln2_g[l], ln2_b[l])
    return x
```

```cpp
#include <hip/hip_runtime.h>
#include <hip/hip_cooperative_groups.h>
#include <cstdio>
#include <cstdint>
namespace cg = cooperative_groups;

#define LAS __attribute__((address_space(3)))
typedef unsigned short bf16_t;
typedef short bf16x8 __attribute__((ext_vector_type(8)));
typedef short s16x4 __attribute__((ext_vector_type(4)));
typedef float f32x4 __attribute__((ext_vector_type(4)));
typedef float f32x2 __attribute__((ext_vector_type(2)));
typedef float f32x16 __attribute__((ext_vector_type(16)));
typedef unsigned u32x4 __attribute__((ext_vector_type(4)));
typedef unsigned u32x2 __attribute__((ext_vector_type(2)));
typedef __bf16 bf16x2_t __attribute__((ext_vector_type(2)));

constexpr int BATCH = 2, SEQ = 16384, DM = 1024, NTOK = BATCH * SEQ;
constexpr int NPROJ = 3072, NE = 32, TOPK = 4, DFF = 1024;
constexpr int NROWS_MAX = NTOK * TOPK + NE * 256;
constexpr float LN_EPS = 1e-5f;
constexpr float ALPHA = 1.189207115002721f;
constexpr float LOG2E = 1.4426950408889634f;
constexpr float C2 = 0.125f * LOG2E;
constexpr float LAM_INIT = 0.2f;
constexpr float NEG_BIG = -1e30f;

constexpr size_t MiB = 1u << 20;
constexpr size_t WS_CTL = 0, CTL_ZERO_BYTES = 4096;
constexpr size_t WS_WIN = 2 * MiB, WS_WOUT = 8 * MiB, WS_WUP = 16 * MiB, WS_WDN = 144 * MiB;
constexpr size_t WS_XB = 208 * MiB;
constexpr size_t WS_PROJ = 272 * MiB;
constexpr size_t PROJ_STRIDE = (size_t)NTOK * 512;
constexpr size_t WS_MIXED = 464 * MiB;
constexpr size_t WS_Z = 272 * MiB;
constexpr size_t WS_H = 400 * MiB;
constexpr size_t WS_Y = 672 * MiB;
constexpr size_t WS_APART = 672 * MiB;
constexpr size_t APART_UNIT = 2 * 1024 * 64 * 4 + 2 * 1024 * 2 * 4;
constexpr size_t WS_ROUTE = 944 * MiB;
constexpr size_t WS_END = 952 * MiB;

constexpr int RING_BYTES = 131072;
constexpr int LX_TILE = 131072;
constexpr int LX_TOK = 132096;
constexpr int LX_MISC = 144384;
constexpr int LDS_BYTES = 147456;

__device__ __forceinline__ unsigned cvtpk(float lo, float hi) { f32x2 v = {lo, hi}; bf16x2_t b = __builtin_convertvector(v, bf16x2_t); return __builtin_bit_cast(unsigned, b); }
__device__ __forceinline__ float wave_sum(float v) {
#pragma unroll
    for (int o = 1; o < 64; o <<= 1) v += __shfl_xor(v, o);
    return v;
}

namespace pg8 {
constexpr int BM = 256, BK = 64, HALF = 128, HTB = HALF * BK * 2, STAGE_BYTES = 8 * HTB, NXCD = 8, WGM = 8;
__host__ __device__ __forceinline__ int lds_byte(int r, int c) { const int st = (r >> 4) * 2 + (c >> 5), rr = r & 15, cc = c & 31, ob = rr * 64 + cc * 2; return st * 1024 + (ob ^ (((ob >> 9) & 1) << 5)); }
__host__ __device__ __forceinline__ void stage_rc(int b, int& R, int& C) { const int st = b / 1024, sb = b % 1024, swz = sb ^ (((sb >> 9) & 1) << 5); R = (st >> 1) * 16 + swz / 64; C = (st & 1) * 32 + (swz % 64) / 2; }
__host__ __device__ __forceinline__ int perm32(int rho) { const int n = rho >> 4, i = rho & 15; return 8 * (i >> 2) + 4 * n + (i & 3); }

struct Unit { int pm, pn; };
struct Gemm { const bf16_t* A; const bf16_t* Bt; int M, N, K; };

struct StaticOrder {
    int nM, nN, nwg, G, c;
    __host__ __device__ void init(int M, int N, int G_, int c_) { nM = M / BM; nN = N / BM; nwg = nM * nN; G = G_; c = c_; }
    __host__ __device__ bool next(int i, Unit& u) const {
        const long L = (long)i * G + c; if (L >= nwg) return false;
        int wgid = (int)L; { const int q = nwg / NXCD, r = nwg % NXCD, xcd = wgid % NXCD, off = wgid / NXCD; wgid = (xcd < r ? xcd * (q + 1) : r * (q + 1) + (xcd - r) * q) + off; }
        const int nig = WGM * nN, gid = wgid / nig, fm = gid * WGM, gsz = (nM - fm) < WGM ? (nM - fm) : WGM;
        u.pm = fm + ((wgid % nig) % gsz); u.pn = (wgid % nig) / gsz; return true;
    }
    __device__ __forceinline__ const LAS unsigned short* tok_table(int) const { return nullptr; }
};

template <class Epi, class Sched, bool ALIGN_EPI, bool GATHER>
__device__ __forceinline__ void gemm_phase(LAS unsigned char* lds, const Gemm g, const Sched& S, const Epi& E) {
    const int tid = threadIdx.x, wid = __builtin_amdgcn_readfirstlane(tid >> 6), lane = tid & 63, wr = wid >> 2, wc = wid & 3, fr = lane & 15, fq = lane >> 4;
    const int K = g.K, nt = K / BK;
    unsigned voffA[2], voffB[2]; int rowA[2];
#pragma unroll
    for (int i = 0; i < 2; ++i) { int R, C; stage_rc(tid * 16 + i * 8192, R, C); const int Rb = Epi::PERM ? ((R & ~31) + perm32(R & 31)) : R;
        voffA[i] = GATHER ? (unsigned)(C * 2) : (unsigned)(R * K + C) * 2u; voffB[i] = (unsigned)(Rb * K + C) * 2u; rowA[i] = R; }
    const size_t kstep = (size_t)(BK * 2);
    const size_t hstep = (size_t)HALF * K * 2;
    const size_t tstep = 2 * hstep;
    const unsigned ldsw = (unsigned)wid * 1024u;
    const int aoff = lds_byte(wr * 64 + fr, fq * 8), boff = lds_byte(wc * 32 + fr, fq * 8);
#define PG8_SA(b, h) (((b) * 2 + (h)) * HTB)
#define PG8_SB(b, h) ((4 + (b) * 2 + (h)) * HTB)
#define PG8_STAGE(bufoff, gbase, voff) do { _Pragma("unroll") for (int _i = 0; _i < 2; ++_i) \
        __builtin_amdgcn_global_load_lds((const unsigned*)((const char*)(gbase) + (voff)[_i]), (LAS unsigned*)(lds + (bufoff) + ldsw + _i * 8192), 16, 0, 0); } while (0)
#define PG8_STAGE_A(bufoff, NX, h, kb) do { if constexpr (GATHER) { const unsigned* _o = (NX) ? gN[h] : gC[h]; PG8_STAGE(bufoff, (const char*)g.A + (kb), _o); } \
        else { PG8_STAGE(bufoff, ((NX) ? nA : cA) + (h) * hstep + (kb), voffA); } } while (0)
#define PG8_LDA(dst, b, h) do { _Pragma("unroll") for (int m = 0; m < 4; ++m) _Pragma("unroll") for (int k = 0; k < 2; ++k) dst[m][k] = *(const LAS bf16x8*)(lds + PG8_SA(b, h) + aoff + m * 2048 + k * 1024); } while (0)
#define PG8_LDB(dst, b, h) do { _Pragma("unroll") for (int n = 0; n < 2; ++n) _Pragma("unroll") for (int k = 0; k < 2; ++k) dst[n][k] = *(const LAS bf16x8*)(lds + PG8_SB(b, h) + boff + n * 2048 + k * 1024); } while (0)
#define PG8_MMA(ai, bj, At, Bt) do { __builtin_amdgcn_s_setprio(1); _Pragma("unroll") for (int m = 0; m < 4; ++m) _Pragma("unroll") for (int n = 0; n < 2; ++n) _Pragma("unroll") for (int k = 0; k < 2; ++k) \
        acc[ai][bj][m][n] = __builtin_amdgcn_mfma_f32_16x16x32_bf16(Bt[n][k], At[m][k], acc[ai][bj][m][n], 0, 0, 0); __builtin_amdgcn_s_setprio(0); } while (0)
#define PG8_WAIT_V(n) asm volatile("s_waitcnt vmcnt(" #n ")" ::: "memory")
#define PG8_WAIT_L(n) asm volatile("s_waitcnt lgkmcnt(" #n ")" ::: "memory")
#define PG8_BAR __builtin_amdgcn_s_barrier()
#define PG8_SCHED __builtin_amdgcn_sched_barrier(0)
#define PG8_GOFF(dst, ui_) do { if constexpr (GATHER) { const LAS unsigned short* _t = S.tok_table(ui_); _Pragma("unroll") for (int _h = 0; _h < 2; ++_h) _Pragma("unroll") for (int _i = 0; _i < 2; ++_i) \
        dst[_h][_i] = (unsigned)_t[_h * HALF + rowA[_i]] * (unsigned)(K * 2) + voffA[_i]; } } while (0)
    Unit cur, nxt; int ui = 0;
    if (!S.next(0, cur)) return;
    f32x4 acc[2][2][4][2];
#pragma unroll
    for (int a = 0; a < 2; ++a)
#pragma unroll
        for (int b = 0; b < 2; ++b)
#pragma unroll
            for (int m = 0; m < 4; ++m)
#pragma unroll
                for (int n = 0; n < 2; ++n) acc[a][b][m][n] = (f32x4){0.f, 0.f, 0.f, 0.f};
    bf16x8 At[4][2], B0[2][2], B1[2][2];
    unsigned gC[2][2] = {{0u, 0u}, {0u, 0u}}, gN[2][2] = {{0u, 0u}, {0u, 0u}};
    PG8_GOFF(gC, 0);
    const char* cA = (const char*)g.A + (GATHER ? (size_t)0 : (size_t)cur.pm * tstep); const char* cB = (const char*)g.Bt + (size_t)cur.pn * tstep;
    const char* nA = cA;
    {
        PG8_STAGE(PG8_SB(0, 0), cB, voffB); PG8_STAGE(PG8_SB(0, 1), cB + hstep, voffB); PG8_STAGE_A(PG8_SA(0, 0), false, 0, 0); PG8_STAGE_A(PG8_SA(0, 1), false, 1, 0);
        if (wr == 1) PG8_BAR;
        PG8_WAIT_V(2); PG8_BAR;
        PG8_STAGE(PG8_SB(1, 0), cB + kstep, voffB); PG8_STAGE_A(PG8_SA(1, 0), false, 0, kstep); PG8_STAGE(PG8_SB(1, 1), cB + hstep + kstep, voffB);
        PG8_WAIT_V(6); PG8_BAR;
    }
    for (;;) {
        const bool has_next = S.next(ui + 1, nxt);
        nA = has_next ? (const char*)g.A + (GATHER ? (size_t)0 : (size_t)nxt.pm * tstep) : cA; const char* nB = has_next ? (const char*)g.Bt + (size_t)nxt.pn * tstep : cB;
        if (has_next) { PG8_GOFF(gN, ui + 1); } else {
#pragma unroll
            for (int h = 0; h < 2; ++h)
#pragma unroll
                for (int i = 0; i < 2; ++i) gN[h][i] = gC[h][i]; }
        for (int t = 0; t < nt; t += 2) {
            const bool last = (t == nt - 2);
            const size_t k1 = (size_t)(t + 1) * kstep;
            const size_t k2 = last ? (size_t)0 : (size_t)(t + 2) * kstep, k3 = k2 + kstep;
            const char* b2 = last ? nB : cB + (size_t)(t + 2) * kstep; const char* b3 = b2 + kstep;
            PG8_LDB(B0, 0, 0); PG8_LDB(B1, 0, 1); PG8_SCHED; PG8_LDA(At, 0, 0); PG8_STAGE_A(PG8_SA(1, 1), false, 1, k1);
            PG8_WAIT_V(8); PG8_WAIT_L(0); PG8_BAR; PG8_MMA(0, 0, At, B0); PG8_MMA(0, 1, At, B1); PG8_BAR; PG8_SCHED;
            PG8_LDA(At, 0, 1); PG8_STAGE(PG8_SB(0, 0), b2, voffB); PG8_STAGE(PG8_SB(0, 1), b2 + hstep, voffB); PG8_STAGE_A(PG8_SA(0, 0), last, 0, k2);
            PG8_WAIT_V(8); PG8_WAIT_L(0); PG8_BAR; PG8_MMA(1, 0, At, B0); PG8_MMA(1, 1, At, B1); PG8_BAR; PG8_SCHED;
            PG8_LDB(B0, 1, 0); PG8_LDB(B1, 1, 1); PG8_SCHED; PG8_LDA(At, 1, 0); PG8_STAGE_A(PG8_SA(0, 1), last, 1, k2);
            PG8_WAIT_V(8); PG8_WAIT_L(0); PG8_BAR; PG8_MMA(0, 0, At, B0); PG8_MMA(0, 1, At, B1); PG8_BAR; PG8_SCHED;
            PG8_LDA(At, 1, 1); PG8_STAGE(PG8_SB(1, 0), b3, voffB); PG8_STAGE(PG8_SB(1, 1), b3 + hstep, voffB); PG8_STAGE_A(PG8_SA(1, 0), last, 0, k3);
            PG8_WAIT_V(8); PG8_WAIT_L(0); PG8_BAR; PG8_MMA(1, 0, At, B0); PG8_MMA(1, 1, At, B1); PG8_BAR; PG8_SCHED;
        }
        if constexpr (ALIGN_EPI) { if (wr == 0) PG8_BAR; }
        E(acc, cur, wr, wc, fr, fq);
        if (!has_next) break;
#pragma unroll
        for (int a = 0; a < 2; ++a)
#pragma unroll
            for (int b = 0; b < 2; ++b)
#pragma unroll
                for (int m = 0; m < 4; ++m)
#pragma unroll
                    for (int n = 0; n < 2; ++n) acc[a][b][m][n] = (f32x4){0.f, 0.f, 0.f, 0.f};
        cur = nxt; cA = nA; cB = nB; ++ui;
#pragma unroll
        for (int h = 0; h < 2; ++h)
#pragma unroll
            for (int i = 0; i < 2; ++i) gC[h][i] = gN[h][i];
        if constexpr (ALIGN_EPI) { if (wr == 1) PG8_BAR; }
    }
    PG8_WAIT_V(0);
    if constexpr (!ALIGN_EPI) { if (wr == 0) PG8_BAR; }
    PG8_BAR;
#undef PG8_SA
#undef PG8_SB
#undef PG8_STAGE
#undef PG8_STAGE_A
#undef PG8_LDA
#undef PG8_LDB
#undef PG8_MMA
#undef PG8_WAIT_V
#undef PG8_WAIT_L
#undef PG8_BAR
#undef PG8_SCHED
#undef PG8_GOFF
}
}

struct Args {
    const float* x; const float* w_in; const float* w_out; const float* lq1; const float* lk1; const float* lq2; const float* lk2; const float* g_sub;
    const float* ln1_g; const float* ln1_b; const float* w_router; const float* b_router; const float* w_up; const float* b_up; const float* w_down; const float* b_down;
    const float* ln2_g; const float* ln2_b; float* out; unsigned char* ws;
};
struct Frame {
    LAS unsigned char* lds; int tid, lane, wave, vcu, G;
};

struct EpiProj {
    static constexpr bool PERM = true;
    bf16_t* O;
    __device__ __forceinline__ void operator()(const f32x4 (&acc)[2][2][4][2], const pg8::Unit& u, int wr, int wc, int fr, int fq) const {
        const int t = u.pn >> 1; const float sc = (t == 0 || t == 3) ? C2 : 1.f;
        bf16_t* base = O + (size_t)t * PROJ_STRIDE; const int row0 = u.pm * 256 + wr * 64 + fr, col0 = (u.pn & 1) * 256 + wc * 32 + 8 * fq;
#pragma unroll
        for (int ai = 0; ai < 2; ++ai)
#pragma unroll
            for (int m = 0; m < 4; ++m) { bf16_t* rowp = base + (size_t)(row0 + ai * 128 + m * 16) * 512 + col0;
#pragma unroll
                for (int bj = 0; bj < 2; ++bj) { const f32x4 v0 = acc[ai][bj][m][0] * sc, v1 = acc[ai][bj][m][1] * sc; u32x4 w;
                    w.x = cvtpk(v0[0], v0[1]); w.y = cvtpk(v0[2], v0[3]); w.z = cvtpk(v1[0], v1[1]); w.w = cvtpk(v1[2], v1[3]); *(u32x4*)(rowp + bj * 128) = w; } }
    }
};
struct EpiZ {
    static constexpr bool PERM = false;
    const float* x; float* z;
    __device__ __forceinline__ void operator()(const f32x4 (&acc)[2][2][4][2], const pg8::Unit& u, int wr, int wc, int fr, int fq) const {
        const int col0 = u.pn * 256 + wc * 32 + 4 * fq;
#pragma unroll
        for (int ai = 0; ai < 2; ++ai)
#pragma unroll
            for (int m = 0; m < 4; ++m) { const size_t off = (size_t)(u.pm * 256 + ai * 128 + wr * 64 + m * 16 + fr) * DM + col0;
#pragma unroll
                for (int bj = 0; bj < 2; ++bj)
#pragma unroll
                    for (int n = 0; n < 2; ++n) { const f32x4 xv = *(const f32x4*)(x + off + bj * 128 + n * 16); *(f32x4*)(z + off + bj * 128 + n * 16) = xv * ALPHA + acc[ai][bj][m][n]; } }
    }
};
__device__ __forceinline__ float swiglu(float g, float u) {
    g = fminf(g, 7.0f); u = fminf(fmaxf(u, -7.0f), 7.0f);
    const float s = __builtin_amdgcn_rcpf(1.0f + __builtin_amdgcn_exp2f(-1.702f * LOG2E * g));
    return g * s * (u + 1.0f);
}
struct EpiUp {
    static constexpr bool PERM = true;
    bf16_t* H; const float* b_up;
    __device__ __forceinline__ void operator()(const f32x4 (&acc)[2][2][4][2], const pg8::Unit& u, int wr, int wc, int fr, int fq) const {
        const int e = u.pn >> 3, pnl = u.pn & 7, hcol0 = pnl * 128 + wc * 32 + 8 * fq;
        const float* bg = b_up + (size_t)e * 2048 + hcol0; const float* bu = bg + 1024;
        const f32x4 bg0 = *(const f32x4*)bg, bg1 = *(const f32x4*)(bg + 4), bu0 = *(const f32x4*)bu, bu1 = *(const f32x4*)(bu + 4);
#pragma unroll
        for (int ai = 0; ai < 2; ++ai)
#pragma unroll
            for (int m = 0; m < 4; ++m) { const size_t row = (size_t)(u.pm * 256 + ai * 128 + wr * 64 + m * 16 + fr);
                const f32x4 g0 = acc[ai][0][m][0] + bg0, g1 = acc[ai][0][m][1] + bg1, u0 = acc[ai][1][m][0] + bu0, u1 = acc[ai][1][m][1] + bu1; u32x4 w;
                w.x = cvtpk(swiglu(g0[0], u0[0]), swiglu(g0[1], u0[1])); w.y = cvtpk(swiglu(g0[2], u0[2]), swiglu(g0[3], u0[3]));
                w.z = cvtpk(swiglu(g1[0], u1[0]), swiglu(g1[1], u1[1])); w.w = cvtpk(swiglu(g1[2], u1[2]), swiglu(g1[3], u1[3]));
                *(u32x4*)(H + row * DFF + hcol0) = w; }
    }
};
struct EpiDown {
    static constexpr bool PERM = true;
    bf16_t* Y; const float* b_down; const float* row_gate;
    __device__ __forceinline__ void operator()(const f32x4 (&acc)[2][2][4][2], const pg8::Unit& u, int wr, int wc, int fr, int fq) const {
        const int e = u.pn >> 2, pnl = u.pn & 3, col0 = pnl * 256 + wc * 32 + 8 * fq;
        f32x4 bv[2][2];
#pragma unroll
        for (int bj = 0; bj < 2; ++bj)
#pragma unroll
            for (int n = 0; n < 2; ++n) bv[bj][n] = *(const f32x4*)(b_down + (size_t)e * DM + col0 + bj * 128 + 4 * n);
#pragma unroll
        for (int ai = 0; ai < 2; ++ai)
#pragma unroll
            for (int m = 0; m < 4; ++m) { const size_t row = (size_t)(u.pm * 256 + ai * 128 + wr * 64 + m * 16 + fr); const float gt = row_gate[row];
#pragma unroll
                for (int bj = 0; bj < 2; ++bj) { const f32x4 v0 = (acc[ai][bj][m][0] + bv[bj][0]) * gt, v1 = (acc[ai][bj][m][1] + bv[bj][1]) * gt; u32x4 w;
                    w.x = cvtpk(v0[0], v0[1]); w.y = cvtpk(v0[2], v0[3]); w.z = cvtpk(v1[0], v1[1]); w.w = cvtpk(v1[2], v1[3]); *(u32x4*)(Y + row * DM + col0 + bj * 128) = w; } }
    }
};
struct MoeOrder {
    pg8::StaticOrder so; const LAS unsigned char* tile_e; const LAS unsigned short* tok; int ncolt;
    __device__ __forceinline__ bool next(int i, pg8::Unit& u) const {
        if (!so.next(i, u)) return false;
        const int e = __builtin_amdgcn_readfirstlane((int)tile_e[u.pm]); u.pn = e * ncolt + u.pn; return true; }
    __device__ __forceinline__ const LAS unsigned short* tok_table(int ui) const { return tok + ui * 256; }
};

__device__ __forceinline__ void p0_transpose_item(const float* W, int K, int N, bf16_t* WT, int k0, int n0, int row0, LAS float* scr, int lane) {
#pragma unroll 8
    for (int i = 0; i < 32; ++i) { const int kk = 2 * i + (lane >> 5); scr[kk * 33 + (lane & 31)] = W[(size_t)(k0 + kk) * N + n0 + (lane & 31)]; }
    asm volatile("s_waitcnt lgkmcnt(0)" ::: "memory");
    const int c = lane & 7;
#pragma unroll
    for (int j = 0; j < 4; ++j) { const int n = (lane >> 3) + 8 * j; const LAS float* s = scr + (8 * c) * 33 + n;
        u32x4 o; o.x = cvtpk(s[0 * 33], s[1 * 33]); o.y = cvtpk(s[2 * 33], s[3 * 33]); o.z = cvtpk(s[4 * 33], s[5 * 33]); o.w = cvtpk(s[6 * 33], s[7 * 33]);
        *(u32x4*)(WT + (size_t)(row0 + n) * K + k0 + 8 * c) = o; }
    asm volatile("s_waitcnt lgkmcnt(0)" ::: "memory");
}
__device__ __forceinline__ void p0_prologue(const Frame& F, const Args& a) {
    LAS float* scr = (LAS float*)(F.lds + F.wave * 16384);
    const int gw = F.vcu * 8 + F.wave, NGW = F.G * 8;
    bf16_t* WinT = (bf16_t*)(a.ws + WS_WIN); bf16_t* WoutT = (bf16_t*)(a.ws + WS_WOUT); bf16_t* WupT = (bf16_t*)(a.ws + WS_WUP); bf16_t* WdnT = (bf16_t*)(a.ws + WS_WDN);
    constexpr int I_IN = 16 * 96, I_OUT = 16 * 32, I_UP = 16 * 64, I_DN = 16 * 32;
    constexpr int NITEMS = I_IN + I_OUT + NE * I_UP + NE * I_DN;
    for (int it = gw; it < NITEMS; it += NGW) {
        int r = it;
        if (r < I_IN) { const int kb = r / 96, nb = r % 96; p0_transpose_item(a.w_in, DM, NPROJ, WinT, 64 * kb, 32 * nb, 32 * nb, scr, F.lane); continue; } r -= I_IN;
        if (r < I_OUT) { const int kb = r / 32, nb = r % 32; p0_transpose_item(a.w_out, DM, DM, WoutT, 64 * kb, 32 * nb, 32 * nb, scr, F.lane); continue; } r -= I_OUT;
        if (r < NE * I_UP) { const int e = r / I_UP, q = r % I_UP, kb = q / 64, nb = q % 64, n0 = 32 * nb;
            const int nn = n0 & 1023, row0 = (nn >> 7) * 256 + (n0 >> 10) * 128 + (nn & 127);
            p0_transpose_item(a.w_up + (size_t)e * DM * 2048, DM, 2048, WupT + (size_t)e * 2048 * DM, 64 * kb, n0, row0, scr, F.lane); continue; } r -= NE * I_UP;
        { const int e = r / I_DN, q = r % I_DN, kb = q / 32, nb = q % 32; p0_transpose_item(a.w_down + (size_t)e * DFF * DM, DFF, DM, WdnT + (size_t)e * DM * DFF, 64 * kb, 32 * nb, 32 * nb, scr, F.lane); }
    }
    bf16_t* XB = (bf16_t*)(a.ws + WS_XB);
    for (int m = gw; m < NTOK; m += NGW) {
        const f32x4* xr = (const f32x4*)(a.x + (size_t)m * DM) + F.lane; unsigned long long* o8 = (unsigned long long*)(XB + (size_t)m * DM) + F.lane;
#pragma unroll
        for (int j = 0; j < 4; ++j) { const f32x4 v = xr[64 * j]; o8[64 * j] = (unsigned long long)cvtpk(v[0], v[1]) | ((unsigned long long)cvtpk(v[2], v[3]) << 32); }
    }
}

__device__ __forceinline__ int crow(int r, int hi) { return (r & 3) + 8 * (r >> 2) + 4 * hi; }
typedef LAS const char* lds_cptr;
typedef short v4i16_t __attribute__((ext_vector_type(4)));
__device__ __forceinline__ s16x4 vtr(lds_cptr p) { return __builtin_bit_cast(s16x4, __builtin_amdgcn_ds_read_tr16_b64_v4i16((LAS v4i16_t*)p)); }
#define MX3(a, b, c) __builtin_fmaxf(__builtin_fmaxf((a), (b)), (c))
__device__ __forceinline__ float rowmax(const f32x16& p0, const f32x16& p1) {
    float a = MX3(p0[0], p0[1], p1[0]), b = MX3(p0[2], p0[3], p1[1]); a = MX3(a, p1[2], p1[3]);
#pragma unroll
    for (int r = 4; r < 16; r += 4) { a = MX3(a, p0[r], p0[r + 1]); b = MX3(b, p0[r + 2], p0[r + 3]); a = MX3(a, p1[r], p1[r + 1]); b = MX3(b, p1[r + 2], p1[r + 3]); }
    float m = __builtin_fmaxf(a, b); auto rr = __builtin_amdgcn_permlane32_swap(__float_as_uint(m), __float_as_uint(m), false, false);
    return __builtin_fmaxf(__uint_as_float(rr[0]), __uint_as_float(rr[1]));
}
__device__ __forceinline__ float halfsum(float v) { auto rr = __builtin_amdgcn_permlane32_swap(__float_as_uint(v), __float_as_uint(v), false, false); return __uint_as_float(rr[0]) + __uint_as_float(rr[1]); }
#define MFMA32(a, b, c) __builtin_amdgcn_mfma_f32_32x32x16_bf16(a, b, c, 0, 0, 0)

template <int ND>
__device__ __forceinline__ void softmax_tile(f32x16& p0, f32x16& p1, float& mhat, float& lsum, f32x16 (&o)[ND], u32x4 (&pw)[4]) {
    const float rm = rowmax(p0, p1);
    const float mnew = __builtin_fmaxf(mhat, rm);
    if (__any(mnew != mhat)) {
        const float al = __builtin_amdgcn_exp2f(mhat - mnew); lsum *= al;
#pragma unroll
        for (int d = 0; d < ND; ++d)
#pragma unroll
            for (int r = 0; r < 16; ++r) o[d][r] *= al;
        mhat = mnew;
    }
    float s = 0.f;
#pragma unroll
    for (int r = 0; r < 16; ++r) { p0[r] = __builtin_amdgcn_exp2f(p0[r] - mhat); p1[r] = __builtin_amdgcn_exp2f(p1[r] - mhat); s += p0[r] + p1[r]; }
    lsum += s;
    pw[0] = (u32x4){cvtpk(p0[0], p0[1]), cvtpk(p0[2], p0[3]), cvtpk(p0[4], p0[5]), cvtpk(p0[6], p0[7])};
    pw[1] = (u32x4){cvtpk(p0[8], p0[9]), cvtpk(p0[10], p0[11]), cvtpk(p0[12], p0[13]), cvtpk(p0[14], p0[15])};
    pw[2] = (u32x4){cvtpk(p1[0], p1[1]), cvtpk(p1[2], p1[3]), cvtpk(p1[4], p1[5]), cvtpk(p1[6], p1[7])};
    pw[3] = (u32x4){cvtpk(p1[8], p1[9]), cvtpk(p1[10], p1[11]), cvtpk(p1[12], p1[13]), cvtpk(p1[14], p1[15])};
}
template <int ND>
__device__ __forceinline__ void pv_tile(f32x16 (&o)[ND], lds_cptr vbase, const u32x4 (&pw)[4]) {
#pragma unroll
    for (int d0 = 0; d0 < ND; ++d0)
#pragma unroll
        for (int ks = 0; ks < 4; ++ks) {
            const s16x4 lo = vtr(vbase + d0 * 4096 + ks * 1024), hi = vtr(vbase + d0 * 4096 + ks * 1024 + 512);
            const bf16x8 vf = (bf16x8){lo[0], lo[1], lo[2], lo[3], hi[0], hi[1], hi[2], hi[3]};
            o[d0] = MFMA32(vf, __builtin_bit_cast(bf16x8, pw[ks]), o[d0]);
        }
}

__device__ __forceinline__ void attnB_unit(const Frame& F, const Args& a, int b, int h, int qblk, float lam) {
    const int lane = F.lane, r32 = lane & 31, hi = lane >> 5, wid = F.wave, c = wid >> 2, qs = wid & 3;
    const bf16_t* QD = (const bf16_t*)(a.ws + WS_PROJ) + 3 * PROJ_STRIDE; const bf16_t* KD = QD + PROJ_STRIDE; const bf16_t* VD = KD + PROJ_STRIDE;
    const size_t rowbase = (size_t)b * SEQ; const int q0 = qblk * 128, qpos = q0 + 32 * qs + r32;
    bf16x8 qr[4];
    { const bf16_t* Qp = QD + (rowbase + qpos) * 512 + h * 128 + c * 64 + 8 * hi;
#pragma unroll
      for (int d0 = 0; d0 < 4; ++d0) qr[d0] = *(const bf16x8*)(Qp + 16 * d0); }
    const float slope2 = __builtin_amdgcn_exp2f(-2.0f * (float)(h + 1)) * LOG2E;
    const bf16_t* ksrc = KD + (rowbase + lane) * 512 + h * 128 + wid * 8;
    const bf16_t* vsrc = VD + (rowbase + 16 * (wid & 3) + (lane >> 2)) * 512 + h * 128 + 32 * (wid >> 2) + 8 * (lane & 3);
    LAS unsigned char* L = F.lds;
#define B_DMA(t, s) do { const bf16_t* _k = ksrc + (size_t)(t) * 64 * 512; const bf16_t* _v = vsrc + (size_t)(t) * 64 * 512; LAS unsigned char* _d = L + (s) * 32768 + wid * 1024; \
        __builtin_amdgcn_global_load_lds((const unsigned*)_k, (LAS unsigned*)_d, 16, 0, 0); __builtin_amdgcn_global_load_lds((const unsigned*)(_k + 64), (LAS unsigned*)(_d + 8192), 16, 0, 0); \
        __builtin_amdgcn_global_load_lds((const unsigned*)_v, (LAS unsigned*)(_d + 16384), 16, 0, 0); __builtin_amdgcn_global_load_lds((const unsigned*)(_v + 64), (LAS unsigned*)(_d + 16384 + 8192), 16, 0, 0); } while (0)
    float mhat = NEG_BIG, lsum = 0.f; f32x16 o[4];
#pragma unroll
    for (int d = 0; d < 4; ++d) o[d] = (f32x16){};
    const int koff = (c * 8 + hi) * 1024 + r32 * 16;
    const int voff = 16384 + ((lane >> 4) & 1) * 32 + (lane & 3) * 8 + (4 * hi + ((lane & 15) >> 2)) * 64;
    constexpr int NTK = SEQ / 64;
    B_DMA(0, 0);
    for (int t = 0; t < NTK; ++t) {
        asm volatile("s_waitcnt vmcnt(0)" ::: "memory");
        __syncthreads();
        if (t + 1 < NTK) B_DMA(t + 1, (t + 1) & 1);
        const LAS unsigned char* buf = L + (t & 1) * 32768;
        f32x16 p0, p1; const float dq = (float)(qpos - t * 64 - 4 * hi);
#pragma unroll
        for (int r = 0; r < 16; ++r) { const float kk = (float)((r & 3) + 8 * (r >> 2)); p0[r] = -slope2 * __builtin_fabsf(dq - kk); p1[r] = -slope2 * __builtin_fabsf(dq - 32.f - kk); }
#pragma unroll
        for (int d0 = 0; d0 < 4; ++d0) {
            const bf16x8 k0 = *(const LAS bf16x8*)(buf + koff + d0 * 2048), k1 = *(const LAS bf16x8*)(buf + koff + d0 * 2048 + 512);
            p0 = MFMA32(k0, qr[d0], p0); p1 = MFMA32(k1, qr[d0], p1);
        }
        u32x4 pw[4];
        softmax_tile<4>(p0, p1, mhat, lsum, o, pw);
        pv_tile<4>(o, (lds_cptr)(buf + voff), pw);
    }
#undef B_DMA
    const float inv = 1.0f / halfsum(lsum);
    LAS float* ex = (LAS float*)(L + 65536);
    __syncthreads();
    if (c == 1) {
#pragma unroll
        for (int d0 = 0; d0 < 4; ++d0)
#pragma unroll
            for (int r = 0; r < 16; ++r) ex[(qs * 128 + 32 * d0 + crow(r, hi)) * 32 + r32] = o[d0][r] * inv;
    }
    __syncthreads();
    if (c == 0) {
        float ss = 0.f;
#pragma unroll
        for (int d0 = 0; d0 < 4; ++d0)
#pragma unroll
            for (int r = 0; r < 16; ++r) { const float v = o[d0][r] * inv - lam * ex[(qs * 128 + 32 * d0 + crow(r, hi)) * 32 + r32]; o[d0][r] = v; ss += v * v; }
        ss = halfsum(ss);
        const float rs = __builtin_amdgcn_rsqf(ss * (1.0f / 128.0f) + LN_EPS) * (1.0f - LAM_INIT);
        bf16_t* op = (bf16_t*)(a.ws + WS_MIXED) + (rowbase + qpos) * DM + 512 + h * 128 + 4 * hi;
#pragma unroll
        for (int d0 = 0; d0 < 4; ++d0)
#pragma unroll
            for (int g = 0; g < 4; ++g) { const int dv = 32 * d0 + 8 * g + 4 * hi; const f32x4 gs = *(const f32x4*)(a.g_sub + dv);
                u32x2 w; w.x = cvtpk(o[d0][4 * g] * rs * gs[0], o[d0][4 * g + 1] * rs * gs[1]); w.y = cvtpk(o[d0][4 * g + 2] * rs * gs[2], o[d0][4 * g + 3] * rs * gs[3]);
                *(u32x2*)(op + 32 * d0 + 8 * g) = w; }
    }
    __syncthreads();
}

__device__ __forceinline__ void attnA_task(const Frame& F, const Args& a, int b, int head, int d, int r, int n0, int L, LAS unsigned char* vw, f32x16 (&o)[2], float& mhat, float& ltot) {
    const int lane = F.lane, r32 = lane & 31, hi = lane >> 5;
    const bf16_t* QA = (const bf16_t*)(a.ws + WS_PROJ); const bf16_t* KA = QA + PROJ_STRIDE; const bf16_t* VA = KA + PROJ_STRIDE;
    const size_t rowbase = (size_t)b * SEQ; const int qn = n0 + r32;
    bf16x8 qr[4];
    { const bf16_t* Qp = QA + (rowbase + (size_t)(d * qn + r)) * 512 + head * 64 + 8 * hi;
#pragma unroll
      for (int d0 = 0; d0 < 4; ++d0) qr[d0] = *(const bf16x8*)(Qp + 16 * d0); }
    const float sl = __builtin_amdgcn_exp2f(-(float)(head + 1)) * LOG2E * (float)d;
    mhat = NEG_BIG; float lsum = 0.f; o[0] = (f32x16){}; o[1] = (f32x16){};
    const int voff = ((lane >> 4) & 1) * 32 + (lane & 3) * 8 + (4 * hi + ((lane & 15) >> 2)) * 64;
#pragma unroll 1
    for (int it = 0; it < 3; ++it) {
        const int kt = (it == 0) ? 1 : (it == 1 ? 0 : 2); const int kbase = n0 - 64 + 64 * kt;
        if (kbase + 63 < 0 || kbase >= L) continue;
        bf16x8 kf[8];
#pragma unroll
        for (int kh = 0; kh < 2; ++kh) { int kn = kbase + 32 * kh + r32; kn = kn < 0 ? 0 : (kn >= L ? L - 1 : kn);
            const bf16_t* Kp = KA + (rowbase + (size_t)(d * kn + r)) * 512 + head * 64 + 8 * hi;
#pragma unroll
            for (int d0 = 0; d0 < 4; ++d0) kf[2 * d0 + kh] = *(const bf16x8*)(Kp + 16 * d0); }
        u32x4 vv[8];
#pragma unroll
        for (int ks = 0; ks < 4; ++ks) { int kn = kbase + 16 * ks + (lane >> 2); kn = kn < 0 ? 0 : (kn >= L ? L - 1 : kn);
            const bf16_t* Vp = VA + (rowbase + (size_t)(d * kn + r)) * 512 + head * 64 + 8 * (lane & 3);
            vv[ks] = *(const u32x4*)Vp; vv[4 + ks] = *(const u32x4*)(Vp + 32); }
        f32x16 p0, p1;
#pragma unroll
        for (int rr = 0; rr < 16; ++rr) { const int k0 = kbase + crow(rr, hi), k1 = k0 + 32; const int d0_ = k0 - qn, d1_ = k1 - qn;
            const bool v0 = (k0 >= 0) && (k0 < L) && (d0_ <= 64) && (d0_ >= -64), v1 = (k1 >= 0) && (k1 < L) && (d1_ <= 64) && (d1_ >= -64);
            p0[rr] = v0 ? -sl * __builtin_fabsf((float)d0_) : NEG_BIG; p1[rr] = v1 ? -sl * __builtin_fabsf((float)d1_) : NEG_BIG; }
#pragma unroll
        for (int d0 = 0; d0 < 4; ++d0) { p0 = MFMA32(kf[2 * d0], qr[d0], p0); p1 = MFMA32(kf[2 * d0 + 1], qr[d0], p1); }
#pragma unroll
        for (int i = 0; i < 8; ++i) *(LAS u32x4*)(vw + i * 1024 + lane * 16) = vv[i];
        u32x4 pw[4];
        softmax_tile<2>(p0, p1, mhat, lsum, o, pw);
        asm volatile("s_waitcnt lgkmcnt(0)" ::: "memory");
        pv_tile<2>(o, (lds_cptr)(vw + voff), pw);
        asm volatile("s_waitcnt lgkmcnt(0)" ::: "memory");
    }
    ltot = halfsum(lsum);
}
__device__ __forceinline__ void attnA_unit(const Frame& F, const Args& a, int unit) {
    const int lane = F.lane, r32 = lane & 31, hi = lane >> 5, wid = F.wave;
    const int b = unit >> 7, head = (unit >> 4) & 7, tb = unit & 15, T0 = tb * 1024;
    float* part = (float*)(a.ws + WS_APART + (size_t)unit * APART_UNIT); float* ml = part + 2 * 1024 * 64;
    LAS unsigned char* vw = F.lds + wid * 8192;
    for (int task = wid; task < 64; task += 8) {
        int pat, d, r, n0, L;
        if (task < 32) { pat = 0; d = 16; r = task >> 1; n0 = T0 / 16 + 32 * (task & 1); L = SEQ / 16; }
        else { const int tt = task - 32; pat = 1; d = 4; r = tt >> 3; n0 = T0 / 4 + 32 * (tt & 7); L = SEQ / 4; }
        f32x16 o[2]; float mhat, ltot;
        attnA_task(F, a, b, head, d, r, n0, L, vw, o, mhat, ltot);
        const int tl = d * (n0 + r32) + r - T0;
        float* pp = part + ((size_t)pat * 1024 + tl) * 64 + 4 * hi;
#pragma unroll
        for (int d0 = 0; d0 < 2; ++d0)
#pragma unroll
            for (int g = 0; g < 4; ++g) *(f32x4*)(pp + 32 * d0 + 8 * g) = (f32x4){o[d0][4 * g], o[d0][4 * g + 1], o[d0][4 * g + 2], o[d0][4 * g + 3]};
        if (hi == 0) *(f32x2*)(ml + ((size_t)pat * 1024 + tl) * 2) = (f32x2){mhat, ltot};
    }
    __threadfence();
    __syncthreads();
    for (int task = wid; task < 32; task += 8) {
        const int n0 = T0 + 32 * task;
        f32x16 o[2]; float m0, l0;
        attnA_task(F, a, b, head, 1, 0, n0, SEQ, vw, o, m0, l0);
        const int tl = 32 * task + r32;
        const f32x2 ml1 = *(const f32x2*)(ml + ((size_t)0 * 1024 + tl) * 2), ml2 = *(const f32x2*)(ml + ((size_t)1 * 1024 + tl) * 2);
        const float M = MX3(m0, ml1[0], ml2[0]);
        const float w0 = __builtin_amdgcn_exp2f(m0 - M), w1 = __builtin_amdgcn_exp2f(ml1[0] - M), w2 = __builtin_amdgcn_exp2f(ml2[0] - M);
        const float rden = 1.0f / (w0 * l0 + w1 * ml1[1] + w2 * ml2[1]);
        const float* p1 = part + ((size_t)0 * 1024 + tl) * 64 + 4 * hi; const float* p2 = part + ((size_t)1 * 1024 + tl) * 64 + 4 * hi;
        bf16_t* op = (bf16_t*)(a.ws + WS_MIXED) + ((size_t)b * SEQ + T0 + tl) * DM + head * 64 + 4 * hi;
#pragma unroll
        for (int d0 = 0; d0 < 2; ++d0)
#pragma unroll
            for (int g = 0; g < 4; ++g) { const f32x4 a1 = *(const f32x4*)(p1 + 32 * d0 + 8 * g), a2 = *(const f32x4*)(p2 + 32 * d0 + 8 * g); float v[4];
#pragma unroll
                for (int j = 0; j < 4; ++j) v[j] = (w0 * o[d0][4 * g + j] + w1 * a1[j] + w2 * a2[j]) * rden;
                u32x2 w; w.x = cvtpk(v[0], v[1]); w.y = cvtpk(v[2], v[3]); *(u32x2*)(op + 32 * d0 + 8 * g) = w; }
    }
    __syncthreads();
}

__device__ __forceinline__ unsigned ordkey(float v) { const unsigned u = __float_as_uint(v); return u ^ ((u >> 31) ? 0xFFFFFFFFu : 0x80000000u); }
__device__ __forceinline__ float unordkey(unsigned k) { const unsigned u = (k & 0x80000000u) ? (k ^ 0x80000000u) : ~k; return __uint_as_float(u); }
__device__ __forceinline__ void p4_ln_router(const Frame& F, const Args& a) {
    const int lane = F.lane, wid = F.wave;
    LAS float* Wr = (LAS float*)F.lds;
    LAS unsigned* misc = (LAS unsigned*)(F.lds + LX_MISC);
    for (int i = F.tid; i < DM * NE / 4; i += 512) ((LAS f32x4*)Wr)[i] = ((const f32x4*)a.w_router)[i];
    if (F.tid < 64) misc[F.tid] = 0u;
    float* Z = (float*)(a.ws + WS_Z); bf16_t* X1B = (bf16_t*)(a.ws + WS_XB);
    const int r0 = (F.vcu * 8 + wid) * 16;
    {
        f32x4 gv[4], bv[4];
#pragma unroll
        for (int j = 0; j < 4; ++j) { gv[j] = ((const f32x4*)a.ln1_g)[lane + 64 * j]; bv[j] = ((const f32x4*)a.ln1_b)[lane + 64 * j]; }
        for (int rr = 0; rr < 16; ++rr) {
            f32x4* zr = (f32x4*)(Z + (size_t)(r0 + rr) * DM) + lane; f32x4 v[4]; float s = 0.f;
#pragma unroll
            for (int j = 0; j < 4; ++j) { v[j] = zr[64 * j]; s += (v[j][0] + v[j][1]) + (v[j][2] + v[j][3]); }
            const float mean = wave_sum(s) * (1.f / DM); float s2 = 0.f;
#pragma unroll
            for (int j = 0; j < 4; ++j) { v[j] = v[j] - mean; s2 += (v[j][0] * v[j][0] + v[j][1] * v[j][1]) + (v[j][2] * v[j][2] + v[j][3] * v[j][3]); }
            const float rstd = 1.f / sqrtf(wave_sum(s2) * (1.f / DM) + LN_EPS);
            unsigned long long* o8 = (unsigned long long*)(X1B + (size_t)(r0 + rr) * DM) + lane;
#pragma unroll
            for (int j = 0; j < 4; ++j) { const f32x4 y = v[j] * rstd * gv[j] + bv[j]; zr[64 * j] = y; o8[64 * j] = (unsigned long long)cvtpk(y[0], y[1]) | ((unsigned long long)cvtpk(y[2], y[3]) << 32); }
        }
    }
    __threadfence();
    __syncthreads();
    const int rl = lane & 15, q = lane >> 4;
    f32x4 acc0 = (f32x4){0.f, 0.f, 0.f, 0.f}, acc1 = acc0;
    const float* xr = Z + (size_t)(r0 + rl) * DM + 4 * q;
#pragma unroll 4
    for (int cidx = 0; cidx < 64; ++cidx) {
        const f32x4 xv = *(const f32x4*)(xr + 16 * cidx);
#pragma unroll
        for (int j = 0; j < 4; ++j) { const int k = 16 * cidx + 4 * q + j;
            acc0 = __builtin_amdgcn_mfma_f32_16x16x4f32(xv[j], Wr[k * 32 + rl], acc0, 0, 0, 0);
            acc1 = __builtin_amdgcn_mfma_f32_16x16x4f32(xv[j], Wr[k * 32 + 16 + rl], acc1, 0, 0, 0); }
    }
    const float br0 = a.b_router[rl], br1 = a.b_router[16 + rl];
    int* sel_e = (int*)(a.ws + WS_ROUTE); int* sel_pos = sel_e + NTOK * TOPK; float* sel_gate = (float*)(sel_pos + NTOK * TOPK);
    int my_e[4] = {0, 0, 0, 0}, my_lp[4] = {0, 0, 0, 0}; float my_g[4] = {0.f, 0.f, 0.f, 0.f};
#pragma unroll
    for (int i = 0; i < 4; ++i) {
        unsigned k0 = (ordkey(acc0[i] + br0) & ~31u) | (unsigned)(31 - rl), k1 = (ordkey(acc1[i] + br1) & ~31u) | (unsigned)(15 - rl);
        unsigned selk[4];
#pragma unroll
        for (int t = 0; t < 4; ++t) {
            unsigned m = k0 > k1 ? k0 : k1;
#pragma unroll
            for (int ofs = 1; ofs < 16; ofs <<= 1) { const unsigned other = (unsigned)__shfl_xor((int)m, ofs); m = other > m ? other : m; }
            selk[t] = m; if (k0 == m) k0 = 0u; if (k1 == m) k1 = 0u;
        }
        const float v0 = unordkey(selk[0] & ~31u), v1 = unordkey(selk[1] & ~31u), v2 = unordkey(selk[2] & ~31u), v3 = unordkey(selk[3] & ~31u);
        const float e1 = __expf(v1 - v0), e2 = __expf(v2 - v0), e3 = __expf(v3 - v0); const float rs = 1.0f / (1.0f + e1 + e2 + e3);
        if (rl < 4) { const unsigned sk = rl == 0 ? selk[0] : (rl == 1 ? selk[1] : (rl == 2 ? selk[2] : selk[3]));
            const float ge = rl == 0 ? 1.0f : (rl == 1 ? e1 : (rl == 2 ? e2 : e3));
            my_e[i] = 31 - (int)(sk & 31u); my_g[i] = ge * rs; my_lp[i] = (int)atomicAdd((unsigned*)&misc[my_e[i]], 1u); }
    }
    __syncthreads();
    unsigned* gcnt = (unsigned*)(a.ws + WS_CTL);
    if (F.tid < 32) misc[32 + F.tid] = atomicAdd(&gcnt[F.tid], misc[F.tid]);
    __syncthreads();
    if (rl < 4) {
#pragma unroll
        for (int i = 0; i < 4; ++i) { const int tok = r0 + 4 * q + i, idx = tok * 4 + rl; sel_e[idx] = my_e[i]; sel_pos[idx] = (int)misc[32 + my_e[i]] + my_lp[i]; sel_gate[idx] = my_g[i]; }
    }
}

__device__ __forceinline__ int build_tiles(const Frame& F, const Args& a) {
    LAS unsigned* misc = (LAS unsigned*)(F.lds + LX_MISC); LAS unsigned char* tile_e = F.lds + LX_TILE;
    const unsigned* gcnt = (const unsigned*)(a.ws + WS_CTL);
    if (F.tid == 0) { unsigned acc = 0; for (int e = 0; e < NE; ++e) { misc[64 + e] = acc; acc += (__hip_atomic_load(&gcnt[e], __ATOMIC_RELAXED, __HIP_MEMORY_SCOPE_AGENT) + 255u) >> 8; } misc[64 + NE] = acc; }
    __syncthreads();
    const int nt = (int)misc[64 + NE];
    for (int e = 0; e < NE; ++e) { const int t0 = (int)misc[64 + e], t1 = (int)misc[65 + e]; for (int t = t0 + F.tid; t < t1; t += 512) tile_e[t] = (unsigned char)e; }
    __syncthreads();
    return nt;
}

__global__ void __launch_bounds__(512, 2) fwd_megakernel(Args a) {
    extern __shared__ __attribute__((aligned(16))) unsigned char lds_raw[];
    cg::grid_group grid = cg::this_grid();
    Frame F; F.lds = (LAS unsigned char*)lds_raw; F.tid = threadIdx.x; F.lane = F.tid & 63; F.wave = __builtin_amdgcn_readfirstlane(F.tid >> 6);
    F.G = gridDim.x; { const int bx = blockIdx.x; F.vcu = (F.G % 8 == 0) ? (bx % 8) * (F.G / 8) + bx / 8 : bx; }
    unsigned char* ws = a.ws;

    p0_prologue(F, a);
    grid.sync();

    {
        pg8::Gemm g{(const bf16_t*)(ws + WS_XB), (const bf16_t*)(ws + WS_WIN), NTOK, NPROJ, DM}; pg8::StaticOrder S; S.init(NTOK, NPROJ, F.G, (int)blockIdx.x);
        EpiProj E{(bf16_t*)(ws + WS_PROJ)};
        pg8::gemm_phase<EpiProj, pg8::StaticOrder, true, false>(F.lds, g, S, E);
    }
    grid.sync();

    {
        float s1 = 0.f, s2 = 0.f;
        for (int i = 0; i < 64; ++i) { s1 += a.lq1[i] * a.lk1[i]; s2 += a.lq2[i] * a.lk2[i]; }
        const float lam = __expf(s1) - __expf(s2) + LAM_INIT;
        for (int u = F.vcu; u < 256; u += F.G) attnA_unit(F, a, u);
        for (int i = 0; i < 4; ++i) { const int bh = F.vcu >> 5, qblk = (F.vcu & 31) + 32 * i; if (F.G == 256) attnB_unit(F, a, bh >> 2, bh & 3, qblk, lam); }
        if (F.G != 256) for (int u = F.vcu; u < 1024; u += F.G) attnB_unit(F, a, u >> 9, (u >> 7) & 3, u & 127, lam);
    }
    grid.sync();

    {
        pg8::Gemm g{(const bf16_t*)(ws + WS_MIXED), (const bf16_t*)(ws + WS_WOUT), NTOK, DM, DM}; pg8::StaticOrder S; S.init(NTOK, DM, F.G, (int)blockIdx.x);
        EpiZ E{a.x, (float*)(ws + WS_Z)};
        pg8::gemm_phase<EpiZ, pg8::StaticOrder, true, false>(F.lds, g, S, E);
    }
    grid.sync();

    if (F.G == 256) p4_ln_router(F, a);
    grid.sync();

    int* sel_e = (int*)(ws + WS_ROUTE); int* sel_pos = sel_e + NTOK * TOPK; float* sel_gate = (float*)(sel_pos + NTOK * TOPK);
    int* inv = (int*)(sel_gate + NTOK * TOPK); int* row_tok = inv + NTOK * TOPK; float* row_gate = (float*)(row_tok + 262144);
    {
        const int ntl = build_tiles(F, a); (void)ntl;
        LAS unsigned* misc = (LAS unsigned*)(F.lds + LX_MISC);
        const unsigned* gcnt = (const unsigned*)(ws + WS_CTL);
        for (int idx = F.vcu * 512 + F.tid; idx < NTOK * TOPK; idx += F.G * 512) {
            const int e = sel_e[idx], dest = (int)misc[64 + e] * 256 + sel_pos[idx];
            row_tok[dest] = idx >> 2; row_gate[dest] = sel_gate[idx]; inv[idx] = dest;
        }
        for (int e = F.vcu; e < NE; e += F.G) {
            const int c = (int)__hip_atomic_load(&gcnt[e], __ATOMIC_RELAXED, __HIP_MEMORY_SCOPE_AGENT), base = (int)misc[64 + e] * 256, end = (int)misc[65 + e] * 256;
            for (int r = base + c + F.tid; r < end; r += 512) { row_tok[r] = 0; row_gate[r] = 0.f; }
        }
    }
    grid.sync();

    {
        const int ntl = build_tiles(F, a);
        MoeOrder S; S.so.init(ntl * 256, 2048, F.G, (int)blockIdx.x); S.tile_e = F.lds + LX_TILE; S.tok = (const LAS unsigned short*)(F.lds + LX_TOK); S.ncolt = 8;
        {
            LAS unsigned short* tk = (LAS unsigned short*)(F.lds + LX_TOK); pg8::Unit u;
            for (int i = 0; i < 24 && S.so.next(i, u); ++i) { if (F.tid < 256) tk[i * 256 + F.tid] = (unsigned short)row_tok[u.pm * 256 + F.tid]; }
            __syncthreads();
        }
        pg8::Gemm g{(const bf16_t*)(ws + WS_XB), (const bf16_t*)(ws + WS_WUP), ntl * 256, 2048, DM};
        EpiUp E{(bf16_t*)(ws + WS_H), a.b_up};
        pg8::gemm_phase<EpiUp, MoeOrder, true, true>(F.lds, g, S, E);
    }
    grid.sync();

    {
        const int ntl = build_tiles(F, a);
        MoeOrder S; S.so.init(ntl * 256, 1024, F.G, (int)blockIdx.x); S.tile_e = F.lds + LX_TILE; S.tok = nullptr; S.ncolt = 4;
        pg8::Gemm g{(const bf16_t*)(ws + WS_H), (const bf16_t*)(ws + WS_WDN), ntl * 256, DM, DFF};
        EpiDown E{(bf16_t*)(ws + WS_Y), a.b_down, row_gate};
        pg8::gemm_phase<EpiDown, MoeOrder, true, false>(F.lds, g, S, E);
    }
    grid.sync();

    {
        const int lane = F.lane; const float* X1 = (const float*)(ws + WS_Z); const bf16_t* Y = (const bf16_t*)(ws + WS_Y);
        f32x4 gv[4], bv[4];
#pragma unroll
        for (int j = 0; j < 4; ++j) { gv[j] = ((const f32x4*)a.ln2_g)[lane + 64 * j]; bv[j] = ((const f32x4*)a.ln2_b)[lane + 64 * j]; }
        for (int m = F.vcu * 8 + F.wave; m < NTOK; m += F.G * 8) {
            const f32x4* xr = (const f32x4*)(X1 + (size_t)m * DM) + lane; f32x4 v[4];
#pragma unroll
            for (int j = 0; j < 4; ++j) v[j] = xr[64 * j] * ALPHA;
#pragma unroll
            for (int t = 0; t < 4; ++t) { const int dest = inv[m * 4 + t]; const u32x2* yr = (const u32x2*)(Y + (size_t)dest * DM) + lane;
#pragma unroll
                for (int j = 0; j < 4; ++j) { const u32x2 w = yr[64 * j];
                    v[j][0] += __uint_as_float(w.x << 16); v[j][1] += __uint_as_float(w.x & 0xFFFF0000u); v[j][2] += __uint_as_float(w.y << 16); v[j][3] += __uint_as_float(w.y & 0xFFFF0000u); } }
            float s = 0.f;
#pragma unroll
            for (int j = 0; j < 4; ++j) s += (v[j][0] + v[j][1]) + (v[j][2] + v[j][3]);
            const float mean = wave_sum(s) * (1.f / DM); float s2 = 0.f;
#pragma unroll
            for (int j = 0; j < 4; ++j) { v[j] = v[j] - mean; s2 += (v[j][0] * v[j][0] + v[j][1] * v[j][1]) + (v[j][2] * v[j][2] + v[j][3] * v[j][3]); }
            const float rstd = 1.f / sqrtf(wave_sum(s2) * (1.f / DM) + LN_EPS);
            f32x4* orow = (f32x4*)(a.out + (size_t)m * DM) + lane;
#pragma unroll
            for (int j = 0; j < 4; ++j) orow[64 * j] = v[j] * rstd * gv[j] + bv[j];
        }
    }
}

extern "C" void kernel_launch(void* const* d_in, const int* in_sizes, int n_in, void* d_out, int out_size, void* d_ws, size_t ws_size, hipStream_t stream) {
    static int grid = 0;
    if (grid == 0) {
        if (n_in != 18 || in_sizes[0] != NTOK * DM || out_size != NTOK * DM || ws_size < WS_END) {
            fprintf(stderr, "kernel_launch: unexpected shapes (n_in %d, in0 %d, out %d, ws %zu need %zu); nothing launched\n", n_in, n_in > 0 ? in_sizes[0] : -1, out_size, ws_size, (size_t)WS_END); grid = -1; return; }
        int dev = 0, cus = 0, per_cu = 0;
        if (hipGetDevice(&dev) != hipSuccess || hipDeviceGetAttribute(&cus, hipDeviceAttributeMultiprocessorCount, dev) != hipSuccess) { grid = -1; return; }
        if (hipFuncSetAttribute((const void*)fwd_megakernel, hipFuncAttributeMaxDynamicSharedMemorySize, LDS_BYTES) != hipSuccess) { fprintf(stderr, "kernel_launch: hipFuncSetAttribute failed\n"); grid = -1; return; }
        if (hipOccupancyMaxActiveBlocksPerMultiprocessor(&per_cu, (const void*)fwd_megakernel, 512, LDS_BYTES) != hipSuccess || per_cu < 1) { fprintf(stderr, "kernel_launch: occupancy query says %d\n", per_cu); per_cu = 1; }
        (void)hipGetLastError();
        grid = cus * (per_cu > 1 ? 1 : per_cu);
        fprintf(stderr, "kernel_launch: grid %d (cus %d, per_cu %d)\n", grid, cus, per_cu);
    }
    if (grid < 0) return;
    if (hipMemsetAsync((char*)d_ws + WS_CTL, 0, CTL_ZERO_BYTES, stream) != hipSuccess) return;
    Args a{};
    const float* const* in = (const float* const*)d_in;
    a.x = in[0]; a.w_in = in[1]; a.w_out = in[2]; a.lq1 = in[3]; a.lk1 = in[4]; a.lq2 = in[5]; a.lk2 = in[6]; a.g_sub = in[7];
    a.ln1_g = in[8]; a.ln1_b = in[9]; a.w_router = in[10]; a.b_router = in[11]; a.w_up = in[12]; a.b_up = in[13]; a.w_down = in[14]; a.b_down = in[15];
    a.ln2_g = in[16]; a.ln2_b = in[17]; a.out = (float*)d_out; a.ws = (unsigned char*)d_ws;
    void* args[] = {&a};
    hipError_t e = hipLaunchCooperativeKernel((void*)fwd_megakernel, dim3(grid), dim3(512), args, LDS_BYTES, stream);
    if (e != hipSuccess) fprintf(stderr, "kernel_launch: cooperative launch failed: %s (grid %d)\n", hipGetErrorString(e), grid);
}
```

```cpp
#include <hip/hip_runtime.h>
#include <hip/hip_cooperative_groups.h>
#include <cstdio>
#include <cstdint>
namespace cg = cooperative_groups;
#ifndef REP_P0
#define REP_P0 1
#endif
#ifndef REP_P1
#define REP_P1 1
#endif
#ifndef REP_A
#define REP_A 1
#endif
#ifndef REP_B
#define REP_B 1
#endif
#ifndef REP_P3
#define REP_P3 1
#endif
#ifndef REP_P6
#define REP_P6 1
#endif
#ifndef REP_P7
#define REP_P7 1
#endif
#ifndef REP_P8
#define REP_P8 1
#endif

#define LAS __attribute__((address_space(3)))
typedef unsigned short bf16_t;
typedef short bf16x8 __attribute__((ext_vector_type(8)));
typedef short s16x4 __attribute__((ext_vector_type(4)));
typedef float f32x4 __attribute__((ext_vector_type(4)));
typedef float f32x2 __attribute__((ext_vector_type(2)));
typedef float f32x16 __attribute__((ext_vector_type(16)));
typedef unsigned u32x4 __attribute__((ext_vector_type(4)));
typedef unsigned u32x2 __attribute__((ext_vector_type(2)));
typedef __bf16 bf16x2_t __attribute__((ext_vector_type(2)));

constexpr int BATCH = 2, SEQ = 16384, DM = 1024, NTOK = BATCH * SEQ;
constexpr int NPROJ = 3072, NE = 32, TOPK = 4, DFF = 1024;
constexpr int NROWS_MAX = NTOK * TOPK + NE * 256;
constexpr float LN_EPS = 1e-5f;
constexpr float ALPHA = 1.189207115002721f;
constexpr float LOG2E = 1.4426950408889634f;
constexpr float C2 = 0.125f * LOG2E;
constexpr float LAM_INIT = 0.2f;
constexpr float NEG_BIG = -1e30f;

constexpr size_t MiB = 1u << 20;
constexpr size_t WS_CTL = 0, CTL_ZERO_BYTES = 4096;
constexpr int CW_QMAX = 64, CW_KMAX = 128, CW_QUEUE = 256;
constexpr size_t WS_WIN = 2 * MiB, WS_WOUT = 8 * MiB, WS_WUP = 16 * MiB, WS_WDN = 144 * MiB;
constexpr size_t WS_XB = 208 * MiB;
constexpr size_t WS_PROJ = 272 * MiB;
constexpr size_t PROJ_STRIDE = (size_t)NTOK * 512;
constexpr size_t WS_MIXED = 464 * MiB;
constexpr size_t WS_Z = 272 * MiB;
constexpr size_t WS_H = 400 * MiB;
constexpr size_t WS_Y = 672 * MiB;
constexpr size_t WS_APART = 672 * MiB;
constexpr size_t APART_UNIT = 2 * 1024 * 64 * 4 + 2 * 1024 * 2 * 4;
constexpr size_t WS_ROUTE = 944 * MiB;
constexpr size_t WS_END = 952 * MiB;

constexpr int RING_BYTES = 131072;
constexpr int LX_TILE = 131072;
constexpr int LX_TOK = 132096;
constexpr int LX_MISC = 144384;
constexpr int LDS_BYTES = 147456;

__device__ __forceinline__ unsigned cvtpk(float lo, float hi) { f32x2 v = {lo, hi}; bf16x2_t b = __builtin_convertvector(v, bf16x2_t); return __builtin_bit_cast(unsigned, b); }
__device__ __forceinline__ float wave_sum(float v) {
#pragma unroll
    for (int o = 1; o < 64; o <<= 1) v += __shfl_xor(v, o);
    return v;
}

namespace pg8 {
constexpr int BM = 256, BK = 64, HALF = 128, HTB = HALF * BK * 2, STAGE_BYTES = 8 * HTB, NXCD = 8, WGM = 8;
__host__ __device__ __forceinline__ int lds_byte(int r, int c) { const int st = (r >> 4) * 2 + (c >> 5), rr = r & 15, cc = c & 31, ob = rr * 64 + cc * 2; return st * 1024 + (ob ^ (((ob >> 9) & 1) << 5)); }
__host__ __device__ __forceinline__ void stage_rc(int b, int& R, int& C) { const int st = b / 1024, sb = b % 1024, swz = sb ^ (((sb >> 9) & 1) << 5); R = (st >> 1) * 16 + swz / 64; C = (st & 1) * 32 + (swz % 64) / 2; }
__host__ __device__ __forceinline__ int perm32(int rho) { const int n = rho >> 4, i = rho & 15; return 8 * (i >> 2) + 4 * n + (i & 3); }

struct Unit { int pm, pn; };
struct Gemm { const bf16_t* A; const bf16_t* Bt; int M, N, K; };

struct StaticOrder {
    int nM, nN, nwg, G, c;
    __host__ __device__ void init(int M, int N, int G_, int c_) { nM = M / BM; nN = N / BM; nwg = nM * nN; G = G_; c = c_; }
    __host__ __device__ bool next(int i, Unit& u) const {
        const long L = (long)i * G + c; if (L >= nwg) return false;
        int wgid = (int)L; { const int q = nwg / NXCD, r = nwg % NXCD, xcd = wgid % NXCD, off = wgid / NXCD; wgid = (xcd < r ? xcd * (q + 1) : r * (q + 1) + (xcd - r) * q) + off; }
        const int nig = WGM * nN, gid = wgid / nig, fm = gid * WGM, gsz = (nM - fm) < WGM ? (nM - fm) : WGM;
        u.pm = fm + ((wgid % nig) % gsz); u.pn = (wgid % nig) / gsz; return true;
    }
    __device__ __forceinline__ const LAS unsigned short* tok_table(int) const { return nullptr; }
};

template <class Epi, class Sched, bool ALIGN_EPI, bool GATHER>
__device__ __forceinline__ void gemm_phase(LAS unsigned char* lds, const Gemm g, const Sched& S, const Epi& E) {
    const int tid = threadIdx.x, wid = __builtin_amdgcn_readfirstlane(tid >> 6), lane = tid & 63, wr = wid >> 2, wc = wid & 3, fr = lane & 15, fq = lane >> 4;
    const int K = g.K, nt = K / BK;
    unsigned voffA[2], voffB[2]; int rowA[2];
#pragma unroll
    for (int i = 0; i < 2; ++i) { int R, C; stage_rc(tid * 16 + i * 8192, R, C); const int Rb = Epi::PERM ? ((R & ~31) + perm32(R & 31)) : R;
        voffA[i] = GATHER ? (unsigned)(C * 2) : (unsigned)(R * K + C) * 2u; voffB[i] = (unsigned)(Rb * K + C) * 2u; rowA[i] = R; }
    const size_t kstep = (size_t)(BK * 2);
    const size_t hstep = (size_t)HALF * K * 2;
    const size_t tstep = 2 * hstep;
    const unsigned ldsw = (unsigned)wid * 1024u;
    const int aoff = lds_byte(wr * 64 + fr, fq * 8), boff = lds_byte(wc * 32 + fr, fq * 8);
#define PG8_SA(b, h) (((b) * 2 + (h)) * HTB)
#define PG8_SB(b, h) ((4 + (b) * 2 + (h)) * HTB)
#define PG8_STAGE(bufoff, gbase, voff) do { _Pragma("unroll") for (int _i = 0; _i < 2; ++_i) \
        __builtin_amdgcn_global_load_lds((const unsigned*)((const char*)(gbase) + (voff)[_i]), (LAS unsigned*)(lds + (bufoff) + ldsw + _i * 8192), 16, 0, 0); } while (0)
#define PG8_STAGE_A(bufoff, NX, h, kb) do { if constexpr (GATHER) { const unsigned* _o = (NX) ? gN[h] : gC[h]; PG8_STAGE(bufoff, (const char*)g.A + (kb), _o); } \
        else { PG8_STAGE(bufoff, ((NX) ? nA : cA) + (h) * hstep + (kb), voffA); } } while (0)
#define PG8_LDA(dst, b, h) do { _Pragma("unroll") for (int m = 0; m < 4; ++m) _Pragma("unroll") for (int k = 0; k < 2; ++k) dst[m][k] = *(const LAS bf16x8*)(lds + PG8_SA(b, h) + aoff + m * 2048 + k * 1024); } while (0)
#define PG8_LDB(dst, b, h) do { _Pragma("unroll") for (int n = 0; n < 2; ++n) _Pragma("unroll") for (int k = 0; k < 2; ++k) dst[n][k] = *(const LAS bf16x8*)(lds + PG8_SB(b, h) + boff + n * 2048 + k * 1024); } while (0)
#define PG8_MMA(ai, bj, At, Bt) do { __builtin_amdgcn_s_setprio(1); _Pragma("unroll") for (int m = 0; m < 4; ++m) _Pragma("unroll") for (int n = 0; n < 2; ++n) _Pragma("unroll") for (int k = 0; k < 2; ++k) \
        acc[ai][bj][m][n] = __builtin_amdgcn_mfma_f32_16x16x32_bf16(Bt[n][k], At[m][k], acc[ai][bj][m][n], 0, 0, 0); __builtin_amdgcn_s_setprio(0); } while (0)
#define PG8_WAIT_V(n) asm volatile("s_waitcnt vmcnt(" #n ")" ::: "memory")
#define PG8_WAIT_L(n) asm volatile("s_waitcnt lgkmcnt(" #n ")" ::: "memory")
#define PG8_BAR __builtin_amdgcn_s_barrier()
#define PG8_SCHED __builtin_amdgcn_sched_barrier(0)
#define PG8_GOFF(dst, ui_) do { if constexpr (GATHER) { const LAS unsigned short* _t = S.tok_table(ui_); _Pragma("unroll") for (int _h = 0; _h < 2; ++_h) _Pragma("unroll") for (int _i = 0; _i < 2; ++_i) \
        dst[_h][_i] = (unsigned)_t[_h * HALF + rowA[_i]] * (unsigned)(K * 2) + voffA[_i]; } } while (0)
    Unit cur, nxt; int ui = 0;
    if (!S.next(0, cur)) return;
    f32x4 acc[2][2][4][2];
#pragma unroll
    for (int a = 0; a < 2; ++a)
#pragma unroll
        for (int b = 0; b < 2; ++b)
#pragma unroll
            for (int m = 0; m < 4; ++m)
#pragma unroll
                for (int n = 0; n < 2; ++n) acc[a][b][m][n] = (f32x4){0.f, 0.f, 0.f, 0.f};
    bf16x8 At[4][2], B0[2][2], B1[2][2];
    unsigned gC[2][2] = {{0u, 0u}, {0u, 0u}}, gN[2][2] = {{0u, 0u}, {0u, 0u}};
    PG8_GOFF(gC, 0);
    const char* cA = (const char*)g.A + (GATHER ? (size_t)0 : (size_t)cur.pm * tstep); const char* cB = (const char*)g.Bt + (size_t)cur.pn * tstep;
    const char* nA = cA;
    {
        PG8_STAGE(PG8_SB(0, 0), cB, voffB); PG8_STAGE(PG8_SB(0, 1), cB + hstep, voffB); PG8_STAGE_A(PG8_SA(0, 0), false, 0, 0); PG8_STAGE_A(PG8_SA(0, 1), false, 1, 0);
        if (wr == 1) PG8_BAR;
        PG8_WAIT_V(2); PG8_BAR;
        PG8_STAGE(PG8_SB(1, 0), cB + kstep, voffB); PG8_STAGE_A(PG8_SA(1, 0), false, 0, kstep); PG8_STAGE(PG8_SB(1, 1), cB + hstep + kstep, voffB);
        PG8_WAIT_V(6); PG8_BAR;
    }
    for (;;) {
        const bool has_next = S.next(ui + 1, nxt);
        nA = has_next ? (const char*)g.A + (GATHER ? (size_t)0 : (size_t)nxt.pm * tstep) : cA; const char* nB = has_next ? (const char*)g.Bt + (size_t)nxt.pn * tstep : cB;
        if (has_next) { PG8_GOFF(gN, ui + 1); } else {
#pragma unroll
            for (int h = 0; h < 2; ++h)
#pragma unroll
                for (int i = 0; i < 2; ++i) gN[h][i] = gC[h][i]; }
        for (int t = 0; t < nt; t += 2) {
            const bool last = (t == nt - 2);
            const size_t k1 = (size_t)(t + 1) * kstep;
            const size_t k2 = last ? (size_t)0 : (size_t)(t + 2) * kstep, k3 = k2 + kstep;
            const char* b2 = last ? nB : cB + (size_t)(t + 2) * kstep; const char* b3 = b2 + kstep;
            PG8_LDB(B0, 0, 0); PG8_LDB(B1, 0, 1); PG8_SCHED; PG8_LDA(At, 0, 0); PG8_STAGE_A(PG8_SA(1, 1), false, 1, k1);
            PG8_WAIT_V(8); PG8_WAIT_L(0); PG8_BAR; PG8_MMA(0, 0, At, B0); PG8_MMA(0, 1, At, B1); PG8_BAR; PG8_SCHED;
            PG8_LDA(At, 0, 1); PG8_STAGE(PG8_SB(0, 0), b2, voffB); PG8_STAGE(PG8_SB(0, 1), b2 + hstep, voffB); PG8_STAGE_A(PG8_SA(0, 0), last, 0, k2);
            PG8_WAIT_V(8); PG8_WAIT_L(0); PG8_BAR; PG8_MMA(1, 0, At, B0); PG8_MMA(1, 1, At, B1); PG8_BAR; PG8_SCHED;
            PG8_LDB(B0, 1, 0); PG8_LDB(B1, 1, 1); PG8_SCHED; PG8_LDA(At, 1, 0); PG8_STAGE_A(PG8_SA(0, 1), last, 1, k2);
            PG8_WAIT_V(8); PG8_WAIT_L(0); PG8_BAR; PG8_MMA(0, 0, At, B0); PG8_MMA(0, 1, At, B1); PG8_BAR; PG8_SCHED;
            PG8_LDA(At, 1, 1); PG8_STAGE(PG8_SB(1, 0), b3, voffB); PG8_STAGE(PG8_SB(1, 1), b3 + hstep, voffB); PG8_STAGE_A(PG8_SA(1, 0), last, 0, k3);
            PG8_WAIT_V(8); PG8_WAIT_L(0); PG8_BAR; PG8_MMA(1, 0, At, B0); PG8_MMA(1, 1, At, B1); PG8_BAR; PG8_SCHED;
        }
        if constexpr (ALIGN_EPI) { if (wr == 0) PG8_BAR; }
        E(acc, cur, wr, wc, fr, fq);
        if (!has_next) break;
#pragma unroll
        for (int a = 0; a < 2; ++a)
#pragma unroll
            for (int b = 0; b < 2; ++b)
#pragma unroll
                for (int m = 0; m < 4; ++m)
#pragma unroll
                    for (int n = 0; n < 2; ++n) acc[a][b][m][n] = (f32x4){0.f, 0.f, 0.f, 0.f};
        cur = nxt; cA = nA; cB = nB; ++ui;
#pragma unroll
        for (int h = 0; h < 2; ++h)
#pragma unroll
            for (int i = 0; i < 2; ++i) gC[h][i] = gN[h][i];
        if constexpr (ALIGN_EPI) { if (wr == 1) PG8_BAR; }
    }
    PG8_WAIT_V(0);
    if constexpr (!ALIGN_EPI) { if (wr == 0) PG8_BAR; }
    PG8_BAR;
#undef PG8_SA
#undef PG8_SB
#undef PG8_STAGE
#undef PG8_STAGE_A
#undef PG8_LDA
#undef PG8_LDB
#undef PG8_MMA
#undef PG8_WAIT_V
#undef PG8_WAIT_L
#undef PG8_BAR
#undef PG8_SCHED
#undef PG8_GOFF
}
}

struct Args {
    const float* x; const float* w_in; const float* w_out; const float* lq1; const float* lk1; const float* lq2; const float* lk2; const float* g_sub;
    const float* ln1_g; const float* ln1_b; const float* w_router; const float* b_router; const float* w_up; const float* b_up; const float* w_down; const float* b_down;
    const float* ln2_g; const float* ln2_b; float* out; unsigned char* ws;
};
struct Frame {
    LAS unsigned char* lds; int tid, lane, wave, vcu, G;
};

struct EpiProj {
    static constexpr bool PERM = true;
    bf16_t* O; unsigned* ctl;
    __device__ __forceinline__ void operator()(const f32x4 (&acc)[2][2][4][2], const pg8::Unit& u, int wr, int wc, int fr, int fq) const {
        const int t = u.pn >> 1; const float sc = (t == 0 || t == 3) ? C2 : 1.f; const bool nrm = (t == 3 || t == 4);
        bf16_t* base = O + (size_t)t * PROJ_STRIDE; const int row0 = u.pm * 256 + wr * 64 + fr, col0 = (u.pn & 1) * 256 + wc * 32 + 8 * fq;
        float mx0 = 0.f, mx1 = 0.f;
#pragma unroll
        for (int ai = 0; ai < 2; ++ai)
#pragma unroll
            for (int m = 0; m < 4; ++m) { bf16_t* rowp = base + (size_t)(row0 + ai * 128 + m * 16) * 512 + col0;
#pragma unroll
                for (int bj = 0; bj < 2; ++bj) { const f32x4 v0 = acc[ai][bj][m][0] * sc, v1 = acc[ai][bj][m][1] * sc; u32x4 w;
                    w.x = cvtpk(v0[0], v0[1]); w.y = cvtpk(v0[2], v0[3]); w.z = cvtpk(v1[0], v1[1]); w.w = cvtpk(v1[2], v1[3]); *(u32x4*)(rowp + bj * 128) = w;
                    if (nrm) { float ss = 0.f;
#pragma unroll
                        for (int j = 0; j < 4; ++j) { const float lo = __uint_as_float(w[j] << 16), hi = __uint_as_float(w[j] & 0xFFFF0000u); ss += lo * lo + hi * hi; }
                        ss += __shfl_xor(ss, 16); ss += __shfl_xor(ss, 32);
                        if (bj == 0) mx0 = fmaxf(mx0, ss); else mx1 = fmaxf(mx1, ss); } } }
        if (nrm) {
#pragma unroll
            for (int ofs = 1; ofs < 16; ofs <<= 1) { mx0 = fmaxf(mx0, __shfl_xor(mx0, ofs)); mx1 = fmaxf(mx1, __shfl_xor(mx1, ofs)); }
            if (fr == 0 && fq == 0) { const int b = u.pm >> 6, cw = (t == 3) ? CW_QMAX : CW_KMAX;
                atomicMax(ctl + cw + (((b * 4 + (u.pn & 1) * 2 + 0) * 2 + (wc >> 1)) * 2 + (wc & 1)), __float_as_uint(mx0));
                atomicMax(ctl + cw + (((b * 4 + (u.pn & 1) * 2 + 1) * 2 + (wc >> 1)) * 2 + (wc & 1)), __float_as_uint(mx1)); }
        }
    }
};
struct EpiZ {
    static constexpr bool PERM = false;
    const float* x; float* z;
    __device__ __forceinline__ void operator()(const f32x4 (&acc)[2][2][4][2], const pg8::Unit& u, int wr, int wc, int fr, int fq) const {
        const int col0 = u.pn * 256 + wc * 32 + 4 * fq;
#pragma unroll
        for (int ai = 0; ai < 2; ++ai)
#pragma unroll
            for (int m = 0; m < 4; ++m) { const size_t off = (size_t)(u.pm * 256 + ai * 128 + wr * 64 + m * 16 + fr) * DM + col0;
#pragma unroll
                for (int bj = 0; bj < 2; ++bj)
#pragma unroll
                    for (int n = 0; n < 2; ++n) { const f32x4 xv = *(const f32x4*)(x + off + bj * 128 + n * 16); *(f32x4*)(z + off + bj * 128 + n * 16) = xv * ALPHA + acc[ai][bj][m][n]; } }
    }
};
__device__ __forceinline__ float swiglu(float g, float u) {
    g = fminf(g, 7.0f); u = fminf(fmaxf(u, -7.0f), 7.0f);
    const float s = __builtin_amdgcn_rcpf(1.0f + __builtin_amdgcn_exp2f(-1.702f * LOG2E * g));
    return g * s * (u + 1.0f);
}
struct EpiUp {
    static constexpr bool PERM = true;
    bf16_t* H; const float* b_up;
    __device__ __forceinline__ void operator()(const f32x4 (&acc)[2][2][4][2], const pg8::Unit& u, int wr, int wc, int fr, int fq) const {
        const int e = u.pn >> 3, pnl = u.pn & 7, hcol0 = pnl * 128 + wc * 32 + 8 * fq;
        const float* bg = b_up + (size_t)e * 2048 + hcol0; const float* bu = bg + 1024;
        const f32x4 bg0 = *(const f32x4*)bg, bg1 = *(const f32x4*)(bg + 4), bu0 = *(const f32x4*)bu, bu1 = *(const f32x4*)(bu + 4);
#pragma unroll
        for (int ai = 0; ai < 2; ++ai)
#pragma unroll
            for (int m = 0; m < 4; ++m) { const size_t row = (size_t)(u.pm * 256 + ai * 128 + wr * 64 + m * 16 + fr);
                const f32x4 g0 = acc[ai][0][m][0] + bg0, g1 = acc[ai][0][m][1] + bg1, u0 = acc[ai][1][m][0] + bu0, u1 = acc[ai][1][m][1] + bu1; u32x4 w;
                w.x = cvtpk(swiglu(g0[0], u0[0]), swiglu(g0[1], u0[1])); w.y = cvtpk(swiglu(g0[2], u0[2]), swiglu(g0[3], u0[3]));
                w.z = cvtpk(swiglu(g1[0], u1[0]), swiglu(g1[1], u1[1])); w.w = cvtpk(swiglu(g1[2], u1[2]), swiglu(g1[3], u1[3]));
                *(u32x4*)(H + row * DFF + hcol0) = w; }
    }
};
struct EpiDown {
    static constexpr bool PERM = true;
    bf16_t* Y; const float* b_down; const float* row_gate;
    __device__ __forceinline__ void operator()(const f32x4 (&acc)[2][2][4][2], const pg8::Unit& u, int wr, int wc, int fr, int fq) const {
        const int e = u.pn >> 2, pnl = u.pn & 3, col0 = pnl * 256 + wc * 32 + 8 * fq;
        f32x4 bv[2][2];
#pragma unroll
        for (int bj = 0; bj < 2; ++bj)
#pragma unroll
            for (int n = 0; n < 2; ++n) bv[bj][n] = *(const f32x4*)(b_down + (size_t)e * DM + col0 + bj * 128 + 4 * n);
#pragma unroll
        for (int ai = 0; ai < 2; ++ai)
#pragma unroll
            for (int m = 0; m < 4; ++m) { const size_t row = (size_t)(u.pm * 256 + ai * 128 + wr * 64 + m * 16 + fr); const float gt = row_gate[row];
#pragma unroll
                for (int bj = 0; bj < 2; ++bj) { const f32x4 v0 = (acc[ai][bj][m][0] + bv[bj][0]) * gt, v1 = (acc[ai][bj][m][1] + bv[bj][1]) * gt; u32x4 w;
                    w.x = cvtpk(v0[0], v0[1]); w.y = cvtpk(v0[2], v0[3]); w.z = cvtpk(v1[0], v1[1]); w.w = cvtpk(v1[2], v1[3]); *(u32x4*)(Y + row * DM + col0 + bj * 128) = w; } }
    }
};
struct MoeOrder {
    pg8::StaticOrder so; const LAS unsigned char* tile_e; const LAS unsigned short* tok; int ncolt;
    __device__ __forceinline__ bool next(int i, pg8::Unit& u) const {
        if (!so.next(i, u)) return false;
        const int e = __builtin_amdgcn_readfirstlane((int)tile_e[u.pm]); u.pn = e * ncolt + u.pn; return true; }
    __device__ __forceinline__ const LAS unsigned short* tok_table(int ui) const { return tok + ui * 256; }
};

__device__ __forceinline__ void p0_transpose_item(const float* W, int K, int N, bf16_t* WT, int k0, int n0, int row0, LAS float* scr, int lane) {
#pragma unroll 8
    for (int i = 0; i < 32; ++i) { const int kk = 2 * i + (lane >> 5); scr[kk * 33 + (lane & 31)] = W[(size_t)(k0 + kk) * N + n0 + (lane & 31)]; }
    asm volatile("s_waitcnt lgkmcnt(0)" ::: "memory");
    const int c = lane & 7;
#pragma unroll
    for (int j = 0; j < 4; ++j) { const int n = (lane >> 3) + 8 * j; const LAS float* s = scr + (8 * c) * 33 + n;
        u32x4 o; o.x = cvtpk(s[0 * 33], s[1 * 33]); o.y = cvtpk(s[2 * 33], s[3 * 33]); o.z = cvtpk(s[4 * 33], s[5 * 33]); o.w = cvtpk(s[6 * 33], s[7 * 33]);
        *(u32x4*)(WT + (size_t)(row0 + n) * K + k0 + 8 * c) = o; }
    asm volatile("s_waitcnt lgkmcnt(0)" ::: "memory");
}
__device__ __forceinline__ void p0_prologue(const Frame& F, const Args& a) {
    LAS float* scr = (LAS float*)(F.lds + F.wave * 16384);
    const int gw = F.vcu * 8 + F.wave, NGW = F.G * 8;
    bf16_t* WinT = (bf16_t*)(a.ws + WS_WIN); bf16_t* WoutT = (bf16_t*)(a.ws + WS_WOUT); bf16_t* WupT = (bf16_t*)(a.ws + WS_WUP); bf16_t* WdnT = (bf16_t*)(a.ws + WS_WDN);
    constexpr int I_IN = 16 * 96, I_OUT = 16 * 32, I_UP = 16 * 64, I_DN = 16 * 32;
    constexpr int NITEMS = I_IN + I_OUT + NE * I_UP + NE * I_DN;
    for (int it = gw; it < NITEMS; it += NGW) {
        int r = it;
        if (r < I_IN) { const int kb = r / 96, nb = r % 96; p0_transpose_item(a.w_in, DM, NPROJ, WinT, 64 * kb, 32 * nb, 32 * nb, scr, F.lane); continue; } r -= I_IN;
        if (r < I_OUT) { const int kb = r / 32, nb = r % 32; p0_transpose_item(a.w_out, DM, DM, WoutT, 64 * kb, 32 * nb, 32 * nb, scr, F.lane); continue; } r -= I_OUT;
        if (r < NE * I_UP) { const int e = r / I_UP, q = r % I_UP, kb = q / 64, nb = q % 64, n0 = 32 * nb;
            const int nn = n0 & 1023, row0 = (nn >> 7) * 256 + (n0 >> 10) * 128 + (nn & 127);
            p0_transpose_item(a.w_up + (size_t)e * DM * 2048, DM, 2048, WupT + (size_t)e * 2048 * DM, 64 * kb, n0, row0, scr, F.lane); continue; } r -= NE * I_UP;
        { const int e = r / I_DN, q = r % I_DN, kb = q / 32, nb = q % 32; p0_transpose_item(a.w_down + (size_t)e * DFF * DM, DFF, DM, WdnT + (size_t)e * DM * DFF, 64 * kb, 32 * nb, 32 * nb, scr, F.lane); }
    }
    bf16_t* XB = (bf16_t*)(a.ws + WS_XB);
    for (int m = gw; m < NTOK; m += NGW) {
        const f32x4* xr = (const f32x4*)(a.x + (size_t)m * DM) + F.lane; unsigned long long* o8 = (unsigned long long*)(XB + (size_t)m * DM) + F.lane;
#pragma unroll
        for (int j = 0; j < 4; ++j) { const f32x4 v = xr[64 * j]; o8[64 * j] = (unsigned long long)cvtpk(v[0], v[1]) | ((unsigned long long)cvtpk(v[2], v[3]) << 32); }
    }
}

__device__ __forceinline__ int crow(int r, int hi) { return (r & 3) + 8 * (r >> 2) + 4 * hi; }
typedef LAS const char* lds_cptr;
typedef short v4i16_t __attribute__((ext_vector_type(4)));
__device__ __forceinline__ s16x4 vtr(lds_cptr p) { return __builtin_bit_cast(s16x4, __builtin_amdgcn_ds_read_tr16_b64_v4i16((LAS v4i16_t*)p)); }
#define MX3(a, b, c) __builtin_fmaxf(__builtin_fmaxf((a), (b)), (c))
__device__ __forceinline__ float rowmax(const f32x16& p0, const f32x16& p1) {
    float a = MX3(p0[0], p0[1], p1[0]), b = MX3(p0[2], p0[3], p1[1]); a = MX3(a, p1[2], p1[3]);
#pragma unroll
    for (int r = 4; r < 16; r += 4) { a = MX3(a, p0[r], p0[r + 1]); b = MX3(b, p0[r + 2], p0[r + 3]); a = MX3(a, p1[r], p1[r + 1]); b = MX3(b, p1[r + 2], p1[r + 3]); }
    float m = __builtin_fmaxf(a, b); auto rr = __builtin_amdgcn_permlane32_swap(__float_as_uint(m), __float_as_uint(m), false, false);
    return __builtin_fmaxf(__uint_as_float(rr[0]), __uint_as_float(rr[1]));
}
__device__ __forceinline__ float halfsum(float v) { auto rr = __builtin_amdgcn_permlane32_swap(__float_as_uint(v), __float_as_uint(v), false, false); return __uint_as_float(rr[0]) + __uint_as_float(rr[1]); }
#define MFMA32(a, b, c) __builtin_amdgcn_mfma_f32_32x32x16_bf16(a, b, c, 0, 0, 0)

template <int ND>
__device__ __forceinline__ void softmax_tile(f32x16& p0, f32x16& p1, float& mhat, float& lsum, f32x16 (&o)[ND], u32x4 (&pw)[4]) {
    const float rm = rowmax(p0, p1);
    const float mnew = __builtin_fmaxf(mhat, rm);
    if (__any(mnew != mhat)) {
        const float al = __builtin_amdgcn_exp2f(mhat - mnew); lsum *= al;
#pragma unroll
        for (int d = 0; d < ND; ++d)
#pragma unroll
            for (int r = 0; r < 16; ++r) o[d][r] *= al;
        mhat = mnew;
    }
    float s = 0.f;
#pragma unroll
    for (int r = 0; r < 16; ++r) { p0[r] = __builtin_amdgcn_exp2f(p0[r] - mhat); p1[r] = __builtin_amdgcn_exp2f(p1[r] - mhat); s += p0[r] + p1[r]; }
    lsum += s;
    pw[0] = (u32x4){cvtpk(p0[0], p0[1]), cvtpk(p0[2], p0[3]), cvtpk(p0[4], p0[5]), cvtpk(p0[6], p0[7])};
    pw[1] = (u32x4){cvtpk(p0[8], p0[9]), cvtpk(p0[10], p0[11]), cvtpk(p0[12], p0[13]), cvtpk(p0[14], p0[15])};
    pw[2] = (u32x4){cvtpk(p1[0], p1[1]), cvtpk(p1[2], p1[3]), cvtpk(p1[4], p1[5]), cvtpk(p1[6], p1[7])};
    pw[3] = (u32x4){cvtpk(p1[8], p1[9]), cvtpk(p1[10], p1[11]), cvtpk(p1[12], p1[13]), cvtpk(p1[14], p1[15])};
}
template <int ND>
__device__ __forceinline__ void pv_tile(f32x16 (&o)[ND], lds_cptr vbase, const u32x4 (&pw)[4]) {
#pragma unroll
    for (int d0 = 0; d0 < ND; ++d0)
#pragma unroll
        for (int ks = 0; ks < 4; ++ks) {
            const s16x4 lo = vtr(vbase + d0 * 4096 + ks * 1024), hi = vtr(vbase + d0 * 4096 + ks * 1024 + 512);
            const bf16x8 vf = (bf16x8){lo[0], lo[1], lo[2], lo[3], hi[0], hi[1], hi[2], hi[3]};
            o[d0] = MFMA32(vf, __builtin_bit_cast(bf16x8, pw[ks]), o[d0]);
        }
}

template <bool FAST>
__device__ __forceinline__ void attnB_unit(const Frame& F, const Args& a, int b, int h, int qblk, float lam, int t_lo, int t_hi, float kn0, float kn1) {
    const int lane = F.lane, r32 = lane & 31, hi = lane >> 5, wid = F.wave, c = wid >> 2, qs = wid & 3;
    const bf16_t* QD = (const bf16_t*)(a.ws + WS_PROJ) + 3 * PROJ_STRIDE; const bf16_t* KD = QD + PROJ_STRIDE; const bf16_t* VD = KD + PROJ_STRIDE;
    const size_t rowbase = (size_t)b * SEQ; const int q0 = qblk * 128, qpos = q0 + 32 * qs + r32;
    bf16x8 qr[4];
    { const bf16_t* Qp = QD + (rowbase + qpos) * 512 + h * 128 + c * 64 + 8 * hi;
#pragma unroll
      for (int d0 = 0; d0 < 4; ++d0) qr[d0] = *(const bf16x8*)(Qp + 16 * d0); }
    float ref = 0.f;
    if (FAST) { float qq = 0.f;
#pragma unroll
        for (int d0 = 0; d0 < 4; ++d0)
#pragma unroll
            for (int j = 0; j < 8; ++j) { const float v = __uint_as_float((unsigned)(unsigned short)qr[d0][j] << 16); qq += v * v; }
        ref = sqrtf(halfsum(qq)) * (c ? kn1 : kn0) * 1.01f + 0.01f; }
    const float slope2 = __builtin_amdgcn_exp2f(-2.0f * (float)(h + 1)) * LOG2E;
    const bf16_t* ksrc = KD + (rowbase + lane) * 512 + h * 128 + wid * 8;
    const bf16_t* vsrc = VD + (rowbase + 16 * (wid & 3) + (lane >> 2)) * 512 + h * 128 + 32 * (wid >> 2) + 8 * (lane & 3);
    LAS unsigned char* L = F.lds;
#define B_DMA(t, s) do { const bf16_t* _k = ksrc + (size_t)(t) * 64 * 512; const bf16_t* _v = vsrc + (size_t)(t) * 64 * 512; LAS unsigned char* _d = L + (s) * 32768 + wid * 1024; \
        __builtin_amdgcn_global_load_lds((const unsigned*)_k, (LAS unsigned*)_d, 16, 0, 0); __builtin_amdgcn_global_load_lds((const unsigned*)(_k + 64), (LAS unsigned*)(_d + 8192), 16, 0, 0); \
        __builtin_amdgcn_global_load_lds((const unsigned*)_v, (LAS unsigned*)(_d + 16384), 16, 0, 0); __builtin_amdgcn_global_load_lds((const unsigned*)(_v + 64), (LAS unsigned*)(_d + 16384 + 8192), 16, 0, 0); } while (0)
    float mhat = NEG_BIG, lsum = 0.f; f32x16 o[4];
#pragma unroll
    for (int d = 0; d < 4; ++d) o[d] = (f32x16){};
    const int koff = (c * 8 + hi) * 1024 + r32 * 16;
    const int voff = 16384 + ((lane >> 4) & 1) * 32 + (lane & 3) * 8 + (4 * hi + ((lane & 15) >> 2)) * 64;
    const int tdiag = q0 >> 6;
    f32x16 C0 = (f32x16){}, C1 = (f32x16){};
    B_DMA(t_lo, 0);
    for (int t = t_lo; t <= t_hi; ++t) {
        asm volatile("s_waitcnt vmcnt(0)" ::: "memory");
        __syncthreads();
        const int sb = (t - t_lo) & 1;
        if (t < t_hi) B_DMA(t + 1, sb ^ 1);
        const LAS unsigned char* buf = L + sb * 32768;
        if (t == t_lo || (t >= tdiag && t <= tdiag + 2) || ((t - t_lo) & 15) == 0) {
            const float dq = (float)(qpos - t * 64 - 4 * hi);
#pragma unroll
            for (int r = 0; r < 16; ++r) { const float kk = (float)((r & 3) + 8 * (r >> 2)); C0[r] = -slope2 * __builtin_fabsf(dq - kk) - ref; C1[r] = -slope2 * __builtin_fabsf(dq - 32.f - kk) - ref; }
        } else { const float st = (t < tdiag) ? 64.f * slope2 : -64.f * slope2; C0 = C0 + st; C1 = C1 + st; }
        f32x16 p0, p1;
        {   const bf16x8 k0 = *(const LAS bf16x8*)(buf + koff), k1 = *(const LAS bf16x8*)(buf + koff + 512);
            p0 = MFMA32(k0, qr[0], C0); p1 = MFMA32(k1, qr[0], C1); }
#pragma unroll
        for (int d0 = 1; d0 < 4; ++d0) {
            const bf16x8 k0 = *(const LAS bf16x8*)(buf + koff + d0 * 2048), k1 = *(const LAS bf16x8*)(buf + koff + d0 * 2048 + 512);
            p0 = MFMA32(k0, qr[d0], p0); p1 = MFMA32(k1, qr[d0], p1);
        }
        u32x4 pw[4];
        if (FAST) {
            float s = 0.f;
#pragma unroll
            for (int r = 0; r < 16; ++r) { p0[r] = __builtin_amdgcn_exp2f(p0[r]); p1[r] = __builtin_amdgcn_exp2f(p1[r]); s += p0[r] + p1[r]; }
            lsum += s;
            pw[0] = (u32x4){cvtpk(p0[0], p0[1]), cvtpk(p0[2], p0[3]), cvtpk(p0[4], p0[5]), cvtpk(p0[6], p0[7])};
            pw[1] = (u32x4){cvtpk(p0[8], p0[9]), cvtpk(p0[10], p0[11]), cvtpk(p0[12], p0[13]), cvtpk(p0[14], p0[15])};
            pw[2] = (u32x4){cvtpk(p1[0], p1[1]), cvtpk(p1[2], p1[3]), cvtpk(p1[4], p1[5]), cvtpk(p1[6], p1[7])};
            pw[3] = (u32x4){cvtpk(p1[8], p1[9]), cvtpk(p1[10], p1[11]), cvtpk(p1[12], p1[13]), cvtpk(p1[14], p1[15])};
        } else softmax_tile<4>(p0, p1, mhat, lsum, o, pw);
        pv_tile<4>(o, (lds_cptr)(buf + voff), pw);
    }
#undef B_DMA
    const float inv = 1.0f / halfsum(lsum);
    LAS float* ex = (LAS float*)(L + 65536);
    __syncthreads();
    if (c == 1) {
#pragma unroll
        for (int d0 = 0; d0 < 4; ++d0)
#pragma unroll
            for (int r = 0; r < 16; ++r) ex[(qs * 128 + 32 * d0 + crow(r, hi)) * 32 + r32] = o[d0][r] * inv;
    }
    __syncthreads();
    if (c == 0) {
        float ss = 0.f;
#pragma unroll
        for (int d0 = 0; d0 < 4; ++d0)
#pragma unroll
            for (int r = 0; r < 16; ++r) { const float v = o[d0][r] * inv - lam * ex[(qs * 128 + 32 * d0 + crow(r, hi)) * 32 + r32]; o[d0][r] = v; ss += v * v; }
        ss = halfsum(ss);
        const float rs = __builtin_amdgcn_rsqf(ss * (1.0f / 128.0f) + LN_EPS) * (1.0f - LAM_INIT);
        bf16_t* op = (bf16_t*)(a.ws + WS_MIXED) + (rowbase + qpos) * DM + 512 + h * 128 + 4 * hi;
#pragma unroll
        for (int d0 = 0; d0 < 4; ++d0)
#pragma unroll
            for (int g = 0; g < 4; ++g) { const int dv = 32 * d0 + 8 * g + 4 * hi; const f32x4 gs = *(const f32x4*)(a.g_sub + dv);
                u32x2 w; w.x = cvtpk(o[d0][4 * g] * rs * gs[0], o[d0][4 * g + 1] * rs * gs[1]); w.y = cvtpk(o[d0][4 * g + 2] * rs * gs[2], o[d0][4 * g + 3] * rs * gs[3]);
                *(u32x2*)(op + 32 * d0 + 8 * g) = w; }
    }
    __syncthreads();
}
__device__ __forceinline__ void attnB_item(const Frame& F, const Args& a, int idx, float lam) {
    const int h = 3 - (idx >> 8), b = (idx >> 7) & 1, qblk = idx & 127, q0 = qblk * 128;
    const unsigned* ctl = (const unsigned*)(a.ws + WS_CTL); const int sl = (b * 4 + h) * 4;
    const float qn0 = sqrtf(__uint_as_float(ctl[CW_QMAX + sl]) + __uint_as_float(ctl[CW_QMAX + sl + 1])), qn1 = sqrtf(__uint_as_float(ctl[CW_QMAX + sl + 2]) + __uint_as_float(ctl[CW_QMAX + sl + 3]));
    const float kn0 = sqrtf(__uint_as_float(ctl[CW_KMAX + sl]) + __uint_as_float(ctl[CW_KMAX + sl + 1])), kn1 = sqrtf(__uint_as_float(ctl[CW_KMAX + sl + 2]) + __uint_as_float(ctl[CW_KMAX + sl + 3]));
    const float U = fmaxf(qn0 * kn0, qn1 * kn1) * 1.01f + 0.01f;
    const float slope2 = __builtin_amdgcn_exp2f(-2.0f * (float)(h + 1)) * LOG2E;
    const float Df = (2.0f * U + 152.0f) / slope2;
    const int Dd = Df < 40000.f ? (int)Df + 2 : 40000;
    int t_lo = (q0 - Dd) >> 6; if (q0 - Dd < 0) t_lo = 0;
    int t_hi = (q0 + 127 + Dd) >> 6; if (t_hi > SEQ / 64 - 1) t_hi = SEQ / 64 - 1;
    if (U <= 40.f) attnB_unit<true>(F, a, b, h, qblk, lam, t_lo, t_hi, kn0, kn1);
    else attnB_unit<false>(F, a, b, h, qblk, lam, t_lo, t_hi, kn0, kn1);
}

__device__ __forceinline__ void attnA_task(const Frame& F, const Args& a, int b, int head, int d, int r, int n0, int L, LAS unsigned char* vw, f32x16 (&o)[2], float& mhat, float& ltot) {
    const int lane = F.lane, r32 = lane & 31, hi = lane >> 5;
    const bf16_t* QA = (const bf16_t*)(a.ws + WS_PROJ); const bf16_t* KA = QA + PROJ_STRIDE; const bf16_t* VA = KA + PROJ_STRIDE;
    const size_t rowbase = (size_t)b * SEQ; const int qn = n0 + r32;
    bf16x8 qr[4];
    { const bf16_t* Qp = QA + (rowbase + (size_t)(d * qn + r)) * 512 + head * 64 + 8 * hi;
#pragma unroll
      for (int d0 = 0; d0 < 4; ++d0) qr[d0] = *(const bf16x8*)(Qp + 16 * d0); }
    const float sl = __builtin_amdgcn_exp2f(-(float)(head + 1)) * LOG2E * (float)d;
    mhat = NEG_BIG; float lsum = 0.f; o[0] = (f32x16){}; o[1] = (f32x16){};
    const int voff = ((lane >> 4) & 1) * 32 + (lane & 3) * 8 + (4 * hi + ((lane & 15) >> 2)) * 64;
#pragma unroll 1
    for (int it = 0; it < 3; ++it) {
        const int kt = (it == 0) ? 1 : (it == 1 ? 0 : 2); const int kbase = n0 - 64 + 64 * kt;
        if (kbase + 63 < 0 || kbase >= L) continue;
        bf16x8 kf[8];
#pragma unroll
        for (int kh = 0; kh < 2; ++kh) { int kn = kbase + 32 * kh + r32; kn = kn < 0 ? 0 : (kn >= L ? L - 1 : kn);
            const bf16_t* Kp = KA + (rowbase + (size_t)(d * kn + r)) * 512 + head * 64 + 8 * hi;
#pragma unroll
            for (int d0 = 0; d0 < 4; ++d0) kf[2 * d0 + kh] = *(const bf16x8*)(Kp + 16 * d0); }
        u32x4 vv[8];
#pragma unroll
        for (int ks = 0; ks < 4; ++ks) { int kn = kbase + 16 * ks + (lane >> 2); kn = kn < 0 ? 0 : (kn >= L ? L - 1 : kn);
            const bf16_t* Vp = VA + (rowbase + (size_t)(d * kn + r)) * 512 + head * 64 + 8 * (lane & 3);
            vv[ks] = *(const u32x4*)Vp; vv[4 + ks] = *(const u32x4*)(Vp + 32); }
        f32x16 p0, p1;
#pragma unroll
        for (int rr = 0; rr < 16; ++rr) { const int k0 = kbase + crow(rr, hi), k1 = k0 + 32; const int d0_ = k0 - qn, d1_ = k1 - qn;
            const bool v0 = (k0 >= 0) && (k0 < L) && (d0_ <= 64) && (d0_ >= -64), v1 = (k1 >= 0) && (k1 < L) && (d1_ <= 64) && (d1_ >= -64);
            p0[rr] = v0 ? -sl * __builtin_fabsf((float)d0_) : NEG_BIG; p1[rr] = v1 ? -sl * __builtin_fabsf((float)d1_) : NEG_BIG; }
#pragma unroll
        for (int d0 = 0; d0 < 4; ++d0) { p0 = MFMA32(kf[2 * d0], qr[d0], p0); p1 = MFMA32(kf[2 * d0 + 1], qr[d0], p1); }
#pragma unroll
        for (int i = 0; i < 8; ++i) *(LAS u32x4*)(vw + i * 1024 + lane * 16) = vv[i];
        u32x4 pw[4];
        softmax_tile<2>(p0, p1, mhat, lsum, o, pw);
        asm volatile("s_waitcnt lgkmcnt(0)" ::: "memory");
        pv_tile<2>(o, (lds_cptr)(vw + voff), pw);
        asm volatile("s_waitcnt lgkmcnt(0)" ::: "memory");
    }
    ltot = halfsum(lsum);
}
__device__ __forceinline__ void attnA_unit(const Frame& F, const Args& a, int unit) {
    const int lane = F.lane, r32 = lane & 31, hi = lane >> 5, wid = F.wave;
    const int b = unit >> 7, head = (unit >> 4) & 7, tb = unit & 15, T0 = tb * 1024;
    float* part = (float*)(a.ws + WS_APART + (size_t)unit * APART_UNIT); float* ml = part + 2 * 1024 * 64;
    LAS unsigned char* vw = F.lds + wid * 8192;
    for (int task = wid; task < 64; task += 8) {
        int pat, d, r, n0, L;
        if (task < 32) { pat = 0; d = 16; r = task >> 1; n0 = T0 / 16 + 32 * (task & 1); L = SEQ / 16; }
        else { const int tt = task - 32; pat = 1; d = 4; r = tt >> 3; n0 = T0 / 4 + 32 * (tt & 7); L = SEQ / 4; }
        f32x16 o[2]; float mhat, ltot;
        attnA_task(F, a, b, head, d, r, n0, L, vw, o, mhat, ltot);
        const int tl = d * (n0 + r32) + r - T0;
        float* pp = part + ((size_t)pat * 1024 + tl) * 64 + 4 * hi;
#pragma unroll
        for (int d0 = 0; d0 < 2; ++d0)
#pragma unroll
            for (int g = 0; g < 4; ++g) *(f32x4*)(pp + 32 * d0 + 8 * g) = (f32x4){o[d0][4 * g], o[d0][4 * g + 1], o[d0][4 * g + 2], o[d0][4 * g + 3]};
        if (hi == 0) *(f32x2*)(ml + ((size_t)pat * 1024 + tl) * 2) = (f32x2){mhat, ltot};
    }
    __threadfence();
    __syncthreads();
    for (int task = wid; task < 32; task += 8) {
        const int n0 = T0 + 32 * task;
        f32x16 o[2]; float m0, l0;
        attnA_task(F, a, b, head, 1, 0, n0, SEQ, vw, o, m0, l0);
        const int tl = 32 * task + r32;
        const f32x2 ml1 = *(const f32x2*)(ml + ((size_t)0 * 1024 + tl) * 2), ml2 = *(const f32x2*)(ml + ((size_t)1 * 1024 + tl) * 2);
        const float M = MX3(m0, ml1[0], ml2[0]);
        const float w0 = __builtin_amdgcn_exp2f(m0 - M), w1 = __builtin_amdgcn_exp2f(ml1[0] - M), w2 = __builtin_amdgcn_exp2f(ml2[0] - M);
        const float rden = 1.0f / (w0 * l0 + w1 * ml1[1] + w2 * ml2[1]);
        const float* p1 = part + ((size_t)0 * 1024 + tl) * 64 + 4 * hi; const float* p2 = part + ((size_t)1 * 1024 + tl) * 64 + 4 * hi;
        bf16_t* op = (bf16_t*)(a.ws + WS_MIXED) + ((size_t)b * SEQ + T0 + tl) * DM + head * 64 + 4 * hi;
#pragma unroll
        for (int d0 = 0; d0 < 2; ++d0)
#pragma unroll
            for (int g = 0; g < 4; ++g) { const f32x4 a1 = *(const f32x4*)(p1 + 32 * d0 + 8 * g), a2 = *(const f32x4*)(p2 + 32 * d0 + 8 * g); float v[4];
#pragma unroll
                for (int j = 0; j < 4; ++j) v[j] = (w0 * o[d0][4 * g + j] + w1 * a1[j] + w2 * a2[j]) * rden;
                u32x2 w; w.x = cvtpk(v[0], v[1]); w.y = cvtpk(v[2], v[3]); *(u32x2*)(op + 32 * d0 + 8 * g) = w; }
    }
    __syncthreads();
}

__device__ __forceinline__ unsigned ordkey(float v) { const unsigned u = __float_as_uint(v); return u ^ ((u >> 31) ? 0xFFFFFFFFu : 0x80000000u); }
__device__ __forceinline__ float unordkey(unsigned k) { const unsigned u = (k & 0x80000000u) ? (k ^ 0x80000000u) : ~k; return __uint_as_float(u); }
__device__ __forceinline__ void p4_ln_router(const Frame& F, const Args& a) {
    const int lane = F.lane, wid = F.wave;
    LAS float* Wr = (LAS float*)F.lds;
    LAS unsigned* misc = (LAS unsigned*)(F.lds + LX_MISC);
    for (int i = F.tid; i < DM * NE / 4; i += 512) ((LAS f32x4*)Wr)[i] = ((const f32x4*)a.w_router)[i];
    if (F.tid < 64) misc[F.tid] = 0u;
    float* Z = (float*)(a.ws + WS_Z); bf16_t* X1B = (bf16_t*)(a.ws + WS_XB);
    const int r0 = (F.vcu * 8 + wid) * 16;
    {
        f32x4 gv[4], bv[4];
#pragma unroll
        for (int j = 0; j < 4; ++j) { gv[j] = ((const f32x4*)a.ln1_g)[lane + 64 * j]; bv[j] = ((const f32x4*)a.ln1_b)[lane + 64 * j]; }
        for (int rr = 0; rr < 16; ++rr) {
            f32x4* zr = (f32x4*)(Z + (size_t)(r0 + rr) * DM) + lane; f32x4 v[4]; float s = 0.f;
#pragma unroll
            for (int j = 0; j < 4; ++j) { v[j] = zr[64 * j]; s += (v[j][0] + v[j][1]) + (v[j][2] + v[j][3]); }
            const float mean = wave_sum(s) * (1.f / DM); float s2 = 0.f;
#pragma unroll
            for (int j = 0; j < 4; ++j) { v[j] = v[j] - mean; s2 += (v[j][0] * v[j][0] + v[j][1] * v[j][1]) + (v[j][2] * v[j][2] + v[j][3] * v[j][3]); }
            const float rstd = 1.f / sqrtf(wave_sum(s2) * (1.f / DM) + LN_EPS);
            unsigned long long* o8 = (unsigned long long*)(X1B + (size_t)(r0 + rr) * DM) + lane;
#pragma unroll
            for (int j = 0; j < 4; ++j) { const f32x4 y = v[j] * rstd * gv[j] + bv[j]; zr[64 * j] = y; o8[64 * j] = (unsigned long long)cvtpk(y[0], y[1]) | ((unsigned long long)cvtpk(y[2], y[3]) << 32); }
        }
    }
    __threadfence();
    __syncthreads();
    const int rl = lane & 15, q = lane >> 4;
    f32x4 acc0 = (f32x4){0.f, 0.f, 0.f, 0.f}, acc1 = acc0;
    const float* xr = Z + (size_t)(r0 + rl) * DM + 4 * q;
#pragma unroll 4
    for (int cidx = 0; cidx < 64; ++cidx) {
        const f32x4 xv = *(const f32x4*)(xr + 16 * cidx);
#pragma unroll
        for (int j = 0; j < 4; ++j) { const int k = 16 * cidx + 4 * q + j;
            acc0 = __builtin_amdgcn_mfma_f32_16x16x4f32(xv[j], Wr[k * 32 + rl], acc0, 0, 0, 0);
            acc1 = __builtin_amdgcn_mfma_f32_16x16x4f32(xv[j], Wr[k * 32 + 16 + rl], acc1, 0, 0, 0); }
    }
    const float br0 = a.b_router[rl], br1 = a.b_router[16 + rl];
    int* sel_e = (int*)(a.ws + WS_ROUTE); int* sel_pos = sel_e + NTOK * TOPK; float* sel_gate = (float*)(sel_pos + NTOK * TOPK);
    int my_e[4] = {0, 0, 0, 0}, my_lp[4] = {0, 0, 0, 0}; float my_g[4] = {0.f, 0.f, 0.f, 0.f};
#pragma unroll
    for (int i = 0; i < 4; ++i) {
        unsigned k0 = (ordkey(acc0[i] + br0) & ~31u) | (unsigned)(31 - rl), k1 = (ordkey(acc1[i] + br1) & ~31u) | (unsigned)(15 - rl);
        unsigned selk[4];
#pragma unroll
        for (int t = 0; t < 4; ++t) {
            unsigned m = k0 > k1 ? k0 : k1;
#pragma unroll
            for (int ofs = 1; ofs < 16; ofs <<= 1) { const unsigned other = (unsigned)__shfl_xor((int)m, ofs); m = other > m ? other : m; }
            selk[t] = m; if (k0 == m) k0 = 0u; if (k1 == m) k1 = 0u;
        }
        const float v0 = unordkey(selk[0] & ~31u), v1 = unordkey(selk[1] & ~31u), v2 = unordkey(selk[2] & ~31u), v3 = unordkey(selk[3] & ~31u);
        const float e1 = __expf(v1 - v0), e2 = __expf(v2 - v0), e3 = __expf(v3 - v0); const float rs = 1.0f / (1.0f + e1 + e2 + e3);
        if (rl < 4) { const unsigned sk = rl == 0 ? selk[0] : (rl == 1 ? selk[1] : (rl == 2 ? selk[2] : selk[3]));
            const float ge = rl == 0 ? 1.0f : (rl == 1 ? e1 : (rl == 2 ? e2 : e3));
            my_e[i] = 31 - (int)(sk & 31u); my_g[i] = ge * rs; my_lp[i] = (int)atomicAdd((unsigned*)&misc[my_e[i]], 1u); }
    }
    __syncthreads();
    unsigned* gcnt = (unsigned*)(a.ws + WS_CTL);
    if (F.tid < 32) misc[32 + F.tid] = atomicAdd(&gcnt[F.tid], misc[F.tid]);
    __syncthreads();
    if (rl < 4) {
#pragma unroll
        for (int i = 0; i < 4; ++i) { const int tok = r0 + 4 * q + i, idx = tok * 4 + rl; sel_e[idx] = my_e[i]; sel_pos[idx] = (int)misc[32 + my_e[i]] + my_lp[i]; sel_gate[idx] = my_g[i]; }
    }
}

__device__ __forceinline__ int build_tiles(const Frame& F, const Args& a) {
    LAS unsigned* misc = (LAS unsigned*)(F.lds + LX_MISC); LAS unsigned char* tile_e = F.lds + LX_TILE;
    const unsigned* gcnt = (const unsigned*)(a.ws + WS_CTL);
    if (F.tid == 0) { unsigned acc = 0; for (int e = 0; e < NE; ++e) { misc[64 + e] = acc; acc += (__hip_atomic_load(&gcnt[e], __ATOMIC_RELAXED, __HIP_MEMORY_SCOPE_AGENT) + 255u) >> 8; } misc[64 + NE] = acc; }
    __syncthreads();
    const int nt = (int)misc[64 + NE];
    for (int e = 0; e < NE; ++e) { const int t0 = (int)misc[64 + e], t1 = (int)misc[65 + e]; for (int t = t0 + F.tid; t < t1; t += 512) tile_e[t] = (unsigned char)e; }
    __syncthreads();
    return nt;
}

__global__ void __launch_bounds__(512, 2) fwd_megakernel(Args a) {
    extern __shared__ __attribute__((aligned(16))) unsigned char lds_raw[];
    cg::grid_group grid = cg::this_grid();
    Frame F; F.lds = (LAS unsigned char*)lds_raw; F.tid = threadIdx.x; F.lane = F.tid & 63; F.wave = __builtin_amdgcn_readfirstlane(F.tid >> 6);
    F.G = gridDim.x; { const int bx = blockIdx.x; F.vcu = (F.G % 8 == 0) ? (bx % 8) * (F.G / 8) + bx / 8 : bx; }
    unsigned char* ws = a.ws;

    for (int rep = 0; rep < REP_P0; ++rep) p0_prologue(F, a);
    grid.sync();

    for (int rep = 0; rep < REP_P1; ++rep) {
        pg8::Gemm g{(const bf16_t*)(ws + WS_XB), (const bf16_t*)(ws + WS_WIN), NTOK, NPROJ, DM}; pg8::StaticOrder S; S.init(NTOK, NPROJ, F.G, (int)blockIdx.x);
        EpiProj E{(bf16_t*)(ws + WS_PROJ), (unsigned*)(ws + WS_CTL)};
        pg8::gemm_phase<EpiProj, pg8::StaticOrder, true, false>(F.lds, g, S, E);
    }
    grid.sync();

    {
        float s1 = 0.f, s2 = 0.f;
        for (int i = 0; i < 64; ++i) { s1 += a.lq1[i] * a.lk1[i]; s2 += a.lq2[i] * a.lk2[i]; }
        const float lam = __expf(s1) - __expf(s2) + LAM_INIT;
        for (int rep = 0; rep < REP_A; ++rep) for (int u = F.vcu; u < 256; u += F.G) attnA_unit(F, a, u);
        {
            LAS unsigned* misc = (LAS unsigned*)(F.lds + LX_MISC); unsigned* ctl = (unsigned*)(ws + WS_CTL);
            for (;;) {
                __syncthreads();
                if (F.tid == 0) misc[100] = atomicAdd(ctl + CW_QUEUE, 1u);
                __syncthreads();
                const int idx = __builtin_amdgcn_readfirstlane((int)misc[100]);
                if (idx >= 1024) break;
                attnB_item(F, a, idx, lam);
            }
        }
    }
    grid.sync();

    for (int rep = 0; rep < REP_P3; ++rep) {
        pg8::Gemm g{(const bf16_t*)(ws + WS_MIXED), (const bf16_t*)(ws + WS_WOUT), NTOK, DM, DM}; pg8::StaticOrder S; S.init(NTOK, DM, F.G, (int)blockIdx.x);
        EpiZ E{a.x, (float*)(ws + WS_Z)};
        pg8::gemm_phase<EpiZ, pg8::StaticOrder, true, false>(F.lds, g, S, E);
    }
    grid.sync();

    if (F.G == 256) p4_ln_router(F, a);
    grid.sync();

    int* sel_e = (int*)(ws + WS_ROUTE); int* sel_pos = sel_e + NTOK * TOPK; float* sel_gate = (float*)(sel_pos + NTOK * TOPK);
    int* inv = (int*)(sel_gate + NTOK * TOPK); int* row_tok = inv + NTOK * TOPK; float* row_gate = (float*)(row_tok + 262144);
    {
        const int ntl = build_tiles(F, a); (void)ntl;
        LAS unsigned* misc = (LAS unsigned*)(F.lds + LX_MISC);
        const unsigned* gcnt = (const unsigned*)(ws + WS_CTL);
        for (int idx = F.vcu * 512 + F.tid; idx < NTOK * TOPK; idx += F.G * 512) {
            const int e = sel_e[idx], dest = (int)misc[64 + e] * 256 + sel_pos[idx];
            row_tok[dest] = idx >> 2; row_gate[dest] = sel_gate[idx]; inv[idx] = dest;
        }
        for (int e = F.vcu; e < NE; e += F.G) {
            const int c = (int)__hip_atomic_load(&gcnt[e], __ATOMIC_RELAXED, __HIP_MEMORY_SCOPE_AGENT), base = (int)misc[64 + e] * 256, end = (int)misc[65 + e] * 256;
            for (int r = base + c + F.tid; r < end; r += 512) { row_tok[r] = 0; row_gate[r] = 0.f; }
        }
    }
    grid.sync();

    for (int rep = 0; rep < REP_P6; ++rep) {
        const int ntl = build_tiles(F, a);
        MoeOrder S; S.so.init(ntl * 256, 2048, F.G, (int)blockIdx.x); S.tile_e = F.lds + LX_TILE; S.tok = (const LAS unsigned short*)(F.lds + LX_TOK); S.ncolt = 8;
        {
            LAS unsigned short* tk = (LAS unsigned short*)(F.lds + LX_TOK); pg8::Unit u;
            for (int i = 0; i < 24 && S.so.next(i, u); ++i) { if (F.tid < 256) tk[i * 256 + F.tid] = (unsigned short)row_tok[u.pm * 256 + F.tid]; }
            __syncthreads();
        }
        pg8::Gemm g{(const bf16_t*)(ws + WS_XB), (const bf16_t*)(ws + WS_WUP), ntl * 256, 2048, DM};
        EpiUp E{(bf16_t*)(ws + WS_H), a.b_up};
        pg8::gemm_phase<EpiUp, MoeOrder, true, true>(F.lds, g, S, E);
    }
    grid.sync();

    for (int rep = 0; rep < REP_P7; ++rep) {
        const int ntl = build_tiles(F, a);
        MoeOrder S; S.so.init(ntl * 256, 1024, F.G, (int)blockIdx.x); S.tile_e = F.lds + LX_TILE; S.tok = nullptr; S.ncolt = 4;
        pg8::Gemm g{(const bf16_t*)(ws + WS_H), (const bf16_t*)(ws + WS_WDN), ntl * 256, DM, DFF};
        EpiDown E{(bf16_t*)(ws + WS_Y), a.b_down, row_gate};
        pg8::gemm_phase<EpiDown, MoeOrder, true, false>(F.lds, g, S, E);
    }
    grid.sync();

    for (int rep = 0; rep < REP_P8; ++rep) {
        const int lane = F.lane; const float* X1 = (const float*)(ws + WS_Z); const bf16_t* Y = (const bf16_t*)(ws + WS_Y);
        f32x4 gv[4], bv[4];
#pragma unroll
        for (int j = 0; j < 4; ++j) { gv[j] = ((const f32x4*)a.ln2_g)[lane + 64 * j]; bv[j] = ((const f32x4*)a.ln2_b)[lane + 64 * j]; }
        for (int m = F.vcu * 8 + F.wave; m < NTOK; m += F.G * 8) {
            const f32x4* xr = (const f32x4*)(X1 + (size_t)m * DM) + lane; f32x4 v[4];
#pragma unroll
            for (int j = 0; j < 4; ++j) v[j] = xr[64 * j] * ALPHA;
#pragma unroll
            for (int t = 0; t < 4; ++t) { const int dest = inv[m * 4 + t]; const u32x2* yr = (const u32x2*)(Y + (size_t)dest * DM) + lane;
#pragma unroll
                for (int j = 0; j < 4; ++j) { const u32x2 w = yr[64 * j];
                    v[j][0] += __uint_as_float(w.x << 16); v[j][1] += __uint_as_float(w.x & 0xFFFF0000u); v[j][2] += __uint_as_float(w.y << 16); v[j][3] += __uint_as_float(w.y & 0xFFFF0000u); } }
            float s = 0.f;
#pragma unroll
            for (int j = 0; j < 4; ++j) s += (v[j][0] + v[j][1]) + (v[j][2] + v[j][3]);
            const float mean = wave_sum(s) * (1.f / DM); float s2 = 0.f;
#pragma unroll
            for (int j = 0; j < 4; ++j) { v[j] = v[j] - mean; s2 += (v[j][0] * v[j][0] + v[j][1] * v[j][1]) + (v[j][2] * v[j][2] + v[j][3] * v[j][3]); }
            const float rstd = 1.f / sqrtf(wave_sum(s2) * (1.f / DM) + LN_EPS);
            f32x4* orow = (f32x4*)(a.out + (size_t)m * DM) + lane;
#pragma unroll
            for (int j = 0; j < 4; ++j) orow[64 * j] = v[j] * rstd * gv[j] + bv[j];
        }
    }
}

extern "C" void kernel_launch(void* const* d_in, const int* in_sizes, int n_in, void* d_out, int out_size, void* d_ws, size_t ws_size, hipStream_t stream) {
    static int grid = 0;
    if (grid == 0) {
        if (n_in != 18 || in_sizes[0] != NTOK * DM || out_size != NTOK * DM || ws_size < WS_END) {
            fprintf(stderr, "kernel_launch: unexpected shapes (n_in %d, in0 %d, out %d, ws %zu need %zu); nothing launched\n", n_in, n_in > 0 ? in_sizes[0] : -1, out_size, ws_size, (size_t)WS_END); grid = -1; return; }
        int dev = 0, cus = 0, per_cu = 0;
        if (hipGetDevice(&dev) != hipSuccess || hipDeviceGetAttribute(&cus, hipDeviceAttributeMultiprocessorCount, dev) != hipSuccess) { grid = -1; return; }
        if (hipFuncSetAttribute((const void*)fwd_megakernel, hipFuncAttributeMaxDynamicSharedMemorySize, LDS_BYTES) != hipSuccess) { fprintf(stderr, "kernel_launch: hipFuncSetAttribute failed\n"); grid = -1; return; }
        if (hipOccupancyMaxActiveBlocksPerMultiprocessor(&per_cu, (const void*)fwd_megakernel, 512, LDS_BYTES) != hipSuccess || per_cu < 1) { fprintf(stderr, "kernel_launch: occupancy query says %d\n", per_cu); per_cu = 1; }
        (void)hipGetLastError();
        grid = cus * (per_cu > 1 ? 1 : per_cu);
        fprintf(stderr, "kernel_launch: grid %d (cus %d, per_cu %d)\n", grid, cus, per_cu);
    }
    if (grid < 0) return;
    if (hipMemsetAsync((char*)d_ws + WS_CTL, 0, CTL_ZERO_BYTES, stream) != hipSuccess) return;
    Args a{};
    const float* const* in = (const float* const*)d_in;
    a.x = in[0]; a.w_in = in[1]; a.w_out = in[2]; a.lq1 = in[3]; a.lk1 = in[4]; a.lq2 = in[5]; a.lk2 = in[6]; a.g_sub = in[7];
    a.ln1_g = in[8]; a.ln1_b = in[9]; a.w_router = in[10]; a.b_router = in[11]; a.w_up = in[12]; a.b_up = in[13]; a.w_down = in[14]; a.b_down = in[15];
    a.ln2_g = in[16]; a.ln2_b = in[17]; a.out = (float*)d_out; a.ws = (unsigned char*)d_ws;
    void* args[] = {&a};
    hipError_t e = hipLaunchCooperativeKernel((void*)fwd_megakernel, dim3(grid), dim3(512), args, LDS_BYTES, stream);
    if (e != hipSuccess) fprintf(stderr, "kernel_launch: cooperative launch failed: %s (grid %d)\n", hipGetErrorString(e), grid);
}
```

```cpp
#include <hip/hip_runtime.h>
#include <hip/hip_cooperative_groups.h>
#include <cstdio>
#include <cstdint>
namespace cg = cooperative_groups;
#ifndef KREP_P1
#define KREP_P1 1
#endif
#ifndef KREP_P3
#define KREP_P3 1
#endif
#ifndef KREP_P6
#define KREP_P6 1
#endif
#ifndef KREP_P7
#define KREP_P7 1
#endif
#ifndef ORD_SWZ
#define ORD_SWZ 0
#endif
#ifndef ORD_REV7
#define ORD_REV7 1
#endif
#ifndef REP_P0
#define REP_P0 1
#endif
#ifndef REP_P1
#define REP_P1 1
#endif
#ifndef REP_A
#define REP_A 1
#endif
#ifndef REP_B
#define REP_B 1
#endif
#ifndef REP_P3
#define REP_P3 1
#endif
#ifndef REP_P6
#define REP_P6 1
#endif
#ifndef REP_P7
#define REP_P7 1
#endif
#ifndef REP_P8
#define REP_P8 1
#endif

#define LAS __attribute__((address_space(3)))
typedef unsigned short bf16_t;
typedef short bf16x8 __attribute__((ext_vector_type(8)));
typedef short s16x4 __attribute__((ext_vector_type(4)));
typedef float f32x4 __attribute__((ext_vector_type(4)));
typedef float f32x2 __attribute__((ext_vector_type(2)));
typedef float f32x16 __attribute__((ext_vector_type(16)));
typedef unsigned u32x4 __attribute__((ext_vector_type(4)));
typedef unsigned u32x2 __attribute__((ext_vector_type(2)));
typedef __bf16 bf16x2_t __attribute__((ext_vector_type(2)));

constexpr int BATCH = 2, SEQ = 16384, DM = 1024, NTOK = BATCH * SEQ;
constexpr int NPROJ = 3072, NE = 32, TOPK = 4, DFF = 1024;
constexpr int NROWS_MAX = NTOK * TOPK + NE * 256;
constexpr float LN_EPS = 1e-5f;
constexpr float ALPHA = 1.189207115002721f;
constexpr float LOG2E = 1.4426950408889634f;
constexpr float C2 = 0.125f * LOG2E;
constexpr float LAM_INIT = 0.2f;
constexpr float NEG_BIG = -1e30f;

constexpr size_t MiB = 1u << 20;
constexpr size_t WS_CTL = 0, CTL_ZERO_BYTES = 65536;
constexpr int CW_QMAX = 64, CW_KMAX = 128, CW_QUEUE = 256, CW_BAR = 4096;
constexpr size_t WS_WIN = 2 * MiB, WS_WOUT = 8 * MiB, WS_WUP = 16 * MiB, WS_WDN = 144 * MiB;
constexpr size_t WS_XB = 208 * MiB;
constexpr size_t WS_PROJ = 272 * MiB;
constexpr size_t PROJ_STRIDE = (size_t)NTOK * 512;
constexpr size_t WS_MIXED = 464 * MiB;
constexpr size_t WS_Z = 272 * MiB;
constexpr size_t WS_H = 400 * MiB;
constexpr size_t WS_Y = 672 * MiB;
constexpr size_t WS_APART = 672 * MiB;
constexpr size_t APART_UNIT = 2 * 1024 * 64 * 4 + 2 * 1024 * 2 * 4;
constexpr size_t WS_ROUTE = 944 * MiB;
constexpr size_t WS_END = 952 * MiB;

constexpr int RING_BYTES = 131072;
constexpr int LX_TILE = 131072;
constexpr int LX_TOK = 132096;
constexpr int LX_MISC = 144384;
constexpr int LDS_BYTES = 147456;

__device__ __forceinline__ unsigned cvtpk(float lo, float hi) { f32x2 v = {lo, hi}; bf16x2_t b = __builtin_convertvector(v, bf16x2_t); return __builtin_bit_cast(unsigned, b); }
__device__ __forceinline__ unsigned cvt4_fp8(float a, float b, float c, float d) { int w = 0; w = __builtin_amdgcn_cvt_pk_fp8_f32(a, b, w, false); w = __builtin_amdgcn_cvt_pk_fp8_f32(c, d, w, true); return (unsigned)w; }
__device__ __forceinline__ float wave_sum(float v) {
#pragma unroll
    for (int o = 1; o < 64; o <<= 1) v += __shfl_xor(v, o);
    return v;
}

namespace pg8 {
constexpr int BM = 256, BK = 64, HALF = 128, HTB = HALF * BK * 2, STAGE_BYTES = 8 * HTB, NXCD = 8, WGM = 8;
__host__ __device__ __forceinline__ int lds_byte(int r, int c) { const int st = (r >> 4) * 2 + (c >> 5), rr = r & 15, cc = c & 31, ob = rr * 64 + cc * 2; return st * 1024 + (ob ^ (((ob >> 9) & 1) << 5)); }
__host__ __device__ __forceinline__ void stage_rc(int b, int& R, int& C) { const int st = b / 1024, sb = b % 1024, swz = sb ^ (((sb >> 9) & 1) << 5); R = (st >> 1) * 16 + swz / 64; C = (st & 1) * 32 + (swz % 64) / 2; }
__host__ __device__ __forceinline__ int perm32(int rho) { const int n = rho >> 4, i = rho & 15; return 8 * (i >> 2) + 4 * n + (i & 3); }

struct Unit { int pm, pn; };
struct Gemm { const bf16_t* A; const bf16_t* Bt; int M, N, K; int scale_a, scale_b; };
typedef int v4i_t __attribute__((ext_vector_type(4))); typedef int v8i_t __attribute__((ext_vector_type(8)));

struct StaticOrder {
    int nM, nN, nwg, G, c, rev, swz;
    __host__ __device__ void init(int M, int N, int G_, int c_, int rev_ = 0, int swz_ = ORD_SWZ) { nM = M / BM; nN = N / BM; nwg = nM * nN; G = G_; c = c_; rev = rev_; swz = swz_; }
    __host__ __device__ bool next(int i, Unit& u) const {
        const long L = (long)i * G + c; if (L >= nwg) return false;
        int wgid = (rev == 1) ? nwg - 1 - (int)L : (int)L;
        if (swz) { const int q = nwg / NXCD, r = nwg % NXCD, xcd = wgid % NXCD; int off = wgid / NXCD; const int len = xcd < r ? q + 1 : q;
            if (rev == 2) off = len - 1 - off;
            wgid = (xcd < r ? xcd * (q + 1) : r * (q + 1) + (xcd - r) * q) + off; }
        const int nig = WGM * nN, gid = wgid / nig, fm = gid * WGM, gsz = (nM - fm) < WGM ? (nM - fm) : WGM;
        u.pm = fm + ((wgid % nig) % gsz); u.pn = (wgid % nig) / gsz; return true;
    }
    __device__ __forceinline__ const LAS unsigned short* tok_table(int) const { return nullptr; }
};

template <class Epi, class Sched, bool ALIGN_EPI, bool GATHER, int KREP = 1, bool F8 = false>
__device__ __forceinline__ void gemm_phase(LAS unsigned char* lds, const Gemm g, const Sched& S, const Epi& E, const int tid) {
    const int wid = __builtin_amdgcn_readfirstlane(tid >> 6), lane = tid & 63, wr = wid >> 2, wc = wid & 3, fr = lane & 15, fq = lane >> 4;
    constexpr int ES = F8 ? 1 : 2;
    const int sclW = g.scale_b, sclX = g.scale_a;
    const int K = g.K, ntr = K * ES / (BK * 2), nt = ntr * KREP;
    unsigned voffA[2], voffB[2]; int rowA[2];
#pragma unroll
    for (int i = 0; i < 2; ++i) { int R, C; stage_rc(tid * 16 + i * 8192, R, C); const int Rb = Epi::PERM ? ((R & ~31) + perm32(R & 31)) : R;
        voffA[i] = GATHER ? (unsigned)(C * 2) : (unsigned)(R * K * ES + C * 2); voffB[i] = (unsigned)(Rb * K * ES + C * 2); rowA[i] = R; }
    const size_t kstep = (size_t)(BK * 2);
    const size_t hstep = (size_t)HALF * K * ES;
    const size_t tstep = 2 * hstep;
    const unsigned ldsw = (unsigned)wid * 1024u;
    const int aoff = lds_byte(wr * 64 + fr, fq * 8), boff = lds_byte(wc * 32 + fr, fq * 8);
    const int aoff8 = lds_byte(wr * 64 + fr, fq * 16), boff8 = lds_byte(wc * 32 + fr, fq * 16);
#define PG8_SA(b, h) (((b) * 2 + (h)) * HTB)
#define PG8_SB(b, h) ((4 + (b) * 2 + (h)) * HTB)
#define PG8_STAGE(bufoff, gbase, voff) do { _Pragma("unroll") for (int _i = 0; _i < 2; ++_i) \
        __builtin_amdgcn_global_load_lds((const unsigned*)((const char*)(gbase) + (voff)[_i]), (LAS unsigned*)(lds + (bufoff) + ldsw + _i * 8192), 16, 0, 0); } while (0)
#define PG8_STAGE_A(bufoff, NX, h, kb) do { if constexpr (GATHER) { const unsigned* _o = (NX) ? gN[h] : gC[h]; PG8_STAGE(bufoff, (const char*)g.A + (kb), _o); } \
        else { PG8_STAGE(bufoff, ((NX) ? nA : cA) + (h) * hstep + (kb), voffA); } } while (0)
#define PG8_LDA(dst, b, h) do { _Pragma("unroll") for (int m = 0; m < 4; ++m) _Pragma("unroll") for (int k = 0; k < 2; ++k) dst[m][k] = *(const LAS bf16x8*)(lds + PG8_SA(b, h) + (F8 ? aoff8 + k * 16 : aoff + k * 1024) + m * 2048); } while (0)
#define PG8_LDB(dst, b, h) do { _Pragma("unroll") for (int n = 0; n < 2; ++n) _Pragma("unroll") for (int k = 0; k < 2; ++k) dst[n][k] = *(const LAS bf16x8*)(lds + PG8_SB(b, h) + (F8 ? boff8 + k * 16 : boff + k * 1024) + n * 2048); } while (0)
#define PG8_F8OP(x) __builtin_shufflevector(__builtin_bit_cast(v4i_t, x[0]), __builtin_bit_cast(v4i_t, x[1]), 0, 1, 2, 3, 4, 5, 6, 7)
#define PG8_MMA(ai, bj, At, Bt) do { __builtin_amdgcn_s_setprio(1); _Pragma("unroll") for (int m = 0; m < 4; ++m) _Pragma("unroll") for (int n = 0; n < 2; ++n) { \
        if constexpr (F8) { const v8i_t _a = PG8_F8OP(Bt[n]), _b = PG8_F8OP(At[m]); asm volatile("v_mfma_scale_f32_16x16x128_f8f6f4 %0, %1, %2, %0, %3, %4 op_sel_hi:[0,0,0]" : "+v"(acc[ai][bj][m][n]) : "v"(_a), "v"(_b), "v"(sclW), "v"(sclX)); } \
        else { _Pragma("unroll") for (int k = 0; k < 2; ++k) acc[ai][bj][m][n] = __builtin_amdgcn_mfma_f32_16x16x32_bf16(Bt[n][k], At[m][k], acc[ai][bj][m][n], 0, 0, 0); } } \
        __builtin_amdgcn_s_setprio(0); } while (0)
#define PG8_WAIT_V(n) asm volatile("s_waitcnt vmcnt(" #n ")" ::: "memory")
#define PG8_WAIT_L(n) asm volatile("s_waitcnt lgkmcnt(" #n ")" ::: "memory")
#define PG8_BAR __builtin_amdgcn_s_barrier()
#define PG8_SCHED __builtin_amdgcn_sched_barrier(0)
#define PG8_GOFF(dst, ui_) do { if constexpr (GATHER) { const LAS unsigned short* _t = S.tok_table(ui_); _Pragma("unroll") for (int _h = 0; _h < 2; ++_h) _Pragma("unroll") for (int _i = 0; _i < 2; ++_i) \
        dst[_h][_i] = (unsigned)_t[_h * HALF + rowA[_i]] * (unsigned)(K * ES) + voffA[_i]; } } while (0)
    Unit cur, nxt; int ui = 0;
    if (!S.next(0, cur)) return;
    f32x4 acc[2][2][4][2];
    E.init(acc, cur, wc, fq);
    bf16x8 At[4][2], B0[2][2], B1[2][2];
    unsigned gC[2][2] = {{0u, 0u}, {0u, 0u}}, gN[2][2] = {{0u, 0u}, {0u, 0u}};
    PG8_GOFF(gC, 0);
    const char* cA = (const char*)g.A + (GATHER ? (size_t)0 : (size_t)cur.pm * tstep); const char* cB = (const char*)g.Bt + (size_t)cur.pn * tstep;
    const char* nA = cA;
    {
        PG8_STAGE(PG8_SB(0, 0), cB, voffB); PG8_STAGE(PG8_SB(0, 1), cB + hstep, voffB); PG8_STAGE_A(PG8_SA(0, 0), false, 0, 0); PG8_STAGE_A(PG8_SA(0, 1), false, 1, 0);
        if (wr == 1) PG8_BAR;
        PG8_WAIT_V(2); PG8_BAR;
        PG8_STAGE(PG8_SB(1, 0), cB + kstep, voffB); PG8_STAGE_A(PG8_SA(1, 0), false, 0, kstep); PG8_STAGE(PG8_SB(1, 1), cB + hstep + kstep, voffB);
        PG8_WAIT_V(6); PG8_BAR;
    }
    for (;;) {
        const bool has_next = S.next(ui + 1, nxt);
        nA = has_next ? (const char*)g.A + (GATHER ? (size_t)0 : (size_t)nxt.pm * tstep) : cA; const char* nB = has_next ? (const char*)g.Bt + (size_t)nxt.pn * tstep : cB;
        if (has_next) { PG8_GOFF(gN, ui + 1); } else {
#pragma unroll
            for (int h = 0; h < 2; ++h)
#pragma unroll
                for (int i = 0; i < 2; ++i) gN[h][i] = gC[h][i]; }
#pragma unroll 1
        for (int t = 0; t < nt; t += 2) {
            const bool last = (t == nt - 2);
            const size_t k1 = (size_t)((t + 1) % ntr) * kstep;
            const size_t k2 = last ? (size_t)0 : (size_t)((t + 2) % ntr) * kstep, k3 = k2 + kstep;
            const char* b2 = last ? nB : cB + (size_t)((t + 2) % ntr) * kstep; const char* b3 = b2 + kstep;
            PG8_LDB(B0, 0, 0); PG8_LDB(B1, 0, 1); PG8_SCHED; PG8_LDA(At, 0, 0); PG8_STAGE_A(PG8_SA(1, 1), false, 1, k1);
            PG8_WAIT_V(8); PG8_WAIT_L(0); PG8_BAR; PG8_MMA(0, 0, At, B0); PG8_MMA(0, 1, At, B1); PG8_BAR; PG8_SCHED;
            PG8_LDA(At, 0, 1); PG8_STAGE(PG8_SB(0, 0), b2, voffB); PG8_STAGE(PG8_SB(0, 1), b2 + hstep, voffB); PG8_STAGE_A(PG8_SA(0, 0), last, 0, k2);
            PG8_WAIT_V(8); PG8_WAIT_L(0); PG8_BAR; PG8_MMA(1, 0, At, B0); PG8_MMA(1, 1, At, B1); PG8_BAR; PG8_SCHED;
            PG8_LDB(B0, 1, 0); PG8_LDB(B1, 1, 1); PG8_SCHED; PG8_LDA(At, 1, 0); PG8_STAGE_A(PG8_SA(0, 1), last, 1, k2);
            PG8_WAIT_V(8); PG8_WAIT_L(0); PG8_BAR; PG8_MMA(0, 0, At, B0); PG8_MMA(0, 1, At, B1); PG8_BAR; PG8_SCHED;
            PG8_LDA(At, 1, 1); PG8_STAGE(PG8_SB(1, 0), b3, voffB); PG8_STAGE(PG8_SB(1, 1), b3 + hstep, voffB); PG8_STAGE_A(PG8_SA(1, 0), last, 0, k3);
            PG8_WAIT_V(8); PG8_WAIT_L(0); PG8_BAR; PG8_MMA(1, 0, At, B0); PG8_MMA(1, 1, At, B1); PG8_BAR; PG8_SCHED;
        }
        if constexpr (ALIGN_EPI) { if (wr == 0) PG8_BAR; }
        if constexpr (F8) asm volatile("s_nop 15\n\ts_nop 15" ::: "memory");
        if constexpr (KREP > 1) {
_Pragma("unroll") for (int a_ = 0; a_ < 2; ++a_) _Pragma("unroll") for (int b_ = 0; b_ < 2; ++b_) _Pragma("unroll") for (int m_ = 0; m_ < 4; ++m_) _Pragma("unroll") for (int n_ = 0; n_ < 2; ++n_) acc[a_][b_][m_][n_] = acc[a_][b_][m_][n_] * (1.0f / KREP); }
        E(acc, cur, wr, wc, fr, fq);
        if (!has_next) break;
        E.init(acc, nxt, wc, fq);
        cur = nxt; cA = nA; cB = nB; ++ui;
#pragma unroll
        for (int h = 0; h < 2; ++h)
#pragma unroll
            for (int i = 0; i < 2; ++i) gC[h][i] = gN[h][i];
        if constexpr (ALIGN_EPI) { if (wr == 1) PG8_BAR; }
    }
    PG8_WAIT_V(0);
    if constexpr (!ALIGN_EPI) { if (wr == 0) PG8_BAR; }
    PG8_BAR;
#undef PG8_SA
#undef PG8_SB
#undef PG8_STAGE
#undef PG8_STAGE_A
#undef PG8_LDA
#undef PG8_LDB
#undef PG8_MMA
#undef PG8_F8OP
#undef PG8_WAIT_V
#undef PG8_WAIT_L
#undef PG8_BAR
#undef PG8_SCHED
#undef PG8_GOFF
}
}

struct Args {
    const float* x; const float* w_in; const float* w_out; const float* lq1; const float* lk1; const float* lq2; const float* lk2; const float* g_sub;
    const float* ln1_g; const float* ln1_b; const float* w_router; const float* b_router; const float* w_up; const float* b_up; const float* w_down; const float* b_down;
    const float* ln2_g; const float* ln2_b; float* out; unsigned char* ws;
};
struct Frame {
    LAS unsigned char* lds; int wave, vcu, G;
};
__device__ __forceinline__ int lane_now() { int l; asm volatile("v_mbcnt_lo_u32_b32 %0, -1, 0\n\tv_mbcnt_hi_u32_b32 %0, -1, %0" : "=v"(l)); return l; }
#define F_LANE lane_now()
#define F_TID (F.wave * 64 + lane_now())

struct EpiProj {
    static constexpr bool PERM = true;
    bf16_t* O; unsigned* ctl;
    __device__ __forceinline__ void init(f32x4 (&acc)[2][2][4][2], const pg8::Unit&, int, int) const {
#pragma unroll
        for (int a_ = 0; a_ < 2; ++a_)
#pragma unroll
            for (int b_ = 0; b_ < 2; ++b_)
#pragma unroll
                for (int m_ = 0; m_ < 4; ++m_)
#pragma unroll
                    for (int n_ = 0; n_ < 2; ++n_) acc[a_][b_][m_][n_] = (f32x4){0.f, 0.f, 0.f, 0.f};
    }
    __device__ __forceinline__ void operator()(const f32x4 (&acc)[2][2][4][2], const pg8::Unit& u, int wr, int wc, int fr, int fq) const {
        const int t = u.pn >> 1; const float sc = (t == 0 || t == 3) ? C2 : 1.f; const bool nrm = (t == 3 || t == 4);
        bf16_t* base = O + (size_t)t * PROJ_STRIDE; const int row0 = u.pm * 256 + wr * 64 + fr, col0 = (u.pn & 1) * 256 + wc * 32 + 8 * fq;
        float mx0 = 0.f, mx1 = 0.f;
#pragma unroll
        for (int ai = 0; ai < 2; ++ai)
#pragma unroll
            for (int m = 0; m < 4; ++m) { bf16_t* rowp = base + (size_t)(row0 + ai * 128 + m * 16) * 512 + col0;
#pragma unroll
                for (int bj = 0; bj < 2; ++bj) { const f32x4 v0 = acc[ai][bj][m][0] * sc, v1 = acc[ai][bj][m][1] * sc; u32x4 w;
                    w.x = cvtpk(v0[0], v0[1]); w.y = cvtpk(v0[2], v0[3]); w.z = cvtpk(v1[0], v1[1]); w.w = cvtpk(v1[2], v1[3]);
                    if (t >= 4) {
                        const int row = row0 + ai * 128 + m * 16, bb = row >> 14, sq = row & (SEQ - 1), key = sq & 63, hh = (u.pn & 1) * 2 + bj;
                        bf16_t* tb = O + 4 * PROJ_STRIDE + ((size_t)((bb * 4 + hh) * 256 + (sq >> 6))) * 16384;
                        if (t == 4) *(u32x4*)(tb + (4 * wc + fq) * 512 + key * 8) = w;
                        else *(u32x4*)(tb + 8192 + (wc * 4 + (key >> 4)) * 512 + (key & 15) * 32 + fq * 8) = w;
                    } else *(u32x4*)(rowp + bj * 128) = w;
                    if (nrm) { float ss = 0.f;
#pragma unroll
                        for (int j = 0; j < 4; ++j) { const float lo = __uint_as_float(w[j] << 16), hi = __uint_as_float(w[j] & 0xFFFF0000u); ss += lo * lo + hi * hi; }
                        ss += __shfl_xor(ss, 16); ss += __shfl_xor(ss, 32);
                        if (bj == 0) mx0 = fmaxf(mx0, ss); else mx1 = fmaxf(mx1, ss); } } }
        if (nrm) {
#pragma unroll
            for (int ofs = 1; ofs < 16; ofs <<= 1) { mx0 = fmaxf(mx0, __shfl_xor(mx0, ofs)); mx1 = fmaxf(mx1, __shfl_xor(mx1, ofs)); }
            if (fr == 0 && fq == 0) { const int b = u.pm >> 6, cw = (t == 3) ? CW_QMAX : CW_KMAX;
                atomicMax(ctl + cw + (((b * 4 + (u.pn & 1) * 2 + 0) * 2 + (wc >> 1)) * 2 + (wc & 1)), __float_as_uint(mx0));
                atomicMax(ctl + cw + (((b * 4 + (u.pn & 1) * 2 + 1) * 2 + (wc >> 1)) * 2 + (wc & 1)), __float_as_uint(mx1)); }
        }
    }
};
struct EpiZ {
    static constexpr bool PERM = false;
    const float* x; float* z;
    __device__ __forceinline__ void init(f32x4 (&acc)[2][2][4][2], const pg8::Unit&, int, int) const {
#pragma unroll
        for (int a_ = 0; a_ < 2; ++a_)
#pragma unroll
            for (int b_ = 0; b_ < 2; ++b_)
#pragma unroll
                for (int m_ = 0; m_ < 4; ++m_)
#pragma unroll
                    for (int n_ = 0; n_ < 2; ++n_) acc[a_][b_][m_][n_] = (f32x4){0.f, 0.f, 0.f, 0.f};
    }
    __device__ __forceinline__ void operator()(const f32x4 (&acc)[2][2][4][2], const pg8::Unit& u, int wr, int wc, int fr, int fq) const {
        const int col0 = u.pn * 256 + wc * 32 + 4 * fq;
#pragma unroll
        for (int ai = 0; ai < 2; ++ai)
#pragma unroll
            for (int m = 0; m < 4; ++m) { const size_t off = (size_t)(u.pm * 256 + ai * 128 + wr * 64 + m * 16 + fr) * DM + col0;
#pragma unroll
                for (int bj = 0; bj < 2; ++bj)
#pragma unroll
                    for (int n = 0; n < 2; ++n) { const f32x4 xv = *(const f32x4*)(x + off + bj * 128 + n * 16); *(f32x4*)(z + off + bj * 128 + n * 16) = xv * ALPHA + acc[ai][bj][m][n]; } }
    }
};
__device__ __forceinline__ f32x2 swiglu4_pk(f32x2 g, f32x2 u) {
    g = __builtin_elementwise_min(g, (f32x2){7.0f, 7.0f});
    u = __builtin_elementwise_min(__builtin_elementwise_max(u, (f32x2){-7.0f, -7.0f}), (f32x2){7.0f, 7.0f});
    const f32x2 a_ = g * (-1.702f * LOG2E) + (-2.0f);
    f32x2 e_; e_.x = __builtin_amdgcn_exp2f(a_.x); e_.y = __builtin_amdgcn_exp2f(a_.y);
    const f32x2 d_ = e_ + 0.25f;
    f32x2 s_; s_.x = __builtin_amdgcn_rcpf(d_.x); s_.y = __builtin_amdgcn_rcpf(d_.y);
    const f32x2 t_ = g * s_;
    return t_ * u + t_;
}
struct EpiUp {
    static constexpr bool PERM = true;
    bf16_t* H; const float* b_up;
    __device__ __forceinline__ void init(f32x4 (&acc)[2][2][4][2], const pg8::Unit& u, int wc, int fq) const {
        const int e = u.pn >> 3, pnl = u.pn & 7, hcol0 = pnl * 128 + wc * 32 + 8 * fq;
        const float* bg = b_up + (size_t)e * 2048 + hcol0; const float* bu = bg + 1024;
        const f32x4 bg0 = *(const f32x4*)bg, bg1 = *(const f32x4*)(bg + 4), bu0 = *(const f32x4*)bu, bu1 = *(const f32x4*)(bu + 4);
#pragma unroll
        for (int a_ = 0; a_ < 2; ++a_)
#pragma unroll
            for (int m_ = 0; m_ < 4; ++m_) { acc[a_][0][m_][0] = bg0; acc[a_][0][m_][1] = bg1; acc[a_][1][m_][0] = bu0; acc[a_][1][m_][1] = bu1; }
    }
    __device__ __forceinline__ void operator()(const f32x4 (&acc)[2][2][4][2], const pg8::Unit& u, int wr, int wc, int fr, int fq) const {
        const int e = u.pn >> 3, pnl = u.pn & 7, hcol0 = pnl * 128 + wc * 32 + 8 * fq;
#pragma unroll
        for (int ai = 0; ai < 2; ++ai)
#pragma unroll
            for (int m = 0; m < 4; ++m) { const size_t row = (size_t)(u.pm * 256 + ai * 128 + wr * 64 + m * 16 + fr);
                const f32x4 g0 = acc[ai][0][m][0], g1 = acc[ai][0][m][1], u0 = acc[ai][1][m][0], u1 = acc[ai][1][m][1];
                const f32x2 r0 = swiglu4_pk((f32x2){g0[0], g0[1]}, (f32x2){u0[0], u0[1]}), r1 = swiglu4_pk((f32x2){g0[2], g0[3]}, (f32x2){u0[2], u0[3]});
                const f32x2 r2 = swiglu4_pk((f32x2){g1[0], g1[1]}, (f32x2){u1[0], u1[1]}), r3 = swiglu4_pk((f32x2){g1[2], g1[3]}, (f32x2){u1[2], u1[3]});
                u32x2 w8; w8.x = cvt4_fp8(r0.x, r0.y, r1.x, r1.y); w8.y = cvt4_fp8(r2.x, r2.y, r3.x, r3.y);
                *(u32x2*)((unsigned char*)H + row * DFF + hcol0) = w8; }
    }
};
struct EpiDown {
    static constexpr bool PERM = true;
    bf16_t* Y; const float* b_down; const float* row_gate;
    __device__ __forceinline__ void init(f32x4 (&acc)[2][2][4][2], const pg8::Unit& u, int wc, int fq) const {
        const int e = u.pn >> 2, pnl = u.pn & 3, col0 = pnl * 256 + wc * 32 + 8 * fq;
#pragma unroll
        for (int bj = 0; bj < 2; ++bj)
#pragma unroll
            for (int n = 0; n < 2; ++n) { const f32x4 bv = *(const f32x4*)(b_down + (size_t)e * DM + col0 + bj * 128 + 4 * n);
#pragma unroll
                for (int a_ = 0; a_ < 2; ++a_)
#pragma unroll
                    for (int m_ = 0; m_ < 4; ++m_) acc[a_][bj][m_][n] = bv; }
    }
    __device__ __forceinline__ void operator()(const f32x4 (&acc)[2][2][4][2], const pg8::Unit& u, int wr, int wc, int fr, int fq) const {
        const int e = u.pn >> 2, pnl = u.pn & 3, col0 = pnl * 256 + wc * 32 + 8 * fq;
#pragma unroll
        for (int ai = 0; ai < 2; ++ai)
#pragma unroll
            for (int m = 0; m < 4; ++m) { const size_t row = (size_t)(u.pm * 256 + ai * 128 + wr * 64 + m * 16 + fr); const float gt = row_gate[row];
#pragma unroll
                for (int bj = 0; bj < 2; ++bj) { const f32x4 v0 = acc[ai][bj][m][0] * (gt * 32.f), v1 = acc[ai][bj][m][1] * (gt * 32.f); u32x2 w;
                    w.x = cvt4_fp8(v0[0], v0[1], v0[2], v0[3]); w.y = cvt4_fp8(v1[0], v1[1], v1[2], v1[3]); *(u32x2*)((unsigned char*)Y + row * DM + col0 + bj * 128) = w; } }
    }
};
struct MoeOrder {
    pg8::StaticOrder so; const LAS unsigned char* tile_e; const LAS unsigned short* tok; int ncolt;
    __device__ __forceinline__ bool next(int i, pg8::Unit& u) const {
        if (!so.next(i, u)) return false;
        const int e = __builtin_amdgcn_readfirstlane((int)tile_e[u.pm]); u.pn = e * ncolt + u.pn; return true; }
    __device__ __forceinline__ const LAS unsigned short* tok_table(int ui) const { return tok + ui * 256; }
};

__device__ __forceinline__ void p0_transpose_item(const float* W, int K, int N, bf16_t* WT, int k0, int n0, int row0, LAS float* scr, int lane) {
#pragma unroll 8
    for (int i = 0; i < 32; ++i) { const int kk = 2 * i + (lane >> 5); scr[kk * 33 + (lane & 31)] = W[(size_t)(k0 + kk) * N + n0 + (lane & 31)]; }
    asm volatile("s_waitcnt lgkmcnt(0)" ::: "memory");
    const int c = lane & 7;
#pragma unroll
    for (int j = 0; j < 4; ++j) { const int n = (lane >> 3) + 8 * j; const LAS float* s = scr + (8 * c) * 33 + n;
        u32x4 o; o.x = cvtpk(s[0 * 33], s[1 * 33]); o.y = cvtpk(s[2 * 33], s[3 * 33]); o.z = cvtpk(s[4 * 33], s[5 * 33]); o.w = cvtpk(s[6 * 33], s[7 * 33]);
        *(u32x4*)(WT + (size_t)(row0 + n) * K + k0 + 8 * c) = o; }
    asm volatile("s_waitcnt lgkmcnt(0)" ::: "memory");
}
__device__ __forceinline__ void p0_transpose_item_f8(const float* W, int K, int N, unsigned char* WT, int k0, int n0, int row0, LAS float* scr, int lane) {
#pragma unroll 8
    for (int i = 0; i < 32; ++i) { const int kk = 2 * i + (lane >> 5); scr[kk * 33 + (lane & 31)] = W[(size_t)(k0 + kk) * N + n0 + (lane & 31)]; }
    asm volatile("s_waitcnt lgkmcnt(0)" ::: "memory");
    const int c = lane & 7;
#pragma unroll
    for (int j = 0; j < 4; ++j) { const int n = (lane >> 3) + 8 * j; const LAS float* s = scr + (8 * c) * 33 + n;
        u32x2 o; o.x = cvt4_fp8(256.f * s[0 * 33], 256.f * s[1 * 33], 256.f * s[2 * 33], 256.f * s[3 * 33]); o.y = cvt4_fp8(256.f * s[4 * 33], 256.f * s[5 * 33], 256.f * s[6 * 33], 256.f * s[7 * 33]);
        *(u32x2*)(WT + (size_t)(row0 + n) * K + k0 + 8 * c) = o; }
    asm volatile("s_waitcnt lgkmcnt(0)" ::: "memory");
}
__device__ __forceinline__ void p0_prologue(const Frame& F, const Args& a) {
    LAS float* scr = (LAS float*)(F.lds + F.wave * 16384);
    const int gw = F.vcu * 8 + F.wave, NGW = F.G * 8;
    bf16_t* WinT = (bf16_t*)(a.ws + WS_WIN); bf16_t* WoutT = (bf16_t*)(a.ws + WS_WOUT); bf16_t* WupT = (bf16_t*)(a.ws + WS_WUP); bf16_t* WdnT = (bf16_t*)(a.ws + WS_WDN);
    constexpr int I_IN = 16 * 96, I_OUT = 16 * 32, I_UP = 16 * 64, I_DN = 16 * 32;
    constexpr int NITEMS = I_IN + I_OUT + NE * I_UP + NE * I_DN;
    for (int it = gw; it < NITEMS; it += NGW) {
        int r = it;
        if (r < I_IN) { const int kb = r / 96, nb = r % 96; p0_transpose_item(a.w_in, DM, NPROJ, WinT, 64 * kb, 32 * nb, 32 * nb, scr, F_LANE); continue; } r -= I_IN;
        if (r < I_OUT) { const int kb = r / 32, nb = r % 32; p0_transpose_item(a.w_out, DM, DM, WoutT, 64 * kb, 32 * nb, 32 * nb, scr, F_LANE); continue; } r -= I_OUT;
        if (r < NE * I_UP) { const int e = r / I_UP, q = r % I_UP, kb = q / 64, nb = q % 64, n0 = 32 * nb;
            const int nn = n0 & 1023, row0 = (nn >> 7) * 256 + (n0 >> 10) * 128 + (nn & 127);
            p0_transpose_item_f8(a.w_up + (size_t)e * DM * 2048, DM, 2048, (unsigned char*)WupT + (size_t)e * 2048 * DM, 64 * kb, n0, row0, scr, F_LANE); continue; } r -= NE * I_UP;
        { const int e = r / I_DN, q = r % I_DN, kb = q / 32, nb = q % 32; p0_transpose_item_f8(a.w_down + (size_t)e * DFF * DM, DFF, DM, (unsigned char*)WdnT + (size_t)e * DM * DFF, 64 * kb, 32 * nb, 32 * nb, scr, F_LANE); }
    }
    bf16_t* XB = (bf16_t*)(a.ws + WS_XB);
    for (int m = gw; m < NTOK; m += NGW) {
        const f32x4* xr = (const f32x4*)(a.x + (size_t)m * DM) + F_LANE; unsigned long long* o8 = (unsigned long long*)(XB + (size_t)m * DM) + F_LANE;
#pragma unroll
        for (int j = 0; j < 4; ++j) { const f32x4 v = xr[64 * j]; o8[64 * j] = (unsigned long long)cvtpk(v[0], v[1]) | ((unsigned long long)cvtpk(v[2], v[3]) << 32); }
    }
}

__device__ __forceinline__ void glds16(const void* gsrc, unsigned lds_dst) { unsigned keep;
    asm volatile("s_mov_b32 %0, m0\n\ts_mov_b32 m0, %2\n\ts_nop 0\n\tglobal_load_lds_dwordx4 %1, off\n\ts_mov_b32 m0, %0" : "=&s"(keep) : "v"(gsrc), "s"(lds_dst) : "memory"); }
__device__ __forceinline__ int crow(int r, int hi) { return (r & 3) + 8 * (r >> 2) + 4 * hi; }
typedef LAS const char* lds_cptr;
typedef short v4i16_t __attribute__((ext_vector_type(4)));
__device__ __forceinline__ s16x4 vtr(lds_cptr p) { return __builtin_bit_cast(s16x4, __builtin_amdgcn_ds_read_tr16_b64_v4i16((LAS v4i16_t*)p)); }
#define MX3(a, b, c) __builtin_fmaxf(__builtin_fmaxf((a), (b)), (c))
__device__ __forceinline__ float rowmax(const f32x16& p0, const f32x16& p1) {
    float a = MX3(p0[0], p0[1], p1[0]), b = MX3(p0[2], p0[3], p1[1]); a = MX3(a, p1[2], p1[3]);
#pragma unroll
    for (int r = 4; r < 16; r += 4) { a = MX3(a, p0[r], p0[r + 1]); b = MX3(b, p0[r + 2], p0[r + 3]); a = MX3(a, p1[r], p1[r + 1]); b = MX3(b, p1[r + 2], p1[r + 3]); }
    float m = __builtin_fmaxf(a, b); auto rr = __builtin_amdgcn_permlane32_swap(__float_as_uint(m), __float_as_uint(m), false, false);
    return __builtin_fmaxf(__uint_as_float(rr[0]), __uint_as_float(rr[1]));
}
__device__ __forceinline__ float halfsum(float v) { auto rr = __builtin_amdgcn_permlane32_swap(__float_as_uint(v), __float_as_uint(v), false, false); return __uint_as_float(rr[0]) + __uint_as_float(rr[1]); }
#define MFMA32(a, b, c) __builtin_amdgcn_mfma_f32_32x32x16_bf16(a, b, c, 0, 0, 0)

template <int ND>
__device__ __forceinline__ void softmax_tile(f32x16& p0, f32x16& p1, float& mhat, float& lsum, f32x16 (&o)[ND], u32x4 (&pw)[4]) {
    const float rm = rowmax(p0, p1);
    const float mnew = __builtin_fmaxf(mhat, rm);
    if (__any(mnew != mhat)) {
        const float al = __builtin_amdgcn_exp2f(mhat - mnew); lsum *= al;
#pragma unroll
        for (int d = 0; d < ND; ++d)
#pragma unroll
            for (int r = 0; r < 16; ++r) o[d][r] *= al;
        mhat = mnew;
    }
    float s = 0.f;
#pragma unroll
    for (int r = 0; r < 16; ++r) { p0[r] = __builtin_amdgcn_exp2f(p0[r] - mhat); p1[r] = __builtin_amdgcn_exp2f(p1[r] - mhat); s += p0[r] + p1[r]; }
    lsum += s;
    pw[0] = (u32x4){cvtpk(p0[0], p0[1]), cvtpk(p0[2], p0[3]), cvtpk(p0[4], p0[5]), cvtpk(p0[6], p0[7])};
    pw[1] = (u32x4){cvtpk(p0[8], p0[9]), cvtpk(p0[10], p0[11]), cvtpk(p0[12], p0[13]), cvtpk(p0[14], p0[15])};
    pw[2] = (u32x4){cvtpk(p1[0], p1[1]), cvtpk(p1[2], p1[3]), cvtpk(p1[4], p1[5]), cvtpk(p1[6], p1[7])};
    pw[3] = (u32x4){cvtpk(p1[8], p1[9]), cvtpk(p1[10], p1[11]), cvtpk(p1[12], p1[13]), cvtpk(p1[14], p1[15])};
}
template <int ND>
__device__ __forceinline__ void pv_tile(f32x16 (&o)[ND], lds_cptr vbase, const u32x4 (&pw)[4]) {
#pragma unroll
    for (int d0 = 0; d0 < ND; ++d0)
#pragma unroll
        for (int ks = 0; ks < 4; ++ks) {
            const s16x4 lo = vtr(vbase + d0 * 4096 + ks * 1024), hi = vtr(vbase + d0 * 4096 + ks * 1024 + 512);
            const bf16x8 vf = (bf16x8){lo[0], lo[1], lo[2], lo[3], hi[0], hi[1], hi[2], hi[3]};
            o[d0] = MFMA32(vf, __builtin_bit_cast(bf16x8, pw[ks]), o[d0]);
        }
}

template <bool FAST>
__device__ __forceinline__ void attnB_unit(const Frame& F, const Args& a, int b, int h, int qblk, float lam, int t_lo, int t_hi, float kn0, float kn1) {
    const int lane = F_LANE, r32 = lane & 31, hi = lane >> 5, wid = F.wave, c = wid >> 2, qs = wid & 3;
    const bf16_t* QD = (const bf16_t*)(a.ws + WS_PROJ) + 3 * PROJ_STRIDE; const bf16_t* KD = QD + PROJ_STRIDE; const bf16_t* VD = KD + PROJ_STRIDE;
    const size_t rowbase = (size_t)b * SEQ; const int q0 = qblk * 128, qpos = q0 + 32 * qs + r32;
    bf16x8 qr[4];
    { const bf16_t* Qp = QD + (rowbase + qpos) * 512 + h * 128 + c * 64 + 8 * hi;
#pragma unroll
      for (int d0 = 0; d0 < 4; ++d0) qr[d0] = *(const bf16x8*)(Qp + 16 * d0); }
    float ref = 0.f;
    { float qq = 0.f;
#pragma unroll
        for (int d0 = 0; d0 < 4; ++d0)
#pragma unroll
            for (int j = 0; j < 8; ++j) { const float v = __uint_as_float((unsigned)(unsigned short)qr[d0][j] << 16); qq += v * v; }
        qq = halfsum(qq); asm volatile("" : "+v"(qq));
        if (FAST) ref = sqrtf(qq) * (c ? kn1 : kn0) * 1.01f + 0.01f; }
    const float slope2 = __builtin_amdgcn_exp2f(-2.0f * (float)(h + 1)) * LOG2E;
    const bf16_t* tsrc = KD + (size_t)((b * 4 + h) * 256) * 16384 + wid * 2048 + lane * 8;
    LAS unsigned char* L = F.lds;
    const unsigned dbase = (unsigned)(uintptr_t)L + (unsigned)wid * 4096u;
#define B_DMA(tt, slot) do { const bf16_t* _k = tsrc + (size_t)(tt) * 16384; const unsigned _d = (unsigned)__builtin_amdgcn_readfirstlane((int)(dbase + (unsigned)(slot) * 32768u)); unsigned _keep; \
        asm volatile("s_mov_b32 %0, m0\n\ts_mov_b32 m0, %2\n\ts_nop 0\n\tglobal_load_lds_dwordx4 %1, off\n\tglobal_load_lds_dwordx4 %1, off offset:1024\n\tglobal_load_lds_dwordx4 %1, off offset:2048\n\tglobal_load_lds_dwordx4 %1, off offset:3072\n\ts_mov_b32 m0, %0" \
                     : "=&s"(_keep) : "v"(_k), "s"(_d) : "memory"); } while (0)
#define WAIT_BAR(N) asm volatile("s_waitcnt vmcnt(" #N ") lgkmcnt(0)\n\ts_barrier" ::: "memory")
#define SBAR() __builtin_amdgcn_sched_barrier(0)
#define PIN(x) asm volatile("" : "+v"(x))
#define VFRAG(dst, base, d0, ks) do { const s16x4 lo_ = vtr((base) + (d0) * 4096 + (ks) * 1024), hi_ = vtr((base) + (d0) * 4096 + (ks) * 1024 + 512); \
        dst = (bf16x8){lo_[0], lo_[1], lo_[2], lo_[3], hi_[0], hi_[1], hi_[2], hi_[3]}; } while (0)
#define GEN_C(tt) do { const float dq = (float)(qpos - (tt) * 64 - 4 * hi); \
        _Pragma("unroll") for (int r = 0; r < 16; ++r) { const float kk = (float)((r & 3) + 8 * (r >> 2)); C0[r] = -slope2 * __builtin_fabsf(dq - kk) - ref; C1[r] = -slope2 * __builtin_fabsf(dq - 32.f - kk) - ref; } } while (0)
    float mhat = NEG_BIG, lsum = 0.f; f32x16 o[4];
#pragma unroll
    for (int d = 0; d < 4; ++d) o[d] = (f32x16){};
    const int koff = (c * 8 + hi) * 1024 + r32 * 16;
    const int voff = 16384 + ((lane >> 4) & 1) * 32 + (lane & 3) * 8 + (4 * hi + ((lane & 15) >> 2)) * 64;
    const int tdiag = q0 >> 6;
    f32x16 C0, C1;
    u32x4 pw[4];
    const int NT = t_hi - t_lo + 1;
    GEN_C(t_lo);
    B_DMA(t_lo, 0); if (NT > 1) B_DMA(t_lo + 1, 1); if (NT > 2) B_DMA(t_lo + 2, 2);
    int sl = 0;
    for (int tau = 0; tau < NT; ++tau) {
        if (tau + 2 < NT) WAIT_BAR(8); else if (tau + 1 < NT) WAIT_BAR(4); else WAIT_BAR(0);
        if (tau + 3 < NT) B_DMA(t_lo + tau + 3, (sl + 3) & 3);
        const int t = t_lo + tau; const LAS unsigned char* buf = L + sl * 32768; const lds_cptr vbase = (lds_cptr)(buf + voff);
        bf16x8 kf[8];
#pragma unroll
        for (int d0 = 0; d0 < 4; ++d0) { kf[2 * d0] = *(const LAS bf16x8*)(buf + koff + d0 * 2048); kf[2 * d0 + 1] = *(const LAS bf16x8*)(buf + koff + d0 * 2048 + 512); }
        SBAR();
        f32x16 p0, p1;
        if constexpr (FAST) {
            bf16x8 vA[4], vB[4]; float sacc = 0.f;
#define EXPS(P, A, B) do { _Pragma("unroll") for (int r = (A); r < (B); ++r) { P[r] = __builtin_amdgcn_exp2f(P[r]); sacc += P[r]; } PIN(P); PIN(sacc); } while (0)
#define PK4(P, B) (u32x4){cvtpk(P[B], P[B + 1]), cvtpk(P[B + 2], P[B + 3]), cvtpk(P[B + 4], P[B + 5]), cvtpk(P[B + 6], P[B + 7])}
#define PWF(k) __builtin_bit_cast(bf16x8, pw[k])
            const float st = (t + 1 < tdiag) ? 64.f * slope2 : -64.f * slope2;
            p0 = MFMA32(kf[0], qr[0], C0); SBAR(); VFRAG(vA[0], vbase, 0, 0); SBAR();
            p0 = MFMA32(kf[2], qr[1], p0); SBAR(); VFRAG(vA[1], vbase, 1, 0); SBAR();
            p0 = MFMA32(kf[4], qr[2], p0); SBAR(); VFRAG(vA[2], vbase, 2, 0); SBAR();
            p0 = MFMA32(kf[6], qr[3], p0); SBAR(); VFRAG(vA[3], vbase, 3, 0); SBAR();
            p1 = MFMA32(kf[1], qr[0], C1); SBAR();
            p1 = MFMA32(kf[3], qr[1], p1); SBAR(); EXPS(p0, 0, 5); SBAR();
            p1 = MFMA32(kf[5], qr[2], p1); SBAR(); EXPS(p0, 5, 11); SBAR();
            p1 = MFMA32(kf[7], qr[3], p1); SBAR(); EXPS(p0, 11, 16); pw[0] = PK4(p0, 0); PIN(pw[0]); SBAR();
            o[0] = MFMA32(vA[0], PWF(0), o[0]); SBAR(); pw[1] = PK4(p0, 8); PIN(pw[1]); VFRAG(vB[0], vbase, 0, 1); SBAR();
            o[1] = MFMA32(vA[1], PWF(0), o[1]); SBAR(); EXPS(p1, 0, 3); VFRAG(vB[1], vbase, 1, 1); SBAR();
            o[2] = MFMA32(vA[2], PWF(0), o[2]); SBAR(); EXPS(p1, 3, 6); VFRAG(vB[2], vbase, 2, 1); SBAR();
            o[3] = MFMA32(vA[3], PWF(0), o[3]); SBAR(); EXPS(p1, 6, 8); VFRAG(vB[3], vbase, 3, 1); SBAR();
            o[0] = MFMA32(vB[0], PWF(1), o[0]); SBAR(); EXPS(p1, 8, 10); VFRAG(vA[0], vbase, 0, 2); SBAR();
            o[1] = MFMA32(vB[1], PWF(1), o[1]); SBAR(); EXPS(p1, 10, 12); VFRAG(vA[1], vbase, 1, 2); SBAR();
            o[2] = MFMA32(vB[2], PWF(1), o[2]); SBAR(); EXPS(p1, 12, 14); VFRAG(vA[2], vbase, 2, 2); SBAR();
            o[3] = MFMA32(vB[3], PWF(1), o[3]); SBAR(); EXPS(p1, 14, 16); VFRAG(vA[3], vbase, 3, 2); pw[2] = PK4(p1, 0); PIN(pw[2]); SBAR();
            o[0] = MFMA32(vA[0], PWF(2), o[0]); SBAR(); pw[3] = PK4(p1, 8); PIN(pw[3]); VFRAG(vB[0], vbase, 0, 3); SBAR();
            o[1] = MFMA32(vA[1], PWF(2), o[1]); SBAR(); VFRAG(vB[1], vbase, 1, 3);
#pragma unroll
            for (int r = 0; r < 8; ++r) C0[r] += st;
            PIN(C0); SBAR();
            o[2] = MFMA32(vA[2], PWF(2), o[2]); SBAR(); VFRAG(vB[2], vbase, 2, 3);
#pragma unroll
            for (int r = 8; r < 16; ++r) C0[r] += st;
            PIN(C0); SBAR();
            o[3] = MFMA32(vA[3], PWF(2), o[3]); SBAR(); VFRAG(vB[3], vbase, 3, 3);
#pragma unroll
            for (int r = 0; r < 8; ++r) C1[r] += st;
            PIN(C1); SBAR();
            o[0] = MFMA32(vB[0], PWF(3), o[0]); SBAR();
#pragma unroll
            for (int r = 8; r < 16; ++r) C1[r] += st;
            PIN(C1); SBAR();
            o[1] = MFMA32(vB[1], PWF(3), o[1]);
            o[2] = MFMA32(vB[2], PWF(3), o[2]);
            o[3] = MFMA32(vB[3], PWF(3), o[3]);
            lsum += sacc;
#undef EXPS
#undef PK4
#undef PWF
        } else {
            p0 = MFMA32(kf[0], qr[0], C0); p1 = MFMA32(kf[1], qr[0], C1);
#pragma unroll
            for (int d0 = 1; d0 < 4; ++d0) { p0 = MFMA32(kf[2 * d0], qr[d0], p0); p1 = MFMA32(kf[2 * d0 + 1], qr[d0], p1); }
            softmax_tile<4>(p0, p1, mhat, lsum, o, pw);
            pv_tile<4>(o, vbase, pw);
            const float st = (t + 1 < tdiag) ? 64.f * slope2 : -64.f * slope2; C0 = C0 + st; C1 = C1 + st;
        }
        if ((t + 1 >= tdiag && t + 1 <= tdiag + 2) || ((tau + 1) & 15) == 0) GEN_C(t + 1);
        sl = (sl + 1) & 3;
    }
#undef B_DMA
#undef WAIT_BAR
#undef VFRAG
#undef GEN_C
#undef SBAR
#undef PIN
    const float inv = 1.0f / halfsum(lsum);
    LAS float* ex = (LAS float*)(L + 65536);
    __syncthreads();
    if (c == 1) {
#pragma unroll
        for (int d0 = 0; d0 < 4; ++d0)
#pragma unroll
            for (int r = 0; r < 16; ++r) ex[(qs * 128 + 32 * d0 + crow(r, hi)) * 32 + r32] = o[d0][r] * inv;
    }
    __syncthreads();
    if (c == 0) {
        float ss = 0.f;
#pragma unroll
        for (int d0 = 0; d0 < 4; ++d0)
#pragma unroll
            for (int r = 0; r < 16; ++r) { const float v = o[d0][r] * inv - lam * ex[(qs * 128 + 32 * d0 + crow(r, hi)) * 32 + r32]; o[d0][r] = v; ss += v * v; }
        ss = halfsum(ss);
        const float rs = __builtin_amdgcn_rsqf(ss * (1.0f / 128.0f) + LN_EPS) * (1.0f - LAM_INIT);
        bf16_t* op = (bf16_t*)(a.ws + WS_MIXED) + (rowbase + qpos) * DM + 512 + h * 128 + 4 * hi;
#pragma unroll
        for (int d0 = 0; d0 < 4; ++d0)
#pragma unroll
            for (int g = 0; g < 4; ++g) { const int dv = 32 * d0 + 8 * g + 4 * hi; const f32x4 gs = *(const f32x4*)(a.g_sub + dv);
                u32x2 w; w.x = cvtpk(o[d0][4 * g] * rs * gs[0], o[d0][4 * g + 1] * rs * gs[1]); w.y = cvtpk(o[d0][4 * g + 2] * rs * gs[2], o[d0][4 * g + 3] * rs * gs[3]);
                *(u32x2*)(op + 32 * d0 + 8 * g) = w; }
    }
    __syncthreads();
}
__device__ __forceinline__ void attnB_item(const Frame& F, const Args& a, int h, int b, int qblk, float lam) {
    const int q0 = qblk * 128;
    const unsigned* ctl = (const unsigned*)(a.ws + WS_CTL); const int sl = (b * 4 + h) * 4;
    const float qn0 = sqrtf(__uint_as_float(ctl[CW_QMAX + sl]) + __uint_as_float(ctl[CW_QMAX + sl + 1])), qn1 = sqrtf(__uint_as_float(ctl[CW_QMAX + sl + 2]) + __uint_as_float(ctl[CW_QMAX + sl + 3]));
    const float kn0 = sqrtf(__uint_as_float(ctl[CW_KMAX + sl]) + __uint_as_float(ctl[CW_KMAX + sl + 1])), kn1 = sqrtf(__uint_as_float(ctl[CW_KMAX + sl + 2]) + __uint_as_float(ctl[CW_KMAX + sl + 3]));
    const float U = fmaxf(qn0 * kn0, qn1 * kn1) * 1.01f + 0.01f;
    const float slope2 = __builtin_amdgcn_exp2f(-2.0f * (float)(h + 1)) * LOG2E;
    const float Df = (2.0f * U + 152.0f) / slope2;
    const int Dd = Df < 40000.f ? (int)Df + 2 : 40000;
    int t_lo = (q0 - Dd) >> 6; if (q0 - Dd < 0) t_lo = 0;
    int t_hi = (q0 + 127 + Dd) >> 6; if (t_hi > SEQ / 64 - 1) t_hi = SEQ / 64 - 1;
    if (U <= 40.f) attnB_unit<true>(F, a, b, h, qblk, lam, t_lo, t_hi, kn0, kn1);
    else attnB_unit<false>(F, a, b, h, qblk, lam, t_lo, t_hi, kn0, kn1);
}

__device__ __forceinline__ int a_kbase(int n0, int it) { return n0 - 64 + 64 * ((it == 0) ? 1 : (it == 1 ? 0 : 2)); }
__device__ __forceinline__ void a_load_k(const bf16_t* KA, size_t rowbase, int head, int d, int r, int L, int kbase, int r32, int hi, bf16x8 (&kf)[8]) {
#pragma unroll
    for (int kh = 0; kh < 2; ++kh) { int kn = kbase + 32 * kh + r32; kn = kn < 0 ? 0 : (kn >= L ? L - 1 : kn);
        const bf16_t* Kp = KA + (rowbase + (size_t)(d * kn + r)) * 512 + head * 64 + 8 * hi;
#pragma unroll
        for (int d0 = 0; d0 < 4; ++d0) kf[2 * d0 + kh] = *(const bf16x8*)(Kp + 16 * d0); }
}
__device__ __forceinline__ void attnA_task(const Frame& F, const Args& a, int b, int head, int d, int r, int n0, int L, LAS unsigned char* vw, f32x16 (&o)[2], float& mhat, float& ltot) {
    const int lane = F_LANE, r32 = lane & 31, hi = lane >> 5;
    const bf16_t* QA = (const bf16_t*)(a.ws + WS_PROJ); const bf16_t* KA = QA + PROJ_STRIDE; const bf16_t* VA = KA + PROJ_STRIDE;
    const size_t rowbase = (size_t)b * SEQ; const int qn = n0 + r32;
    bf16x8 qr[4], kf[8], kfn[8];
    { const bf16_t* Qp = QA + (rowbase + (size_t)(d * qn + r)) * 512 + head * 64 + 8 * hi;
#pragma unroll
      for (int d0 = 0; d0 < 4; ++d0) qr[d0] = *(const bf16x8*)(Qp + 16 * d0); }
    a_load_k(KA, rowbase, head, d, r, L, a_kbase(n0, 0), r32, hi, kf);
    const float sl = __builtin_amdgcn_exp2f(-(float)(head + 1)) * LOG2E * (float)d;
    mhat = NEG_BIG; float lsum = 0.f; o[0] = (f32x16){}; o[1] = (f32x16){};
    const int voff = ((lane >> 4) & 1) * 32 + (lane & 3) * 8 + (4 * hi + ((lane & 15) >> 2)) * 64;
#pragma unroll
    for (int it = 0; it < 3; ++it) {
        const int kbase = a_kbase(n0, it);
        u32x4 vv[8];
#pragma unroll
        for (int ks = 0; ks < 4; ++ks) { int kn = kbase + 16 * ks + (lane >> 2); kn = kn < 0 ? 0 : (kn >= L ? L - 1 : kn);
            const bf16_t* Vp = VA + (rowbase + (size_t)(d * kn + r)) * 512 + head * 64 + 8 * (lane & 3);
            vv[ks] = *(const u32x4*)Vp; vv[4 + ks] = *(const u32x4*)(Vp + 32); }
        if (it < 2) a_load_k(KA, rowbase, head, d, r, L, a_kbase(n0, it + 1), r32, hi, kfn);
        __builtin_amdgcn_sched_barrier(0);
        f32x16 p0, p1;
#pragma unroll
        for (int rr = 0; rr < 16; ++rr) { const int k0 = kbase + crow(rr, hi), k1 = k0 + 32; const int d0_ = k0 - qn, d1_ = k1 - qn;
            const bool v0 = (k0 >= 0) && (k0 < L) && (d0_ <= 64) && (d0_ >= -64), v1 = (k1 >= 0) && (k1 < L) && (d1_ <= 64) && (d1_ >= -64);
            p0[rr] = v0 ? -sl * __builtin_fabsf((float)d0_) : NEG_BIG; p1[rr] = v1 ? -sl * __builtin_fabsf((float)d1_) : NEG_BIG; }
#pragma unroll
        for (int d0 = 0; d0 < 4; ++d0) { p0 = MFMA32(kf[2 * d0], qr[d0], p0); p1 = MFMA32(kf[2 * d0 + 1], qr[d0], p1); }
        u32x4 pw[4];
        softmax_tile<2>(p0, p1, mhat, lsum, o, pw);
        __builtin_amdgcn_sched_barrier(0);
#pragma unroll
        for (int i = 0; i < 8; ++i) *(LAS u32x4*)(vw + i * 1024 + lane * 16) = vv[i];
        asm volatile("s_waitcnt lgkmcnt(0)" ::: "memory");
        pv_tile<2>(o, (lds_cptr)(vw + voff), pw);
        asm volatile("s_waitcnt lgkmcnt(0)" ::: "memory");
        if (it < 2) {
#pragma unroll
            for (int j = 0; j < 8; ++j) kf[j] = kfn[j];
        }
    }
    ltot = halfsum(lsum);
}
__device__ __forceinline__ void attnA_unit(const Frame& F, const Args& a, int unit) {
    const int lane = F_LANE, r32 = lane & 31, hi = lane >> 5, wid = F.wave;
    const int b = unit >> 7, head = (unit >> 4) & 7, tb = unit & 15, T0 = tb * 1024;
    float* part = (float*)(a.ws + WS_APART + (size_t)unit * APART_UNIT); float* ml = part + 2 * 1024 * 64;
    LAS unsigned char* vw = F.lds + wid * 8192;
    for (int task = wid; task < 64; task += 8) {
        int pat, d, r, n0, L;
        if (task < 32) { pat = 0; d = 16; r = task >> 1; n0 = T0 / 16 + 32 * (task & 1); L = SEQ / 16; }
        else { const int tt = task - 32; pat = 1; d = 4; r = tt >> 3; n0 = T0 / 4 + 32 * (tt & 7); L = SEQ / 4; }
        f32x16 o[2]; float mhat, ltot;
        attnA_task(F, a, b, head, d, r, n0, L, vw, o, mhat, ltot);
        const int tl = d * (n0 + r32) + r - T0;
        float* pp = part + ((size_t)pat * 1024 + tl) * 64 + 4 * hi;
#pragma unroll
        for (int d0 = 0; d0 < 2; ++d0)
#pragma unroll
            for (int g = 0; g < 4; ++g) *(f32x4*)(pp + 32 * d0 + 8 * g) = (f32x4){o[d0][4 * g], o[d0][4 * g + 1], o[d0][4 * g + 2], o[d0][4 * g + 3]};
        if (hi == 0) *(f32x2*)(ml + ((size_t)pat * 1024 + tl) * 2) = (f32x2){mhat, ltot};
    }
    asm volatile("s_waitcnt vmcnt(0)" ::: "memory");
    __syncthreads();
    __builtin_amdgcn_fence(__ATOMIC_ACQUIRE, "agent");
    for (int task = wid; task < 32; task += 8) {
        const int n0 = T0 + 32 * task;
        f32x16 o[2]; float m0, l0;
        attnA_task(F, a, b, head, 1, 0, n0, SEQ, vw, o, m0, l0);
        const int tl = 32 * task + r32;
        const f32x2 ml1 = *(const f32x2*)(ml + ((size_t)0 * 1024 + tl) * 2), ml2 = *(const f32x2*)(ml + ((size_t)1 * 1024 + tl) * 2);
        const float M = MX3(m0, ml1[0], ml2[0]);
        const float w0 = __builtin_amdgcn_exp2f(m0 - M), w1 = __builtin_amdgcn_exp2f(ml1[0] - M), w2 = __builtin_amdgcn_exp2f(ml2[0] - M);
        const float rden = 1.0f / (w0 * l0 + w1 * ml1[1] + w2 * ml2[1]);
        const float* p1 = part + ((size_t)0 * 1024 + tl) * 64 + 4 * hi; const float* p2 = part + ((size_t)1 * 1024 + tl) * 64 + 4 * hi;
        bf16_t* op = (bf16_t*)(a.ws + WS_MIXED) + ((size_t)b * SEQ + T0 + tl) * DM + head * 64 + 4 * hi;
#pragma unroll
        for (int d0 = 0; d0 < 2; ++d0)
#pragma unroll
            for (int g = 0; g < 4; ++g) { const f32x4 a1 = *(const f32x4*)(p1 + 32 * d0 + 8 * g), a2 = *(const f32x4*)(p2 + 32 * d0 + 8 * g); float v[4];
#pragma unroll
                for (int j = 0; j < 4; ++j) v[j] = (w0 * o[d0][4 * g + j] + w1 * a1[j] + w2 * a2[j]) * rden;
                u32x2 w; w.x = cvtpk(v[0], v[1]); w.y = cvtpk(v[2], v[3]); *(u32x2*)(op + 32 * d0 + 8 * g) = w; }
    }
    __syncthreads();
}

__device__ __forceinline__ unsigned ordkey(float v) { const unsigned u = __float_as_uint(v); return u ^ ((u >> 31) ? 0xFFFFFFFFu : 0x80000000u); }
__device__ __forceinline__ float unordkey(unsigned k) { const unsigned u = (k & 0x80000000u) ? (k ^ 0x80000000u) : ~k; return __uint_as_float(u); }
__device__ __forceinline__ void p4_ln_router(const Frame& F, const Args& a) {
    const int lane = F_LANE, wid = F.wave, tid = F_TID;
    LAS float* Wr = (LAS float*)F.lds;
    LAS unsigned* misc = (LAS unsigned*)(F.lds + LX_MISC);
    LAS float* pc = (LAS float*)(F.lds + LX_TOK);
    for (int i = tid; i < DM * NE / 4; i += 512) ((LAS f32x4*)Wr)[i] = ((const f32x4*)a.w_router)[i] * a.ln1_g[i >> 3];
    if (tid < 64) misc[tid] = 0u;
    float* Z = (float*)(a.ws + WS_Z); bf16_t* X1B = (bf16_t*)(a.ws + WS_XB);
    const int r0 = (F.vcu * 8 + wid) * 16;
    const int rl = lane & 15, q = lane >> 4;
    float mym[4] = {0.f, 0.f, 0.f, 0.f}, myr[4] = {0.f, 0.f, 0.f, 0.f};
    {
        f32x4 gv[4], bv[4];
#pragma unroll
        for (int j = 0; j < 4; ++j) { gv[j] = ((const f32x4*)a.ln1_g)[lane + 64 * j]; bv[j] = ((const f32x4*)a.ln1_b)[lane + 64 * j]; }
        float* stats = (float*)(a.ws + WS_ROUTE + 4 * MiB);
#pragma unroll 4
        for (int rr = 0; rr < 16; ++rr) {
            const f32x4* zr = (const f32x4*)(Z + (size_t)(r0 + rr) * DM) + lane; f32x4 v[4]; float s = 0.f;
#pragma unroll
            for (int j = 0; j < 4; ++j) { v[j] = zr[64 * j]; s += (v[j][0] + v[j][1]) + (v[j][2] + v[j][3]); }
            const float mean = wave_sum(s) * (1.f / DM); float s2 = 0.f;
#pragma unroll
            for (int j = 0; j < 4; ++j) { v[j] = v[j] - mean; s2 += (v[j][0] * v[j][0] + v[j][1] * v[j][1]) + (v[j][2] * v[j][2] + v[j][3] * v[j][3]); }
            const float rstd = 1.f / sqrtf(wave_sum(s2) * (1.f / DM) + LN_EPS);
            unsigned* o8 = (unsigned*)((unsigned char*)X1B + (size_t)(r0 + rr) * DM) + lane;
#pragma unroll
            for (int j = 0; j < 4; ++j) { const f32x4 y = (v[j] * rstd * gv[j] + bv[j]) * 8.f; o8[64 * j] = cvt4_fp8(y[0], y[1], y[2], y[3]); }
            if (lane == 0) *(f32x2*)(stats + 2 * (r0 + rr)) = (f32x2){mean, rstd};
            if ((rr >> 2) == q) {
#pragma unroll
                for (int i = 0; i < 4; ++i) if ((rr & 3) == i) { mym[i] = mean; myr[i] = rstd; } }
        }
    }
    __syncthreads();
    {
        const int e = tid & 31, part = tid >> 5; float s0 = 0.f, s1 = 0.f;
        for (int k = part * 64; k < part * 64 + 64; ++k) { s0 += Wr[k * 32 + e]; s1 += a.ln1_b[k] * a.w_router[k * 32 + e]; }
        pc[part * 32 + e] = s0; pc[512 + part * 32 + e] = s1;
    }
    __syncthreads();
    if (tid < 64) { const int e = tid & 31, w = tid >> 5; float t = 0.f; for (int p = 0; p < 16; ++p) t += pc[w * 512 + p * 32 + e]; pc[1024 + tid] = t + (w ? a.b_router[e] : 0.f); }
    __syncthreads();
    f32x4 acc0 = (f32x4){0.f, 0.f, 0.f, 0.f}, acc1 = acc0;
    const float* xr = Z + (size_t)(r0 + rl) * DM + 4 * q;
#pragma unroll 4
    for (int cidx = 0; cidx < 64; ++cidx) {
        const f32x4 xv = *(const f32x4*)(xr + 16 * cidx);
#pragma unroll
        for (int j = 0; j < 4; ++j) { const int k = 16 * cidx + 4 * q + j;
            acc0 = __builtin_amdgcn_mfma_f32_16x16x4f32(xv[j], Wr[k * 32 + rl], acc0, 0, 0, 0);
            acc1 = __builtin_amdgcn_mfma_f32_16x16x4f32(xv[j], Wr[k * 32 + 16 + rl], acc1, 0, 0, 0); }
    }
    {   const float cs0 = pc[1024 + rl], cs1 = pc[1024 + 16 + rl], cb0 = pc[1024 + 32 + rl], cb1 = pc[1024 + 48 + rl];
#pragma unroll
        for (int i = 0; i < 4; ++i) { acc0[i] = myr[i] * (acc0[i] - mym[i] * cs0) + cb0; acc1[i] = myr[i] * (acc1[i] - mym[i] * cs1) + cb1; } }
    const float br0 = 0.f, br1 = 0.f;
    int* sel_e = (int*)(a.ws + WS_ROUTE); int* sel_pos = sel_e + NTOK * TOPK; float* sel_gate = (float*)(sel_pos + NTOK * TOPK);
    int my_e[4] = {0, 0, 0, 0}, my_lp[4] = {0, 0, 0, 0}; float my_g[4] = {0.f, 0.f, 0.f, 0.f};
#pragma unroll
    for (int i = 0; i < 4; ++i) {
        unsigned k0 = (ordkey(acc0[i] + br0) & ~31u) | (unsigned)(31 - rl), k1 = (ordkey(acc1[i] + br1) & ~31u) | (unsigned)(15 - rl);
        unsigned selk[4];
#pragma unroll
        for (int t = 0; t < 4; ++t) {
            unsigned m = k0 > k1 ? k0 : k1;
#pragma unroll
            for (int ofs = 1; ofs < 16; ofs <<= 1) { const unsigned other = (unsigned)__shfl_xor((int)m, ofs); m = other > m ? other : m; }
            selk[t] = m; if (k0 == m) k0 = 0u; if (k1 == m) k1 = 0u;
        }
        const float v0 = unordkey(selk[0] & ~31u), v1 = unordkey(selk[1] & ~31u), v2 = unordkey(selk[2] & ~31u), v3 = unordkey(selk[3] & ~31u);
        const float e1 = __expf(v1 - v0), e2 = __expf(v2 - v0), e3 = __expf(v3 - v0); const float rs = 1.0f / (1.0f + e1 + e2 + e3);
        if (rl < 4) { const unsigned sk = rl == 0 ? selk[0] : (rl == 1 ? selk[1] : (rl == 2 ? selk[2] : selk[3]));
            const float ge = rl == 0 ? 1.0f : (rl == 1 ? e1 : (rl == 2 ? e2 : e3));
            my_e[i] = 31 - (int)(sk & 31u); my_g[i] = ge * rs; my_lp[i] = (int)atomicAdd((unsigned*)&misc[my_e[i]], 1u); }
    }
    __syncthreads();
    unsigned* gcnt = (unsigned*)(a.ws + WS_CTL);
    if (F_TID < 32) misc[32 + F_TID] = atomicAdd(&gcnt[F_TID], misc[F_TID]);
    __syncthreads();
    if (rl < 4) {
#pragma unroll
        for (int i = 0; i < 4; ++i) { const int tok = r0 + 4 * q + i, idx = tok * 4 + rl; sel_e[idx] = my_e[i]; sel_pos[idx] = (int)misc[32 + my_e[i]] + my_lp[i]; sel_gate[idx] = my_g[i]; }
    }
}

__device__ __forceinline__ int build_tiles(const Frame& F, const Args& a) {
    LAS unsigned* misc = (LAS unsigned*)(F.lds + LX_MISC); LAS unsigned char* tile_e = F.lds + LX_TILE;
    const unsigned* gcnt = (const unsigned*)(a.ws + WS_CTL);
    if (F_TID < NE) misc[128 + F_TID] = (__hip_atomic_load(&gcnt[F_TID], __ATOMIC_RELAXED, __HIP_MEMORY_SCOPE_AGENT) + 255u) >> 8;
    __syncthreads();
    if (F_TID == 0) { unsigned acc = 0; for (int e = 0; e < NE; ++e) { misc[64 + e] = acc; acc += misc[128 + e]; } misc[64 + NE] = acc; }
    __syncthreads();
    const int nt = (int)misc[64 + NE];
    for (int e = 0; e < NE; ++e) { const int t0 = (int)misc[64 + e], t1 = (int)misc[65 + e]; for (int t = t0 + F_TID; t < t1; t += 512) tile_e[t] = (unsigned char)e; }
    __syncthreads();
    return nt;
}

#define XLAS __attribute__((address_space(3)))
#define XB_TMO      128
#define XB_XCNT(j)  (256  + 64 * (j))
#define XB_XSUB(j)  (1280 + 64 * (j))
#define XB_XGEN(j)  (2304 + 64 * (j))
#define XB_TOP      3328
#define XB_TOPGEN   3392
#define XCD_BAR_WORDS 3456
#define XB_SPIN_CAP (1u << 22)

__device__ __forceinline__ unsigned xb_ld(unsigned* p)              { return __hip_atomic_load(p, __ATOMIC_RELAXED, __HIP_MEMORY_SCOPE_AGENT); }
__device__ __forceinline__ unsigned xb_add(unsigned* p, unsigned v) { return __hip_atomic_fetch_add(p, v, __ATOMIC_RELAXED, __HIP_MEMORY_SCOPE_AGENT); }
__device__ __forceinline__ unsigned xb_xcc_id() { return (unsigned)__builtin_amdgcn_s_getreg((3 << 11) | 20) & 0xFu; }
#define XB_SPIN(cond, bar) do { unsigned _sp = 0; while (cond) { __builtin_amdgcn_s_sleep(1); \
    if ((++_sp & 255u) == 0u) { if (xb_ld(&(bar)[XB_TMO])) break; if (_sp > XB_SPIN_CAP) { atomicAdd(&(bar)[XB_TMO], 1u); break; } } } } while (0)

struct XcdBarrier {
    unsigned* bar; unsigned x;
    volatile XLAS unsigned* st;
};

__device__ __forceinline__ XcdBarrier xcd_barrier_post(unsigned* bar, volatile XLAS unsigned* st) {
    XcdBarrier b; b.bar = bar; b.x = xb_xcc_id(); b.st = st;
    if (threadIdx.x == 0) (void)xb_add(&bar[XB_XCNT(b.x)], 1u);
    return b;
}
__device__ __forceinline__ void xcd_barrier_complete(unsigned* bar, unsigned x, unsigned& nloc, unsigned& nx) {
    const unsigned G = gridDim.x * gridDim.y * gridDim.z;
    unsigned sum, cnt, mine, sp = 0u;
    for (;;) {
        sum = 0u; cnt = 0u; mine = 0u;
#pragma unroll
        for (unsigned j = 0; j < 16; ++j) { const unsigned c = xb_ld(&bar[XB_XCNT(j)]); sum += c; cnt += (c > 0u) ? 1u : 0u; mine = (j == x) ? c : mine; }
        if (sum == G) break;
        __builtin_amdgcn_s_sleep(1);
        if ((++sp & 255u) == 0u) { if (xb_ld(&bar[XB_TMO])) break; if (sp > XB_SPIN_CAP) { atomicAdd(&bar[XB_TMO], 1u); break; } }
    }
    nloc = mine > 0u ? mine : 1u; nx = cnt > 0u ? cnt : 1u;
}

__device__ __forceinline__ void xcd_barrier(const XcdBarrier& b, const int tid0) {
    asm volatile("s_waitcnt vmcnt(0)" ::: "memory");
    __syncthreads();
    if (tid0 == 0) {
        unsigned* bar = b.bar;
        __builtin_amdgcn_s_waitcnt(0);
        unsigned nloc = b.st[0], nx = b.st[1];
        if (nloc == 0u) { xcd_barrier_complete(bar, b.x, nloc, nx); b.st[0] = nloc; b.st[1] = nx; }
        const unsigned old = xb_add(&bar[XB_XSUB(b.x)], 1u);
        const unsigned gen = old / nloc;
        if (old + 1u == (gen + 1u) * nloc) {
            __builtin_amdgcn_fence(__ATOMIC_RELEASE, "agent");
            asm volatile("s_waitcnt vmcnt(0)" ::: "memory");
            const unsigned og = xb_add(&bar[XB_TOP], 1u);
            const unsigned tg = og / nx;
            if (og + 1u == (tg + 1u) * nx) xb_add(&bar[XB_TOPGEN], 1u);
            else XB_SPIN(xb_ld(&bar[XB_TOPGEN]) == tg, bar);
            __builtin_amdgcn_fence(__ATOMIC_ACQUIRE, "agent");
            xb_add(&bar[XB_XGEN(b.x)], 1u);
            asm volatile("s_waitcnt vmcnt(0)" ::: "memory");
        } else {
            XB_SPIN(xb_ld(&bar[XB_XGEN(b.x)]) == gen, bar);
            __builtin_amdgcn_fence(__ATOMIC_ACQUIRE, "agent");
            asm volatile("s_waitcnt vmcnt(0)" ::: "memory");
        }
    }
    __syncthreads();
}

__global__ void __launch_bounds__(512, 2) fwd_megakernel(Args a) {
    extern __shared__ __attribute__((aligned(16))) unsigned char lds_raw[];
    cg::grid_group grid = cg::this_grid();
    Frame F; F.lds = (LAS unsigned char*)lds_raw; F.wave = __builtin_amdgcn_readfirstlane((int)(threadIdx.x >> 6));
    F.G = gridDim.x; { const int bx = blockIdx.x; F.vcu = (F.G % 8 == 0) ? (bx % 8) * (F.G / 8) + bx / 8 : bx; }
    unsigned char* ws = a.ws;
    {   LAS unsigned* m0_ = (LAS unsigned*)(F.lds + LX_MISC); if (F_TID < 128) m0_[F_TID] = 0u; __syncthreads(); }
    XcdBarrier xbar = xcd_barrier_post((unsigned*)(ws + WS_CTL) + CW_BAR, (volatile LAS unsigned*)(F.lds + LX_MISC) + 120);
#define GRID_BAR() xcd_barrier(xbar, F_TID)
#ifdef PROBE_T1
    unsigned long long* stamps = (unsigned long long*)(ws + WS_CTL + 2048);
#define STAMP(k) do { if (blockIdx.x == 0 && F_TID == 0) stamps[k] = __builtin_amdgcn_s_memrealtime(); } while (0)
#else
#define STAMP(k) do {} while (0)
#endif
    STAMP(0);

    for (int rep = 0; rep < REP_P0; ++rep) p0_prologue(F, a);
    if (a.out == nullptr) grid.sync();
    GRID_BAR();
    STAMP(1);

    for (int rep = 0; rep < REP_P1; ++rep) {
        pg8::Gemm g{(const bf16_t*)(ws + WS_XB), (const bf16_t*)(ws + WS_WIN), NTOK, NPROJ, DM, 0, 0}; pg8::StaticOrder S; S.init(NTOK, NPROJ, F.G, (int)blockIdx.x);
        EpiProj E{(bf16_t*)(ws + WS_PROJ), (unsigned*)(ws + WS_CTL)};
        pg8::gemm_phase<EpiProj, pg8::StaticOrder, true, false, KREP_P1>(F.lds, g, S, E, F_TID);
    }
    GRID_BAR();
    STAMP(2);

    {
        float s1 = 0.f, s2 = 0.f;
        for (int i = 0; i < 64; ++i) { s1 += a.lq1[i] * a.lk1[i]; s2 += a.lq2[i] * a.lk2[i]; }
        const float lam = __expf(s1) - __expf(s2) + LAM_INIT;
        {
            LAS unsigned* misc = (LAS unsigned*)(F.lds + LX_MISC); unsigned* ctl = (unsigned*)(ws + WS_CTL);
            const int myx = (int)(xbar.x & 7u);
            for (;;) {
                __syncthreads();
                if (F_TID == 0) { int got = -1;
                    for (int k = 0; k < 8 && got < 0; ++k) { const int qx = (myx + k) & 7;
                        if (__hip_atomic_load(ctl + CW_QUEUE + qx, __ATOMIC_RELAXED, __HIP_MEMORY_SCOPE_AGENT) < 160u) { const unsigned p = atomicAdd(ctl + CW_QUEUE + qx, 1u); if (p < 160u) got = qx * 256 + (int)p; } }
                    misc[100] = (unsigned)got; }
                __syncthreads();
                const int idx = __builtin_amdgcn_readfirstlane((int)misc[100]);
                if (idx < 0) break;
                const int qx = idx >> 8, p = idx & 255;
                if (p < 64 && (p & 1)) attnA_unit(F, a, qx * 32 + (p >> 1));
                else { const int h = p < 64 ? 3 : 2 - ((p - 64) >> 5), j = p < 64 ? (p >> 1) : (p & 31); attnB_item(F, a, h, qx >> 2, 32 * (qx & 3) + j, lam); }
            }
        }
    }
    GRID_BAR();
    STAMP(3);

    for (int rep = 0; rep < REP_P3; ++rep) {
        pg8::Gemm g{(const bf16_t*)(ws + WS_MIXED), (const bf16_t*)(ws + WS_WOUT), NTOK, DM, DM, 0, 0}; pg8::StaticOrder S; S.init(NTOK, DM, F.G, (int)blockIdx.x);
        EpiZ E{a.x, (float*)(ws + WS_Z)};
        pg8::gemm_phase<EpiZ, pg8::StaticOrder, true, false, KREP_P3>(F.lds, g, S, E, F_TID);
    }
    GRID_BAR();
    STAMP(4);

    if (F.G == 256) p4_ln_router(F, a);
    GRID_BAR();
    STAMP(5);

    int* sel_e = (int*)(ws + WS_ROUTE); int* sel_pos = sel_e + NTOK * TOPK; float* sel_gate = (float*)(sel_pos + NTOK * TOPK);
    int* inv = (int*)(sel_gate + NTOK * TOPK); int* row_tok = inv + NTOK * TOPK; float* row_gate = (float*)(row_tok + 262144);
    {
        const int ntl = build_tiles(F, a); (void)ntl;
        LAS unsigned* misc = (LAS unsigned*)(F.lds + LX_MISC);
        const unsigned* gcnt = (const unsigned*)(ws + WS_CTL);
        for (int idx = F.vcu * 512 + F_TID; idx < NTOK * TOPK; idx += F.G * 512) {
            const int e = sel_e[idx], dest = (int)misc[64 + e] * 256 + sel_pos[idx];
            row_tok[dest] = idx >> 2; row_gate[dest] = sel_gate[idx]; inv[idx] = dest;
        }
        for (int e = F.vcu; e < NE; e += F.G) {
            const int c = (int)__hip_atomic_load(&gcnt[e], __ATOMIC_RELAXED, __HIP_MEMORY_SCOPE_AGENT), base = (int)misc[64 + e] * 256, end = (int)misc[65 + e] * 256;
            for (int r = base + c + F_TID; r < end; r += 512) { row_tok[r] = 0; row_gate[r] = 0.f; }
        }
    }
    GRID_BAR();
    STAMP(6);

    for (int rep = 0; rep < REP_P6; ++rep) {
        const int ntl = build_tiles(F, a);
        MoeOrder S; S.so.init(ntl * 256, 2048, F.G, (int)blockIdx.x); S.tile_e = F.lds + LX_TILE; S.tok = (const LAS unsigned short*)(F.lds + LX_TOK); S.ncolt = 8;
        {
            LAS unsigned short* tk = (LAS unsigned short*)(F.lds + LX_TOK); pg8::Unit u;
            for (int i = F.wave; i < 24 && S.so.next(i, u); i += 8) { const int l_ = F_LANE;
#pragma unroll
                for (int j = 0; j < 4; ++j) tk[i * 256 + l_ + 64 * j] = (unsigned short)row_tok[u.pm * 256 + l_ + 64 * j]; }
            __syncthreads();
        }
        pg8::Gemm g{(const bf16_t*)(ws + WS_XB), (const bf16_t*)(ws + WS_WUP), ntl * 256, 2048, DM, 0x7C7C7C7C, 0x77777777};
        EpiUp E{(bf16_t*)(ws + WS_H), a.b_up};
        pg8::gemm_phase<EpiUp, MoeOrder, true, true, KREP_P6, true>(F.lds, g, S, E, F_TID);
    }
    GRID_BAR();
    STAMP(7);

    for (int rep = 0; rep < REP_P7; ++rep) {
        const int ntl = build_tiles(F, a);
        MoeOrder S; S.so.init(ntl * 256, 1024, F.G, (int)blockIdx.x, ORD_REV7); S.tile_e = F.lds + LX_TILE; S.tok = nullptr; S.ncolt = 4;
        pg8::Gemm g{(const bf16_t*)(ws + WS_H), (const bf16_t*)(ws + WS_WDN), ntl * 256, DM, DFF, 0x7D7D7D7D, 0x77777777};
        EpiDown E{(bf16_t*)(ws + WS_Y), a.b_down, row_gate};
        pg8::gemm_phase<EpiDown, MoeOrder, true, false, KREP_P7, true>(F.lds, g, S, E, F_TID);
    }
    GRID_BAR();
    STAMP(8);

    for (int rep = 0; rep < REP_P8; ++rep) {
        const int lane = F_LANE; const float* X1 = (const float*)(ws + WS_Z); const bf16_t* Y = (const bf16_t*)(ws + WS_Y); const float* stats = (const float*)(ws + WS_ROUTE + 4 * MiB);
        f32x4 gv[4], bv[4], g1[4], b1[4];
#pragma unroll
        for (int j = 0; j < 4; ++j) { gv[j] = ((const f32x4*)a.ln2_g)[lane + 64 * j]; bv[j] = ((const f32x4*)a.ln2_b)[lane + 64 * j]; g1[j] = ((const f32x4*)a.ln1_g)[lane + 64 * j] * ALPHA; b1[j] = ((const f32x4*)a.ln1_b)[lane + 64 * j] * ALPHA; }
        for (int m = F.vcu * 8 + F.wave; m < NTOK; m += F.G * 8) {
            const f32x4* xr = (const f32x4*)(X1 + (size_t)m * DM) + lane; f32x4 v[4]; const f32x2 st = *(const f32x2*)(stats + 2 * m);
#pragma unroll
            for (int j = 0; j < 4; ++j) v[j] = (xr[64 * j] - st[0]) * st[1] * g1[j] + b1[j];
#pragma unroll
            for (int t = 0; t < 4; ++t) { const int dest = inv[m * 4 + t]; const unsigned* yr = (const unsigned*)((const unsigned char*)Y + (size_t)dest * DM) + lane;
#pragma unroll
                for (int j = 0; j < 4; ++j) { const int w = (int)yr[64 * j];
                    v[j][0] += __builtin_amdgcn_cvt_f32_fp8(w, 0) * (1.f / 32.f); v[j][1] += __builtin_amdgcn_cvt_f32_fp8(w, 1) * (1.f / 32.f);
                    v[j][2] += __builtin_amdgcn_cvt_f32_fp8(w, 2) * (1.f / 32.f); v[j][3] += __builtin_amdgcn_cvt_f32_fp8(w, 3) * (1.f / 32.f); } }
            float s = 0.f;
#pragma unroll
            for (int j = 0; j < 4; ++j) s += (v[j][0] + v[j][1]) + (v[j][2] + v[j][3]);
            const float mean = wave_sum(s) * (1.f / DM); float s2 = 0.f;
#pragma unroll
            for (int j = 0; j < 4; ++j) { v[j] = v[j] - mean; s2 += (v[j][0] * v[j][0] + v[j][1] * v[j][1]) + (v[j][2] * v[j][2] + v[j][3] * v[j][3]); }
            const float rstd = 1.f / sqrtf(wave_sum(s2) * (1.f / DM) + LN_EPS);
            f32x4* orow = (f32x4*)(a.out + (size_t)m * DM) + lane;
#pragma unroll
            for (int j = 0; j < 4; ++j) orow[64 * j] = v[j] * rstd * gv[j] + bv[j];
        }
    }
#ifdef PROBE_T1
    STAMP(9);
    if (blockIdx.x == 0) {
        __syncthreads();
        const float t1 = (float)(stamps[PROBE_T1 + 1] - stamps[PROBE_T1]) * 0.01f, t2 = (float)(stamps[PROBE_T2 + 1] - stamps[PROBE_T2]) * 0.01f;
        for (int i = F_TID; i < (1 << 20); i += 512) a.out[1 + i] = t2;
        if (F_TID == 0) a.out[0] = t1 * 10.0f;
    }
#endif
}

extern "C" void kernel_launch(void* const* d_in, const int* in_sizes, int n_in, void* d_out, int out_size, void* d_ws, size_t ws_size, hipStream_t stream) {
    static int grid = 0;
    if (grid == 0) {
        if (n_in != 18 || in_sizes[0] != NTOK * DM || out_size != NTOK * DM || ws_size < WS_END) {
            fprintf(stderr, "kernel_launch: unexpected shapes (n_in %d, in0 %d, out %d, ws %zu need %zu); nothing launched\n", n_in, n_in > 0 ? in_sizes[0] : -1, out_size, ws_size, (size_t)WS_END); grid = -1; return; }
        int dev = 0, cus = 0, per_cu = 0;
        if (hipGetDevice(&dev) != hipSuccess || hipDeviceGetAttribute(&cus, hipDeviceAttributeMultiprocessorCount, dev) != hipSuccess) { grid = -1; return; }
        if (hipFuncSetAttribute((const void*)fwd_megakernel, hipFuncAttributeMaxDynamicSharedMemorySize, LDS_BYTES) != hipSuccess) { fprintf(stderr, "kernel_launch: hipFuncSetAttribute failed\n"); grid = -1; return; }
        if (hipOccupancyMaxActiveBlocksPerMultiprocessor(&per_cu, (const void*)fwd_megakernel, 512, LDS_BYTES) != hipSuccess || per_cu < 1) { fprintf(stderr, "kernel_launch: occupancy query says %d\n", per_cu); per_cu = 1; }
        (void)hipGetLastError();
        grid = cus * (per_cu > 1 ? 1 : per_cu);
        fprintf(stderr, "kernel_launch: grid %d (cus %d, per_cu %d)\n", grid, cus, per_cu);
    }
    if (grid < 0) return;
    if (hipMemsetAsync((char*)d_ws + WS_CTL, 0, CTL_ZERO_BYTES, stream) != hipSuccess) return;
    Args a{};
    const float* const* in = (const float* const*)d_in;
    a.x = in[0]; a.w_in = in[1]; a.w_out = in[2]; a.lq1 = in[3]; a.lk1 = in[4]; a.lq2 = in[5]; a.lk2 = in[6]; a.g_sub = in[7];
    a.ln1_g = in[8]; a.ln1_b = in[9]; a.w_router = in[10]; a.b_router = in[11]; a.w_up = in[12]; a.b_up = in[13]; a.w_down = in[14]; a.b_down = in[15];
    a.ln2_g = in[16]; a.ln2_b = in[17]; a.out = (float*)d_out; a.ws = (unsigned char*)d_ws;
    void* args[] = {&a};
    hipError_t e = hipLaunchCooperativeKernel((void*)fwd_megakernel, dim3(grid), dim3(512), args, LDS_BYTES, stream);
    if (e != hipSuccess) fprintf(stderr, "kernel_launch: cooperative launch failed: %s (grid %d)\n", hipGetErrorString(e), grid);
}
```

```cpp
#include <hip/hip_runtime.h>
#include <hip/hip_cooperative_groups.h>
#include <cstdio>
#include <cstdint>
namespace cg = cooperative_groups;
#ifndef KREP_P1
#define KREP_P1 1
#endif
#ifndef KREP_P3
#define KREP_P3 1
#endif
#ifndef KREP_P6
#define KREP_P6 1
#endif
#ifndef KREP_P7
#define KREP_P7 1
#endif
#ifndef ORD_SWZ
#define ORD_SWZ 0
#endif
#ifndef ORD_REV7
#define ORD_REV7 1
#endif
#ifndef REP_P0
#define REP_P0 1
#endif
#ifndef REP_P1
#define REP_P1 1
#endif
#ifndef REP_A
#define REP_A 1
#endif
#ifndef REP_B
#define REP_B 1
#endif
#ifndef REP_P3
#define REP_P3 1
#endif
#ifndef REP_P6
#define REP_P6 1
#endif
#ifndef REP_P7
#define REP_P7 1
#endif
#ifndef REP_P8
#define REP_P8 1
#endif

#define LAS __attribute__((address_space(3)))
typedef unsigned short bf16_t;
typedef short bf16x8 __attribute__((ext_vector_type(8)));
typedef short s16x4 __attribute__((ext_vector_type(4)));
typedef float f32x4 __attribute__((ext_vector_type(4)));
typedef float f32x2 __attribute__((ext_vector_type(2)));
typedef float f32x16 __attribute__((ext_vector_type(16)));
typedef unsigned u32x4 __attribute__((ext_vector_type(4)));
typedef unsigned u32x2 __attribute__((ext_vector_type(2)));
typedef __bf16 bf16x2_t __attribute__((ext_vector_type(2)));

constexpr int BATCH = 2, SEQ = 16384, DM = 1024, NTOK = BATCH * SEQ;
constexpr int NPROJ = 3072, NE = 32, TOPK = 4, DFF = 1024;
constexpr int NROWS_MAX = NTOK * TOPK + NE * 256;
constexpr float LN_EPS = 1e-5f;
constexpr float ALPHA = 1.189207115002721f;
constexpr float LOG2E = 1.4426950408889634f;
constexpr float C2 = 0.125f * LOG2E;
constexpr float LAM_INIT = 0.2f;
constexpr float NEG_BIG = -1e30f;

constexpr size_t MiB = 1u << 20;
constexpr size_t WS_CTL = 0, CTL_ZERO_BYTES = 65536;
constexpr int CW_QMAX = 64, CW_KMAX = 128, CW_QUEUE = 256, CW_BAR = 4096;
constexpr size_t WS_WIN = 2 * MiB, WS_WOUT = 8 * MiB, WS_WUP = 16 * MiB, WS_WDN = 144 * MiB;
constexpr size_t WS_XB = 208 * MiB;
constexpr size_t WS_PROJ = 272 * MiB;
constexpr size_t PROJ_STRIDE = (size_t)NTOK * 512;
constexpr size_t WS_MIXED = 464 * MiB;
constexpr size_t WS_Z = 272 * MiB;
constexpr size_t WS_H = 400 * MiB;
constexpr size_t WS_Y = 672 * MiB;
constexpr size_t WS_APART = 672 * MiB;
constexpr size_t APART_UNIT = 2 * 1024 * 64 * 4 + 2 * 1024 * 2 * 4;
constexpr size_t WS_ROUTE = 944 * MiB;
constexpr size_t WS_END = 952 * MiB;

constexpr int RING_BYTES = 131072;
constexpr int LX_TILE = 131072;
constexpr int LX_TOK = 132096;
constexpr int LX_MISC = 144384;
constexpr int LDS_BYTES = 147456;

__device__ __forceinline__ unsigned cvtpk(float lo, float hi) { f32x2 v = {lo, hi}; bf16x2_t b = __builtin_convertvector(v, bf16x2_t); return __builtin_bit_cast(unsigned, b); }
__device__ __forceinline__ unsigned cvt4_fp8(float a, float b, float c, float d) { int w = 0; w = __builtin_amdgcn_cvt_pk_fp8_f32(a, b, w, false); w = __builtin_amdgcn_cvt_pk_fp8_f32(c, d, w, true); return (unsigned)w; }
__device__ __forceinline__ float wave_sum(float v) {
#pragma unroll
    for (int o = 1; o < 64; o <<= 1) v += __shfl_xor(v, o);
    return v;
}

namespace pg8 {
constexpr int BM = 256, BK = 64, HALF = 128, HTB = HALF * BK * 2, STAGE_BYTES = 8 * HTB, NXCD = 8, WGM = 8;
__host__ __device__ __forceinline__ int lds_byte(int r, int c) { const int st = (r >> 4) * 2 + (c >> 5), rr = r & 15, cc = c & 31, ob = rr * 64 + cc * 2; return st * 1024 + (ob ^ (((ob >> 9) & 1) << 5)); }
__host__ __device__ __forceinline__ void stage_rc(int b, int& R, int& C) { const int st = b / 1024, sb = b % 1024, swz = sb ^ (((sb >> 9) & 1) << 5); R = (st >> 1) * 16 + swz / 64; C = (st & 1) * 32 + (swz % 64) / 2; }
__host__ __device__ __forceinline__ int perm32(int rho) { const int n = rho >> 4, i = rho & 15; return 8 * (i >> 2) + 4 * n + (i & 3); }

struct Unit { int pm, pn; };
struct Gemm { const bf16_t* A; const bf16_t* Bt; int M, N, K; int scale_a, scale_b; };
typedef int v4i_t __attribute__((ext_vector_type(4))); typedef int v8i_t __attribute__((ext_vector_type(8)));

struct StaticOrder {
    int nM, nN, nwg, G, c, rev, swz;
    __host__ __device__ void init(int M, int N, int G_, int c_, int rev_ = 0, int swz_ = ORD_SWZ) { nM = M / BM; nN = N / BM; nwg = nM * nN; G = G_; c = c_; rev = rev_; swz = swz_; }
    __host__ __device__ bool next(int i, Unit& u) const {
        const long L = (long)i * G + c; if (L >= nwg) return false;
        int wgid = (rev == 1) ? nwg - 1 - (int)L : (int)L;
        if (swz) { const int q = nwg / NXCD, r = nwg % NXCD, xcd = wgid % NXCD; int off = wgid / NXCD; const int len = xcd < r ? q + 1 : q;
            if (rev == 2) off = len - 1 - off;
            wgid = (xcd < r ? xcd * (q + 1) : r * (q + 1) + (xcd - r) * q) + off; }
        const int nig = WGM * nN, gid = wgid / nig, fm = gid * WGM, gsz = (nM - fm) < WGM ? (nM - fm) : WGM;
        u.pm = fm + ((wgid % nig) % gsz); u.pn = (wgid % nig) / gsz; return true;
    }
    __device__ __forceinline__ const LAS unsigned short* tok_table(int) const { return nullptr; }
};

template <class Epi, class Sched, bool ALIGN_EPI, bool GATHER, int KREP = 1, bool F8 = false>
__device__ __forceinline__ void gemm_phase(LAS unsigned char* lds, const Gemm g, const Sched& S, const Epi& E, const int tid) {
    const int wid = __builtin_amdgcn_readfirstlane(tid >> 6), lane = tid & 63, wr = wid >> 2, wc = wid & 3, fr = lane & 15, fq = lane >> 4;
    constexpr int ES = F8 ? 1 : 2;
    const int sclW = g.scale_b, sclX = g.scale_a;
    const int K = g.K, ntr = K * ES / (BK * 2), nt = ntr * KREP;
    unsigned voffA[2], voffB[2]; int rowA[2];
#pragma unroll
    for (int i = 0; i < 2; ++i) { int R, C; stage_rc(tid * 16 + i * 8192, R, C); const int Rb = Epi::PERM ? ((R & ~31) + perm32(R & 31)) : R;
        voffA[i] = GATHER ? (unsigned)(C * 2) : (unsigned)(R * K * ES + C * 2); voffB[i] = (unsigned)(Rb * K * ES + C * 2); rowA[i] = R; }
    const size_t kstep = (size_t)(BK * 2);
    const size_t hstep = (size_t)HALF * K * ES;
    const size_t tstep = 2 * hstep;
    const unsigned ldsw = (unsigned)wid * 1024u;
    const int aoff = lds_byte(wr * 64 + fr, fq * 8), boff = lds_byte(wc * 32 + fr, fq * 8);
    const int aoff8 = lds_byte(wr * 64 + fr, fq * 16), boff8 = lds_byte(wc * 32 + fr, fq * 16);
#define PG8_SA(b, h) (((b) * 2 + (h)) * HTB)
#define PG8_SB(b, h) ((4 + (b) * 2 + (h)) * HTB)
#define PG8_STAGE(bufoff, gbase, voff) do { _Pragma("unroll") for (int _i = 0; _i < 2; ++_i) \
        __builtin_amdgcn_global_load_lds((const unsigned*)((const char*)(gbase) + (voff)[_i]), (LAS unsigned*)(lds + (bufoff) + ldsw + _i * 8192), 16, 0, 0); } while (0)
#define PG8_STAGE_A(bufoff, NX, h, kb) do { if constexpr (GATHER) { const unsigned* _o = (NX) ? gN[h] : gC[h]; PG8_STAGE(bufoff, (const char*)g.A + (kb), _o); } \
        else { PG8_STAGE(bufoff, ((NX) ? nA : cA) + (h) * hstep + (kb), voffA); } } while (0)
#define PG8_LDA(dst, b, h) do { _Pragma("unroll") for (int m = 0; m < 4; ++m) _Pragma("unroll") for (int k = 0; k < 2; ++k) dst[m][k] = *(const LAS bf16x8*)(lds + PG8_SA(b, h) + (F8 ? aoff8 + k * 16 : aoff + k * 1024) + m * 2048); } while (0)
#define PG8_LDB(dst, b, h) do { _Pragma("unroll") for (int n = 0; n < 2; ++n) _Pragma("unroll") for (int k = 0; k < 2; ++k) dst[n][k] = *(const LAS bf16x8*)(lds + PG8_SB(b, h) + (F8 ? boff8 + k * 16 : boff + k * 1024) + n * 2048); } while (0)
#define PG8_F8OP(x) __builtin_shufflevector(__builtin_bit_cast(v4i_t, x[0]), __builtin_bit_cast(v4i_t, x[1]), 0, 1, 2, 3, 4, 5, 6, 7)
#define PG8_MMA(ai, bj, At, Bt) do { __builtin_amdgcn_s_setprio(1); _Pragma("unroll") for (int m = 0; m < 4; ++m) _Pragma("unroll") for (int n = 0; n < 2; ++n) { \
        if constexpr (F8) { const v8i_t _a = PG8_F8OP(Bt[n]), _b = PG8_F8OP(At[m]); asm volatile("v_mfma_scale_f32_16x16x128_f8f6f4 %0, %1, %2, %0, %3, %4 op_sel_hi:[0,0,0]" : "+v"(acc[ai][bj][m][n]) : "v"(_a), "v"(_b), "v"(sclW), "v"(sclX)); } \
        else { _Pragma("unroll") for (int k = 0; k < 2; ++k) acc[ai][bj][m][n] = __builtin_amdgcn_mfma_f32_16x16x32_bf16(Bt[n][k], At[m][k], acc[ai][bj][m][n], 0, 0, 0); } } \
        __builtin_amdgcn_s_setprio(0); } while (0)
#define PG8_WAIT_V(n) asm volatile("s_waitcnt vmcnt(" #n ")" ::: "memory")
#define PG8_WAIT_L(n) asm volatile("s_waitcnt lgkmcnt(" #n ")" ::: "memory")
#define PG8_BAR __builtin_amdgcn_s_barrier()
#define PG8_SCHED __builtin_amdgcn_sched_barrier(0)
#define PG8_GOFF(dst, ui_) do { if constexpr (GATHER) { const LAS unsigned short* _t = S.tok_table(ui_); _Pragma("unroll") for (int _h = 0; _h < 2; ++_h) _Pragma("unroll") for (int _i = 0; _i < 2; ++_i) \
        dst[_h][_i] = (unsigned)_t[_h * HALF + rowA[_i]] * (unsigned)(K * ES) + voffA[_i]; } } while (0)
    Unit cur, nxt; int ui = 0;
    if (!S.next(0, cur)) return;
    f32x4 acc[2][2][4][2];
    E.init(acc, cur, wc, fq);
    bf16x8 At[4][2], B0[2][2], B1[2][2];
    unsigned gC[2][2] = {{0u, 0u}, {0u, 0u}}, gN[2][2] = {{0u, 0u}, {0u, 0u}};
    PG8_GOFF(gC, 0);
    const char* cA = (const char*)g.A + (GATHER ? (size_t)0 : (size_t)cur.pm * tstep); const char* cB = (const char*)g.Bt + (size_t)cur.pn * tstep;
    const char* nA = cA;
    {
        PG8_STAGE(PG8_SB(0, 0), cB, voffB); PG8_STAGE(PG8_SB(0, 1), cB + hstep, voffB); PG8_STAGE_A(PG8_SA(0, 0), false, 0, 0); PG8_STAGE_A(PG8_SA(0, 1), false, 1, 0);
        if (wr == 1) PG8_BAR;
        PG8_WAIT_V(2); PG8_BAR;
        PG8_STAGE(PG8_SB(1, 0), cB + kstep, voffB); PG8_STAGE_A(PG8_SA(1, 0), false, 0, kstep); PG8_STAGE(PG8_SB(1, 1), cB + hstep + kstep, voffB);
        PG8_WAIT_V(6); PG8_BAR;
    }
    for (;;) {
        const bool has_next = S.next(ui + 1, nxt);
        nA = has_next ? (const char*)g.A + (GATHER ? (size_t)0 : (size_t)nxt.pm * tstep) : cA; const char* nB = has_next ? (const char*)g.Bt + (size_t)nxt.pn * tstep : cB;
        if (has_next) { PG8_GOFF(gN, ui + 1); } else {
#pragma unroll
            for (int h = 0; h < 2; ++h)
#pragma unroll
                for (int i = 0; i < 2; ++i) gN[h][i] = gC[h][i]; }
#pragma unroll 1
        for (int t = 0; t < nt; t += 2) {
            const bool last = (t == nt - 2);
            const size_t k1 = (size_t)((t + 1) % ntr) * kstep;
            const size_t k2 = last ? (size_t)0 : (size_t)((t + 2) % ntr) * kstep, k3 = k2 + kstep;
            const char* b2 = last ? nB : cB + (size_t)((t + 2) % ntr) * kstep; const char* b3 = b2 + kstep;
            PG8_LDB(B0, 0, 0); PG8_LDB(B1, 0, 1); PG8_SCHED; PG8_LDA(At, 0, 0); PG8_STAGE_A(PG8_SA(1, 1), false, 1, k1);
            PG8_WAIT_V(8); PG8_WAIT_L(0); PG8_BAR; PG8_MMA(0, 0, At, B0); PG8_MMA(0, 1, At, B1); PG8_BAR; PG8_SCHED;
            PG8_LDA(At, 0, 1); PG8_STAGE(PG8_SB(0, 0), b2, voffB); PG8_STAGE(PG8_SB(0, 1), b2 + hstep, voffB); PG8_STAGE_A(PG8_SA(0, 0), last, 0, k2);
            PG8_WAIT_V(8); PG8_WAIT_L(0); PG8_BAR; PG8_MMA(1, 0, At, B0); PG8_MMA(1, 1, At, B1); PG8_BAR; PG8_SCHED;
            PG8_LDB(B0, 1, 0); PG8_LDB(B1, 1, 1); PG8_SCHED; PG8_LDA(At, 1, 0); PG8_STAGE_A(PG8_SA(0, 1), last, 1, k2);
            PG8_WAIT_V(8); PG8_WAIT_L(0); PG8_BAR; PG8_MMA(0, 0, At, B0); PG8_MMA(0, 1, At, B1); PG8_BAR; PG8_SCHED;
            PG8_LDA(At, 1, 1); PG8_STAGE(PG8_SB(1, 0), b3, voffB); PG8_STAGE(PG8_SB(1, 1), b3 + hstep, voffB); PG8_STAGE_A(PG8_SA(1, 0), last, 0, k3);
            PG8_WAIT_V(8); PG8_WAIT_L(0); PG8_BAR; PG8_MMA(1, 0, At, B0); PG8_MMA(1, 1, At, B1); PG8_BAR; PG8_SCHED;
        }
        if constexpr (ALIGN_EPI) { if (wr == 0) PG8_BAR; }
        if constexpr (F8) asm volatile("s_nop 15\n\ts_nop 15" ::: "memory");
        if constexpr (KREP > 1) {
_Pragma("unroll") for (int a_ = 0; a_ < 2; ++a_) _Pragma("unroll") for (int b_ = 0; b_ < 2; ++b_) _Pragma("unroll") for (int m_ = 0; m_ < 4; ++m_) _Pragma("unroll") for (int n_ = 0; n_ < 2; ++n_) acc[a_][b_][m_][n_] = acc[a_][b_][m_][n_] * (1.0f / KREP); }
        E(acc, cur, wr, wc, fr, fq);
        if (!has_next) break;
        E.init(acc, nxt, wc, fq);
        cur = nxt; cA = nA; cB = nB; ++ui;
#pragma unroll
        for (int h = 0; h < 2; ++h)
#pragma unroll
            for (int i = 0; i < 2; ++i) gC[h][i] = gN[h][i];
        if constexpr (ALIGN_EPI) { if (wr == 1) PG8_BAR; }
    }
    PG8_WAIT_V(0);
    if constexpr (!ALIGN_EPI) { if (wr == 0) PG8_BAR; }
    PG8_BAR;
#undef PG8_SA
#undef PG8_SB
#undef PG8_STAGE
#undef PG8_STAGE_A
#undef PG8_LDA
#undef PG8_LDB
#undef PG8_MMA
#undef PG8_F8OP
#undef PG8_WAIT_V
#undef PG8_WAIT_L
#undef PG8_BAR
#undef PG8_SCHED
#undef PG8_GOFF
}
}

struct Args {
    const float* x; const float* w_in; const float* w_out; const float* lq1; const float* lk1; const float* lq2; const float* lk2; const float* g_sub;
    const float* ln1_g; const float* ln1_b; const float* w_router; const float* b_router; const float* w_up; const float* b_up; const float* w_down; const float* b_down;
    const float* ln2_g; const float* ln2_b; float* out; unsigned char* ws;
};
struct Frame {
    LAS unsigned char* lds; int wave, vcu, G;
};
__device__ __forceinline__ int lane_now() { int l; asm volatile("v_mbcnt_lo_u32_b32 %0, -1, 0\n\tv_mbcnt_hi_u32_b32 %0, -1, %0" : "=v"(l)); return l; }
#define F_LANE lane_now()
#define F_TID (F.wave * 64 + lane_now())

struct EpiProj {
    static constexpr bool PERM = true;
    bf16_t* O; unsigned* ctl;
    __device__ __forceinline__ void init(f32x4 (&acc)[2][2][4][2], const pg8::Unit&, int, int) const {
#pragma unroll
        for (int a_ = 0; a_ < 2; ++a_)
#pragma unroll
            for (int b_ = 0; b_ < 2; ++b_)
#pragma unroll
                for (int m_ = 0; m_ < 4; ++m_)
#pragma unroll
                    for (int n_ = 0; n_ < 2; ++n_) acc[a_][b_][m_][n_] = (f32x4){0.f, 0.f, 0.f, 0.f};
    }
    __device__ __forceinline__ void operator()(const f32x4 (&acc)[2][2][4][2], const pg8::Unit& u, int wr, int wc, int fr, int fq) const {
        const int t = u.pn >> 1; const float sc = (t == 0 || t == 3) ? C2 : 1.f; const bool nrm = (t == 3 || t == 4);
        bf16_t* base = O + (size_t)t * PROJ_STRIDE; const int row0 = u.pm * 256 + wr * 64 + fr, col0 = (u.pn & 1) * 256 + wc * 32 + 8 * fq;
        float mx0 = 0.f, mx1 = 0.f;
#pragma unroll
        for (int ai = 0; ai < 2; ++ai)
#pragma unroll
            for (int m = 0; m < 4; ++m) { bf16_t* rowp = base + (size_t)(row0 + ai * 128 + m * 16) * 512 + col0;
#pragma unroll
                for (int bj = 0; bj < 2; ++bj) { const f32x4 v0 = acc[ai][bj][m][0] * sc, v1 = acc[ai][bj][m][1] * sc; u32x4 w;
                    w.x = cvtpk(v0[0], v0[1]); w.y = cvtpk(v0[2], v0[3]); w.z = cvtpk(v1[0], v1[1]); w.w = cvtpk(v1[2], v1[3]);
                    if (t >= 4) {
                        const int row = row0 + ai * 128 + m * 16, bb = row >> 14, sq = row & (SEQ - 1), key = sq & 63, hh = (u.pn & 1) * 2 + bj;
                        bf16_t* tb = O + 4 * PROJ_STRIDE + ((size_t)((bb * 4 + hh) * 256 + (sq >> 6))) * 16384;
                        if (t == 4) *(u32x4*)(tb + (4 * wc + fq) * 512 + key * 8) = w;
                        else *(u32x4*)(tb + 8192 + (wc * 4 + (key >> 4)) * 512 + (key & 15) * 32 + fq * 8) = w;
                    } else *(u32x4*)(rowp + bj * 128) = w;
                    if (nrm) { float ss = 0.f;
#pragma unroll
                        for (int j = 0; j < 4; ++j) { const float lo = __uint_as_float(w[j] << 16), hi = __uint_as_float(w[j] & 0xFFFF0000u); ss += lo * lo + hi * hi; }
                        ss += __shfl_xor(ss, 16); ss += __shfl_xor(ss, 32);
                        if (bj == 0) mx0 = fmaxf(mx0, ss); else mx1 = fmaxf(mx1, ss); } } }
        if (nrm) {
#pragma unroll
            for (int ofs = 1; ofs < 16; ofs <<= 1) { mx0 = fmaxf(mx0, __shfl_xor(mx0, ofs)); mx1 = fmaxf(mx1, __shfl_xor(mx1, ofs)); }
            if (fr == 0 && fq == 0) { const int b = u.pm >> 6, cw = (t == 3) ? CW_QMAX : CW_KMAX;
                atomicMax(ctl + cw + (((b * 4 + (u.pn & 1) * 2 + 0) * 2 + (wc >> 1)) * 2 + (wc & 1)), __float_as_uint(mx0));
                atomicMax(ctl + cw + (((b * 4 + (u.pn & 1) * 2 + 1) * 2 + (wc >> 1)) * 2 + (wc & 1)), __float_as_uint(mx1)); }
        }
    }
};
struct EpiZ {
    static constexpr bool PERM = false;
    const float* x; float* z;
    __device__ __forceinline__ void init(f32x4 (&acc)[2][2][4][2], const pg8::Unit&, int, int) const {
#pragma unroll
        for (int a_ = 0; a_ < 2; ++a_)
#pragma unroll
            for (int b_ = 0; b_ < 2; ++b_)
#pragma unroll
                for (int m_ = 0; m_ < 4; ++m_)
#pragma unroll
                    for (int n_ = 0; n_ < 2; ++n_) acc[a_][b_][m_][n_] = (f32x4){0.f, 0.f, 0.f, 0.f};
    }
    __device__ __forceinline__ void operator()(const f32x4 (&acc)[2][2][4][2], const pg8::Unit& u, int wr, int wc, int fr, int fq) const {
        const int col0 = u.pn * 256 + wc * 32 + 4 * fq;
#pragma unroll
        for (int ai = 0; ai < 2; ++ai)
#pragma unroll
            for (int m = 0; m < 4; ++m) { const size_t off = (size_t)(u.pm * 256 + ai * 128 + wr * 64 + m * 16 + fr) * DM + col0;
#pragma unroll
                for (int bj = 0; bj < 2; ++bj)
#pragma unroll
                    for (int n = 0; n < 2; ++n) { const f32x4 xv = *(const f32x4*)(x + off + bj * 128 + n * 16); *(f32x4*)(z + off + bj * 128 + n * 16) = xv * ALPHA + acc[ai][bj][m][n]; } }
    }
};
__device__ __forceinline__ f32x2 swiglu4_pk(f32x2 g, f32x2 u) {
    g = __builtin_elementwise_min(g, (f32x2){7.0f, 7.0f});
    u = __builtin_elementwise_min(__builtin_elementwise_max(u, (f32x2){-7.0f, -7.0f}), (f32x2){7.0f, 7.0f});
    const f32x2 a_ = g * (-1.702f * LOG2E) + (-2.0f);
    f32x2 e_; e_.x = __builtin_amdgcn_exp2f(a_.x); e_.y = __builtin_amdgcn_exp2f(a_.y);
    const f32x2 d_ = e_ + 0.25f;
    f32x2 s_; s_.x = __builtin_amdgcn_rcpf(d_.x); s_.y = __builtin_amdgcn_rcpf(d_.y);
    const f32x2 t_ = g * s_;
    return t_ * u + t_;
}
struct EpiUp {
    static constexpr bool PERM = true;
    bf16_t* H; const float* b_up;
    __device__ __forceinline__ void init(f32x4 (&acc)[2][2][4][2], const pg8::Unit& u, int wc, int fq) const {
        const int e = u.pn >> 3, pnl = u.pn & 7, hcol0 = pnl * 128 + wc * 32 + 8 * fq;
        const float* bg = b_up + (size_t)e * 2048 + hcol0; const float* bu = bg + 1024;
        const f32x4 bg0 = *(const f32x4*)bg, bg1 = *(const f32x4*)(bg + 4), bu0 = *(const f32x4*)bu, bu1 = *(const f32x4*)(bu + 4);
#pragma unroll
        for (int a_ = 0; a_ < 2; ++a_)
#pragma unroll
            for (int m_ = 0; m_ < 4; ++m_) { acc[a_][0][m_][0] = bg0; acc[a_][0][m_][1] = bg1; acc[a_][1][m_][0] = bu0; acc[a_][1][m_][1] = bu1; }
    }
    __device__ __forceinline__ void operator()(const f32x4 (&acc)[2][2][4][2], const pg8::Unit& u, int wr, int wc, int fr, int fq) const {
        const int e = u.pn >> 3, pnl = u.pn & 7, hcol0 = pnl * 128 + wc * 32 + 8 * fq;
#pragma unroll
        for (int ai = 0; ai < 2; ++ai)
#pragma unroll
            for (int m = 0; m < 4; ++m) { const size_t row = (size_t)(u.pm * 256 + ai * 128 + wr * 64 + m * 16 + fr);
                const f32x4 g0 = acc[ai][0][m][0], g1 = acc[ai][0][m][1], u0 = acc[ai][1][m][0], u1 = acc[ai][1][m][1];
                const f32x2 r0 = swiglu4_pk((f32x2){g0[0], g0[1]}, (f32x2){u0[0], u0[1]}), r1 = swiglu4_pk((f32x2){g0[2], g0[3]}, (f32x2){u0[2], u0[3]});
                const f32x2 r2 = swiglu4_pk((f32x2){g1[0], g1[1]}, (f32x2){u1[0], u1[1]}), r3 = swiglu4_pk((f32x2){g1[2], g1[3]}, (f32x2){u1[2], u1[3]});
                u32x2 w8; w8.x = cvt4_fp8(r0.x, r0.y, r1.x, r1.y); w8.y = cvt4_fp8(r2.x, r2.y, r3.x, r3.y);
                *(u32x2*)((unsigned char*)H + row * DFF + hcol0) = w8; }
    }
};
struct EpiDown {
    static constexpr bool PERM = true;
    bf16_t* Y; const float* b_down; const float* row_gate;
    __device__ __forceinline__ void init(f32x4 (&acc)[2][2][4][2], const pg8::Unit& u, int wc, int fq) const {
        const int e = u.pn >> 2, pnl = u.pn & 3, col0 = pnl * 256 + wc * 32 + 8 * fq;
#pragma unroll
        for (int bj = 0; bj < 2; ++bj)
#pragma unroll
            for (int n = 0; n < 2; ++n) { const f32x4 bv = *(const f32x4*)(b_down + (size_t)e * DM + col0 + bj * 128 + 4 * n);
#pragma unroll
                for (int a_ = 0; a_ < 2; ++a_)
#pragma unroll
                    for (int m_ = 0; m_ < 4; ++m_) acc[a_][bj][m_][n] = bv; }
    }
    __device__ __forceinline__ void operator()(const f32x4 (&acc)[2][2][4][2], const pg8::Unit& u, int wr, int wc, int fr, int fq) const {
        const int e = u.pn >> 2, pnl = u.pn & 3, col0 = pnl * 256 + wc * 32 + 8 * fq;
#pragma unroll
        for (int ai = 0; ai < 2; ++ai)
#pragma unroll
            for (int m = 0; m < 4; ++m) { const size_t row = (size_t)(u.pm * 256 + ai * 128 + wr * 64 + m * 16 + fr); const float gt = row_gate[row];
#pragma unroll
                for (int bj = 0; bj < 2; ++bj) { const f32x4 v0 = acc[ai][bj][m][0] * (gt * 32.f), v1 = acc[ai][bj][m][1] * (gt * 32.f); u32x2 w;
                    w.x = cvt4_fp8(v0[0], v0[1], v0[2], v0[3]); w.y = cvt4_fp8(v1[0], v1[1], v1[2], v1[3]); *(u32x2*)((unsigned char*)Y + row * DM + col0 + bj * 128) = w; } }
    }
};
struct MoeOrder {
    pg8::StaticOrder so; const LAS unsigned char* tile_e; const LAS unsigned short* tok; int ncolt;
    __device__ __forceinline__ bool next(int i, pg8::Unit& u) const {
        if (!so.next(i, u)) return false;
        const int e = __builtin_amdgcn_readfirstlane((int)tile_e[u.pm]); u.pn = e * ncolt + u.pn; return true; }
    __device__ __forceinline__ const LAS unsigned short* tok_table(int ui) const { return tok + ui * 256; }
};

__device__ __forceinline__ void p0_transpose_item(const float* W, int K, int N, bf16_t* WT, int k0, int n0, int row0, LAS float* scr, int lane) {
#pragma unroll 8
    for (int i = 0; i < 32; ++i) { const int kk = 2 * i + (lane >> 5); scr[kk * 33 + (lane & 31)] = W[(size_t)(k0 + kk) * N + n0 + (lane & 31)]; }
    asm volatile("s_waitcnt lgkmcnt(0)" ::: "memory");
    const int c = lane & 7;
#pragma unroll
    for (int j = 0; j < 4; ++j) { const int n = (lane >> 3) + 8 * j; const LAS float* s = scr + (8 * c) * 33 + n;
        u32x4 o; o.x = cvtpk(s[0 * 33], s[1 * 33]); o.y = cvtpk(s[2 * 33], s[3 * 33]); o.z = cvtpk(s[4 * 33], s[5 * 33]); o.w = cvtpk(s[6 * 33], s[7 * 33]);
        *(u32x4*)(WT + (size_t)(row0 + n) * K + k0 + 8 * c) = o; }
    asm volatile("s_waitcnt lgkmcnt(0)" ::: "memory");
}
__device__ __forceinline__ void p0_transpose_item_f8(const float* W, int K, int N, unsigned char* WT, int k0, int n0, int row0, LAS float* scr, int lane) {
#pragma unroll 8
    for (int i = 0; i < 32; ++i) { const int kk = 2 * i + (lane >> 5); scr[kk * 33 + (lane & 31)] = W[(size_t)(k0 + kk) * N + n0 + (lane & 31)]; }
    asm volatile("s_waitcnt lgkmcnt(0)" ::: "memory");
    const int c = lane & 7;
#pragma unroll
    for (int j = 0; j < 4; ++j) { const int n = (lane >> 3) + 8 * j; const LAS float* s = scr + (8 * c) * 33 + n;
        u32x2 o; o.x = cvt4_fp8(256.f * s[0 * 33], 256.f * s[1 * 33], 256.f * s[2 * 33], 256.f * s[3 * 33]); o.y = cvt4_fp8(256.f * s[4 * 33], 256.f * s[5 * 33], 256.f * s[6 * 33], 256.f * s[7 * 33]);
        *(u32x2*)(WT + (size_t)(row0 + n) * K + k0 + 8 * c) = o; }
    asm volatile("s_waitcnt lgkmcnt(0)" ::: "memory");
}
__device__ __forceinline__ void p0_prologue(const Frame& F, const Args& a) {
    LAS float* scr = (LAS float*)(F.lds + F.wave * 16384);
    const int gw = F.vcu * 8 + F.wave, NGW = F.G * 8;
    bf16_t* WinT = (bf16_t*)(a.ws + WS_WIN); bf16_t* WoutT = (bf16_t*)(a.ws + WS_WOUT); bf16_t* WupT = (bf16_t*)(a.ws + WS_WUP); bf16_t* WdnT = (bf16_t*)(a.ws + WS_WDN);
    constexpr int I_IN = 16 * 96, I_OUT = 16 * 32, I_UP = 16 * 64, I_DN = 16 * 32;
    constexpr int NITEMS = I_IN + I_OUT + NE * I_UP + NE * I_DN;
    for (int it = gw; it < NITEMS; it += NGW) {
        int r = it;
        if (r < I_IN) { const int kb = r / 96, nb = r % 96; p0_transpose_item(a.w_in, DM, NPROJ, WinT, 64 * kb, 32 * nb, 32 * nb, scr, F_LANE); continue; } r -= I_IN;
        if (r < I_OUT) { const int kb = r / 32, nb = r % 32; p0_transpose_item(a.w_out, DM, DM, WoutT, 64 * kb, 32 * nb, 32 * nb, scr, F_LANE); continue; } r -= I_OUT;
        if (r < NE * I_UP) { const int e = r / I_UP, q = r % I_UP, kb = q / 64, nb = q % 64, n0 = 32 * nb;
            const int nn = n0 & 1023, row0 = (nn >> 7) * 256 + (n0 >> 10) * 128 + (nn & 127);
            p0_transpose_item_f8(a.w_up + (size_t)e * DM * 2048, DM, 2048, (unsigned char*)WupT + (size_t)e * 2048 * DM, 64 * kb, n0, row0, scr, F_LANE); continue; } r -= NE * I_UP;
        { const int e = r / I_DN, q = r % I_DN, kb = q / 32, nb = q % 32; p0_transpose_item_f8(a.w_down + (size_t)e * DFF * DM, DFF, DM, (unsigned char*)WdnT + (size_t)e * DM * DFF, 64 * kb, 32 * nb, 32 * nb, scr, F_LANE); }
    }
    bf16_t* XB = (bf16_t*)(a.ws + WS_XB);
    for (int m = gw; m < NTOK; m += NGW) {
        const f32x4* xr = (const f32x4*)(a.x + (size_t)m * DM) + F_LANE; unsigned long long* o8 = (unsigned long long*)(XB + (size_t)m * DM) + F_LANE;
#pragma unroll
        for (int j = 0; j < 4; ++j) { const f32x4 v = xr[64 * j]; o8[64 * j] = (unsigned long long)cvtpk(v[0], v[1]) | ((unsigned long long)cvtpk(v[2], v[3]) << 32); }
    }
}

__device__ __forceinline__ void glds16(const void* gsrc, unsigned lds_dst) { unsigned keep;
    asm volatile("s_mov_b32 %0, m0\n\ts_mov_b32 m0, %2\n\ts_nop 0\n\tglobal_load_lds_dwordx4 %1, off\n\ts_mov_b32 m0, %0" : "=&s"(keep) : "v"(gsrc), "s"(lds_dst) : "memory"); }
__device__ __forceinline__ int crow(int r, int hi) { return (r & 3) + 8 * (r >> 2) + 4 * hi; }
typedef LAS const char* lds_cptr;
typedef short v4i16_t __attribute__((ext_vector_type(4)));
__device__ __forceinline__ s16x4 vtr(lds_cptr p) { return __builtin_bit_cast(s16x4, __builtin_amdgcn_ds_read_tr16_b64_v4i16((LAS v4i16_t*)p)); }
#define MX3(a, b, c) __builtin_fmaxf(__builtin_fmaxf((a), (b)), (c))
__device__ __forceinline__ float rowmax(const f32x16& p0, const f32x16& p1) {
    float a = MX3(p0[0], p0[1], p1[0]), b = MX3(p0[2], p0[3], p1[1]); a = MX3(a, p1[2], p1[3]);
#pragma unroll
    for (int r = 4; r < 16; r += 4) { a = MX3(a, p0[r], p0[r + 1]); b = MX3(b, p0[r + 2], p0[r + 3]); a = MX3(a, p1[r], p1[r + 1]); b = MX3(b, p1[r + 2], p1[r + 3]); }
    float m = __builtin_fmaxf(a, b); auto rr = __builtin_amdgcn_permlane32_swap(__float_as_uint(m), __float_as_uint(m), false, false);
    return __builtin_fmaxf(__uint_as_float(rr[0]), __uint_as_float(rr[1]));
}
__device__ __forceinline__ float halfsum(float v) { auto rr = __builtin_amdgcn_permlane32_swap(__float_as_uint(v), __float_as_uint(v), false, false); return __uint_as_float(rr[0]) + __uint_as_float(rr[1]); }
#define MFMA32(a, b, c) __builtin_amdgcn_mfma_f32_32x32x16_bf16(a, b, c, 0, 0, 0)

template <int ND>
__device__ __forceinline__ void softmax_tile(f32x16& p0, f32x16& p1, float& mhat, float& lsum, f32x16 (&o)[ND], u32x4 (&pw)[4]) {
    const float rm = rowmax(p0, p1);
    const float mnew = __builtin_fmaxf(mhat, rm);
    if (__any(mnew != mhat)) {
        const float al = __builtin_amdgcn_exp2f(mhat - mnew); lsum *= al;
#pragma unroll
        for (int d = 0; d < ND; ++d)
#pragma unroll
            for (int r = 0; r < 16; ++r) o[d][r] *= al;
        mhat = mnew;
    }
    float s = 0.f;
#pragma unroll
    for (int r = 0; r < 16; ++r) { p0[r] = __builtin_amdgcn_exp2f(p0[r] - mhat); p1[r] = __builtin_amdgcn_exp2f(p1[r] - mhat); s += p0[r] + p1[r]; }
    lsum += s;
    pw[0] = (u32x4){cvtpk(p0[0], p0[1]), cvtpk(p0[2], p0[3]), cvtpk(p0[4], p0[5]), cvtpk(p0[6], p0[7])};
    pw[1] = (u32x4){cvtpk(p0[8], p0[9]), cvtpk(p0[10], p0[11]), cvtpk(p0[12], p0[13]), cvtpk(p0[14], p0[15])};
    pw[2] = (u32x4){cvtpk(p1[0], p1[1]), cvtpk(p1[2], p1[3]), cvtpk(p1[4], p1[5]), cvtpk(p1[6], p1[7])};
    pw[3] = (u32x4){cvtpk(p1[8], p1[9]), cvtpk(p1[10], p1[11]), cvtpk(p1[12], p1[13]), cvtpk(p1[14], p1[15])};
}
template <int ND>
__device__ __forceinline__ void pv_tile(f32x16 (&o)[ND], lds_cptr vbase, const u32x4 (&pw)[4]) {
#pragma unroll
    for (int d0 = 0; d0 < ND; ++d0)
#pragma unroll
        for (int ks = 0; ks < 4; ++ks) {
            const s16x4 lo = vtr(vbase + d0 * 4096 + ks * 1024), hi = vtr(vbase + d0 * 4096 + ks * 1024 + 512);
            const bf16x8 vf = (bf16x8){lo[0], lo[1], lo[2], lo[3], hi[0], hi[1], hi[2], hi[3]};
            o[d0] = MFMA32(vf, __builtin_bit_cast(bf16x8, pw[ks]), o[d0]);
        }
}

__device__ __forceinline__ unsigned bfb(float x) { return cvtpk(x, 0.f) & 0xFFFFu; }
__device__ __forceinline__ float bff(unsigned b) { return __uint_as_float(b << 16); }
__device__ __forceinline__ void bf_split3(float x, unsigned& h, unsigned& m, unsigned& l) { h = bfb(x); const float r1 = x - bff(h); m = bfb(r1); const float r2 = r1 - bff(m); l = bfb(r2); }
__device__ __forceinline__ void attnB_finish(const Frame& F, const Args& a, f32x16 (&o)[4], float lsum, float lam, size_t rowbase, int qpos, int h, int c, int qs, int r32, int hi) {
    LAS unsigned char* L = F.lds;
    const float inv = 1.0f / halfsum(lsum);
    LAS float* ex = (LAS float*)(L + 65536);
    __syncthreads();
    if (c == 1) {
#pragma unroll
        for (int d0 = 0; d0 < 4; ++d0)
#pragma unroll
            for (int r = 0; r < 16; ++r) ex[(qs * 128 + 32 * d0 + crow(r, hi)) * 32 + r32] = o[d0][r] * inv;
    }
    __syncthreads();
    if (c == 0) {
        float ss = 0.f;
#pragma unroll
        for (int d0 = 0; d0 < 4; ++d0)
#pragma unroll
            for (int r = 0; r < 16; ++r) { const float v = o[d0][r] * inv - lam * ex[(qs * 128 + 32 * d0 + crow(r, hi)) * 32 + r32]; o[d0][r] = v; ss += v * v; }
        ss = halfsum(ss);
        const float rs = __builtin_amdgcn_rsqf(ss * (1.0f / 128.0f) + LN_EPS) * (1.0f - LAM_INIT);
        bf16_t* op = (bf16_t*)(a.ws + WS_MIXED) + (rowbase + qpos) * DM + 512 + h * 128 + 4 * hi;
#pragma unroll
        for (int d0 = 0; d0 < 4; ++d0)
#pragma unroll
            for (int g = 0; g < 4; ++g) { const int dv = 32 * d0 + 8 * g + 4 * hi; const f32x4 gs = *(const f32x4*)(a.g_sub + dv);
                u32x2 w; w.x = cvtpk(o[d0][4 * g] * rs * gs[0], o[d0][4 * g + 1] * rs * gs[1]); w.y = cvtpk(o[d0][4 * g + 2] * rs * gs[2], o[d0][4 * g + 3] * rs * gs[3]);
                *(u32x2*)(op + 32 * d0 + 8 * g) = w; }
    }
    __syncthreads();
}

template <bool FAST>
__device__ __forceinline__ void attnB_unit(const Frame& F, const Args& a, int b, int h, int qblk, float lam, int t_lo, int t_hi, float kn0, float kn1) {
    const int lane = F_LANE, r32 = lane & 31, hi = lane >> 5, wid = F.wave, c = wid >> 2, qs = wid & 3;
    const bf16_t* QD = (const bf16_t*)(a.ws + WS_PROJ) + 3 * PROJ_STRIDE; const bf16_t* KD = QD + PROJ_STRIDE; const bf16_t* VD = KD + PROJ_STRIDE;
    const size_t rowbase = (size_t)b * SEQ; const int q0 = qblk * 128, qpos = q0 + 32 * qs + r32;
    bf16x8 qr[4];
    { const bf16_t* Qp = QD + (rowbase + qpos) * 512 + h * 128 + c * 64 + 8 * hi;
#pragma unroll
      for (int d0 = 0; d0 < 4; ++d0) qr[d0] = *(const bf16x8*)(Qp + 16 * d0); }
    float ref = 0.f;
    { float qq = 0.f;
#pragma unroll
        for (int d0 = 0; d0 < 4; ++d0)
#pragma unroll
            for (int j = 0; j < 8; ++j) { const float v = __uint_as_float((unsigned)(unsigned short)qr[d0][j] << 16); qq += v * v; }
        qq = halfsum(qq); asm volatile("" : "+v"(qq));
        if (FAST) ref = sqrtf(qq) * (c ? kn1 : kn0) * 1.01f + 0.01f; }
    const float slope2 = __builtin_amdgcn_exp2f(-2.0f * (float)(h + 1)) * LOG2E;
    const bf16_t* tsrc = KD + (size_t)((b * 4 + h) * 256) * 16384 + wid * 2048 + lane * 8;
    LAS unsigned char* L = F.lds;
    const unsigned dbase = (unsigned)(uintptr_t)L + (unsigned)wid * 4096u;
#define B_DMA(tt, slot) do { const bf16_t* _k = tsrc + (size_t)(tt) * 16384; const unsigned _d = (unsigned)__builtin_amdgcn_readfirstlane((int)(dbase + (unsigned)(slot) * 32768u)); unsigned _keep; \
        asm volatile("s_mov_b32 %0, m0\n\ts_mov_b32 m0, %2\n\ts_nop 0\n\tglobal_load_lds_dwordx4 %1, off\n\tglobal_load_lds_dwordx4 %1, off offset:1024\n\tglobal_load_lds_dwordx4 %1, off offset:2048\n\tglobal_load_lds_dwordx4 %1, off offset:3072\n\ts_mov_b32 m0, %0" \
                     : "=&s"(_keep) : "v"(_k), "s"(_d) : "memory"); } while (0)
#define WAIT_BAR(N) asm volatile("s_waitcnt vmcnt(" #N ") lgkmcnt(0)\n\ts_barrier" ::: "memory")
#define SBAR() __builtin_amdgcn_sched_barrier(0)
#define PIN(x) asm volatile("" : "+v"(x))
#define VFRAG(dst, base, d0, ks) do { const s16x4 lo_ = vtr((base) + (d0) * 4096 + (ks) * 1024), hi_ = vtr((base) + (d0) * 4096 + (ks) * 1024 + 512); \
        dst = (bf16x8){lo_[0], lo_[1], lo_[2], lo_[3], hi_[0], hi_[1], hi_[2], hi_[3]}; } while (0)
#define GEN_C(tt) do { const float dq = (float)(qpos - (tt) * 64 - 4 * hi); \
        _Pragma("unroll") for (int r = 0; r < 16; ++r) { const float kk = (float)((r & 3) + 8 * (r >> 2)); C0[r] = -slope2 * __builtin_fabsf(dq - kk) - ref; C1[r] = -slope2 * __builtin_fabsf(dq - 32.f - kk) - ref; } } while (0)
    float mhat = NEG_BIG, lsum = 0.f; f32x16 o[4];
#pragma unroll
    for (int d = 0; d < 4; ++d) o[d] = (f32x16){};
    const int koff = (c * 8 + hi) * 1024 + r32 * 16;
    const int voff = 16384 + ((lane >> 4) & 1) * 32 + (lane & 3) * 8 + (4 * hi + ((lane & 15) >> 2)) * 64;
    const int tdiag = q0 >> 6;
    f32x16 C0, C1;
    u32x4 pw[4];
    const int NT = t_hi - t_lo + 1;
    GEN_C(t_lo);
    B_DMA(t_lo, 0); if (NT > 1) B_DMA(t_lo + 1, 1); if (NT > 2) B_DMA(t_lo + 2, 2);
    int sl = 0;
    for (int tau = 0; tau < NT; ++tau) {
        if (tau + 2 < NT) WAIT_BAR(8); else if (tau + 1 < NT) WAIT_BAR(4); else WAIT_BAR(0);
        if (tau + 3 < NT) B_DMA(t_lo + tau + 3, (sl + 3) & 3);
        const int t = t_lo + tau; const LAS unsigned char* buf = L + sl * 32768; const lds_cptr vbase = (lds_cptr)(buf + voff);
        bf16x8 kf[8];
#pragma unroll
        for (int d0 = 0; d0 < 4; ++d0) { kf[2 * d0] = *(const LAS bf16x8*)(buf + koff + d0 * 2048); kf[2 * d0 + 1] = *(const LAS bf16x8*)(buf + koff + d0 * 2048 + 512); }
        SBAR();
        f32x16 p0, p1;
        if constexpr (FAST) {
            bf16x8 vA[4], vB[4]; float sacc = 0.f;
#define EXPS(P, A, B) do { _Pragma("unroll") for (int r = (A); r < (B); ++r) { P[r] = __builtin_amdgcn_exp2f(P[r]); sacc += P[r]; } PIN(P); PIN(sacc); } while (0)
#define PK4(P, B) (u32x4){cvtpk(P[B], P[B + 1]), cvtpk(P[B + 2], P[B + 3]), cvtpk(P[B + 4], P[B + 5]), cvtpk(P[B + 6], P[B + 7])}
#define PWF(k) __builtin_bit_cast(bf16x8, pw[k])
            const float st = (t + 1 < tdiag) ? 64.f * slope2 : -64.f * slope2;
            p0 = MFMA32(kf[0], qr[0], C0); SBAR(); VFRAG(vA[0], vbase, 0, 0); SBAR();
            p0 = MFMA32(kf[2], qr[1], p0); SBAR(); VFRAG(vA[1], vbase, 1, 0); SBAR();
            p0 = MFMA32(kf[4], qr[2], p0); SBAR(); VFRAG(vA[2], vbase, 2, 0); SBAR();
            p0 = MFMA32(kf[6], qr[3], p0); SBAR(); VFRAG(vA[3], vbase, 3, 0); SBAR();
            p1 = MFMA32(kf[1], qr[0], C1); SBAR();
            p1 = MFMA32(kf[3], qr[1], p1); SBAR(); EXPS(p0, 0, 5); SBAR();
            p1 = MFMA32(kf[5], qr[2], p1); SBAR(); EXPS(p0, 5, 11); SBAR();
            p1 = MFMA32(kf[7], qr[3], p1); SBAR(); EXPS(p0, 11, 16); pw[0] = PK4(p0, 0); PIN(pw[0]); SBAR();
            o[0] = MFMA32(vA[0], PWF(0), o[0]); SBAR(); pw[1] = PK4(p0, 8); PIN(pw[1]); VFRAG(vB[0], vbase, 0, 1); SBAR();
            o[1] = MFMA32(vA[1], PWF(0), o[1]); SBAR(); EXPS(p1, 0, 3); VFRAG(vB[1], vbase, 1, 1); SBAR();
            o[2] = MFMA32(vA[2], PWF(0), o[2]); SBAR(); EXPS(p1, 3, 6); VFRAG(vB[2], vbase, 2, 1); SBAR();
            o[3] = MFMA32(vA[3], PWF(0), o[3]); SBAR(); EXPS(p1, 6, 8); VFRAG(vB[3], vbase, 3, 1); SBAR();
            o[0] = MFMA32(vB[0], PWF(1), o[0]); SBAR(); EXPS(p1, 8, 10); VFRAG(vA[0], vbase, 0, 2); SBAR();
            o[1] = MFMA32(vB[1], PWF(1), o[1]); SBAR(); EXPS(p1, 10, 12); VFRAG(vA[1], vbase, 1, 2); SBAR();
            o[2] = MFMA32(vB[2], PWF(1), o[2]); SBAR(); EXPS(p1, 12, 14); VFRAG(vA[2], vbase, 2, 2); SBAR();
            o[3] = MFMA32(vB[3], PWF(1), o[3]); SBAR(); EXPS(p1, 14, 16); VFRAG(vA[3], vbase, 3, 2); pw[2] = PK4(p1, 0); PIN(pw[2]); SBAR();
            o[0] = MFMA32(vA[0], PWF(2), o[0]); SBAR(); pw[3] = PK4(p1, 8); PIN(pw[3]); VFRAG(vB[0], vbase, 0, 3); SBAR();
            o[1] = MFMA32(vA[1], PWF(2), o[1]); SBAR(); VFRAG(vB[1], vbase, 1, 3);
#pragma unroll
            for (int r = 0; r < 8; ++r) C0[r] += st;
            PIN(C0); SBAR();
            o[2] = MFMA32(vA[2], PWF(2), o[2]); SBAR(); VFRAG(vB[2], vbase, 2, 3);
#pragma unroll
            for (int r = 8; r < 16; ++r) C0[r] += st;
            PIN(C0); SBAR();
            o[3] = MFMA32(vA[3], PWF(2), o[3]); SBAR(); VFRAG(vB[3], vbase, 3, 3);
#pragma unroll
            for (int r = 0; r < 8; ++r) C1[r] += st;
            PIN(C1); SBAR();
            o[0] = MFMA32(vB[0], PWF(3), o[0]); SBAR();
#pragma unroll
            for (int r = 8; r < 16; ++r) C1[r] += st;
            PIN(C1); SBAR();
            o[1] = MFMA32(vB[1], PWF(3), o[1]);
            o[2] = MFMA32(vB[2], PWF(3), o[2]);
            o[3] = MFMA32(vB[3], PWF(3), o[3]);
            lsum += sacc;
#undef EXPS
#undef PK4
#undef PWF
        } else {
            p0 = MFMA32(kf[0], qr[0], C0); p1 = MFMA32(kf[1], qr[0], C1);
#pragma unroll
            for (int d0 = 1; d0 < 4; ++d0) { p0 = MFMA32(kf[2 * d0], qr[d0], p0); p1 = MFMA32(kf[2 * d0 + 1], qr[d0], p1); }
            softmax_tile<4>(p0, p1, mhat, lsum, o, pw);
            pv_tile<4>(o, vbase, pw);
            const float st = (t + 1 < tdiag) ? 64.f * slope2 : -64.f * slope2; C0 = C0 + st; C1 = C1 + st;
        }
        if ((t + 1 >= tdiag && t + 1 <= tdiag + 2) || ((tau + 1) & 15) == 0) GEN_C(t + 1);
        sl = (sl + 1) & 3;
    }
#undef B_DMA
#undef WAIT_BAR
#undef VFRAG
#undef GEN_C
#undef SBAR
#undef PIN
    attnB_finish(F, a, o, lsum, lam, rowbase, qpos, h, c, qs, r32, hi);
}
__device__ __forceinline__ void attnB_fast(const Frame& F, const Args& a, int b, int h, int qblk, float lam, int t_lo, int t_hi, float kn0, float kn1) {
    const int lane = F_LANE, r32 = lane & 31, hi = lane >> 5, wid = F.wave, c = wid >> 2, qs = wid & 3;
    const bf16_t* QD = (const bf16_t*)(a.ws + WS_PROJ) + 3 * PROJ_STRIDE; const bf16_t* KD = QD + PROJ_STRIDE;
    const size_t rowbase = (size_t)b * SEQ; const int q0 = qblk * 128, qpos = q0 + 32 * qs + r32;
    bf16x8 qr[4];
    { const bf16_t* Qp = QD + (rowbase + qpos) * 512 + h * 128 + c * 64 + 8 * hi;
#pragma unroll
      for (int d0 = 0; d0 < 4; ++d0) qr[d0] = *(const bf16x8*)(Qp + 16 * d0); }
    float ref;
    { float qq = 0.f;
#pragma unroll
        for (int d0 = 0; d0 < 4; ++d0)
#pragma unroll
            for (int j = 0; j < 8; ++j) { const float v = __uint_as_float((unsigned)(unsigned short)qr[d0][j] << 16); qq += v * v; }
        qq = halfsum(qq); asm volatile("" : "+v"(qq));
        ref = sqrtf(qq) * (c ? kn1 : kn0) * 1.01f + 0.01f; }
    const float slope2 = __builtin_amdgcn_exp2f(-2.0f * (float)(h + 1)) * LOG2E;
    const bf16_t* tsrc = KD + (size_t)((b * 4 + h) * 256) * 16384 + wid * 2048 + lane * 8;
    LAS unsigned char* L = F.lds;
    const unsigned dbase = (unsigned)(uintptr_t)L + (unsigned)wid * 4096u;
#define B_DMA(tt, slot) do { const bf16_t* _k = tsrc + (size_t)(tt) * 16384; const unsigned _d = (unsigned)__builtin_amdgcn_readfirstlane((int)(dbase + (unsigned)(slot) * 32768u)); unsigned _keep; \
        asm volatile("s_mov_b32 %0, m0\n\ts_mov_b32 m0, %2\n\ts_nop 0\n\tglobal_load_lds_dwordx4 %1, off\n\tglobal_load_lds_dwordx4 %1, off offset:1024\n\tglobal_load_lds_dwordx4 %1, off offset:2048\n\tglobal_load_lds_dwordx4 %1, off offset:3072\n\ts_mov_b32 m0, %0" \
                     : "=&s"(_keep) : "v"(_k), "s"(_d) : "memory"); } while (0)
#define WAIT_BAR(N) asm volatile("s_waitcnt vmcnt(" #N ") lgkmcnt(0)\n\ts_barrier" : "+v"(p1), "+v"(sacc) :: "memory")
#define VFRAG(dst, base, d0, ks) do { const s16x4 lo_ = vtr((base) + (d0) * 4096 + (ks) * 1024), hi_ = vtr((base) + (d0) * 4096 + (ks) * 1024 + 512); \
        dst = (bf16x8){lo_[0], lo_[1], lo_[2], lo_[3], hi_[0], hi_[1], hi_[2], hi_[3]}; } while (0)
#define MF_ "v_mfma_f32_32x32x16_bf16 "
#define AMF(D, A, B)              asm volatile(MF_ "%0, %1, %2, %0" : "+v"(D) : "v"(A), "v"(B) : "memory")
#define AMF1(D, A, B, X)          asm volatile(MF_ "%0, %2, %3, %0" : "+v"(D), "+v"(X) : "v"(A), "v"(B) : "memory")
#define AMF2(D, A, B, X, Y)       asm volatile(MF_ "%0, %3, %4, %0" : "+v"(D), "+v"(X), "+v"(Y) : "v"(A), "v"(B) : "memory")
#define AMF3(D, A, B, X, Y, Z)    asm volatile(MF_ "%0, %4, %5, %0" : "+v"(D), "+v"(X), "+v"(Y), "+v"(Z) : "v"(A), "v"(B) : "memory")
#define AMF0(D, A, B)             asm volatile(MF_ "%0, %1, %2, 0" : "=&v"(D) : "v"(A), "v"(B) : "memory")
#define PK4(P, B) (u32x4){cvtpk(P[B], P[B + 1]), cvtpk(P[B + 2], P[B + 3]), cvtpk(P[B + 4], P[B + 5]), cvtpk(P[B + 6], P[B + 7])}
#define XE(P, r) { P[r] = __builtin_amdgcn_exp2f(P[r]); sacc += P[r]; }
#define XE2(P, r) do { XE(P, r) XE(P, (r) + 1) } while (0)
#define KLD(bk, i) kf[i] = *(const LAS bf16x8*)((bk) + koff + ((i) >> 1) * 2048 + ((i) & 1) * 512)
#define SET_KA(tn) do { const unsigned w_ = __builtin_amdgcn_perm(0u, __float_as_uint(tf), 0x03020302u); ka0[1] = w_; ka1[1] = w_; tf += tinc; if ((tn) == tdiag + 2) qa = qaR; } while (0)
#define BIAS_HALF(P, KA, e, tn) do { \
        if ((unsigned)((tn) - tdiag) < 2u) { const int kb_ = 2 * (tn) + (e); \
            if (kb_ == qb) { float dq_ = (float)(qpos - (tn) * 64 - 32 * (e) - 4 * hi), ns_ = -slope2, nr_ = -ref; asm volatile("" : "+v"(dq_), "+v"(ns_), "+v"(nr_)); \
                             _Pragma("unroll") for (int r = 0; r < 16; ++r) { const float kk_ = (float)((r & 3) + 8 * (r >> 2)); P[r] = __builtin_fmaf(ns_, __builtin_fabsf(dq_ - kk_), nr_); } \
                             asm volatile("s_nop 4" : "+v"(P) :: "memory"); } \
            else if (kb_ < qb) { AMF0(P, KA, qaL); } else { AMF0(P, KA, qaR); } } \
        else { AMF0(P, KA, qa); } } while (0)
    const int tdiag = q0 >> 6, qb = 4 * qblk + qs;
    const unsigned msk = hi ? 0u : 0xFFFFFFFFu;
    bf16x8 qaL, qaR, qa; u32x4 ka0, ka1;
    { const float S64 = 64.f * slope2;
        const unsigned sh = bfb(slope2), slo = bfb(slope2 - bff(sh)), Sh = bfb(S64), Slo = bfb(S64 - bff(Sh));
        unsigned ch, cm, cl, dh, dm, dl;
        bf_split3(slope2 * (float)(qpos - 64 * tdiag) - ref, ch, cm, cl);
        bf_split3(-slope2 * (float)(qpos - 64 * tdiag) - ref, dh, dm, dl);
        const u32x4 r_ = (u32x4){(((slo ^ 0x8000u) << 16) | (sh ^ 0x8000u)) & msk, (((Slo ^ 0x8000u) << 16) | (Sh ^ 0x8000u)) & msk, ((cm << 16) | ch) & msk, cl & msk};
        const u32x4 l_ = (u32x4){((slo << 16) | sh) & msk, ((Slo << 16) | Sh) & msk, ((dm << 16) | dh) & msk, dl & msk};
        qaR = __builtin_bit_cast(bf16x8, r_); qaL = __builtin_bit_cast(bf16x8, l_); qa = (t_lo < tdiag + 2) ? qaL : qaR;
        const unsigned j0 = bfb((float)r32), j1 = bfb((float)(32 + r32));
        ka0 = (u32x4){((j0 << 16) | j0) & msk, 0u, 0x3F803F80u & msk, 0x00003F80u & msk}; ka1 = ka0; ka1[0] = ((j1 << 16) | j1) & msk; }
    float tf = hi ? 0.f : (float)(t_lo - tdiag); const float tinc = hi ? 0.f : 1.f;
    f32x16 o[4], p0, p1; u32x4 pw[4]; bf16x8 kf[8], vA[4], vB[4]; float sacc = 0.f;
#pragma unroll
    for (int d = 0; d < 4; ++d) o[d] = (f32x16){};
    p1 = (f32x16){};
    const int koff = (c * 8 + hi) * 1024 + r32 * 16;
    const int voff = 16384 + ((lane >> 4) & 1) * 32 + (lane & 3) * 8 + (4 * hi + ((lane & 15) >> 2)) * 64;
    const int NT = t_hi - t_lo + 1;
    B_DMA(t_lo, 0); if (NT > 1) B_DMA(t_lo + 1, 1); if (NT > 2) B_DMA(t_lo + 2, 2);
    if (NT > 2) WAIT_BAR(8); else if (NT > 1) WAIT_BAR(4); else WAIT_BAR(0);
    {
        const LAS unsigned char* bk = L;
#pragma unroll
        for (int i = 0; i < 8; ++i) KLD(bk, i);
        SET_KA(t_lo);
        asm volatile("s_nop 1" : "+v"(ka0), "+v"(ka1), "+v"(qa) :: "memory");
        BIAS_HALF(p0, ka0, 0, t_lo);
        AMF(p0, kf[0], qr[0]); AMF(p0, kf[2], qr[1]); AMF(p0, kf[4], qr[2]); AMF(p0, kf[6], qr[3]);
        BIAS_HALF(p1, ka1, 1, t_lo);
        AMF(p1, kf[1], qr[0]); AMF(p1, kf[3], qr[1]); AMF(p1, kf[5], qr[2]); AMF(p1, kf[7], qr[3]);
        const lds_cptr vb0 = (lds_cptr)(bk + voff);
        VFRAG(vA[0], vb0, 0, 0); VFRAG(vA[1], vb0, 1, 0); VFRAG(vA[2], vb0, 2, 0); VFRAG(vA[3], vb0, 3, 0);
        asm volatile("s_nop 15\n\ts_nop 15" : "+v"(p0), "+v"(p1) :: "memory");
#pragma unroll
        for (int r = 0; r < 16; r += 2) XE2(p0, r);
#pragma unroll
        for (int r = 0; r < 16; r += 2) XE2(p1, r);
        pw[0] = PK4(p0, 0); pw[1] = PK4(p0, 8); pw[2] = PK4(p1, 0);
    }
    int sl = 0;
    for (int tau = 0; tau + 1 < NT; ++tau) {
        if (tau + 2 < NT) WAIT_BAR(4); else WAIT_BAR(0);
        if (tau + 3 < NT) B_DMA(t_lo + tau + 3, (sl + 3) & 3);
        const LAS unsigned char* buf = L + sl * 32768; const LAS unsigned char* bufn = L + ((sl + 1) & 3) * 32768;
        const lds_cptr vb = (lds_cptr)(buf + voff), vbn = (lds_cptr)(bufn + voff);
        const int tn = t_lo + tau + 1;
        SET_KA(tn);
        AMF(o[0], vA[0], pw[0]);            KLD(bufn, 0); KLD(bufn, 2);
        AMF1(o[1], vA[1], pw[0], p1);       KLD(bufn, 4); KLD(bufn, 6); pw[3] = PK4(p1, 8);
        AMF1(o[2], vA[2], pw[0], pw[3]);    KLD(bufn, 1); KLD(bufn, 3);
        AMF(o[3], vA[3], pw[0]);            KLD(bufn, 5); KLD(bufn, 7);
        BIAS_HALF(p0, ka0, 0, tn);          VFRAG(vB[0], vb, 0, 1);
        AMF(p0, kf[0], qr[0]);              VFRAG(vB[1], vb, 1, 1);
        AMF(p0, kf[2], qr[1]);              VFRAG(vB[2], vb, 2, 1);
        AMF(p0, kf[4], qr[2]);              VFRAG(vB[3], vb, 3, 1);
        AMF(p0, kf[6], qr[3]);
        BIAS_HALF(p1, ka1, 1, tn);
        AMF1(p1, kf[1], qr[0], p0);         XE2(p0, 0);
        AMF2(p1, kf[3], qr[1], p0, sacc);   XE2(p0, 2);
        AMF2(p1, kf[5], qr[2], p0, sacc);   XE2(p0, 4);
        AMF2(p1, kf[7], qr[3], p0, sacc);   XE2(p0, 6);
        AMF2(o[0], vB[0], pw[1], p0, sacc); XE2(p0, 8);  VFRAG(vA[0], vb, 0, 2);
        AMF2(o[1], vB[1], pw[1], p0, sacc); XE2(p0, 10); VFRAG(vA[1], vb, 1, 2);
        AMF2(o[2], vB[2], pw[1], p0, sacc); XE2(p0, 12); VFRAG(vA[2], vb, 2, 2);
        AMF2(o[3], vB[3], pw[1], p0, sacc); XE2(p0, 14); VFRAG(vA[3], vb, 3, 2);
        AMF3(o[0], vA[0], pw[2], p0, sacc, p1);     pw[0] = PK4(p0, 0); XE2(p1, 0); VFRAG(vB[0], vb, 0, 3);
        AMF3(o[1], vA[1], pw[2], p1, sacc, pw[0]);  XE2(p1, 2); VFRAG(vB[1], vb, 1, 3);
        AMF3(o[2], vA[2], pw[2], p1, sacc, p0);     pw[1] = PK4(p0, 8); XE2(p1, 4); VFRAG(vB[2], vb, 2, 3);
        AMF3(o[3], vA[3], pw[2], p1, sacc, pw[1]);  XE2(p1, 6); VFRAG(vB[3], vb, 3, 3);
        AMF2(o[0], vB[0], pw[3], p1, sacc); XE2(p1, 8);  VFRAG(vA[0], vbn, 0, 0);
        AMF2(o[1], vB[1], pw[3], p1, sacc); XE2(p1, 10); VFRAG(vA[1], vbn, 1, 0);
        AMF2(o[2], vB[2], pw[3], p1, sacc); pw[2] = PK4(p1, 0); XE2(p1, 12); VFRAG(vA[2], vbn, 2, 0);
        AMF3(o[3], vB[3], pw[3], p1, sacc, pw[2]);  XE2(p1, 14); VFRAG(vA[3], vbn, 3, 0);
        sl = (sl + 1) & 3;
    }
    {
        const lds_cptr vb = (lds_cptr)(L + sl * 32768 + voff);
        pw[3] = PK4(p1, 8);
        AMF3(o[0], vA[0], pw[0], p1, sacc, pw[3]); VFRAG(vB[0], vb, 0, 1);
        AMF(o[1], vA[1], pw[0]); VFRAG(vB[1], vb, 1, 1);
        AMF(o[2], vA[2], pw[0]); VFRAG(vB[2], vb, 2, 1);
        AMF(o[3], vA[3], pw[0]); VFRAG(vB[3], vb, 3, 1);
        AMF(o[0], vB[0], pw[1]); VFRAG(vA[0], vb, 0, 2);
        AMF(o[1], vB[1], pw[1]); VFRAG(vA[1], vb, 1, 2);
        AMF(o[2], vB[2], pw[1]); VFRAG(vA[2], vb, 2, 2);
        AMF(o[3], vB[3], pw[1]); VFRAG(vA[3], vb, 3, 2);
        AMF(o[0], vA[0], pw[2]); VFRAG(vB[0], vb, 0, 3);
        AMF(o[1], vA[1], pw[2]); VFRAG(vB[1], vb, 1, 3);
        AMF(o[2], vA[2], pw[2]); VFRAG(vB[2], vb, 2, 3);
        AMF(o[3], vA[3], pw[2]); VFRAG(vB[3], vb, 3, 3);
        AMF(o[0], vB[0], pw[3]); AMF(o[1], vB[1], pw[3]); AMF(o[2], vB[2], pw[3]); AMF(o[3], vB[3], pw[3]);
        asm volatile("s_nop 15\n\ts_nop 15" : "+v"(o[0]), "+v"(o[1]), "+v"(o[2]), "+v"(o[3]) :: "memory");
    }
#undef B_DMA
#undef WAIT_BAR
#undef VFRAG
#undef MF_
#undef AMF
#undef AMF1
#undef AMF2
#undef AMF3
#undef AMF0
#undef PK4
#undef XE
#undef XE2
#undef KLD
#undef SET_KA
#undef BIAS_HALF
    attnB_finish(F, a, o, sacc, lam, rowbase, qpos, h, c, qs, r32, hi);
}
__device__ __forceinline__ void attnB_item(const Frame& F, const Args& a, int h, int b, int qblk, float lam) {
    const int q0 = qblk * 128;
    const unsigned* ctl = (const unsigned*)(a.ws + WS_CTL); const int sl = (b * 4 + h) * 4;
    const float qn0 = sqrtf(__uint_as_float(ctl[CW_QMAX + sl]) + __uint_as_float(ctl[CW_QMAX + sl + 1])), qn1 = sqrtf(__uint_as_float(ctl[CW_QMAX + sl + 2]) + __uint_as_float(ctl[CW_QMAX + sl + 3]));
    const float kn0 = sqrtf(__uint_as_float(ctl[CW_KMAX + sl]) + __uint_as_float(ctl[CW_KMAX + sl + 1])), kn1 = sqrtf(__uint_as_float(ctl[CW_KMAX + sl + 2]) + __uint_as_float(ctl[CW_KMAX + sl + 3]));
    const float U = fmaxf(qn0 * kn0, qn1 * kn1) * 1.01f + 0.01f;
    const float slope2 = __builtin_amdgcn_exp2f(-2.0f * (float)(h + 1)) * LOG2E;
    const float Df = (2.0f * U + 152.0f) / slope2;
    const int Dd = Df < 40000.f ? (int)Df + 2 : 40000;
    int t_lo = (q0 - Dd) >> 6; if (q0 - Dd < 0) t_lo = 0;
    int t_hi = (q0 + 127 + Dd) >> 6; if (t_hi > SEQ / 64 - 1) t_hi = SEQ / 64 - 1;
    if (U <= 40.f) attnB_fast(F, a, b, h, qblk, lam, t_lo, t_hi, kn0, kn1);
    else attnB_unit<false>(F, a, b, h, qblk, lam, t_lo, t_hi, kn0, kn1);
}

__device__ __forceinline__ int a_kbase(int n0, int it) { return n0 - 64 + 64 * ((it == 0) ? 1 : (it == 1 ? 0 : 2)); }
__device__ __forceinline__ void a_load_k(const bf16_t* KA, size_t rowbase, int head, int d, int r, int L, int kbase, int r32, int hi, bf16x8 (&kf)[8]) {
#pragma unroll
    for (int kh = 0; kh < 2; ++kh) { int kn = kbase + 32 * kh + r32; kn = kn < 0 ? 0 : (kn >= L ? L - 1 : kn);
        const bf16_t* Kp = KA + (rowbase + (size_t)(d * kn + r)) * 512 + head * 64 + 8 * hi;
#pragma unroll
        for (int d0 = 0; d0 < 4; ++d0) kf[2 * d0 + kh] = *(const bf16x8*)(Kp + 16 * d0); }
}
__device__ __forceinline__ void attnA_task(const Frame& F, const Args& a, int b, int head, int d, int r, int n0, int L, LAS unsigned char* vw, f32x16 (&o)[2], float& mhat, float& ltot) {
    const int lane = F_LANE, r32 = lane & 31, hi = lane >> 5;
    const bf16_t* QA = (const bf16_t*)(a.ws + WS_PROJ); const bf16_t* KA = QA + PROJ_STRIDE; const bf16_t* VA = KA + PROJ_STRIDE;
    const size_t rowbase = (size_t)b * SEQ; const int qn = n0 + r32;
    bf16x8 qr[4], kf[8], kfn[8];
    { const bf16_t* Qp = QA + (rowbase + (size_t)(d * qn + r)) * 512 + head * 64 + 8 * hi;
#pragma unroll
      for (int d0 = 0; d0 < 4; ++d0) qr[d0] = *(const bf16x8*)(Qp + 16 * d0); }
    a_load_k(KA, rowbase, head, d, r, L, a_kbase(n0, 0), r32, hi, kf);
    const float sl = __builtin_amdgcn_exp2f(-(float)(head + 1)) * LOG2E * (float)d;
    mhat = NEG_BIG; float lsum = 0.f; o[0] = (f32x16){}; o[1] = (f32x16){};
    const int voff = ((lane >> 4) & 1) * 32 + (lane & 3) * 8 + (4 * hi + ((lane & 15) >> 2)) * 64;
#pragma unroll
    for (int it = 0; it < 3; ++it) {
        const int kbase = a_kbase(n0, it);
        u32x4 vv[8];
#pragma unroll
        for (int ks = 0; ks < 4; ++ks) { int kn = kbase + 16 * ks + (lane >> 2); kn = kn < 0 ? 0 : (kn >= L ? L - 1 : kn);
            const bf16_t* Vp = VA + (rowbase + (size_t)(d * kn + r)) * 512 + head * 64 + 8 * (lane & 3);
            vv[ks] = *(const u32x4*)Vp; vv[4 + ks] = *(const u32x4*)(Vp + 32); }
        if (it < 2) a_load_k(KA, rowbase, head, d, r, L, a_kbase(n0, it + 1), r32, hi, kfn);
        __builtin_amdgcn_sched_barrier(0);
        f32x16 p0, p1;
#pragma unroll
        for (int rr = 0; rr < 16; ++rr) { const int k0 = kbase + crow(rr, hi), k1 = k0 + 32; const int d0_ = k0 - qn, d1_ = k1 - qn;
            const bool v0 = (k0 >= 0) && (k0 < L) && (d0_ <= 64) && (d0_ >= -64), v1 = (k1 >= 0) && (k1 < L) && (d1_ <= 64) && (d1_ >= -64);
            p0[rr] = v0 ? -sl * __builtin_fabsf((float)d0_) : NEG_BIG; p1[rr] = v1 ? -sl * __builtin_fabsf((float)d1_) : NEG_BIG; }
#pragma unroll
        for (int d0 = 0; d0 < 4; ++d0) { p0 = MFMA32(kf[2 * d0], qr[d0], p0); p1 = MFMA32(kf[2 * d0 + 1], qr[d0], p1); }
        u32x4 pw[4];
        softmax_tile<2>(p0, p1, mhat, lsum, o, pw);
        __builtin_amdgcn_sched_barrier(0);
#pragma unroll
        for (int i = 0; i < 8; ++i) *(LAS u32x4*)(vw + i * 1024 + lane * 16) = vv[i];
        asm volatile("s_waitcnt lgkmcnt(0)" ::: "memory");
        pv_tile<2>(o, (lds_cptr)(vw + voff), pw);
        asm volatile("s_waitcnt lgkmcnt(0)" ::: "memory");
        if (it < 2) {
#pragma unroll
            for (int j = 0; j < 8; ++j) kf[j] = kfn[j];
        }
    }
    ltot = halfsum(lsum);
}
__device__ __forceinline__ void attnA_unit(const Frame& F, const Args& a, int unit) {
    const int lane = F_LANE, r32 = lane & 31, hi = lane >> 5, wid = F.wave;
    const int b = unit >> 7, head = (unit >> 4) & 7, tb = unit & 15, T0 = tb * 1024;
    float* part = (float*)(a.ws + WS_APART + (size_t)unit * APART_UNIT); float* ml = part + 2 * 1024 * 64;
    LAS unsigned char* vw = F.lds + wid * 8192;
    for (int task = wid; task < 64; task += 8) {
        int pat, d, r, n0, L;
        if (task < 32) { pat = 0; d = 16; r = task >> 1; n0 = T0 / 16 + 32 * (task & 1); L = SEQ / 16; }
        else { const int tt = task - 32; pat = 1; d = 4; r = tt >> 3; n0 = T0 / 4 + 32 * (tt & 7); L = SEQ / 4; }
        f32x16 o[2]; float mhat, ltot;
        attnA_task(F, a, b, head, d, r, n0, L, vw, o, mhat, ltot);
        const int tl = d * (n0 + r32) + r - T0;
        float* pp = part + ((size_t)pat * 1024 + tl) * 64 + 4 * hi;
#pragma unroll
        for (int d0 = 0; d0 < 2; ++d0)
#pragma unroll
            for (int g = 0; g < 4; ++g) *(f32x4*)(pp + 32 * d0 + 8 * g) = (f32x4){o[d0][4 * g], o[d0][4 * g + 1], o[d0][4 * g + 2], o[d0][4 * g + 3]};
        if (hi == 0) *(f32x2*)(ml + ((size_t)pat * 1024 + tl) * 2) = (f32x2){mhat, ltot};
    }
    asm volatile("s_waitcnt vmcnt(0)" ::: "memory");
    __syncthreads();
    __builtin_amdgcn_fence(__ATOMIC_ACQUIRE, "agent");
    for (int task = wid; task < 32; task += 8) {
        const int n0 = T0 + 32 * task;
        f32x16 o[2]; float m0, l0;
        attnA_task(F, a, b, head, 1, 0, n0, SEQ, vw, o, m0, l0);
        const int tl = 32 * task + r32;
        const f32x2 ml1 = *(const f32x2*)(ml + ((size_t)0 * 1024 + tl) * 2), ml2 = *(const f32x2*)(ml + ((size_t)1 * 1024 + tl) * 2);
        const float M = MX3(m0, ml1[0], ml2[0]);
        const float w0 = __builtin_amdgcn_exp2f(m0 - M), w1 = __builtin_amdgcn_exp2f(ml1[0] - M), w2 = __builtin_amdgcn_exp2f(ml2[0] - M);
        const float rden = 1.0f / (w0 * l0 + w1 * ml1[1] + w2 * ml2[1]);
        const float* p1 = part + ((size_t)0 * 1024 + tl) * 64 + 4 * hi; const float* p2 = part + ((size_t)1 * 1024 + tl) * 64 + 4 * hi;
        bf16_t* op = (bf16_t*)(a.ws + WS_MIXED) + ((size_t)b * SEQ + T0 + tl) * DM + head * 64 + 4 * hi;
#pragma unroll
        for (int d0 = 0; d0 < 2; ++d0)
#pragma unroll
            for (int g = 0; g < 4; ++g) { const f32x4 a1 = *(const f32x4*)(p1 + 32 * d0 + 8 * g), a2 = *(const f32x4*)(p2 + 32 * d0 + 8 * g); float v[4];
#pragma unroll
                for (int j = 0; j < 4; ++j) v[j] = (w0 * o[d0][4 * g + j] + w1 * a1[j] + w2 * a2[j]) * rden;
                u32x2 w; w.x = cvtpk(v[0], v[1]); w.y = cvtpk(v[2], v[3]); *(u32x2*)(op + 32 * d0 + 8 * g) = w; }
    }
    __syncthreads();
}

__device__ __forceinline__ unsigned ordkey(float v) { const unsigned u = __float_as_uint(v); return u ^ ((u >> 31) ? 0xFFFFFFFFu : 0x80000000u); }
__device__ __forceinline__ float unordkey(unsigned k) { const unsigned u = (k & 0x80000000u) ? (k ^ 0x80000000u) : ~k; return __uint_as_float(u); }
__device__ __forceinline__ void p4_ln_router(const Frame& F, const Args& a) {
    const int lane = F_LANE, wid = F.wave, tid = F_TID;
    LAS float* Wr = (LAS float*)F.lds;
    LAS unsigned* misc = (LAS unsigned*)(F.lds + LX_MISC);
    LAS float* pc = (LAS float*)(F.lds + LX_TOK);
    for (int i = tid; i < DM * NE / 4; i += 512) ((LAS f32x4*)Wr)[i] = ((const f32x4*)a.w_router)[i] * a.ln1_g[i >> 3];
    if (tid < 64) misc[tid] = 0u;
    float* Z = (float*)(a.ws + WS_Z); bf16_t* X1B = (bf16_t*)(a.ws + WS_XB);
    const int r0 = (F.vcu * 8 + wid) * 16;
    const int rl = lane & 15, q = lane >> 4;
    float mym[4] = {0.f, 0.f, 0.f, 0.f}, myr[4] = {0.f, 0.f, 0.f, 0.f};
    {
        f32x4 gv[4], bv[4];
#pragma unroll
        for (int j = 0; j < 4; ++j) { gv[j] = ((const f32x4*)a.ln1_g)[lane + 64 * j]; bv[j] = ((const f32x4*)a.ln1_b)[lane + 64 * j]; }
        float* stats = (float*)(a.ws + WS_ROUTE + 4 * MiB);
#pragma unroll 4
        for (int rr = 0; rr < 16; ++rr) {
            const f32x4* zr = (const f32x4*)(Z + (size_t)(r0 + rr) * DM) + lane; f32x4 v[4]; float s = 0.f;
#pragma unroll
            for (int j = 0; j < 4; ++j) { v[j] = zr[64 * j]; s += (v[j][0] + v[j][1]) + (v[j][2] + v[j][3]); }
            const float mean = wave_sum(s) * (1.f / DM); float s2 = 0.f;
#pragma unroll
            for (int j = 0; j < 4; ++j) { v[j] = v[j] - mean; s2 += (v[j][0] * v[j][0] + v[j][1] * v[j][1]) + (v[j][2] * v[j][2] + v[j][3] * v[j][3]); }
            const float rstd = 1.f / sqrtf(wave_sum(s2) * (1.f / DM) + LN_EPS);
            unsigned* o8 = (unsigned*)((unsigned char*)X1B + (size_t)(r0 + rr) * DM) + lane;
#pragma unroll
            for (int j = 0; j < 4; ++j) { const f32x4 y = (v[j] * rstd * gv[j] + bv[j]) * 8.f; o8[64 * j] = cvt4_fp8(y[0], y[1], y[2], y[3]); }
            if (lane == 0) *(f32x2*)(stats + 2 * (r0 + rr)) = (f32x2){mean, rstd};
            if ((rr >> 2) == q) {
#pragma unroll
                for (int i = 0; i < 4; ++i) if ((rr & 3) == i) { mym[i] = mean; myr[i] = rstd; } }
        }
    }
    __syncthreads();
    {
        const int e = tid & 31, part = tid >> 5; float s0 = 0.f, s1 = 0.f;
        for (int k = part * 64; k < part * 64 + 64; ++k) { s0 += Wr[k * 32 + e]; s1 += a.ln1_b[k] * a.w_router[k * 32 + e]; }
        pc[part * 32 + e] = s0; pc[512 + part * 32 + e] = s1;
    }
    __syncthreads();
    if (tid < 64) { const int e = tid & 31, w = tid >> 5; float t = 0.f; for (int p = 0; p < 16; ++p) t += pc[w * 512 + p * 32 + e]; pc[1024 + tid] = t + (w ? a.b_router[e] : 0.f); }
    __syncthreads();
    f32x4 acc0 = (f32x4){0.f, 0.f, 0.f, 0.f}, acc1 = acc0;
    const float* xr = Z + (size_t)(r0 + rl) * DM + 4 * q;
#pragma unroll 4
    for (int cidx = 0; cidx < 64; ++cidx) {
        const f32x4 xv = *(const f32x4*)(xr + 16 * cidx);
#pragma unroll
        for (int j = 0; j < 4; ++j) { const int k = 16 * cidx + 4 * q + j;
            acc0 = __builtin_amdgcn_mfma_f32_16x16x4f32(xv[j], Wr[k * 32 + rl], acc0, 0, 0, 0);
            acc1 = __builtin_amdgcn_mfma_f32_16x16x4f32(xv[j], Wr[k * 32 + 16 + rl], acc1, 0, 0, 0); }
    }
    {   const float cs0 = pc[1024 + rl], cs1 = pc[1024 + 16 + rl], cb0 = pc[1024 + 32 + rl], cb1 = pc[1024 + 48 + rl];
#pragma unroll
        for (int i = 0; i < 4; ++i) { acc0[i] = myr[i] * (acc0[i] - mym[i] * cs0) + cb0; acc1[i] = myr[i] * (acc1[i] - mym[i] * cs1) + cb1; } }
    const float br0 = 0.f, br1 = 0.f;
    int* sel_e = (int*)(a.ws + WS_ROUTE); int* sel_pos = sel_e + NTOK * TOPK; float* sel_gate = (float*)(sel_pos + NTOK * TOPK);
    int my_e[4] = {0, 0, 0, 0}, my_lp[4] = {0, 0, 0, 0}; float my_g[4] = {0.f, 0.f, 0.f, 0.f};
#pragma unroll
    for (int i = 0; i < 4; ++i) {
        unsigned k0 = (ordkey(acc0[i] + br0) & ~31u) | (unsigned)(31 - rl), k1 = (ordkey(acc1[i] + br1) & ~31u) | (unsigned)(15 - rl);
        unsigned selk[4];
#pragma unroll
        for (int t = 0; t < 4; ++t) {
            unsigned m = k0 > k1 ? k0 : k1;
#pragma unroll
            for (int ofs = 1; ofs < 16; ofs <<= 1) { const unsigned other = (unsigned)__shfl_xor((int)m, ofs); m = other > m ? other : m; }
            selk[t] = m; if (k0 == m) k0 = 0u; if (k1 == m) k1 = 0u;
        }
        const float v0 = unordkey(selk[0] & ~31u), v1 = unordkey(selk[1] & ~31u), v2 = unordkey(selk[2] & ~31u), v3 = unordkey(selk[3] & ~31u);
        const float e1 = __expf(v1 - v0), e2 = __expf(v2 - v0), e3 = __expf(v3 - v0); const float rs = 1.0f / (1.0f + e1 + e2 + e3);
        if (rl < 4) { const unsigned sk = rl == 0 ? selk[0] : (rl == 1 ? selk[1] : (rl == 2 ? selk[2] : selk[3]));
            const float ge = rl == 0 ? 1.0f : (rl == 1 ? e1 : (rl == 2 ? e2 : e3));
            my_e[i] = 31 - (int)(sk & 31u); my_g[i] = ge * rs; my_lp[i] = (int)atomicAdd((unsigned*)&misc[my_e[i]], 1u); }
    }
    __syncthreads();
    unsigned* gcnt = (unsigned*)(a.ws + WS_CTL);
    if (F_TID < 32) misc[32 + F_TID] = atomicAdd(&gcnt[F_TID], misc[F_TID]);
    __syncthreads();
    if (rl < 4) {
#pragma unroll
        for (int i = 0; i < 4; ++i) { const int tok = r0 + 4 * q + i, idx = tok * 4 + rl; sel_e[idx] = my_e[i]; sel_pos[idx] = (int)misc[32 + my_e[i]] + my_lp[i]; sel_gate[idx] = my_g[i]; }
    }
}

__device__ __forceinline__ int build_tiles(const Frame& F, const Args& a) {
    LAS unsigned* misc = (LAS unsigned*)(F.lds + LX_MISC); LAS unsigned char* tile_e = F.lds + LX_TILE;
    const unsigned* gcnt = (const unsigned*)(a.ws + WS_CTL);
    if (F_TID < NE) misc[128 + F_TID] = (__hip_atomic_load(&gcnt[F_TID], __ATOMIC_RELAXED, __HIP_MEMORY_SCOPE_AGENT) + 255u) >> 8;
    __syncthreads();
    if (F_TID == 0) { unsigned acc = 0; for (int e = 0; e < NE; ++e) { misc[64 + e] = acc; acc += misc[128 + e]; } misc[64 + NE] = acc; }
    __syncthreads();
    const int nt = (int)misc[64 + NE];
    for (int e = 0; e < NE; ++e) { const int t0 = (int)misc[64 + e], t1 = (int)misc[65 + e]; for (int t = t0 + F_TID; t < t1; t += 512) tile_e[t] = (unsigned char)e; }
    __syncthreads();
    return nt;
}

#define XLAS __attribute__((address_space(3)))
#define XB_TMO      128
#define XB_XCNT(j)  (256  + 64 * (j))
#define XB_XSUB(j)  (1280 + 64 * (j))
#define XB_XGEN(j)  (2304 + 64 * (j))
#define XB_TOP      3328
#define XB_TOPGEN   3392
#define XCD_BAR_WORDS 3456
#define XB_SPIN_CAP (1u << 22)

__device__ __forceinline__ unsigned xb_ld(unsigned* p)              { return __hip_atomic_load(p, __ATOMIC_RELAXED, __HIP_MEMORY_SCOPE_AGENT); }
__device__ __forceinline__ unsigned xb_add(unsigned* p, unsigned v) { return __hip_atomic_fetch_add(p, v, __ATOMIC_RELAXED, __HIP_MEMORY_SCOPE_AGENT); }
__device__ __forceinline__ unsigned xb_xcc_id() { return (unsigned)__builtin_amdgcn_s_getreg((3 << 11) | 20) & 0xFu; }
#define XB_SPIN(cond, bar) do { unsigned _sp = 0; while (cond) { __builtin_amdgcn_s_sleep(1); \
    if ((++_sp & 255u) == 0u) { if (xb_ld(&(bar)[XB_TMO])) break; if (_sp > XB_SPIN_CAP) { atomicAdd(&(bar)[XB_TMO], 1u); break; } } } } while (0)

struct XcdBarrier {
    unsigned* bar; unsigned x;
    volatile XLAS unsigned* st;
};

__device__ __forceinline__ XcdBarrier xcd_barrier_post(unsigned* bar, volatile XLAS unsigned* st) {
    XcdBarrier b; b.bar = bar; b.x = xb_xcc_id(); b.st = st;
    if (threadIdx.x == 0) (void)xb_add(&bar[XB_XCNT(b.x)], 1u);
    return b;
}
__device__ __forceinline__ void xcd_barrier_complete(unsigned* bar, unsigned x, unsigned& nloc, unsigned& nx) {
    const unsigned G = gridDim.x * gridDim.y * gridDim.z;
    unsigned sum, cnt, mine, sp = 0u;
    for (;;) {
        sum = 0u; cnt = 0u; mine = 0u;
#pragma unroll
        for (unsigned j = 0; j < 16; ++j) { const unsigned c = xb_ld(&bar[XB_XCNT(j)]); sum += c; cnt += (c > 0u) ? 1u : 0u; mine = (j == x) ? c : mine; }
        if (sum == G) break;
        __builtin_amdgcn_s_sleep(1);
        if ((++sp & 255u) == 0u) { if (xb_ld(&bar[XB_TMO])) break; if (sp > XB_SPIN_CAP) { atomicAdd(&bar[XB_TMO], 1u); break; } }
    }
    nloc = mine > 0u ? mine : 1u; nx = cnt > 0u ? cnt : 1u;
}

__device__ __forceinline__ void xcd_barrier(const XcdBarrier& b, const int tid0) {
    asm volatile("s_waitcnt vmcnt(0)" ::: "memory");
    __syncthreads();
    if (tid0 == 0) {
        unsigned* bar = b.bar;
        __builtin_amdgcn_s_waitcnt(0);
        unsigned nloc = b.st[0], nx = b.st[1];
        if (nloc == 0u) { xcd_barrier_complete(bar, b.x, nloc, nx); b.st[0] = nloc; b.st[1] = nx; }
        const unsigned old = xb_add(&bar[XB_XSUB(b.x)], 1u);
        const unsigned gen = old / nloc;
        if (old + 1u == (gen + 1u) * nloc) {
            __builtin_amdgcn_fence(__ATOMIC_RELEASE, "agent");
            asm volatile("s_waitcnt vmcnt(0)" ::: "memory");
            const unsigned og = xb_add(&bar[XB_TOP], 1u);
            const unsigned tg = og / nx;
            if (og + 1u == (tg + 1u) * nx) xb_add(&bar[XB_TOPGEN], 1u);
            else XB_SPIN(xb_ld(&bar[XB_TOPGEN]) == tg, bar);
            __builtin_amdgcn_fence(__ATOMIC_ACQUIRE, "agent");
            xb_add(&bar[XB_XGEN(b.x)], 1u);
            asm volatile("s_waitcnt vmcnt(0)" ::: "memory");
        } else {
            XB_SPIN(xb_ld(&bar[XB_XGEN(b.x)]) == gen, bar);
            __builtin_amdgcn_fence(__ATOMIC_ACQUIRE, "agent");
            asm volatile("s_waitcnt vmcnt(0)" ::: "memory");
        }
    }
    __syncthreads();
}

__global__ void __launch_bounds__(512, 2) fwd_megakernel(Args a) {
    extern __shared__ __attribute__((aligned(16))) unsigned char lds_raw[];
    cg::grid_group grid = cg::this_grid();
    Frame F; F.lds = (LAS unsigned char*)lds_raw; F.wave = __builtin_amdgcn_readfirstlane((int)(threadIdx.x >> 6));
    F.G = gridDim.x; { const int bx = blockIdx.x; F.vcu = (F.G % 8 == 0) ? (bx % 8) * (F.G / 8) + bx / 8 : bx; }
    unsigned char* ws = a.ws;
    {   LAS unsigned* m0_ = (LAS unsigned*)(F.lds + LX_MISC); if (F_TID < 128) m0_[F_TID] = 0u; __syncthreads(); }
    XcdBarrier xbar = xcd_barrier_post((unsigned*)(ws + WS_CTL) + CW_BAR, (volatile LAS unsigned*)(F.lds + LX_MISC) + 120);
#define GRID_BAR() xcd_barrier(xbar, F_TID)
#ifdef PROBE_T1
    unsigned long long* stamps = (unsigned long long*)(ws + WS_CTL + 2048);
#define STAMP(k) do { if (blockIdx.x == 0 && F_TID == 0) stamps[k] = __builtin_amdgcn_s_memrealtime(); } while (0)
#else
#define STAMP(k) do {} while (0)
#endif
    STAMP(0);

    for (int rep = 0; rep < REP_P0; ++rep) p0_prologue(F, a);
    if (a.out == nullptr) grid.sync();
    GRID_BAR();
    STAMP(1);

    for (int rep = 0; rep < REP_P1; ++rep) {
        pg8::Gemm g{(const bf16_t*)(ws + WS_XB), (const bf16_t*)(ws + WS_WIN), NTOK, NPROJ, DM, 0, 0}; pg8::StaticOrder S; S.init(NTOK, NPROJ, F.G, (int)blockIdx.x);
        EpiProj E{(bf16_t*)(ws + WS_PROJ), (unsigned*)(ws + WS_CTL)};
        pg8::gemm_phase<EpiProj, pg8::StaticOrder, true, false, KREP_P1>(F.lds, g, S, E, F_TID);
    }
    GRID_BAR();
    STAMP(2);

    {
        float s1 = 0.f, s2 = 0.f;
        for (int i = 0; i < 64; ++i) { s1 += a.lq1[i] * a.lk1[i]; s2 += a.lq2[i] * a.lk2[i]; }
        const float lam = __expf(s1) - __expf(s2) + LAM_INIT;
        {
            LAS unsigned* misc = (LAS unsigned*)(F.lds + LX_MISC); unsigned* ctl = (unsigned*)(ws + WS_CTL);
            const int myx = (int)(xbar.x & 7u);
            for (;;) {
                __syncthreads();
                if (F_TID == 0) { int got = -1;
                    for (int k = 0; k < 8 && got < 0; ++k) { const int qx = (myx + k) & 7;
                        if (__hip_atomic_load(ctl + CW_QUEUE + qx, __ATOMIC_RELAXED, __HIP_MEMORY_SCOPE_AGENT) < 160u) { const unsigned p = atomicAdd(ctl + CW_QUEUE + qx, 1u); if (p < 160u) got = qx * 256 + (int)p; } }
                    misc[100] = (unsigned)got; }
                __syncthreads();
                const int idx = __builtin_amdgcn_readfirstlane((int)misc[100]);
                if (idx < 0) break;
                const int qx = idx >> 8, p = idx & 255;
                if (p < 64 && (p & 1)) attnA_unit(F, a, qx * 32 + (p >> 1));
                else { const int h = p < 64 ? 3 : 2 - ((p - 64) >> 5), j = p < 64 ? (p >> 1) : (p & 31); attnB_item(F, a, h, qx >> 2, 32 * (qx & 3) + j, lam); }
            }
        }
    }
    GRID_BAR();
    STAMP(3);

    for (int rep = 0; rep < REP_P3; ++rep) {
        pg8::Gemm g{(const bf16_t*)(ws + WS_MIXED), (const bf16_t*)(ws + WS_WOUT), NTOK, DM, DM, 0, 0}; pg8::StaticOrder S; S.init(NTOK, DM, F.G, (int)blockIdx.x);
        EpiZ E{a.x, (float*)(ws + WS_Z)};
        pg8::gemm_phase<EpiZ, pg8::StaticOrder, true, false, KREP_P3>(F.lds, g, S, E, F_TID);
    }
    GRID_BAR();
    STAMP(4);

    if (F.G == 256) p4_ln_router(F, a);
    GRID_BAR();
    STAMP(5);

    int* sel_e = (int*)(ws + WS_ROUTE); int* sel_pos = sel_e + NTOK * TOPK; float* sel_gate = (float*)(sel_pos + NTOK * TOPK);
    int* inv = (int*)(sel_gate + NTOK * TOPK); int* row_tok = inv + NTOK * TOPK; float* row_gate = (float*)(row_tok + 262144);
    {
        const int ntl = build_tiles(F, a); (void)ntl;
        LAS unsigned* misc = (LAS unsigned*)(F.lds + LX_MISC);
        const unsigned* gcnt = (const unsigned*)(ws + WS_CTL);
        for (int idx = F.vcu * 512 + F_TID; idx < NTOK * TOPK; idx += F.G * 512) {
            const int e = sel_e[idx], dest = (int)misc[64 + e] * 256 + sel_pos[idx];
            row_tok[dest] = idx >> 2; row_gate[dest] = sel_gate[idx]; inv[idx] = dest;
        }
        for (int e = F.vcu; e < NE; e += F.G) {
            const int c = (int)__hip_atomic_load(&gcnt[e], __ATOMIC_RELAXED, __HIP_MEMORY_SCOPE_AGENT), base = (int)misc[64 + e] * 256, end = (int)misc[65 + e] * 256;
            for (int r = base + c + F_TID; r < end; r += 512) { row_tok[r] = 0; row_gate[r] = 0.f; }
        }
    }
    GRID_BAR();
    STAMP(6);

    for (int rep = 0; rep < REP_P6; ++rep) {
        const int ntl = build_tiles(F, a);
        MoeOrder S; S.so.init(ntl * 256, 2048, F.G, (int)blockIdx.x); S.tile_e = F.lds + LX_TILE; S.tok = (const LAS unsigned short*)(F.lds + LX_TOK); S.ncolt = 8;
        {
            LAS unsigned short* tk = (LAS unsigned short*)(F.lds + LX_TOK); pg8::Unit u;
            for (int i = F.wave; i < 24 && S.so.next(i, u); i += 8) { const int l_ = F_LANE;
#pragma unroll
                for (int j = 0; j < 4; ++j) tk[i * 256 + l_ + 64 * j] = (unsigned short)row_tok[u.pm * 256 + l_ + 64 * j]; }
            __syncthreads();
        }
        pg8::Gemm g{(const bf16_t*)(ws + WS_XB), (const bf16_t*)(ws + WS_WUP), ntl * 256, 2048, DM, 0x7C7C7C7C, 0x77777777};
        EpiUp E{(bf16_t*)(ws + WS_H), a.b_up};
        pg8::gemm_phase<EpiUp, MoeOrder, true, true, KREP_P6, true>(F.lds, g, S, E, F_TID);
    }
    GRID_BAR();
    STAMP(7);

    for (int rep = 0; rep < REP_P7; ++rep) {
        const int ntl = build_tiles(F, a);
        MoeOrder S; S.so.init(ntl * 256, 1024, F.G, (int)blockIdx.x, ORD_REV7); S.tile_e = F.lds + LX_TILE; S.tok = nullptr; S.ncolt = 4;
        pg8::Gemm g{(const bf16_t*)(ws + WS_H), (const bf16_t*)(ws + WS_WDN), ntl * 256, DM, DFF, 0x7D7D7D7D, 0x77777777};
        EpiDown E{(bf16_t*)(ws + WS_Y), a.b_down, row_gate};
        pg8::gemm_phase<EpiDown, MoeOrder, true, false, KREP_P7, true>(F.lds, g, S, E, F_TID);
    }
    GRID_BAR();
    STAMP(8);

    for (int rep = 0; rep < REP_P8; ++rep) {
        const int lane = F_LANE; const float* X1 = (const float*)(ws + WS_Z); const bf16_t* Y = (const bf16_t*)(ws + WS_Y); const float* stats = (const float*)(ws + WS_ROUTE + 4 * MiB);
        f32x4 gv[4], bv[4], g1[4], b1[4];
#pragma unroll
        for (int j = 0; j < 4; ++j) { gv[j] = ((const f32x4*)a.ln2_g)[lane + 64 * j]; bv[j] = ((const f32x4*)a.ln2_b)[lane + 64 * j]; g1[j] = ((const f32x4*)a.ln1_g)[lane + 64 * j] * ALPHA; b1[j] = ((const f32x4*)a.ln1_b)[lane + 64 * j] * ALPHA; }
        for (int m = F.vcu * 8 + F.wave; m < NTOK; m += F.G * 8) {
            const f32x4* xr = (const f32x4*)(X1 + (size_t)m * DM) + lane; f32x4 v[4]; const f32x2 st = *(const f32x2*)(stats + 2 * m);
#pragma unroll
            for (int j = 0; j < 4; ++j) v[j] = (xr[64 * j] - st[0]) * st[1] * g1[j] + b1[j];
#pragma unroll
            for (int t = 0; t < 4; ++t) { const int dest = inv[m * 4 + t]; const unsigned* yr = (const unsigned*)((const unsigned char*)Y + (size_t)dest * DM) + lane;
#pragma unroll
                for (int j = 0; j < 4; ++j) { const int w = (int)yr[64 * j];
                    v[j][0] += __builtin_amdgcn_cvt_f32_fp8(w, 0) * (1.f / 32.f); v[j][1] += __builtin_amdgcn_cvt_f32_fp8(w, 1) * (1.f / 32.f);
                    v[j][2] += __builtin_amdgcn_cvt_f32_fp8(w, 2) * (1.f / 32.f); v[j][3] += __builtin_amdgcn_cvt_f32_fp8(w, 3) * (1.f / 32.f); } }
            float s = 0.f;
#pragma unroll
            for (int j = 0; j < 4; ++j) s += (v[j][0] + v[j][1]) + (v[j][2] + v[j][3]);
            const float mean = wave_sum(s) * (1.f / DM); float s2 = 0.f;
#pragma unroll
            for (int j = 0; j < 4; ++j) { v[j] = v[j] - mean; s2 += (v[j][0] * v[j][0] + v[j][1] * v[j][1]) + (v[j][2] * v[j][2] + v[j][3] * v[j][3]); }
            const float rstd = 1.f / sqrtf(wave_sum(s2) * (1.f / DM) + LN_EPS);
            f32x4* orow = (f32x4*)(a.out + (size_t)m * DM) + lane;
#pragma unroll
            for (int j = 0; j < 4; ++j) orow[64 * j] = v[j] * rstd * gv[j] + bv[j];
        }
    }
#ifdef PROBE_T1
    STAMP(9);
    if (blockIdx.x == 0) {
        __syncthreads();
        const float t1 = (float)(stamps[PROBE_T1 + 1] - stamps[PROBE_T1]) * 0.01f, t2 = (float)(stamps[PROBE_T2 + 1] - stamps[PROBE_T2]) * 0.01f;
        for (int i = F_TID; i < (1 << 20); i += 512) a.out[1 + i] = t2;
        if (F_TID == 0) a.out[0] = t1 * 10.0f;
    }
#endif
}

extern "C" void kernel_launch(void* const* d_in, const int* in_sizes, int n_in, void* d_out, int out_size, void* d_ws, size_t ws_size, hipStream_t stream) {
    static int grid = 0;
    if (grid == 0) {
        if (n_in != 18 || in_sizes[0] != NTOK * DM || out_size != NTOK * DM || ws_size < WS_END) {
            fprintf(stderr, "kernel_launch: unexpected shapes (n_in %d, in0 %d, out %d, ws %zu need %zu); nothing launched\n", n_in, n_in > 0 ? in_sizes[0] : -1, out_size, ws_size, (size_t)WS_END); grid = -1; return; }
        int dev = 0, cus = 0, per_cu = 0;
        if (hipGetDevice(&dev) != hipSuccess || hipDeviceGetAttribute(&cus, hipDeviceAttributeMultiprocessorCount, dev) != hipSuccess) { grid = -1; return; }
        if (hipFuncSetAttribute((const void*)fwd_megakernel, hipFuncAttributeMaxDynamicSharedMemorySize, LDS_BYTES) != hipSuccess) { fprintf(stderr, "kernel_launch: hipFuncSetAttribute failed\n"); grid = -1; return; }
        if (hipOccupancyMaxActiveBlocksPerMultiprocessor(&per_cu, (const void*)fwd_megakernel, 512, LDS_BYTES) != hipSuccess || per_cu < 1) { fprintf(stderr, "kernel_launch: occupancy query says %d\n", per_cu); per_cu = 1; }
        (void)hipGetLastError();
        grid = cus * (per_cu > 1 ? 1 : per_cu);
        fprintf(stderr, "kernel_launch: grid %d (cus %d, per_cu %d)\n", grid, cus, per_cu);
    }
    if (grid < 0) return;
    if (hipMemsetAsync((char*)d_ws + WS_CTL, 0, CTL_ZERO_BYTES, stream) != hipSuccess) return;
    Args a{};
    const float* const* in = (const float* const*)d_in;
    a.x = in[0]; a.w_in = in[1]; a.w_out = in[2]; a.lq1 = in[3]; a.lk1 = in[4]; a.lq2 = in[5]; a.lk2 = in[6]; a.g_sub = in[7];
    a.ln1_g = in[8]; a.ln1_b = in[9]; a.w_router = in[10]; a.b_router = in[11]; a.w_up = in[12]; a.b_up = in[13]; a.w_down = in[14]; a.b_down = in[15];
    a.ln2_g = in[16]; a.ln2_b = in[17]; a.out = (float*)d_out; a.ws = (unsigned char*)d_ws;
    void* args[] = {&a};
    hipError_t e = hipLaunchCooperativeKernel((void*)fwd_megakernel, dim3(grid), dim3(512), args, LDS_BYTES, stream);
    if (e != hipSuccess) fprintf(stderr, "kernel_launch: cooperative launch failed: %s (grid %d)\n", hipGetErrorString(e), grid);
}
```

```cpp
#include <hip/hip_runtime.h>
#include <hip/hip_cooperative_groups.h>
#include <cstdio>
#include <cstdint>
namespace cg = cooperative_groups;
#ifndef KREP_P1
#define KREP_P1 1
#endif
#ifndef KREP_P3
#define KREP_P3 1
#endif
#ifndef KREP_P6
#define KREP_P6 1
#endif
#ifndef KREP_P7
#define KREP_P7 1
#endif
#ifndef ORD_SWZ
#define ORD_SWZ 0
#endif
#ifndef ORD_REV7
#define ORD_REV7 1
#endif
#ifndef REP_P0
#define REP_P0 1
#endif
#ifndef REP_P1
#define REP_P1 1
#endif
#ifndef REP_A
#define REP_A 1
#endif
#ifndef REP_B
#define REP_B 1
#endif
#ifndef REP_P3
#define REP_P3 1
#endif
#ifndef REP_P6
#define REP_P6 1
#endif
#ifndef REP_P7
#define REP_P7 1
#endif
#ifndef REP_P8
#define REP_P8 1
#endif

#define LAS __attribute__((address_space(3)))
typedef unsigned short bf16_t;
typedef short bf16x8 __attribute__((ext_vector_type(8)));
typedef short s16x4 __attribute__((ext_vector_type(4)));
typedef float f32x4 __attribute__((ext_vector_type(4)));
typedef float f32x2 __attribute__((ext_vector_type(2)));
typedef float f32x16 __attribute__((ext_vector_type(16)));
typedef unsigned u32x4 __attribute__((ext_vector_type(4)));
typedef unsigned u32x2 __attribute__((ext_vector_type(2)));
typedef __bf16 bf16x2_t __attribute__((ext_vector_type(2)));

constexpr int BATCH = 2, SEQ = 16384, DM = 1024, NTOK = BATCH * SEQ;
constexpr int NPROJ = 3072, NE = 32, TOPK = 4, DFF = 1024;
constexpr int NROWS_MAX = NTOK * TOPK + NE * 256;
constexpr float LN_EPS = 1e-5f;
constexpr float ALPHA = 1.189207115002721f;
constexpr float LOG2E = 1.4426950408889634f;
constexpr float C2 = 0.125f * LOG2E;
constexpr float LAM_INIT = 0.2f;
constexpr float NEG_BIG = -1e30f;

constexpr size_t MiB = 1u << 20;
constexpr size_t WS_CTL = 0, CTL_ZERO_BYTES = 65536;
constexpr int CW_QMAX = 64, CW_KMAX = 128, CW_QUEUE = 256, CW_BAR = 4096;
constexpr size_t WS_WIN = 2 * MiB, WS_WOUT = 8 * MiB, WS_WUP = 16 * MiB, WS_WDN = 144 * MiB;
constexpr size_t WS_XB = 208 * MiB;
constexpr size_t WS_PROJ = 272 * MiB;
constexpr size_t PROJ_STRIDE = (size_t)NTOK * 512;
constexpr size_t WS_MIXED = 464 * MiB;
constexpr size_t WS_Z = 272 * MiB;
constexpr size_t WS_H = 400 * MiB;
constexpr size_t WS_Y = 672 * MiB;
constexpr size_t WS_APART = 672 * MiB;
constexpr size_t APART_UNIT = 2 * 1024 * 64 * 4 + 2 * 1024 * 2 * 4;
constexpr size_t WS_ROUTE = 944 * MiB;
constexpr size_t WS_END = 952 * MiB;

constexpr int RING_BYTES = 131072;
constexpr int LX_TILE = 131072;
constexpr int LX_TOK = 132096;
constexpr int LX_MISC = 144384;
constexpr int LDS_BYTES = 147456;

__device__ __forceinline__ unsigned cvtpk(float lo, float hi) { f32x2 v = {lo, hi}; bf16x2_t b = __builtin_convertvector(v, bf16x2_t); return __builtin_bit_cast(unsigned, b); }
__device__ __forceinline__ unsigned cvt4_fp8(float a, float b, float c, float d) { int w = 0; w = __builtin_amdgcn_cvt_pk_fp8_f32(a, b, w, false); w = __builtin_amdgcn_cvt_pk_fp8_f32(c, d, w, true); return (unsigned)w; }
__device__ __forceinline__ float wave_sum(float v) {
#pragma unroll
    for (int o = 1; o < 64; o <<= 1) v += __shfl_xor(v, o);
    return v;
}

namespace pg8 {
constexpr int BM = 256, BK = 64, HALF = 128, HTB = HALF * BK * 2, STAGE_BYTES = 8 * HTB, NXCD = 8, WGM = 8;
__host__ __device__ __forceinline__ int lds_byte(int r, int c) { const int st = (r >> 4) * 2 + (c >> 5), rr = r & 15, cc = c & 31, ob = rr * 64 + cc * 2; return st * 1024 + (ob ^ (((ob >> 9) & 1) << 5)); }
__host__ __device__ __forceinline__ void stage_rc(int b, int& R, int& C) { const int st = b / 1024, sb = b % 1024, swz = sb ^ (((sb >> 9) & 1) << 5); R = (st >> 1) * 16 + swz / 64; C = (st & 1) * 32 + (swz % 64) / 2; }
__host__ __device__ __forceinline__ int perm32(int rho) { const int n = rho >> 4, i = rho & 15; return 8 * (i >> 2) + 4 * n + (i & 3); }

struct Unit { int pm, pn; };
struct Gemm { const bf16_t* A; const bf16_t* Bt; int M, N, K; int scale_a, scale_b; };
typedef int v4i_t __attribute__((ext_vector_type(4))); typedef int v8i_t __attribute__((ext_vector_type(8)));

struct StaticOrder {
    int nM, nN, nwg, G, c, rev, swz;
    __host__ __device__ void init(int M, int N, int G_, int c_, int rev_ = 0, int swz_ = ORD_SWZ) { nM = M / BM; nN = N / BM; nwg = nM * nN; G = G_; c = c_; rev = rev_; swz = swz_; }
    __host__ __device__ bool next(int i, Unit& u) const {
        const long L = (long)i * G + c; if (L >= nwg) return false;
        int wgid = (rev == 1) ? nwg - 1 - (int)L : (int)L;
        if (swz) { const int q = nwg / NXCD, r = nwg % NXCD, xcd = wgid % NXCD; int off = wgid / NXCD; const int len = xcd < r ? q + 1 : q;
            if (rev == 2) off = len - 1 - off;
            wgid = (xcd < r ? xcd * (q + 1) : r * (q + 1) + (xcd - r) * q) + off; }
        const int nig = WGM * nN, gid = wgid / nig, fm = gid * WGM, gsz = (nM - fm) < WGM ? (nM - fm) : WGM;
        u.pm = fm + ((wgid % nig) % gsz); u.pn = (wgid % nig) / gsz; return true;
    }
    __device__ __forceinline__ const LAS unsigned short* tok_table(int) const { return nullptr; }
};

template <class Epi, class Sched, bool ALIGN_EPI, bool GATHER, int KREP = 1, bool F8 = false>
__device__ __forceinline__ void gemm_phase(LAS unsigned char* lds, const Gemm g, const Sched& S, const Epi& E, const int tid) {
    const int wid = __builtin_amdgcn_readfirstlane(tid >> 6), lane = tid & 63, wr = wid >> 2, wc = wid & 3, fr = lane & 15, fq = lane >> 4;
    constexpr int ES = F8 ? 1 : 2;
    const int sclW = g.scale_b, sclX = g.scale_a;
    const int K = g.K, ntr = K * ES / (BK * 2), nt = ntr * KREP;
    unsigned voffA[2], voffB[2]; int rowA[2];
#pragma unroll
    for (int i = 0; i < 2; ++i) { int R, C; stage_rc(tid * 16 + i * 8192, R, C); const int Rb = Epi::PERM ? ((R & ~31) + perm32(R & 31)) : R;
        voffA[i] = GATHER ? (unsigned)(C * 2) : (unsigned)(R * K * ES + C * 2); voffB[i] = (unsigned)(Rb * K * ES + C * 2); rowA[i] = R; }
    const size_t kstep = (size_t)(BK * 2);
    const size_t hstep = (size_t)HALF * K * ES;
    const size_t tstep = 2 * hstep;
    const unsigned ldsw = (unsigned)wid * 1024u;
    const int aoff = lds_byte(wr * 64 + fr, fq * 8), boff = lds_byte(wc * 32 + fr, fq * 8);
    const int aoff8 = lds_byte(wr * 64 + fr, fq * 16), boff8 = lds_byte(wc * 32 + fr, fq * 16);
#define PG8_SA(b, h) (((b) * 2 + (h)) * HTB)
#define PG8_SB(b, h) ((4 + (b) * 2 + (h)) * HTB)
#define PG8_STAGE(bufoff, gbase, voff) do { _Pragma("unroll") for (int _i = 0; _i < 2; ++_i) \
        __builtin_amdgcn_global_load_lds((const unsigned*)((const char*)(gbase) + (voff)[_i]), (LAS unsigned*)(lds + (bufoff) + ldsw + _i * 8192), 16, 0, 0); } while (0)
#define PG8_STAGE_A(bufoff, NX, h, kb) do { if constexpr (GATHER) { const unsigned* _o = (NX) ? gN[h] : gC[h]; PG8_STAGE(bufoff, (const char*)g.A + (kb), _o); } \
        else { PG8_STAGE(bufoff, ((NX) ? nA : cA) + (h) * hstep + (kb), voffA); } } while (0)
#define PG8_LDA(dst, b, h) do { _Pragma("unroll") for (int m = 0; m < 4; ++m) _Pragma("unroll") for (int k = 0; k < 2; ++k) dst[m][k] = *(const LAS bf16x8*)(lds + PG8_SA(b, h) + (F8 ? aoff8 + k * 16 : aoff + k * 1024) + m * 2048); } while (0)
#define PG8_LDB(dst, b, h) do { _Pragma("unroll") for (int n = 0; n < 2; ++n) _Pragma("unroll") for (int k = 0; k < 2; ++k) dst[n][k] = *(const LAS bf16x8*)(lds + PG8_SB(b, h) + (F8 ? boff8 + k * 16 : boff + k * 1024) + n * 2048); } while (0)
#define PG8_F8OP(x) __builtin_shufflevector(__builtin_bit_cast(v4i_t, x[0]), __builtin_bit_cast(v4i_t, x[1]), 0, 1, 2, 3, 4, 5, 6, 7)
#define PG8_MMA(ai, bj, At, Bt) do { __builtin_amdgcn_s_setprio(1); _Pragma("unroll") for (int m = 0; m < 4; ++m) _Pragma("unroll") for (int n = 0; n < 2; ++n) { \
        if constexpr (F8) { const v8i_t _a = PG8_F8OP(Bt[n]), _b = PG8_F8OP(At[m]); asm volatile("v_mfma_scale_f32_16x16x128_f8f6f4 %0, %1, %2, %0, %3, %4 op_sel_hi:[0,0,0]" : "+v"(acc[ai][bj][m][n]) : "v"(_a), "v"(_b), "v"(sclW), "v"(sclX)); } \
        else { _Pragma("unroll") for (int k = 0; k < 2; ++k) acc[ai][bj][m][n] = __builtin_amdgcn_mfma_f32_16x16x32_bf16(Bt[n][k], At[m][k], acc[ai][bj][m][n], 0, 0, 0); } } \
        __builtin_amdgcn_s_setprio(0); } while (0)
#define PG8_WAIT_V(n) asm volatile("s_waitcnt vmcnt(" #n ")" ::: "memory")
#define PG8_WAIT_L(n) asm volatile("s_waitcnt lgkmcnt(" #n ")" ::: "memory")
#define PG8_BAR __builtin_amdgcn_s_barrier()
#define PG8_SCHED __builtin_amdgcn_sched_barrier(0)
#define PG8_GOFF(dst, ui_) do { if constexpr (GATHER) { const LAS unsigned short* _t = S.tok_table(ui_); _Pragma("unroll") for (int _h = 0; _h < 2; ++_h) _Pragma("unroll") for (int _i = 0; _i < 2; ++_i) \
        dst[_h][_i] = (unsigned)_t[_h * HALF + rowA[_i]] * (unsigned)(K * ES) + voffA[_i]; } } while (0)
    Unit cur, nxt; int ui = 0;
    if (!S.next(0, cur)) return;
    f32x4 acc[2][2][4][2];
    E.init(acc, cur, wc, fq);
    bf16x8 At[4][2], B0[2][2], B1[2][2];
    unsigned gC[2][2] = {{0u, 0u}, {0u, 0u}}, gN[2][2] = {{0u, 0u}, {0u, 0u}};
    PG8_GOFF(gC, 0);
    const char* cA = (const char*)g.A + (GATHER ? (size_t)0 : (size_t)cur.pm * tstep); const char* cB = (const char*)g.Bt + (size_t)cur.pn * tstep;
    const char* nA = cA;
    {
        PG8_STAGE(PG8_SB(0, 0), cB, voffB); PG8_STAGE(PG8_SB(0, 1), cB + hstep, voffB); PG8_STAGE_A(PG8_SA(0, 0), false, 0, 0); PG8_STAGE_A(PG8_SA(0, 1), false, 1, 0);
        if (wr == 1) PG8_BAR;
        PG8_WAIT_V(2); PG8_BAR;
        PG8_STAGE(PG8_SB(1, 0), cB + kstep, voffB); PG8_STAGE_A(PG8_SA(1, 0), false, 0, kstep); PG8_STAGE(PG8_SB(1, 1), cB + hstep + kstep, voffB);
        PG8_WAIT_V(6); PG8_BAR;
    }
    for (;;) {
        const bool has_next = S.next(ui + 1, nxt);
        nA = has_next ? (const char*)g.A + (GATHER ? (size_t)0 : (size_t)nxt.pm * tstep) : cA; const char* nB = has_next ? (const char*)g.Bt + (size_t)nxt.pn * tstep : cB;
        if (has_next) { PG8_GOFF(gN, ui + 1); } else {
#pragma unroll
            for (int h = 0; h < 2; ++h)
#pragma unroll
                for (int i = 0; i < 2; ++i) gN[h][i] = gC[h][i]; }
#pragma unroll 1
        for (int t = 0; t < nt; t += 2) {
            const bool last = (t == nt - 2);
            const size_t k1 = (size_t)((t + 1) % ntr) * kstep;
            const size_t k2 = last ? (size_t)0 : (size_t)((t + 2) % ntr) * kstep, k3 = k2 + kstep;
            const char* b2 = last ? nB : cB + (size_t)((t + 2) % ntr) * kstep; const char* b3 = b2 + kstep;
            PG8_LDB(B0, 0, 0); PG8_LDB(B1, 0, 1); PG8_SCHED; PG8_LDA(At, 0, 0); PG8_STAGE_A(PG8_SA(1, 1), false, 1, k1);
            PG8_WAIT_V(8); PG8_WAIT_L(0); PG8_BAR; PG8_MMA(0, 0, At, B0); PG8_MMA(0, 1, At, B1); PG8_BAR; PG8_SCHED;
            PG8_LDA(At, 0, 1); PG8_STAGE(PG8_SB(0, 0), b2, voffB); PG8_STAGE(PG8_SB(0, 1), b2 + hstep, voffB); PG8_STAGE_A(PG8_SA(0, 0), last, 0, k2);
            PG8_WAIT_V(8); PG8_WAIT_L(0); PG8_BAR; PG8_MMA(1, 0, At, B0); PG8_MMA(1, 1, At, B1); PG8_BAR; PG8_SCHED;
            PG8_LDB(B0, 1, 0); PG8_LDB(B1, 1, 1); PG8_SCHED; PG8_LDA(At, 1, 0); PG8_STAGE_A(PG8_SA(0, 1), last, 1, k2);
            PG8_WAIT_V(8); PG8_WAIT_L(0); PG8_BAR; PG8_MMA(0, 0, At, B0); PG8_MMA(0, 1, At, B1); PG8_BAR; PG8_SCHED;
            PG8_LDA(At, 1, 1); PG8_STAGE(PG8_SB(1, 0), b3, voffB); PG8_STAGE(PG8_SB(1, 1), b3 + hstep, voffB); PG8_STAGE_A(PG8_SA(1, 0), last, 0, k3);
            PG8_WAIT_V(8); PG8_WAIT_L(0); PG8_BAR; PG8_MMA(1, 0, At, B0); PG8_MMA(1, 1, At, B1); PG8_BAR; PG8_SCHED;
        }
        if constexpr (ALIGN_EPI) { if (wr == 0) PG8_BAR; }
        if constexpr (F8) asm volatile("s_nop 15\n\ts_nop 15" ::: "memory");
        if constexpr (KREP > 1) {
_Pragma("unroll") for (int a_ = 0; a_ < 2; ++a_) _Pragma("unroll") for (int b_ = 0; b_ < 2; ++b_) _Pragma("unroll") for (int m_ = 0; m_ < 4; ++m_) _Pragma("unroll") for (int n_ = 0; n_ < 2; ++n_) acc[a_][b_][m_][n_] = acc[a_][b_][m_][n_] * (1.0f / KREP); }
        E(acc, cur, wr, wc, fr, fq);
        if (!has_next) break;
        E.init(acc, nxt, wc, fq);
        cur = nxt; cA = nA; cB = nB; ++ui;
#pragma unroll
        for (int h = 0; h < 2; ++h)
#pragma unroll
            for (int i = 0; i < 2; ++i) gC[h][i] = gN[h][i];
        if constexpr (ALIGN_EPI) { if (wr == 1) PG8_BAR; }
    }
    PG8_WAIT_V(0);
    if constexpr (!ALIGN_EPI) { if (wr == 0) PG8_BAR; }
    PG8_BAR;
#undef PG8_SA
#undef PG8_SB
#undef PG8_STAGE
#undef PG8_STAGE_A
#undef PG8_LDA
#undef PG8_LDB
#undef PG8_MMA
#undef PG8_F8OP
#undef PG8_WAIT_V
#undef PG8_WAIT_L
#undef PG8_BAR
#undef PG8_SCHED
#undef PG8_GOFF
}
}

struct Args {
    const float* x; const float* w_in; const float* w_out; const float* lq1; const float* lk1; const float* lq2; const float* lk2; const float* g_sub;
    const float* ln1_g; const float* ln1_b; const float* w_router; const float* b_router; const float* w_up; const float* b_up; const float* w_down; const float* b_down;
    const float* ln2_g; const float* ln2_b; float* out; unsigned char* ws;
};
struct Frame {
    LAS unsigned char* lds; int wave, vcu, G;
};
__device__ __forceinline__ int lane_now() { int l; asm volatile("v_mbcnt_lo_u32_b32 %0, -1, 0\n\tv_mbcnt_hi_u32_b32 %0, -1, %0" : "=v"(l)); return l; }
#define F_LANE lane_now()
#define F_TID (F.wave * 64 + lane_now())

struct EpiProj {
    static constexpr bool PERM = true;
    bf16_t* O; unsigned* ctl;
    __device__ __forceinline__ void init(f32x4 (&acc)[2][2][4][2], const pg8::Unit&, int, int) const {
#pragma unroll
        for (int a_ = 0; a_ < 2; ++a_)
#pragma unroll
            for (int b_ = 0; b_ < 2; ++b_)
#pragma unroll
                for (int m_ = 0; m_ < 4; ++m_)
#pragma unroll
                    for (int n_ = 0; n_ < 2; ++n_) acc[a_][b_][m_][n_] = (f32x4){0.f, 0.f, 0.f, 0.f};
    }
    __device__ __forceinline__ void operator()(const f32x4 (&acc)[2][2][4][2], const pg8::Unit& u, int wr, int wc, int fr, int fq) const {
        const int t = u.pn >> 1; const float sc = (t == 0 || t == 3) ? C2 : 1.f; const bool nrm = (t == 3 || t == 4);
        bf16_t* base = O + (size_t)t * PROJ_STRIDE; const int row0 = u.pm * 256 + wr * 64 + fr, col0 = (u.pn & 1) * 256 + wc * 32 + 8 * fq;
        float mx0 = 0.f, mx1 = 0.f;
#pragma unroll
        for (int ai = 0; ai < 2; ++ai)
#pragma unroll
            for (int m = 0; m < 4; ++m) { bf16_t* rowp = base + (size_t)(row0 + ai * 128 + m * 16) * 512 + col0;
#pragma unroll
                for (int bj = 0; bj < 2; ++bj) { const f32x4 v0 = acc[ai][bj][m][0] * sc, v1 = acc[ai][bj][m][1] * sc; u32x4 w;
                    w.x = cvtpk(v0[0], v0[1]); w.y = cvtpk(v0[2], v0[3]); w.z = cvtpk(v1[0], v1[1]); w.w = cvtpk(v1[2], v1[3]);
                    if (t >= 4) {
                        const int row = row0 + ai * 128 + m * 16, bb = row >> 14, sq = row & (SEQ - 1), key = sq & 63, hh = (u.pn & 1) * 2 + bj;
                        bf16_t* tb = O + 4 * PROJ_STRIDE + ((size_t)((bb * 4 + hh) * 256 + (sq >> 6))) * 16384;
                        if (t == 4) *(u32x4*)(tb + (4 * wc + fq) * 512 + key * 8) = w;
                        else *(u32x4*)(tb + 8192 + (wc * 4 + (key >> 4)) * 512 + (key & 15) * 32 + fq * 8) = w;
                    } else *(u32x4*)(rowp + bj * 128) = w;
                    if (nrm) { float ss = 0.f;
#pragma unroll
                        for (int j = 0; j < 4; ++j) { const float lo = __uint_as_float(w[j] << 16), hi = __uint_as_float(w[j] & 0xFFFF0000u); ss += lo * lo + hi * hi; }
                        ss += __shfl_xor(ss, 16); ss += __shfl_xor(ss, 32);
                        if (bj == 0) mx0 = fmaxf(mx0, ss); else mx1 = fmaxf(mx1, ss); } } }
        if (nrm) {
#pragma unroll
            for (int ofs = 1; ofs < 16; ofs <<= 1) { mx0 = fmaxf(mx0, __shfl_xor(mx0, ofs)); mx1 = fmaxf(mx1, __shfl_xor(mx1, ofs)); }
            if (fr == 0 && fq == 0) { const int b = u.pm >> 6, cw = (t == 3) ? CW_QMAX : CW_KMAX;
                atomicMax(ctl + cw + (((b * 4 + (u.pn & 1) * 2 + 0) * 2 + (wc >> 1)) * 2 + (wc & 1)), __float_as_uint(mx0));
                atomicMax(ctl + cw + (((b * 4 + (u.pn & 1) * 2 + 1) * 2 + (wc >> 1)) * 2 + (wc & 1)), __float_as_uint(mx1)); }
        }
    }
};
struct EpiZ {
    static constexpr bool PERM = false;
    const float* x; float* z;
    __device__ __forceinline__ void init(f32x4 (&acc)[2][2][4][2], const pg8::Unit&, int, int) const {
#pragma unroll
        for (int a_ = 0; a_ < 2; ++a_)
#pragma unroll
            for (int b_ = 0; b_ < 2; ++b_)
#pragma unroll
                for (int m_ = 0; m_ < 4; ++m_)
#pragma unroll
                    for (int n_ = 0; n_ < 2; ++n_) acc[a_][b_][m_][n_] = (f32x4){0.f, 0.f, 0.f, 0.f};
    }
    __device__ __forceinline__ void operator()(const f32x4 (&acc)[2][2][4][2], const pg8::Unit& u, int wr, int wc, int fr, int fq) const {
        const int col0 = u.pn * 256 + wc * 32 + 4 * fq;
#pragma unroll
        for (int ai = 0; ai < 2; ++ai)
#pragma unroll
            for (int m = 0; m < 4; ++m) { const size_t off = (size_t)(u.pm * 256 + ai * 128 + wr * 64 + m * 16 + fr) * DM + col0;
#pragma unroll
                for (int bj = 0; bj < 2; ++bj)
#pragma unroll
                    for (int n = 0; n < 2; ++n) { const f32x4 xv = *(const f32x4*)(x + off + bj * 128 + n * 16); *(f32x4*)(z + off + bj * 128 + n * 16) = xv * ALPHA + acc[ai][bj][m][n]; } }
    }
};
__device__ __forceinline__ f32x2 swiglu4_pk(f32x2 g, f32x2 u) {
    g = __builtin_elementwise_min(g, (f32x2){7.0f, 7.0f});
    u = __builtin_elementwise_min(__builtin_elementwise_max(u, (f32x2){-7.0f, -7.0f}), (f32x2){7.0f, 7.0f});
    const f32x2 a_ = g * (-1.702f * LOG2E) + (-2.0f);
    f32x2 e_; e_.x = __builtin_amdgcn_exp2f(a_.x); e_.y = __builtin_amdgcn_exp2f(a_.y);
    const f32x2 d_ = e_ + 0.25f;
    f32x2 s_; s_.x = __builtin_amdgcn_rcpf(d_.x); s_.y = __builtin_amdgcn_rcpf(d_.y);
    const f32x2 t_ = g * s_;
    return t_ * u + t_;
}
struct EpiUp {
    static constexpr bool PERM = true;
    bf16_t* H; const float* b_up;
    __device__ __forceinline__ void init(f32x4 (&acc)[2][2][4][2], const pg8::Unit& u, int wc, int fq) const {
        const int e = u.pn >> 3, pnl = u.pn & 7, hcol0 = pnl * 128 + wc * 32 + 8 * fq;
        const float* bg = b_up + (size_t)e * 2048 + hcol0; const float* bu = bg + 1024;
        const f32x4 bg0 = *(const f32x4*)bg, bg1 = *(const f32x4*)(bg + 4), bu0 = *(const f32x4*)bu, bu1 = *(const f32x4*)(bu + 4);
#pragma unroll
        for (int a_ = 0; a_ < 2; ++a_)
#pragma unroll
            for (int m_ = 0; m_ < 4; ++m_) { acc[a_][0][m_][0] = bg0; acc[a_][0][m_][1] = bg1; acc[a_][1][m_][0] = bu0; acc[a_][1][m_][1] = bu1; }
    }
    __device__ __forceinline__ void operator()(const f32x4 (&acc)[2][2][4][2], const pg8::Unit& u, int wr, int wc, int fr, int fq) const {
        const int e = u.pn >> 3, pnl = u.pn & 7, hcol0 = pnl * 128 + wc * 32 + 8 * fq;
#pragma unroll
        for (int ai = 0; ai < 2; ++ai)
#pragma unroll
            for (int m = 0; m < 4; ++m) { const size_t row = (size_t)(u.pm * 256 + ai * 128 + wr * 64 + m * 16 + fr);
                const f32x4 g0 = acc[ai][0][m][0], g1 = acc[ai][0][m][1], u0 = acc[ai][1][m][0], u1 = acc[ai][1][m][1];
                const f32x2 r0 = swiglu4_pk((f32x2){g0[0], g0[1]}, (f32x2){u0[0], u0[1]}), r1 = swiglu4_pk((f32x2){g0[2], g0[3]}, (f32x2){u0[2], u0[3]});
                const f32x2 r2 = swiglu4_pk((f32x2){g1[0], g1[1]}, (f32x2){u1[0], u1[1]}), r3 = swiglu4_pk((f32x2){g1[2], g1[3]}, (f32x2){u1[2], u1[3]});
                u32x2 w8; w8.x = cvt4_fp8(r0.x, r0.y, r1.x, r1.y); w8.y = cvt4_fp8(r2.x, r2.y, r3.x, r3.y);
                *(u32x2*)((unsigned char*)H + row * DFF + hcol0) = w8; }
    }
};
struct EpiDown {
    static constexpr bool PERM = true;
    bf16_t* Y; const float* b_down; const float* row_gate;
    __device__ __forceinline__ void init(f32x4 (&acc)[2][2][4][2], const pg8::Unit& u, int wc, int fq) const {
        const int e = u.pn >> 2, pnl = u.pn & 3, col0 = pnl * 256 + wc * 32 + 8 * fq;
#pragma unroll
        for (int bj = 0; bj < 2; ++bj)
#pragma unroll
            for (int n = 0; n < 2; ++n) { const f32x4 bv = *(const f32x4*)(b_down + (size_t)e * DM + col0 + bj * 128 + 4 * n);
#pragma unroll
                for (int a_ = 0; a_ < 2; ++a_)
#pragma unroll
                    for (int m_ = 0; m_ < 4; ++m_) acc[a_][bj][m_][n] = bv; }
    }
    __device__ __forceinline__ void operator()(const f32x4 (&acc)[2][2][4][2], const pg8::Unit& u, int wr, int wc, int fr, int fq) const {
        const int e = u.pn >> 2, pnl = u.pn & 3, col0 = pnl * 256 + wc * 32 + 8 * fq;
#pragma unroll
        for (int ai = 0; ai < 2; ++ai)
#pragma unroll
            for (int m = 0; m < 4; ++m) { const size_t row = (size_t)(u.pm * 256 + ai * 128 + wr * 64 + m * 16 + fr); const float gt = row_gate[row];
#pragma unroll
                for (int bj = 0; bj < 2; ++bj) { const f32x4 v0 = acc[ai][bj][m][0] * (gt * 32.f), v1 = acc[ai][bj][m][1] * (gt * 32.f); u32x2 w;
                    w.x = cvt4_fp8(v0[0], v0[1], v0[2], v0[3]); w.y = cvt4_fp8(v1[0], v1[1], v1[2], v1[3]); *(u32x2*)((unsigned char*)Y + row * DM + col0 + bj * 128) = w; } }
    }
};
struct MoeOrder {
    pg8::StaticOrder so; const LAS unsigned char* tile_e; const LAS unsigned short* tok; int ncolt;
    __device__ __forceinline__ bool next(int i, pg8::Unit& u) const {
        if (!so.next(i, u)) return false;
        const int e = __builtin_amdgcn_readfirstlane((int)tile_e[u.pm]); u.pn = e * ncolt + u.pn; return true; }
    __device__ __forceinline__ const LAS unsigned short* tok_table(int ui) const { return tok + ui * 256; }
};

__device__ __forceinline__ void p0_transpose_item(const float* W, int K, int N, bf16_t* WT, int k0, int n0, int row0, LAS float* scr, int lane) {
#pragma unroll 8
    for (int i = 0; i < 32; ++i) { const int kk = 2 * i + (lane >> 5); scr[kk * 33 + (lane & 31)] = W[(size_t)(k0 + kk) * N + n0 + (lane & 31)]; }
    asm volatile("s_waitcnt lgkmcnt(0)" ::: "memory");
    const int c = lane & 7;
#pragma unroll
    for (int j = 0; j < 4; ++j) { const int n = (lane >> 3) + 8 * j; const LAS float* s = scr + (8 * c) * 33 + n;
        u32x4 o; o.x = cvtpk(s[0 * 33], s[1 * 33]); o.y = cvtpk(s[2 * 33], s[3 * 33]); o.z = cvtpk(s[4 * 33], s[5 * 33]); o.w = cvtpk(s[6 * 33], s[7 * 33]);
        *(u32x4*)(WT + (size_t)(row0 + n) * K + k0 + 8 * c) = o; }
    asm volatile("s_waitcnt lgkmcnt(0)" ::: "memory");
}
__device__ __forceinline__ void p0_transpose_item_f8(const float* W, int K, int N, unsigned char* WT, int k0, int n0, int row0, LAS float* scr, int lane) {
#pragma unroll 8
    for (int i = 0; i < 32; ++i) { const int kk = 2 * i + (lane >> 5); scr[kk * 33 + (lane & 31)] = W[(size_t)(k0 + kk) * N + n0 + (lane & 31)]; }
    asm volatile("s_waitcnt lgkmcnt(0)" ::: "memory");
    const int c = lane & 7;
#pragma unroll
    for (int j = 0; j < 4; ++j) { const int n = (lane >> 3) + 8 * j; const LAS float* s = scr + (8 * c) * 33 + n;
        u32x2 o; o.x = cvt4_fp8(256.f * s[0 * 33], 256.f * s[1 * 33], 256.f * s[2 * 33], 256.f * s[3 * 33]); o.y = cvt4_fp8(256.f * s[4 * 33], 256.f * s[5 * 33], 256.f * s[6 * 33], 256.f * s[7 * 33]);
        *(u32x2*)(WT + (size_t)(row0 + n) * K + k0 + 8 * c) = o; }
    asm volatile("s_waitcnt lgkmcnt(0)" ::: "memory");
}
__device__ __forceinline__ void p0_prologue(const Frame& F, const Args& a) {
    LAS float* scr = (LAS float*)(F.lds + F.wave * 16384);
    const int gw = F.vcu * 8 + F.wave, NGW = F.G * 8;
    bf16_t* WinT = (bf16_t*)(a.ws + WS_WIN); bf16_t* WoutT = (bf16_t*)(a.ws + WS_WOUT); bf16_t* WupT = (bf16_t*)(a.ws + WS_WUP); bf16_t* WdnT = (bf16_t*)(a.ws + WS_WDN);
    constexpr int I_IN = 16 * 96, I_OUT = 16 * 32, I_UP = 16 * 64, I_DN = 16 * 32;
    constexpr int NITEMS = I_IN + I_OUT + NE * I_UP + NE * I_DN;
    for (int it = gw; it < NITEMS; it += NGW) {
        int r = it;
        if (r < I_IN) { const int kb = r / 96, nb = r % 96; p0_transpose_item(a.w_in, DM, NPROJ, WinT, 64 * kb, 32 * nb, 32 * nb, scr, F_LANE); continue; } r -= I_IN;
        if (r < I_OUT) { const int kb = r / 32, nb = r % 32; p0_transpose_item(a.w_out, DM, DM, WoutT, 64 * kb, 32 * nb, 32 * nb, scr, F_LANE); continue; } r -= I_OUT;
        if (r < NE * I_UP) { const int e = r / I_UP, q = r % I_UP, kb = q / 64, nb = q % 64, n0 = 32 * nb;
            const int nn = n0 & 1023, row0 = (nn >> 7) * 256 + (n0 >> 10) * 128 + (nn & 127);
            p0_transpose_item_f8(a.w_up + (size_t)e * DM * 2048, DM, 2048, (unsigned char*)WupT + (size_t)e * 2048 * DM, 64 * kb, n0, row0, scr, F_LANE); continue; } r -= NE * I_UP;
        { const int e = r / I_DN, q = r % I_DN, kb = q / 32, nb = q % 32; p0_transpose_item_f8(a.w_down + (size_t)e * DFF * DM, DFF, DM, (unsigned char*)WdnT + (size_t)e * DM * DFF, 64 * kb, 32 * nb, 32 * nb, scr, F_LANE); }
    }
    bf16_t* XB = (bf16_t*)(a.ws + WS_XB);
    for (int m = gw; m < NTOK; m += NGW) {
        const f32x4* xr = (const f32x4*)(a.x + (size_t)m * DM) + F_LANE; unsigned long long* o8 = (unsigned long long*)(XB + (size_t)m * DM) + F_LANE;
#pragma unroll
        for (int j = 0; j < 4; ++j) { const f32x4 v = xr[64 * j]; o8[64 * j] = (unsigned long long)cvtpk(v[0], v[1]) | ((unsigned long long)cvtpk(v[2], v[3]) << 32); }
    }
}

__device__ __forceinline__ void glds16(const void* gsrc, unsigned lds_dst) { unsigned keep;
    asm volatile("s_mov_b32 %0, m0\n\ts_mov_b32 m0, %2\n\ts_nop 0\n\tglobal_load_lds_dwordx4 %1, off\n\ts_mov_b32 m0, %0" : "=&s"(keep) : "v"(gsrc), "s"(lds_dst) : "memory"); }
__device__ __forceinline__ int crow(int r, int hi) { return (r & 3) + 8 * (r >> 2) + 4 * hi; }
typedef LAS const char* lds_cptr;
typedef short v4i16_t __attribute__((ext_vector_type(4)));
__device__ __forceinline__ s16x4 vtr(lds_cptr p) { return __builtin_bit_cast(s16x4, __builtin_amdgcn_ds_read_tr16_b64_v4i16((LAS v4i16_t*)p)); }
#define MX3(a, b, c) __builtin_fmaxf(__builtin_fmaxf((a), (b)), (c))
__device__ __forceinline__ float rowmax(const f32x16& p0, const f32x16& p1) {
    float a = MX3(p0[0], p0[1], p1[0]), b = MX3(p0[2], p0[3], p1[1]); a = MX3(a, p1[2], p1[3]);
#pragma unroll
    for (int r = 4; r < 16; r += 4) { a = MX3(a, p0[r], p0[r + 1]); b = MX3(b, p0[r + 2], p0[r + 3]); a = MX3(a, p1[r], p1[r + 1]); b = MX3(b, p1[r + 2], p1[r + 3]); }
    float m = __builtin_fmaxf(a, b); auto rr = __builtin_amdgcn_permlane32_swap(__float_as_uint(m), __float_as_uint(m), false, false);
    return __builtin_fmaxf(__uint_as_float(rr[0]), __uint_as_float(rr[1]));
}
__device__ __forceinline__ float halfsum(float v) { auto rr = __builtin_amdgcn_permlane32_swap(__float_as_uint(v), __float_as_uint(v), false, false); return __uint_as_float(rr[0]) + __uint_as_float(rr[1]); }
#define MFMA32(a, b, c) __builtin_amdgcn_mfma_f32_32x32x16_bf16(a, b, c, 0, 0, 0)

template <int ND>
__device__ __forceinline__ void softmax_tile(f32x16& p0, f32x16& p1, float& mhat, float& lsum, f32x16 (&o)[ND], u32x4 (&pw)[4]) {
    const float rm = rowmax(p0, p1);
    const float mnew = __builtin_fmaxf(mhat, rm);
    if (__any(mnew != mhat)) {
        const float al = __builtin_amdgcn_exp2f(mhat - mnew); lsum *= al;
#pragma unroll
        for (int d = 0; d < ND; ++d)
#pragma unroll
            for (int r = 0; r < 16; ++r) o[d][r] *= al;
        mhat = mnew;
    }
    float s = 0.f;
#pragma unroll
    for (int r = 0; r < 16; ++r) { p0[r] = __builtin_amdgcn_exp2f(p0[r] - mhat); p1[r] = __builtin_amdgcn_exp2f(p1[r] - mhat); s += p0[r] + p1[r]; }
    lsum += s;
    pw[0] = (u32x4){cvtpk(p0[0], p0[1]), cvtpk(p0[2], p0[3]), cvtpk(p0[4], p0[5]), cvtpk(p0[6], p0[7])};
    pw[1] = (u32x4){cvtpk(p0[8], p0[9]), cvtpk(p0[10], p0[11]), cvtpk(p0[12], p0[13]), cvtpk(p0[14], p0[15])};
    pw[2] = (u32x4){cvtpk(p1[0], p1[1]), cvtpk(p1[2], p1[3]), cvtpk(p1[4], p1[5]), cvtpk(p1[6], p1[7])};
    pw[3] = (u32x4){cvtpk(p1[8], p1[9]), cvtpk(p1[10], p1[11]), cvtpk(p1[12], p1[13]), cvtpk(p1[14], p1[15])};
}
template <int ND>
__device__ __forceinline__ void pv_tile(f32x16 (&o)[ND], lds_cptr vbase, const u32x4 (&pw)[4]) {
#pragma unroll
    for (int d0 = 0; d0 < ND; ++d0)
#pragma unroll
        for (int ks = 0; ks < 4; ++ks) {
            const s16x4 lo = vtr(vbase + d0 * 4096 + ks * 1024), hi = vtr(vbase + d0 * 4096 + ks * 1024 + 512);
            const bf16x8 vf = (bf16x8){lo[0], lo[1], lo[2], lo[3], hi[0], hi[1], hi[2], hi[3]};
            o[d0] = MFMA32(vf, __builtin_bit_cast(bf16x8, pw[ks]), o[d0]);
        }
}

__device__ __forceinline__ unsigned bfb(float x) { return cvtpk(x, 0.f) & 0xFFFFu; }
__device__ __forceinline__ float bff(unsigned b) { return __uint_as_float(b << 16); }
__device__ __forceinline__ void bf_split3(float x, unsigned& h, unsigned& m, unsigned& l) { h = bfb(x); const float r1 = x - bff(h); m = bfb(r1); const float r2 = r1 - bff(m); l = bfb(r2); }
__device__ __forceinline__ void attnB_finish(const Frame& F, const Args& a, f32x16 (&o)[4], float lsum, float lam, size_t rowbase, int qpos, int h, int c, int qs, int r32, int hi) {
    LAS unsigned char* L = F.lds;
    const float inv = 1.0f / halfsum(lsum);
    LAS float* ex = (LAS float*)(L + 65536);
    __syncthreads();
    if (c == 1) {
#pragma unroll
        for (int d0 = 0; d0 < 4; ++d0)
#pragma unroll
            for (int r = 0; r < 16; ++r) ex[(qs * 128 + 32 * d0 + crow(r, hi)) * 32 + r32] = o[d0][r] * inv;
    }
    __syncthreads();
    if (c == 0) {
        float ss = 0.f;
#pragma unroll
        for (int d0 = 0; d0 < 4; ++d0)
#pragma unroll
            for (int r = 0; r < 16; ++r) { const float v = o[d0][r] * inv - lam * ex[(qs * 128 + 32 * d0 + crow(r, hi)) * 32 + r32]; o[d0][r] = v; ss += v * v; }
        ss = halfsum(ss);
        const float rs = __builtin_amdgcn_rsqf(ss * (1.0f / 128.0f) + LN_EPS) * (1.0f - LAM_INIT);
        bf16_t* op = (bf16_t*)(a.ws + WS_MIXED) + (rowbase + qpos) * DM + 512 + h * 128 + 4 * hi;
#pragma unroll
        for (int d0 = 0; d0 < 4; ++d0)
#pragma unroll
            for (int g = 0; g < 4; ++g) { const int dv = 32 * d0 + 8 * g + 4 * hi; const f32x4 gs = *(const f32x4*)(a.g_sub + dv);
                u32x2 w; w.x = cvtpk(o[d0][4 * g] * rs * gs[0], o[d0][4 * g + 1] * rs * gs[1]); w.y = cvtpk(o[d0][4 * g + 2] * rs * gs[2], o[d0][4 * g + 3] * rs * gs[3]);
                *(u32x2*)(op + 32 * d0 + 8 * g) = w; }
    }
    __syncthreads();
}

template <bool FAST>
__device__ __forceinline__ void attnB_unit(const Frame& F, const Args& a, int b, int h, int qblk, float lam, int t_lo, int t_hi, float kn0, float kn1) {
    const int lane = F_LANE, r32 = lane & 31, hi = lane >> 5, wid = F.wave, c = wid >> 2, qs = wid & 3;
    const bf16_t* QD = (const bf16_t*)(a.ws + WS_PROJ) + 3 * PROJ_STRIDE; const bf16_t* KD = QD + PROJ_STRIDE; const bf16_t* VD = KD + PROJ_STRIDE;
    const size_t rowbase = (size_t)b * SEQ; const int q0 = qblk * 128, qpos = q0 + 32 * qs + r32;
    bf16x8 qr[4];
    { const bf16_t* Qp = QD + (rowbase + qpos) * 512 + h * 128 + c * 64 + 8 * hi;
#pragma unroll
      for (int d0 = 0; d0 < 4; ++d0) qr[d0] = *(const bf16x8*)(Qp + 16 * d0); }
    float ref = 0.f;
    { float qq = 0.f;
#pragma unroll
        for (int d0 = 0; d0 < 4; ++d0)
#pragma unroll
            for (int j = 0; j < 8; ++j) { const float v = __uint_as_float((unsigned)(unsigned short)qr[d0][j] << 16); qq += v * v; }
        qq = halfsum(qq); asm volatile("" : "+v"(qq));
        if (FAST) ref = sqrtf(qq) * (c ? kn1 : kn0) * 1.01f + 0.01f; }
    const float slope2 = __builtin_amdgcn_exp2f(-2.0f * (float)(h + 1)) * LOG2E;
    const bf16_t* tsrc = KD + (size_t)((b * 4 + h) * 256) * 16384 + wid * 2048 + lane * 8;
    LAS unsigned char* L = F.lds;
    const unsigned dbase = (unsigned)(uintptr_t)L + (unsigned)wid * 4096u;
#define B_DMA(tt, slot) do { const bf16_t* _k = tsrc + (size_t)(tt) * 16384; const unsigned _d = (unsigned)__builtin_amdgcn_readfirstlane((int)(dbase + (unsigned)(slot) * 32768u)); unsigned _keep; \
        asm volatile("s_mov_b32 %0, m0\n\ts_mov_b32 m0, %2\n\ts_nop 0\n\tglobal_load_lds_dwordx4 %1, off\n\tglobal_load_lds_dwordx4 %1, off offset:1024\n\tglobal_load_lds_dwordx4 %1, off offset:2048\n\tglobal_load_lds_dwordx4 %1, off offset:3072\n\ts_mov_b32 m0, %0" \
                     : "=&s"(_keep) : "v"(_k), "s"(_d) : "memory"); } while (0)
#define WAIT_BAR(N) asm volatile("s_waitcnt vmcnt(" #N ") lgkmcnt(0)\n\ts_barrier" ::: "memory")
#define SBAR() __builtin_amdgcn_sched_barrier(0)
#define PIN(x) asm volatile("" : "+v"(x))
#define VFRAG(dst, base, d0, ks) do { const s16x4 lo_ = vtr((base) + (d0) * 4096 + (ks) * 1024), hi_ = vtr((base) + (d0) * 4096 + (ks) * 1024 + 512); \
        dst = (bf16x8){lo_[0], lo_[1], lo_[2], lo_[3], hi_[0], hi_[1], hi_[2], hi_[3]}; } while (0)
#define GEN_C(tt) do { const float dq = (float)(qpos - (tt) * 64 - 4 * hi); \
        _Pragma("unroll") for (int r = 0; r < 16; ++r) { const float kk = (float)((r & 3) + 8 * (r >> 2)); C0[r] = -slope2 * __builtin_fabsf(dq - kk) - ref; C1[r] = -slope2 * __builtin_fabsf(dq - 32.f - kk) - ref; } } while (0)
    float mhat = NEG_BIG, lsum = 0.f; f32x16 o[4];
#pragma unroll
    for (int d = 0; d < 4; ++d) o[d] = (f32x16){};
    const int koff = (c * 8 + hi) * 1024 + r32 * 16;
    const int voff = 16384 + ((lane >> 4) & 1) * 32 + (lane & 3) * 8 + (4 * hi + ((lane & 15) >> 2)) * 64;
    const int tdiag = q0 >> 6;
    f32x16 C0, C1;
    u32x4 pw[4];
    const int NT = t_hi - t_lo + 1;
    GEN_C(t_lo);
    B_DMA(t_lo, 0); if (NT > 1) B_DMA(t_lo + 1, 1); if (NT > 2) B_DMA(t_lo + 2, 2);
    int sl = 0;
    for (int tau = 0; tau < NT; ++tau) {
        if (tau + 2 < NT) WAIT_BAR(8); else if (tau + 1 < NT) WAIT_BAR(4); else WAIT_BAR(0);
        if (tau + 3 < NT) B_DMA(t_lo + tau + 3, (sl + 3) & 3);
        const int t = t_lo + tau; const LAS unsigned char* buf = L + sl * 32768; const lds_cptr vbase = (lds_cptr)(buf + voff);
        bf16x8 kf[8];
#pragma unroll
        for (int d0 = 0; d0 < 4; ++d0) { kf[2 * d0] = *(const LAS bf16x8*)(buf + koff + d0 * 2048); kf[2 * d0 + 1] = *(const LAS bf16x8*)(buf + koff + d0 * 2048 + 512); }
        SBAR();
        f32x16 p0, p1;
        if constexpr (FAST) {
            bf16x8 vA[4], vB[4]; float sacc = 0.f;
#define EXPS(P, A, B) do { _Pragma("unroll") for (int r = (A); r < (B); ++r) { P[r] = __builtin_amdgcn_exp2f(P[r]); sacc += P[r]; } PIN(P); PIN(sacc); } while (0)
#define PK4(P, B) (u32x4){cvtpk(P[B], P[B + 1]), cvtpk(P[B + 2], P[B + 3]), cvtpk(P[B + 4], P[B + 5]), cvtpk(P[B + 6], P[B + 7])}
#define PWF(k) __builtin_bit_cast(bf16x8, pw[k])
            const float st = (t + 1 < tdiag) ? 64.f * slope2 : -64.f * slope2;
            p0 = MFMA32(kf[0], qr[0], C0); SBAR(); VFRAG(vA[0], vbase, 0, 0); SBAR();
            p0 = MFMA32(kf[2], qr[1], p0); SBAR(); VFRAG(vA[1], vbase, 1, 0); SBAR();
            p0 = MFMA32(kf[4], qr[2], p0); SBAR(); VFRAG(vA[2], vbase, 2, 0); SBAR();
            p0 = MFMA32(kf[6], qr[3], p0); SBAR(); VFRAG(vA[3], vbase, 3, 0); SBAR();
            p1 = MFMA32(kf[1], qr[0], C1); SBAR();
            p1 = MFMA32(kf[3], qr[1], p1); SBAR(); EXPS(p0, 0, 5); SBAR();
            p1 = MFMA32(kf[5], qr[2], p1); SBAR(); EXPS(p0, 5, 11); SBAR();
            p1 = MFMA32(kf[7], qr[3], p1); SBAR(); EXPS(p0, 11, 16); pw[0] = PK4(p0, 0); PIN(pw[0]); SBAR();
            o[0] = MFMA32(vA[0], PWF(0), o[0]); SBAR(); pw[1] = PK4(p0, 8); PIN(pw[1]); VFRAG(vB[0], vbase, 0, 1); SBAR();
            o[1] = MFMA32(vA[1], PWF(0), o[1]); SBAR(); EXPS(p1, 0, 3); VFRAG(vB[1], vbase, 1, 1); SBAR();
            o[2] = MFMA32(vA[2], PWF(0), o[2]); SBAR(); EXPS(p1, 3, 6); VFRAG(vB[2], vbase, 2, 1); SBAR();
            o[3] = MFMA32(vA[3], PWF(0), o[3]); SBAR(); EXPS(p1, 6, 8); VFRAG(vB[3], vbase, 3, 1); SBAR();
            o[0] = MFMA32(vB[0], PWF(1), o[0]); SBAR(); EXPS(p1, 8, 10); VFRAG(vA[0], vbase, 0, 2); SBAR();
            o[1] = MFMA32(vB[1], PWF(1), o[1]); SBAR(); EXPS(p1, 10, 12); VFRAG(vA[1], vbase, 1, 2); SBAR();
            o[2] = MFMA32(vB[2], PWF(1), o[2]); SBAR(); EXPS(p1, 12, 14); VFRAG(vA[2], vbase, 2, 2); SBAR();
            o[3] = MFMA32(vB[3], PWF(1), o[3]); SBAR(); EXPS(p1, 14, 16); VFRAG(vA[3], vbase, 3, 2); pw[2] = PK4(p1, 0); PIN(pw[2]); SBAR();
            o[0] = MFMA32(vA[0], PWF(2), o[0]); SBAR(); pw[3] = PK4(p1, 8); PIN(pw[3]); VFRAG(vB[0], vbase, 0, 3); SBAR();
            o[1] = MFMA32(vA[1], PWF(2), o[1]); SBAR(); VFRAG(vB[1], vbase, 1, 3);
#pragma unroll
            for (int r = 0; r < 8; ++r) C0[r] += st;
            PIN(C0); SBAR();
            o[2] = MFMA32(vA[2], PWF(2), o[2]); SBAR(); VFRAG(vB[2], vbase, 2, 3);
#pragma unroll
            for (int r = 8; r < 16; ++r) C0[r] += st;
            PIN(C0); SBAR();
            o[3] = MFMA32(vA[3], PWF(2), o[3]); SBAR(); VFRAG(vB[3], vbase, 3, 3);
#pragma unroll
            for (int r = 0; r < 8; ++r) C1[r] += st;
            PIN(C1); SBAR();
            o[0] = MFMA32(vB[0], PWF(3), o[0]); SBAR();
#pragma unroll
            for (int r = 8; r < 16; ++r) C1[r] += st;
            PIN(C1); SBAR();
            o[1] = MFMA32(vB[1], PWF(3), o[1]);
            o[2] = MFMA32(vB[2], PWF(3), o[2]);
            o[3] = MFMA32(vB[3], PWF(3), o[3]);
            lsum += sacc;
#undef EXPS
#undef PK4
#undef PWF
        } else {
            p0 = MFMA32(kf[0], qr[0], C0); p1 = MFMA32(kf[1], qr[0], C1);
#pragma unroll
            for (int d0 = 1; d0 < 4; ++d0) { p0 = MFMA32(kf[2 * d0], qr[d0], p0); p1 = MFMA32(kf[2 * d0 + 1], qr[d0], p1); }
            softmax_tile<4>(p0, p1, mhat, lsum, o, pw);
            pv_tile<4>(o, vbase, pw);
            const float st = (t + 1 < tdiag) ? 64.f * slope2 : -64.f * slope2; C0 = C0 + st; C1 = C1 + st;
        }
        if ((t + 1 >= tdiag && t + 1 <= tdiag + 2) || ((tau + 1) & 15) == 0) GEN_C(t + 1);
        sl = (sl + 1) & 3;
    }
#undef B_DMA
#undef WAIT_BAR
#undef VFRAG
#undef GEN_C
#undef SBAR
#undef PIN
    attnB_finish(F, a, o, lsum, lam, rowbase, qpos, h, c, qs, r32, hi);
}
__device__ __forceinline__ void attnB_fast(const Frame& F, const Args& a, int b, int h, int qblk, float lam, int t_lo, int t_hi, float kn0, float kn1) {
    const int lane = F_LANE, r32 = lane & 31, hi = lane >> 5, wid = F.wave, c = wid >> 2, qs = wid & 3;
    const bf16_t* QD = (const bf16_t*)(a.ws + WS_PROJ) + 3 * PROJ_STRIDE; const bf16_t* KD = QD + PROJ_STRIDE;
    const size_t rowbase = (size_t)b * SEQ; const int q0 = qblk * 128, qpos = q0 + 32 * qs + r32;
    bf16x8 qr[4];
    { const bf16_t* Qp = QD + (rowbase + qpos) * 512 + h * 128 + c * 64 + 8 * hi;
#pragma unroll
      for (int d0 = 0; d0 < 4; ++d0) qr[d0] = *(const bf16x8*)(Qp + 16 * d0); }
    float ref;
    { float qq = 0.f;
#pragma unroll
        for (int d0 = 0; d0 < 4; ++d0)
#pragma unroll
            for (int j = 0; j < 8; ++j) { const float v = __uint_as_float((unsigned)(unsigned short)qr[d0][j] << 16); qq += v * v; }
        qq = halfsum(qq); asm volatile("" : "+v"(qq));
        ref = sqrtf(qq) * (c ? kn1 : kn0) * 1.01f + 0.01f; }
    const float slope2 = __builtin_amdgcn_exp2f(-2.0f * (float)(h + 1)) * LOG2E;
    const bf16_t* tsrc = KD + (size_t)((b * 4 + h) * 256) * 16384 + wid * 2048 + lane * 8;
    LAS unsigned char* L = F.lds;
    const unsigned dbase = (unsigned)(uintptr_t)L + (unsigned)wid * 4096u;
#define B_DMA(tt, slot) do { const bf16_t* _k = tsrc + (size_t)(tt) * 16384; const unsigned _d = (unsigned)__builtin_amdgcn_readfirstlane((int)(dbase + (unsigned)(slot) * 32768u)); unsigned _keep; \
        asm volatile("s_mov_b32 %0, m0\n\ts_mov_b32 m0, %2\n\ts_nop 0\n\tglobal_load_lds_dwordx4 %1, off\n\tglobal_load_lds_dwordx4 %1, off offset:1024\n\tglobal_load_lds_dwordx4 %1, off offset:2048\n\tglobal_load_lds_dwordx4 %1, off offset:3072\n\ts_mov_b32 m0, %0" \
                     : "=&s"(_keep) : "v"(_k), "s"(_d) : "memory"); } while (0)
#define WAIT_BAR(N) asm volatile("s_waitcnt vmcnt(" #N ") lgkmcnt(0)\n\ts_barrier" : "+v"(p1), "+v"(sacc) :: "memory")
#define VFRAG(dst, base, d0, ks) do { const s16x4 lo_ = vtr((base) + (d0) * 4096 + (ks) * 1024), hi_ = vtr((base) + (d0) * 4096 + (ks) * 1024 + 512); \
        dst = (bf16x8){lo_[0], lo_[1], lo_[2], lo_[3], hi_[0], hi_[1], hi_[2], hi_[3]}; } while (0)
#define MF_ "v_mfma_f32_32x32x16_bf16 "
#define AMF(D, A, B)              asm volatile(MF_ "%0, %1, %2, %0" : "+v"(D) : "v"(A), "v"(B) : "memory")
#define AMF1(D, A, B, X)          asm volatile(MF_ "%0, %2, %3, %0" : "+v"(D), "+v"(X) : "v"(A), "v"(B) : "memory")
#define AMF2(D, A, B, X, Y)       asm volatile(MF_ "%0, %3, %4, %0" : "+v"(D), "+v"(X), "+v"(Y) : "v"(A), "v"(B) : "memory")
#define AMF3(D, A, B, X, Y, Z)    asm volatile(MF_ "%0, %4, %5, %0" : "+v"(D), "+v"(X), "+v"(Y), "+v"(Z) : "v"(A), "v"(B) : "memory")
#define AMF0(D, A, B)             asm volatile(MF_ "%0, %1, %2, 0" : "=&v"(D) : "v"(A), "v"(B) : "memory")
#define PK4(P, B) (u32x4){cvtpk(P[B], P[B + 1]), cvtpk(P[B + 2], P[B + 3]), cvtpk(P[B + 4], P[B + 5]), cvtpk(P[B + 6], P[B + 7])}
#define XE(P, r) { P[r] = __builtin_amdgcn_exp2f(P[r]); sacc += P[r]; }
#define XE2(P, r) do { XE(P, r) XE(P, (r) + 1) } while (0)
#define KLD(bk, i) kf[i] = *(const LAS bf16x8*)((bk) + koff + ((i) >> 1) * 2048 + ((i) & 1) * 512)
#define SET_KA(tn) do { const unsigned w_ = __builtin_amdgcn_perm(0u, __float_as_uint(tf), 0x03020302u); ka0[1] = w_; ka1[1] = w_; tf += tinc; if ((tn) == tdiag + 2) qa = qaR; } while (0)
#define BIAS_HALF(P, KA, e, tn) do { \
        if ((unsigned)((tn) - tdiag) < 2u) { const int kb_ = 2 * (tn) + (e); \
            if (kb_ == qb) { float dq_ = (float)(qpos - (tn) * 64 - 32 * (e) - 4 * hi), ns_ = -slope2, nr_ = -ref; asm volatile("" : "+v"(dq_), "+v"(ns_), "+v"(nr_)); \
                             _Pragma("unroll") for (int r = 0; r < 16; ++r) { const float kk_ = (float)((r & 3) + 8 * (r >> 2)); P[r] = __builtin_fmaf(ns_, __builtin_fabsf(dq_ - kk_), nr_); } \
                             asm volatile("s_nop 4" : "+v"(P) :: "memory"); } \
            else if (kb_ < qb) { AMF0(P, KA, qaL); } else { AMF0(P, KA, qaR); } } \
        else { AMF0(P, KA, qa); } } while (0)
    const int tdiag = q0 >> 6, qb = 4 * qblk + qs;
    const unsigned msk = hi ? 0u : 0xFFFFFFFFu;
    bf16x8 qaL, qaR, qa; u32x4 ka0, ka1;
    { const float S64 = 64.f * slope2;
        const unsigned sh = bfb(slope2), slo = bfb(slope2 - bff(sh)), Sh = bfb(S64), Slo = bfb(S64 - bff(Sh));
        unsigned ch, cm, cl, dh, dm, dl;
        bf_split3(slope2 * (float)(qpos - 64 * tdiag) - ref, ch, cm, cl);
        bf_split3(-slope2 * (float)(qpos - 64 * tdiag) - ref, dh, dm, dl);
        const u32x4 r_ = (u32x4){(((slo ^ 0x8000u) << 16) | (sh ^ 0x8000u)) & msk, (((Slo ^ 0x8000u) << 16) | (Sh ^ 0x8000u)) & msk, ((cm << 16) | ch) & msk, cl & msk};
        const u32x4 l_ = (u32x4){((slo << 16) | sh) & msk, ((Slo << 16) | Sh) & msk, ((dm << 16) | dh) & msk, dl & msk};
        qaR = __builtin_bit_cast(bf16x8, r_); qaL = __builtin_bit_cast(bf16x8, l_); qa = (t_lo < tdiag + 2) ? qaL : qaR;
        const unsigned j0 = bfb((float)r32), j1 = bfb((float)(32 + r32));
        ka0 = (u32x4){((j0 << 16) | j0) & msk, 0u, 0x3F803F80u & msk, 0x00003F80u & msk}; ka1 = ka0; ka1[0] = ((j1 << 16) | j1) & msk; }
    float tf = hi ? 0.f : (float)(t_lo - tdiag); const float tinc = hi ? 0.f : 1.f;
    f32x16 o[4], p0, p1; u32x4 pw[4]; bf16x8 kf[8], vA[4], vB[4]; float sacc = 0.f;
#pragma unroll
    for (int d = 0; d < 4; ++d) o[d] = (f32x16){};
    p1 = (f32x16){};
    const int koff = (c * 8 + hi) * 1024 + r32 * 16;
    const int voff = 16384 + ((lane >> 4) & 1) * 32 + (lane & 3) * 8 + (4 * hi + ((lane & 15) >> 2)) * 64;
    const int NT = t_hi - t_lo + 1;
    B_DMA(t_lo, 0); if (NT > 1) B_DMA(t_lo + 1, 1); if (NT > 2) B_DMA(t_lo + 2, 2);
    if (NT > 2) WAIT_BAR(8); else if (NT > 1) WAIT_BAR(4); else WAIT_BAR(0);
    {
        const LAS unsigned char* bk = L;
#pragma unroll
        for (int i = 0; i < 8; ++i) KLD(bk, i);
        SET_KA(t_lo);
        asm volatile("s_nop 1" : "+v"(ka0), "+v"(ka1), "+v"(qa) :: "memory");
        BIAS_HALF(p0, ka0, 0, t_lo);
        AMF(p0, kf[0], qr[0]); AMF(p0, kf[2], qr[1]); AMF(p0, kf[4], qr[2]); AMF(p0, kf[6], qr[3]);
        BIAS_HALF(p1, ka1, 1, t_lo);
        AMF(p1, kf[1], qr[0]); AMF(p1, kf[3], qr[1]); AMF(p1, kf[5], qr[2]); AMF(p1, kf[7], qr[3]);
        const lds_cptr vb0 = (lds_cptr)(bk + voff);
        VFRAG(vA[0], vb0, 0, 0); VFRAG(vA[1], vb0, 1, 0); VFRAG(vA[2], vb0, 2, 0); VFRAG(vA[3], vb0, 3, 0);
        asm volatile("s_nop 15\n\ts_nop 15" : "+v"(p0), "+v"(p1) :: "memory");
#pragma unroll
        for (int r = 0; r < 16; r += 2) XE2(p0, r);
#pragma unroll
        for (int r = 0; r < 16; r += 2) XE2(p1, r);
        pw[0] = PK4(p0, 0); pw[1] = PK4(p0, 8); pw[2] = PK4(p1, 0);
    }
    int sl = 0;
    for (int tau = 0; tau + 1 < NT; ++tau) {
        if (tau + 2 < NT) WAIT_BAR(4); else WAIT_BAR(0);
        if (tau + 3 < NT) B_DMA(t_lo + tau + 3, (sl + 3) & 3);
        const LAS unsigned char* buf = L + sl * 32768; const LAS unsigned char* bufn = L + ((sl + 1) & 3) * 32768;
        const lds_cptr vb = (lds_cptr)(buf + voff), vbn = (lds_cptr)(bufn + voff);
        const int tn = t_lo + tau + 1;
        SET_KA(tn);
        AMF(o[0], vA[0], pw[0]);            KLD(bufn, 0); KLD(bufn, 2);
        AMF1(o[1], vA[1], pw[0], p1);       KLD(bufn, 4); KLD(bufn, 6); pw[3] = PK4(p1, 8);
        AMF1(o[2], vA[2], pw[0], pw[3]);    KLD(bufn, 1); KLD(bufn, 3);
        AMF(o[3], vA[3], pw[0]);            KLD(bufn, 5); KLD(bufn, 7);
        BIAS_HALF(p0, ka0, 0, tn);          VFRAG(vB[0], vb, 0, 1);
        AMF(p0, kf[0], qr[0]);              VFRAG(vB[1], vb, 1, 1);
        AMF(p0, kf[2], qr[1]);              VFRAG(vB[2], vb, 2, 1);
        AMF(p0, kf[4], qr[2]);              VFRAG(vB[3], vb, 3, 1);
        AMF(p0, kf[6], qr[3]);
        BIAS_HALF(p1, ka1, 1, tn);
        AMF1(p1, kf[1], qr[0], p0);         XE2(p0, 0);
        AMF2(p1, kf[3], qr[1], p0, sacc);   XE2(p0, 2);
        AMF2(p1, kf[5], qr[2], p0, sacc);   XE2(p0, 4);
        AMF2(p1, kf[7], qr[3], p0, sacc);   XE2(p0, 6);
        AMF2(o[0], vB[0], pw[1], p0, sacc); XE2(p0, 8);  VFRAG(vA[0], vb, 0, 2);
        AMF2(o[1], vB[1], pw[1], p0, sacc); XE2(p0, 10); VFRAG(vA[1], vb, 1, 2);
        AMF2(o[2], vB[2], pw[1], p0, sacc); XE2(p0, 12); VFRAG(vA[2], vb, 2, 2);
        AMF2(o[3], vB[3], pw[1], p0, sacc); XE2(p0, 14); VFRAG(vA[3], vb, 3, 2);
        AMF3(o[0], vA[0], pw[2], p0, sacc, p1);     pw[0] = PK4(p0, 0); XE2(p1, 0); VFRAG(vB[0], vb, 0, 3);
        AMF3(o[1], vA[1], pw[2], p1, sacc, pw[0]);  XE2(p1, 2); VFRAG(vB[1], vb, 1, 3);
        AMF3(o[2], vA[2], pw[2], p1, sacc, p0);     pw[1] = PK4(p0, 8); XE2(p1, 4); VFRAG(vB[2], vb, 2, 3);
        AMF3(o[3], vA[3], pw[2], p1, sacc, pw[1]);  XE2(p1, 6); VFRAG(vB[3], vb, 3, 3);
        AMF2(o[0], vB[0], pw[3], p1, sacc); XE2(p1, 8);  VFRAG(vA[0], vbn, 0, 0);
        AMF2(o[1], vB[1], pw[3], p1, sacc); XE2(p1, 10); VFRAG(vA[1], vbn, 1, 0);
        AMF2(o[2], vB[2], pw[3], p1, sacc); pw[2] = PK4(p1, 0); XE2(p1, 12); VFRAG(vA[2], vbn, 2, 0);
        AMF3(o[3], vB[3], pw[3], p1, sacc, pw[2]);  XE2(p1, 14); VFRAG(vA[3], vbn, 3, 0);
        sl = (sl + 1) & 3;
    }
    {
        const lds_cptr vb = (lds_cptr)(L + sl * 32768 + voff);
        pw[3] = PK4(p1, 8);
        AMF3(o[0], vA[0], pw[0], p1, sacc, pw[3]); VFRAG(vB[0], vb, 0, 1);
        AMF(o[1], vA[1], pw[0]); VFRAG(vB[1], vb, 1, 1);
        AMF(o[2], vA[2], pw[0]); VFRAG(vB[2], vb, 2, 1);
        AMF(o[3], vA[3], pw[0]); VFRAG(vB[3], vb, 3, 1);
        AMF(o[0], vB[0], pw[1]); VFRAG(vA[0], vb, 0, 2);
        AMF(o[1], vB[1], pw[1]); VFRAG(vA[1], vb, 1, 2);
        AMF(o[2], vB[2], pw[1]); VFRAG(vA[2], vb, 2, 2);
        AMF(o[3], vB[3], pw[1]); VFRAG(vA[3], vb, 3, 2);
        AMF(o[0], vA[0], pw[2]); VFRAG(vB[0], vb, 0, 3);
        AMF(o[1], vA[1], pw[2]); VFRAG(vB[1], vb, 1, 3);
        AMF(o[2], vA[2], pw[2]); VFRAG(vB[2], vb, 2, 3);
        AMF(o[3], vA[3], pw[2]); VFRAG(vB[3], vb, 3, 3);
        AMF(o[0], vB[0], pw[3]); AMF(o[1], vB[1], pw[3]); AMF(o[2], vB[2], pw[3]); AMF(o[3], vB[3], pw[3]);
        asm volatile("s_nop 15\n\ts_nop 15" : "+v"(o[0]), "+v"(o[1]), "+v"(o[2]), "+v"(o[3]) :: "memory");
    }
#undef B_DMA
#undef WAIT_BAR
#undef VFRAG
#undef MF_
#undef AMF
#undef AMF1
#undef AMF2
#undef AMF3
#undef AMF0
#undef PK4
#undef XE
#undef XE2
#undef KLD
#undef SET_KA
#undef BIAS_HALF
    attnB_finish(F, a, o, sacc, lam, rowbase, qpos, h, c, qs, r32, hi);
}
__device__ __forceinline__ void attnB_item(const Frame& F, const Args& a, int h, int b, int qblk, float lam) {
    const int q0 = qblk * 128;
    const unsigned* ctl = (const unsigned*)(a.ws + WS_CTL); const int sl = (b * 4 + h) * 4;
    const float qn0 = sqrtf(__uint_as_float(ctl[CW_QMAX + sl]) + __uint_as_float(ctl[CW_QMAX + sl + 1])), qn1 = sqrtf(__uint_as_float(ctl[CW_QMAX + sl + 2]) + __uint_as_float(ctl[CW_QMAX + sl + 3]));
    const float kn0 = sqrtf(__uint_as_float(ctl[CW_KMAX + sl]) + __uint_as_float(ctl[CW_KMAX + sl + 1])), kn1 = sqrtf(__uint_as_float(ctl[CW_KMAX + sl + 2]) + __uint_as_float(ctl[CW_KMAX + sl + 3]));
    const float U = fmaxf(qn0 * kn0, qn1 * kn1) * 1.01f + 0.01f;
    const float slope2 = __builtin_amdgcn_exp2f(-2.0f * (float)(h + 1)) * LOG2E;
    const float Df = (2.0f * U + 80.0f) / slope2;
    const int Dd = Df < 40000.f ? (int)Df + 2 : 40000;
    int t_lo = (q0 - Dd) >> 6; if (q0 - Dd < 0) t_lo = 0;
    int t_hi = (q0 + 127 + Dd) >> 6; if (t_hi > SEQ / 64 - 1) t_hi = SEQ / 64 - 1;
    if (U <= 40.f) attnB_fast(F, a, b, h, qblk, lam, t_lo, t_hi, kn0, kn1);
    else attnB_unit<false>(F, a, b, h, qblk, lam, t_lo, t_hi, kn0, kn1);
}

__device__ __forceinline__ int a_kbase(int n0, int it) { return n0 - 64 + 64 * ((it == 0) ? 1 : (it == 1 ? 0 : 2)); }
__device__ __forceinline__ void a_load_k(const bf16_t* KA, size_t rowbase, int head, int d, int r, int L, int kbase, int r32, int hi, bf16x8 (&kf)[8]) {
#pragma unroll
    for (int kh = 0; kh < 2; ++kh) { int kn = kbase + 32 * kh + r32; kn = kn < 0 ? 0 : (kn >= L ? L - 1 : kn);
        const bf16_t* Kp = KA + (rowbase + (size_t)(d * kn + r)) * 512 + head * 64 + 8 * hi;
#pragma unroll
        for (int d0 = 0; d0 < 4; ++d0) kf[2 * d0 + kh] = *(const bf16x8*)(Kp + 16 * d0); }
}
__device__ __forceinline__ void attnA_task(const Frame& F, const Args& a, int b, int head, int d, int r, int n0, int L, LAS unsigned char* vw, f32x16 (&o)[2], float& mhat, float& ltot) {
    const int lane = F_LANE, r32 = lane & 31, hi = lane >> 5;
    const bf16_t* QA = (const bf16_t*)(a.ws + WS_PROJ); const bf16_t* KA = QA + PROJ_STRIDE; const bf16_t* VA = KA + PROJ_STRIDE;
    const size_t rowbase = (size_t)b * SEQ; const int qn = n0 + r32;
    bf16x8 qr[4], kf[8], kfn[8];
    { const bf16_t* Qp = QA + (rowbase + (size_t)(d * qn + r)) * 512 + head * 64 + 8 * hi;
#pragma unroll
      for (int d0 = 0; d0 < 4; ++d0) qr[d0] = *(const bf16x8*)(Qp + 16 * d0); }
    a_load_k(KA, rowbase, head, d, r, L, a_kbase(n0, 0), r32, hi, kf);
    const float sl = __builtin_amdgcn_exp2f(-(float)(head + 1)) * LOG2E * (float)d;
    mhat = NEG_BIG; float lsum = 0.f; o[0] = (f32x16){}; o[1] = (f32x16){};
    const int voff = ((lane >> 4) & 1) * 32 + (lane & 3) * 8 + (4 * hi + ((lane & 15) >> 2)) * 64;
#pragma unroll
    for (int it = 0; it < 3; ++it) {
        const int kbase = a_kbase(n0, it);
        u32x4 vv[8];
#pragma unroll
        for (int ks = 0; ks < 4; ++ks) { int kn = kbase + 16 * ks + (lane >> 2); kn = kn < 0 ? 0 : (kn >= L ? L - 1 : kn);
            const bf16_t* Vp = VA + (rowbase + (size_t)(d * kn + r)) * 512 + head * 64 + 8 * (lane & 3);
            vv[ks] = *(const u32x4*)Vp; vv[4 + ks] = *(const u32x4*)(Vp + 32); }
        if (it < 2) a_load_k(KA, rowbase, head, d, r, L, a_kbase(n0, it + 1), r32, hi, kfn);
        __builtin_amdgcn_sched_barrier(0);
        f32x16 p0, p1;
#pragma unroll
        for (int rr = 0; rr < 16; ++rr) { const int k0 = kbase + crow(rr, hi), k1 = k0 + 32; const int d0_ = k0 - qn, d1_ = k1 - qn;
            const bool v0 = (k0 >= 0) && (k0 < L) && (d0_ <= 64) && (d0_ >= -64), v1 = (k1 >= 0) && (k1 < L) && (d1_ <= 64) && (d1_ >= -64);
            p0[rr] = v0 ? -sl * __builtin_fabsf((float)d0_) : NEG_BIG; p1[rr] = v1 ? -sl * __builtin_fabsf((float)d1_) : NEG_BIG; }
#pragma unroll
        for (int d0 = 0; d0 < 4; ++d0) { p0 = MFMA32(kf[2 * d0], qr[d0], p0); p1 = MFMA32(kf[2 * d0 + 1], qr[d0], p1); }
        u32x4 pw[4];
        softmax_tile<2>(p0, p1, mhat, lsum, o, pw);
        __builtin_amdgcn_sched_barrier(0);
#pragma unroll
        for (int i = 0; i < 8; ++i) *(LAS u32x4*)(vw + i * 1024 + lane * 16) = vv[i];
        asm volatile("s_waitcnt lgkmcnt(0)" ::: "memory");
        pv_tile<2>(o, (lds_cptr)(vw + voff), pw);
        asm volatile("s_waitcnt lgkmcnt(0)" ::: "memory");
        if (it < 2) {
#pragma unroll
            for (int j = 0; j < 8; ++j) kf[j] = kfn[j];
        }
    }
    ltot = halfsum(lsum);
}
__device__ __forceinline__ void attnA_unit(const Frame& F, const Args& a, int unit) {
    const int lane = F_LANE, r32 = lane & 31, hi = lane >> 5, wid = F.wave;
    const int b = unit >> 7, head = (unit >> 4) & 7, tb = unit & 15, T0 = tb * 1024;
    float* part = (float*)(a.ws + WS_APART + (size_t)unit * APART_UNIT); float* ml = part + 2 * 1024 * 64;
    LAS unsigned char* vw = F.lds + wid * 8192;
    for (int task = wid; task < 64; task += 8) {
        int pat, d, r, n0, L;
        if (task < 32) { pat = 0; d = 16; r = task >> 1; n0 = T0 / 16 + 32 * (task & 1); L = SEQ / 16; }
        else { const int tt = task - 32; pat = 1; d = 4; r = tt >> 3; n0 = T0 / 4 + 32 * (tt & 7); L = SEQ / 4; }
        f32x16 o[2]; float mhat, ltot;
        attnA_task(F, a, b, head, d, r, n0, L, vw, o, mhat, ltot);
        const int tl = d * (n0 + r32) + r - T0;
        float* pp = part + ((size_t)pat * 1024 + tl) * 64 + 4 * hi;
#pragma unroll
        for (int d0 = 0; d0 < 2; ++d0)
#pragma unroll
            for (int g = 0; g < 4; ++g) *(f32x4*)(pp + 32 * d0 + 8 * g) = (f32x4){o[d0][4 * g], o[d0][4 * g + 1], o[d0][4 * g + 2], o[d0][4 * g + 3]};
        if (hi == 0) *(f32x2*)(ml + ((size_t)pat * 1024 + tl) * 2) = (f32x2){mhat, ltot};
    }
    asm volatile("s_waitcnt vmcnt(0)" ::: "memory");
    __syncthreads();
    __builtin_amdgcn_fence(__ATOMIC_ACQUIRE, "agent");
    for (int task = wid; task < 32; task += 8) {
        const int n0 = T0 + 32 * task;
        f32x16 o[2]; float m0, l0;
        attnA_task(F, a, b, head, 1, 0, n0, SEQ, vw, o, m0, l0);
        const int tl = 32 * task + r32;
        const f32x2 ml1 = *(const f32x2*)(ml + ((size_t)0 * 1024 + tl) * 2), ml2 = *(const f32x2*)(ml + ((size_t)1 * 1024 + tl) * 2);
        const float M = MX3(m0, ml1[0], ml2[0]);
        const float w0 = __builtin_amdgcn_exp2f(m0 - M), w1 = __builtin_amdgcn_exp2f(ml1[0] - M), w2 = __builtin_amdgcn_exp2f(ml2[0] - M);
        const float rden = 1.0f / (w0 * l0 + w1 * ml1[1] + w2 * ml2[1]);
        const float* p1 = part + ((size_t)0 * 1024 + tl) * 64 + 4 * hi; const float* p2 = part + ((size_t)1 * 1024 + tl) * 64 + 4 * hi;
        bf16_t* op = (bf16_t*)(a.ws + WS_MIXED) + ((size_t)b * SEQ + T0 + tl) * DM + head * 64 + 4 * hi;
#pragma unroll
        for (int d0 = 0; d0 < 2; ++d0)
#pragma unroll
            for (int g = 0; g < 4; ++g) { const f32x4 a1 = *(const f32x4*)(p1 + 32 * d0 + 8 * g), a2 = *(const f32x4*)(p2 + 32 * d0 + 8 * g); float v[4];
#pragma unroll
                for (int j = 0; j < 4; ++j) v[j] = (w0 * o[d0][4 * g + j] + w1 * a1[j] + w2 * a2[j]) * rden;
                u32x2 w; w.x = cvtpk(v[0], v[1]); w.y = cvtpk(v[2], v[3]); *(u32x2*)(op + 32 * d0 + 8 * g) = w; }
    }
    __syncthreads();
}

__device__ __forceinline__ unsigned ordkey(float v) { const unsigned u = __float_as_uint(v); return u ^ ((u >> 31) ? 0xFFFFFFFFu : 0x80000000u); }
__device__ __forceinline__ float unordkey(unsigned k) { const unsigned u = (k & 0x80000000u) ? (k ^ 0x80000000u) : ~k; return __uint_as_float(u); }
__device__ __forceinline__ void p4_ln_router(const Frame& F, const Args& a) {
    const int lane = F_LANE, wid = F.wave, tid = F_TID;
    LAS float* Wr = (LAS float*)F.lds;
    LAS unsigned* misc = (LAS unsigned*)(F.lds + LX_MISC);
    LAS float* pc = (LAS float*)(F.lds + LX_TOK);
    for (int i = tid; i < DM * NE / 4; i += 512) ((LAS f32x4*)Wr)[i] = ((const f32x4*)a.w_router)[i] * a.ln1_g[i >> 3];
    if (tid < 64) misc[tid] = 0u;
    float* Z = (float*)(a.ws + WS_Z); bf16_t* X1B = (bf16_t*)(a.ws + WS_XB);
    const int r0 = (F.vcu * 8 + wid) * 16;
    const int rl = lane & 15, q = lane >> 4;
    float mym[4] = {0.f, 0.f, 0.f, 0.f}, myr[4] = {0.f, 0.f, 0.f, 0.f};
    {
        f32x4 gv[4], bv[4];
#pragma unroll
        for (int j = 0; j < 4; ++j) { gv[j] = ((const f32x4*)a.ln1_g)[lane + 64 * j]; bv[j] = ((const f32x4*)a.ln1_b)[lane + 64 * j]; }
        float* stats = (float*)(a.ws + WS_ROUTE + 4 * MiB);
#pragma unroll 4
        for (int rr = 0; rr < 16; ++rr) {
            const f32x4* zr = (const f32x4*)(Z + (size_t)(r0 + rr) * DM) + lane; f32x4 v[4]; float s = 0.f;
#pragma unroll
            for (int j = 0; j < 4; ++j) { v[j] = zr[64 * j]; s += (v[j][0] + v[j][1]) + (v[j][2] + v[j][3]); }
            const float mean = wave_sum(s) * (1.f / DM); float s2 = 0.f;
#pragma unroll
            for (int j = 0; j < 4; ++j) { v[j] = v[j] - mean; s2 += (v[j][0] * v[j][0] + v[j][1] * v[j][1]) + (v[j][2] * v[j][2] + v[j][3] * v[j][3]); }
            const float rstd = 1.f / sqrtf(wave_sum(s2) * (1.f / DM) + LN_EPS);
            unsigned* o8 = (unsigned*)((unsigned char*)X1B + (size_t)(r0 + rr) * DM) + lane;
#pragma unroll
            for (int j = 0; j < 4; ++j) { const f32x4 y = (v[j] * rstd * gv[j] + bv[j]) * 8.f; o8[64 * j] = cvt4_fp8(y[0], y[1], y[2], y[3]); }
            if (lane == 0) *(f32x2*)(stats + 2 * (r0 + rr)) = (f32x2){mean, rstd};
            if ((rr >> 2) == q) {
#pragma unroll
                for (int i = 0; i < 4; ++i) if ((rr & 3) == i) { mym[i] = mean; myr[i] = rstd; } }
        }
    }
    __syncthreads();
    {
        const int e = tid & 31, part = tid >> 5; float s0 = 0.f, s1 = 0.f;
        for (int k = part * 64; k < part * 64 + 64; ++k) { s0 += Wr[k * 32 + e]; s1 += a.ln1_b[k] * a.w_router[k * 32 + e]; }
        pc[part * 32 + e] = s0; pc[512 + part * 32 + e] = s1;
    }
    __syncthreads();
    if (tid < 64) { const int e = tid & 31, w = tid >> 5; float t = 0.f; for (int p = 0; p < 16; ++p) t += pc[w * 512 + p * 32 + e]; pc[1024 + tid] = t + (w ? a.b_router[e] : 0.f); }
    __syncthreads();
    f32x4 acc0 = (f32x4){0.f, 0.f, 0.f, 0.f}, acc1 = acc0;
    const float* xr = Z + (size_t)(r0 + rl) * DM + 4 * q;
#pragma unroll 4
    for (int cidx = 0; cidx < 64; ++cidx) {
        const f32x4 xv = *(const f32x4*)(xr + 16 * cidx);
#pragma unroll
        for (int j = 0; j < 4; ++j) { const int k = 16 * cidx + 4 * q + j;
            acc0 = __builtin_amdgcn_mfma_f32_16x16x4f32(xv[j], Wr[k * 32 + rl], acc0, 0, 0, 0);
            acc1 = __builtin_amdgcn_mfma_f32_16x16x4f32(xv[j], Wr[k * 32 + 16 + rl], acc1, 0, 0, 0); }
    }
    {   const float cs0 = pc[1024 + rl], cs1 = pc[1024 + 16 + rl], cb0 = pc[1024 + 32 + rl], cb1 = pc[1024 + 48 + rl];
#pragma unroll
        for (int i = 0; i < 4; ++i) { acc0[i] = myr[i] * (acc0[i] - mym[i] * cs0) + cb0; acc1[i] = myr[i] * (acc1[i] - mym[i] * cs1) + cb1; } }
    const float br0 = 0.f, br1 = 0.f;
    int* sel_e = (int*)(a.ws + WS_ROUTE); int* sel_pos = sel_e + NTOK * TOPK; float* sel_gate = (float*)(sel_pos + NTOK * TOPK);
    int my_e[4] = {0, 0, 0, 0}, my_lp[4] = {0, 0, 0, 0}; float my_g[4] = {0.f, 0.f, 0.f, 0.f};
#pragma unroll
    for (int i = 0; i < 4; ++i) {
        unsigned k0 = (ordkey(acc0[i] + br0) & ~31u) | (unsigned)(31 - rl), k1 = (ordkey(acc1[i] + br1) & ~31u) | (unsigned)(15 - rl);
        unsigned selk[4];
#pragma unroll
        for (int t = 0; t < 4; ++t) {
            unsigned m = k0 > k1 ? k0 : k1;
#pragma unroll
            for (int ofs = 1; ofs < 16; ofs <<= 1) { const unsigned other = (unsigned)__shfl_xor((int)m, ofs); m = other > m ? other : m; }
            selk[t] = m; if (k0 == m) k0 = 0u; if (k1 == m) k1 = 0u;
        }
        const float v0 = unordkey(selk[0] & ~31u), v1 = unordkey(selk[1] & ~31u), v2 = unordkey(selk[2] & ~31u), v3 = unordkey(selk[3] & ~31u);
        const float e1 = __expf(v1 - v0), e2 = __expf(v2 - v0), e3 = __expf(v3 - v0); const float rs = 1.0f / (1.0f + e1 + e2 + e3);
        if (rl < 4) { const unsigned sk = rl == 0 ? selk[0] : (rl == 1 ? selk[1] : (rl == 2 ? selk[2] : selk[3]));
            const float ge = rl == 0 ? 1.0f : (rl == 1 ? e1 : (rl == 2 ? e2 : e3));
            my_e[i] = 31 - (int)(sk & 31u); my_g[i] = ge * rs; my_lp[i] = (int)atomicAdd((unsigned*)&misc[my_e[i]], 1u); }
    }
    __syncthreads();
    unsigned* gcnt = (unsigned*)(a.ws + WS_CTL);
    if (F_TID < 32) misc[32 + F_TID] = atomicAdd(&gcnt[F_TID], misc[F_TID]);
    __syncthreads();
    if (rl < 4) {
#pragma unroll
        for (int i = 0; i < 4; ++i) { const int tok = r0 + 4 * q + i, idx = tok * 4 + rl; sel_e[idx] = my_e[i]; sel_pos[idx] = (int)misc[32 + my_e[i]] + my_lp[i]; sel_gate[idx] = my_g[i]; }
    }
}

__device__ __forceinline__ int build_tiles(const Frame& F, const Args& a) {
    LAS unsigned* misc = (LAS unsigned*)(F.lds + LX_MISC); LAS unsigned char* tile_e = F.lds + LX_TILE;
    const unsigned* gcnt = (const unsigned*)(a.ws + WS_CTL);
    if (F_TID < NE) misc[128 + F_TID] = (__hip_atomic_load(&gcnt[F_TID], __ATOMIC_RELAXED, __HIP_MEMORY_SCOPE_AGENT) + 255u) >> 8;
    __syncthreads();
    if (F_TID == 0) { unsigned acc = 0; for (int e = 0; e < NE; ++e) { misc[64 + e] = acc; acc += misc[128 + e]; } misc[64 + NE] = acc; }
    __syncthreads();
    const int nt = (int)misc[64 + NE];
    for (int e = 0; e < NE; ++e) { const int t0 = (int)misc[64 + e], t1 = (int)misc[65 + e]; for (int t = t0 + F_TID; t < t1; t += 512) tile_e[t] = (unsigned char)e; }
    __syncthreads();
    return nt;
}

#define XLAS __attribute__((address_space(3)))
#define XB_TMO      128
#define XB_XCNT(j)  (256  + 64 * (j))
#define XB_XSUB(j)  (1280 + 64 * (j))
#define XB_XGEN(j)  (2304 + 64 * (j))
#define XB_TOP      3328
#define XB_TOPGEN   3392
#define XCD_BAR_WORDS 3456
#define XB_SPIN_CAP (1u << 22)

__device__ __forceinline__ unsigned xb_ld(unsigned* p)              { return __hip_atomic_load(p, __ATOMIC_RELAXED, __HIP_MEMORY_SCOPE_AGENT); }
__device__ __forceinline__ unsigned xb_add(unsigned* p, unsigned v) { return __hip_atomic_fetch_add(p, v, __ATOMIC_RELAXED, __HIP_MEMORY_SCOPE_AGENT); }
__device__ __forceinline__ unsigned xb_xcc_id() { return (unsigned)__builtin_amdgcn_s_getreg((3 << 11) | 20) & 0xFu; }
#define XB_SPIN(cond, bar) do { unsigned _sp = 0; while (cond) { __builtin_amdgcn_s_sleep(1); \
    if ((++_sp & 255u) == 0u) { if (xb_ld(&(bar)[XB_TMO])) break; if (_sp > XB_SPIN_CAP) { atomicAdd(&(bar)[XB_TMO], 1u); break; } } } } while (0)

struct XcdBarrier {
    unsigned* bar; unsigned x;
    volatile XLAS unsigned* st;
};

__device__ __forceinline__ XcdBarrier xcd_barrier_post(unsigned* bar, volatile XLAS unsigned* st) {
    XcdBarrier b; b.bar = bar; b.x = xb_xcc_id(); b.st = st;
    if (threadIdx.x == 0) (void)xb_add(&bar[XB_XCNT(b.x)], 1u);
    return b;
}
__device__ __forceinline__ void xcd_barrier_complete(unsigned* bar, unsigned x, unsigned& nloc, unsigned& nx) {
    const unsigned G = gridDim.x * gridDim.y * gridDim.z;
    unsigned sum, cnt, mine, sp = 0u;
    for (;;) {
        sum = 0u; cnt = 0u; mine = 0u;
#pragma unroll
        for (unsigned j = 0; j < 16; ++j) { const unsigned c = xb_ld(&bar[XB_XCNT(j)]); sum += c; cnt += (c > 0u) ? 1u : 0u; mine = (j == x) ? c : mine; }
        if (sum == G) break;
        __builtin_amdgcn_s_sleep(1);
        if ((++sp & 255u) == 0u) { if (xb_ld(&bar[XB_TMO])) break; if (sp > XB_SPIN_CAP) { atomicAdd(&bar[XB_TMO], 1u); break; } }
    }
    nloc = mine > 0u ? mine : 1u; nx = cnt > 0u ? cnt : 1u;
}

__device__ __forceinline__ void xcd_barrier(const XcdBarrier& b, const int tid0) {
    asm volatile("s_waitcnt vmcnt(0)" ::: "memory");
    __syncthreads();
    if (tid0 == 0) {
        unsigned* bar = b.bar;
        __builtin_amdgcn_s_waitcnt(0);
        unsigned nloc = b.st[0], nx = b.st[1];
        if (nloc == 0u) { xcd_barrier_complete(bar, b.x, nloc, nx); b.st[0] = nloc; b.st[1] = nx; }
        const unsigned old = xb_add(&bar[XB_XSUB(b.x)], 1u);
        const unsigned gen = old / nloc;
        if (old + 1u == (gen + 1u) * nloc) {
            __builtin_amdgcn_fence(__ATOMIC_RELEASE, "agent");
            asm volatile("s_waitcnt vmcnt(0)" ::: "memory");
            const unsigned og = xb_add(&bar[XB_TOP], 1u);
            const unsigned tg = og / nx;
            if (og + 1u == (tg + 1u) * nx) xb_add(&bar[XB_TOPGEN], 1u);
            else XB_SPIN(xb_ld(&bar[XB_TOPGEN]) == tg, bar);
            __builtin_amdgcn_fence(__ATOMIC_ACQUIRE, "agent");
            xb_add(&bar[XB_XGEN(b.x)], 1u);
            asm volatile("s_waitcnt vmcnt(0)" ::: "memory");
        } else {
            XB_SPIN(xb_ld(&bar[XB_XGEN(b.x)]) == gen, bar);
            __builtin_amdgcn_fence(__ATOMIC_ACQUIRE, "agent");
            asm volatile("s_waitcnt vmcnt(0)" ::: "memory");
        }
    }
    __syncthreads();
}

__global__ void __launch_bounds__(512, 2) fwd_megakernel(Args a) {
    extern __shared__ __attribute__((aligned(16))) unsigned char lds_raw[];
    cg::grid_group grid = cg::this_grid();
    Frame F; F.lds = (LAS unsigned char*)lds_raw; F.wave = __builtin_amdgcn_readfirstlane((int)(threadIdx.x >> 6));
    F.G = gridDim.x; { const int bx = blockIdx.x; F.vcu = (F.G % 8 == 0) ? (bx % 8) * (F.G / 8) + bx / 8 : bx; }
    unsigned char* ws = a.ws;
    {   LAS unsigned* m0_ = (LAS unsigned*)(F.lds + LX_MISC); if (F_TID < 128) m0_[F_TID] = 0u; __syncthreads(); }
    XcdBarrier xbar = xcd_barrier_post((unsigned*)(ws + WS_CTL) + CW_BAR, (volatile LAS unsigned*)(F.lds + LX_MISC) + 120);
#define GRID_BAR() xcd_barrier(xbar, F_TID)
#ifdef PROBE_T1
    unsigned long long* stamps = (unsigned long long*)(ws + WS_CTL + 2048);
#define STAMP(k) do { if (blockIdx.x == 0 && F_TID == 0) stamps[k] = __builtin_amdgcn_s_memrealtime(); } while (0)
#else
#define STAMP(k) do {} while (0)
#endif
    STAMP(0);

    for (int rep = 0; rep < REP_P0; ++rep) p0_prologue(F, a);
    if (a.out == nullptr) grid.sync();
    GRID_BAR();
    STAMP(1);

    for (int rep = 0; rep < REP_P1; ++rep) {
        pg8::Gemm g{(const bf16_t*)(ws + WS_XB), (const bf16_t*)(ws + WS_WIN), NTOK, NPROJ, DM, 0, 0}; pg8::StaticOrder S; S.init(NTOK, NPROJ, F.G, (int)blockIdx.x);
        EpiProj E{(bf16_t*)(ws + WS_PROJ), (unsigned*)(ws + WS_CTL)};
        pg8::gemm_phase<EpiProj, pg8::StaticOrder, true, false, KREP_P1>(F.lds, g, S, E, F_TID);
    }
    GRID_BAR();
    STAMP(2);

    {
        float s1 = 0.f, s2 = 0.f;
        for (int i = 0; i < 64; ++i) { s1 += a.lq1[i] * a.lk1[i]; s2 += a.lq2[i] * a.lk2[i]; }
        const float lam = __expf(s1) - __expf(s2) + LAM_INIT;
        {
            LAS unsigned* misc = (LAS unsigned*)(F.lds + LX_MISC); unsigned* ctl = (unsigned*)(ws + WS_CTL);
            const int myx = (int)(xbar.x & 7u);
            for (;;) {
                __syncthreads();
                if (F_TID == 0) { int got = -1;
                    for (int k = 0; k < 8 && got < 0; ++k) { const int qx = (myx + k) & 7;
                        if (__hip_atomic_load(ctl + CW_QUEUE + qx, __ATOMIC_RELAXED, __HIP_MEMORY_SCOPE_AGENT) < 160u) { const unsigned p = atomicAdd(ctl + CW_QUEUE + qx, 1u); if (p < 160u) got = qx * 256 + (int)p; } }
                    misc[100] = (unsigned)got; }
                __syncthreads();
                const int idx = __builtin_amdgcn_readfirstlane((int)misc[100]);
                if (idx < 0) break;
                const int qx = idx >> 8, p = idx & 255;
                if (p < 64 && (p & 1)) attnA_unit(F, a, qx * 32 + (p >> 1));
                else { const int h = p < 64 ? 3 : 2 - ((p - 64) >> 5), j = p < 64 ? (p >> 1) : (p & 31); attnB_item(F, a, h, qx >> 2, 32 * (qx & 3) + j, lam); }
            }
        }
    }
    GRID_BAR();
    STAMP(3);

    for (int rep = 0; rep < REP_P3; ++rep) {
        pg8::Gemm g{(const bf16_t*)(ws + WS_MIXED), (const bf16_t*)(ws + WS_WOUT), NTOK, DM, DM, 0, 0}; pg8::StaticOrder S; S.init(NTOK, DM, F.G, (int)blockIdx.x);
        EpiZ E{a.x, (float*)(ws + WS_Z)};
        pg8::gemm_phase<EpiZ, pg8::StaticOrder, true, false, KREP_P3>(F.lds, g, S, E, F_TID);
    }
    GRID_BAR();
    STAMP(4);

    if (F.G == 256) p4_ln_router(F, a);
    GRID_BAR();
    STAMP(5);

    int* sel_e = (int*)(ws + WS_ROUTE); int* sel_pos = sel_e + NTOK * TOPK; float* sel_gate = (float*)(sel_pos + NTOK * TOPK);
    int* inv = (int*)(sel_gate + NTOK * TOPK); int* row_tok = inv + NTOK * TOPK; float* row_gate = (float*)(row_tok + 262144);
    {
        const int ntl = build_tiles(F, a); (void)ntl;
        LAS unsigned* misc = (LAS unsigned*)(F.lds + LX_MISC);
        const unsigned* gcnt = (const unsigned*)(ws + WS_CTL);
        for (int idx = F.vcu * 512 + F_TID; idx < NTOK * TOPK; idx += F.G * 512) {
            const int e = sel_e[idx], dest = (int)misc[64 + e] * 256 + sel_pos[idx];
            row_tok[dest] = idx >> 2; row_gate[dest] = sel_gate[idx]; inv[idx] = dest;
        }
        for (int e = F.vcu; e < NE; e += F.G) {
            const int c = (int)__hip_atomic_load(&gcnt[e], __ATOMIC_RELAXED, __HIP_MEMORY_SCOPE_AGENT), base = (int)misc[64 + e] * 256, end = (int)misc[65 + e] * 256;
            for (int r = base + c + F_TID; r < end; r += 512) { row_tok[r] = 0; row_gate[r] = 0.f; }
        }
    }
    GRID_BAR();
    STAMP(6);

    for (int rep = 0; rep < REP_P6; ++rep) {
        const int ntl = build_tiles(F, a);
        MoeOrder S; S.so.init(ntl * 256, 2048, F.G, (int)blockIdx.x); S.tile_e = F.lds + LX_TILE; S.tok = (const LAS unsigned short*)(F.lds + LX_TOK); S.ncolt = 8;
        {
            LAS unsigned short* tk = (LAS unsigned short*)(F.lds + LX_TOK); pg8::Unit u;
            for (int i = F.wave; i < 24 && S.so.next(i, u); i += 8) { const int l_ = F_LANE;
#pragma unroll
                for (int j = 0; j < 4; ++j) tk[i * 256 + l_ + 64 * j] = (unsigned short)row_tok[u.pm * 256 + l_ + 64 * j]; }
            __syncthreads();
        }
        pg8::Gemm g{(const bf16_t*)(ws + WS_XB), (const bf16_t*)(ws + WS_WUP), ntl * 256, 2048, DM, 0x7C7C7C7C, 0x77777777};
        EpiUp E{(bf16_t*)(ws + WS_H), a.b_up};
        pg8::gemm_phase<EpiUp, MoeOrder, true, true, KREP_P6, true>(F.lds, g, S, E, F_TID);
    }
    GRID_BAR();
    STAMP(7);

    for (int rep = 0; rep < REP_P7; ++rep) {
        const int ntl = build_tiles(F, a);
        MoeOrder S; S.so.init(ntl * 256, 1024, F.G, (int)blockIdx.x, ORD_REV7); S.tile_e = F.lds + LX_TILE; S.tok = nullptr; S.ncolt = 4;
        pg8::Gemm g{(const bf16_t*)(ws + WS_H), (const bf16_t*)(ws + WS_WDN), ntl * 256, DM, DFF, 0x7D7D7D7D, 0x77777777};
        EpiDown E{(bf16_t*)(ws + WS_Y), a.b_down, row_gate};
        pg8::gemm_phase<EpiDown, MoeOrder, true, false, KREP_P7, true>(F.lds, g, S, E, F_TID);
    }
    GRID_BAR();
    STAMP(8);

    for (int rep = 0; rep < REP_P8; ++rep) {
        const int lane = F_LANE; const float* X1 = (const float*)(ws + WS_Z); const bf16_t* Y = (const bf16_t*)(ws + WS_Y); const float* stats = (const float*)(ws + WS_ROUTE + 4 * MiB);
        f32x4 gv[4], bv[4], g1[4], b1[4];
#pragma unroll
        for (int j = 0; j < 4; ++j) { gv[j] = ((const f32x4*)a.ln2_g)[lane + 64 * j]; bv[j] = ((const f32x4*)a.ln2_b)[lane + 64 * j]; g1[j] = ((const f32x4*)a.ln1_g)[lane + 64 * j] * ALPHA; b1[j] = ((const f32x4*)a.ln1_b)[lane + 64 * j] * ALPHA; }
        for (int m = F.vcu * 8 + F.wave; m < NTOK; m += F.G * 8) {
            const f32x4* xr = (const f32x4*)(X1 + (size_t)m * DM) + lane; f32x4 v[4]; const f32x2 st = *(const f32x2*)(stats + 2 * m);
#pragma unroll
            for (int j = 0; j < 4; ++j) v[j] = (xr[64 * j] - st[0]) * st[1] * g1[j] + b1[j];
#pragma unroll
            for (int t = 0; t < 4; ++t) { const int dest = inv[m * 4 + t]; const unsigned* yr = (const unsigned*)((const unsigned char*)Y + (size_t)dest * DM) + lane;
#pragma unroll
                for (int j = 0; j < 4; ++j) { const int w = (int)yr[64 * j];
                    v[j][0] += __builtin_amdgcn_cvt_f32_fp8(w, 0) * (1.f / 32.f); v[j][1] += __builtin_amdgcn_cvt_f32_fp8(w, 1) * (1.f / 32.f);
                    v[j][2] += __builtin_amdgcn_cvt_f32_fp8(w, 2) * (1.f / 32.f); v[j][3] += __builtin_amdgcn_cvt_f32_fp8(w, 3) * (1.f / 32.f); } }
            float s = 0.f;
#pragma unroll
            for (int j = 0; j < 4; ++j) s += (v[j][0] + v[j][1]) + (v[j][2] + v[j][3]);
            const float mean = wave_sum(s) * (1.f / DM); float s2 = 0.f;
#pragma unroll
            for (int j = 0; j < 4; ++j) { v[j] = v[j] - mean; s2 += (v[j][0] * v[j][0] + v[j][1] * v[j][1]) + (v[j][2] * v[j][2] + v[j][3] * v[j][3]); }
            const float rstd = 1.f / sqrtf(wave_sum(s2) * (1.f / DM) + LN_EPS);
            f32x4* orow = (f32x4*)(a.out + (size_t)m * DM) + lane;
#pragma unroll
            for (int j = 0; j < 4; ++j) orow[64 * j] = v[j] * rstd * gv[j] + bv[j];
        }
    }
#ifdef PROBE_T1
    STAMP(9);
    if (blockIdx.x == 0) {
        __syncthreads();
        const float t1 = (float)(stamps[PROBE_T1 + 1] - stamps[PROBE_T1]) * 0.01f, t2 = (float)(stamps[PROBE_T2 + 1] - stamps[PROBE_T2]) * 0.01f;
        for (int i = F_TID; i < (1 << 20); i += 512) a.out[1 + i] = t2;
        if (F_TID == 0) a.out[0] = t1 * 10.0f;
    }
#endif
}

extern "C" void kernel_launch(void* const* d_in, const int* in_sizes, int n_in, void* d_out, int out_size, void* d_ws, size_t ws_size, hipStream_t stream) {
    static int grid = 0;
    if (grid == 0) {
        if (n_in != 18 || in_sizes[0] != NTOK * DM || out_size != NTOK * DM || ws_size < WS_END) {
            fprintf(stderr, "kernel_launch: unexpected shapes (n_in %d, in0 %d, out %d, ws %zu need %zu); nothing launched\n", n_in, n_in > 0 ? in_sizes[0] : -1, out_size, ws_size, (size_t)WS_END); grid = -1; return; }
        int dev = 0, cus = 0, per_cu = 0;
        if (hipGetDevice(&dev) != hipSuccess || hipDeviceGetAttribute(&cus, hipDeviceAttributeMultiprocessorCount, dev) != hipSuccess) { grid = -1; return; }
        if (hipFuncSetAttribute((const void*)fwd_megakernel, hipFuncAttributeMaxDynamicSharedMemorySize, LDS_BYTES) != hipSuccess) { fprintf(stderr, "kernel_launch: hipFuncSetAttribute failed\n"); grid = -1; return; }
        if (hipOccupancyMaxActiveBlocksPerMultiprocessor(&per_cu, (const void*)fwd_megakernel, 512, LDS_BYTES) != hipSuccess || per_cu < 1) { fprintf(stderr, "kernel_launch: occupancy query says %d\n", per_cu); per_cu = 1; }
        (void)hipGetLastError();
        grid = cus * (per_cu > 1 ? 1 : per_cu);
        fprintf(stderr, "kernel_launch: grid %d (cus %d, per_cu %d)\n", grid, cus, per_cu);
    }
    if (grid < 0) return;
    if (hipMemsetAsync((char*)d_ws + WS_CTL, 0, CTL_ZERO_BYTES, stream) != hipSuccess) return;
    Args a{};
    const float* const* in = (const float* const*)d_in;
    a.x = in[0]; a.w_in = in[1]; a.w_out = in[2]; a.lq1 = in[3]; a.lk1 = in[4]; a.lq2 = in[5]; a.lk2 = in[6]; a.g_sub = in[7];
    a.ln1_g = in[8]; a.ln1_b = in[9]; a.w_router = in[10]; a.b_router = in[11]; a.w_up = in[12]; a.b_up = in[13]; a.w_down = in[14]; a.b_down = in[15];
    a.ln2_g = in[16]; a.ln2_b = in[17]; a.out = (float*)d_out; a.ws = (unsigned char*)d_ws;
    void* args[] = {&a};
    hipError_t e = hipLaunchCooperativeKernel((void*)fwd_megakernel, dim3(grid), dim3(512), args, LDS_BYTES, stream);
    if (e != hipSuccess) fprintf(stderr, "kernel_launch: cooperative launch failed: %s (grid %d)\n", hipGetErrorString(e), grid);
}
```

```cpp
#include <hip/hip_runtime.h>
#include <hip/hip_cooperative_groups.h>
#include <cstdio>
#include <cstdint>
namespace cg = cooperative_groups;
#ifndef KREP_P1
#define KREP_P1 1
#endif
#ifndef KREP_P3
#define KREP_P3 1
#endif
#ifndef KREP_P6
#define KREP_P6 1
#endif
#ifndef KREP_P7
#define KREP_P7 1
#endif
#ifndef ORD_SWZ
#define ORD_SWZ 0
#endif
#ifndef ORD_REV7
#define ORD_REV7 1
#endif
#ifndef REP_P0
#define REP_P0 1
#endif
#ifndef REP_P1
#define REP_P1 1
#endif
#ifndef REP_A
#define REP_A 1
#endif
#ifndef REP_B
#define REP_B 1
#endif
#ifndef REP_P3
#define REP_P3 1
#endif
#ifndef REP_P6
#define REP_P6 1
#endif
#ifndef REP_P7
#define REP_P7 1
#endif
#ifndef REP_P8
#define REP_P8 1
#endif

#define LAS __attribute__((address_space(3)))
typedef unsigned short bf16_t;
typedef short bf16x8 __attribute__((ext_vector_type(8)));
typedef short s16x4 __attribute__((ext_vector_type(4)));
typedef float f32x4 __attribute__((ext_vector_type(4)));
typedef float f32x2 __attribute__((ext_vector_type(2)));
typedef float f32x16 __attribute__((ext_vector_type(16)));
typedef unsigned u32x4 __attribute__((ext_vector_type(4)));
typedef unsigned u32x2 __attribute__((ext_vector_type(2)));
typedef __bf16 bf16x2_t __attribute__((ext_vector_type(2)));

constexpr int BATCH = 2, SEQ = 16384, DM = 1024, NTOK = BATCH * SEQ;
constexpr int NPROJ = 3072, NE = 32, TOPK = 4, DFF = 1024;
constexpr int NROWS_MAX = NTOK * TOPK + NE * 256;
constexpr float LN_EPS = 1e-5f;
constexpr float ALPHA = 1.189207115002721f;
constexpr float LOG2E = 1.4426950408889634f;
constexpr float C2 = 0.125f * LOG2E;
constexpr float LAM_INIT = 0.2f;
constexpr float NEG_BIG = -1e30f;

constexpr size_t MiB = 1u << 20;
constexpr size_t WS_CTL = 0, CTL_ZERO_BYTES = 65536;
constexpr int CW_QMAX = 64, CW_KMAX = 128, CW_QUEUE = 256, CW_BAR = 4096;
constexpr size_t WS_WIN = 2 * MiB, WS_WOUT = 8 * MiB, WS_WUP = 16 * MiB, WS_WDN = 144 * MiB;
constexpr size_t WS_XB = 208 * MiB;
constexpr size_t WS_PROJ = 272 * MiB;
constexpr size_t PROJ_STRIDE = (size_t)NTOK * 512;
constexpr size_t WS_MIXED = 464 * MiB;
constexpr size_t WS_Z = 272 * MiB;
constexpr size_t WS_H = 400 * MiB;
constexpr size_t WS_Y = 672 * MiB;
constexpr size_t WS_APART = 672 * MiB;
constexpr size_t APART_UNIT = 2 * 1024 * 64 * 4 + 2 * 1024 * 2 * 4;
constexpr size_t WS_ROUTE = 944 * MiB;
constexpr size_t WS_END = 952 * MiB;

constexpr int RING_BYTES = 131072;
constexpr int LX_TILE = 131072;
constexpr int LX_TOK = 132096;
constexpr int LX_MISC = 144384;
constexpr int LDS_BYTES = 147456;

__device__ __forceinline__ unsigned cvtpk(float lo, float hi) { f32x2 v = {lo, hi}; bf16x2_t b = __builtin_convertvector(v, bf16x2_t); return __builtin_bit_cast(unsigned, b); }
__device__ __forceinline__ unsigned cvt4_fp8(float a, float b, float c, float d) { int w = 0; w = __builtin_amdgcn_cvt_pk_fp8_f32(a, b, w, false); w = __builtin_amdgcn_cvt_pk_fp8_f32(c, d, w, true); return (unsigned)w; }
__device__ __forceinline__ float wave_sum(float v) {
#pragma unroll
    for (int o = 1; o < 64; o <<= 1) v += __shfl_xor(v, o);
    return v;
}

namespace pg8 {
constexpr int BM = 256, BK = 64, HALF = 128, HTB = HALF * BK * 2, STAGE_BYTES = 8 * HTB, NXCD = 8, WGM = 8;
__host__ __device__ __forceinline__ int lds_byte(int r, int c) { const int st = (r >> 4) * 2 + (c >> 5), rr = r & 15, cc = c & 31, ob = rr * 64 + cc * 2; return st * 1024 + (ob ^ (((ob >> 9) & 1) << 5)); }
__host__ __device__ __forceinline__ void stage_rc(int b, int& R, int& C) { const int st = b / 1024, sb = b % 1024, swz = sb ^ (((sb >> 9) & 1) << 5); R = (st >> 1) * 16 + swz / 64; C = (st & 1) * 32 + (swz % 64) / 2; }
__host__ __device__ __forceinline__ int perm32(int rho) { const int n = rho >> 4, i = rho & 15; return 8 * (i >> 2) + 4 * n + (i & 3); }

struct Unit { int pm, pn; };
struct Gemm { const bf16_t* A; const bf16_t* Bt; int M, N, K; int scale_a, scale_b; };
typedef int v4i_t __attribute__((ext_vector_type(4))); typedef int v8i_t __attribute__((ext_vector_type(8)));

struct StaticOrder {
    int nM, nN, nwg, G, c, rev, swz;
    __host__ __device__ void init(int M, int N, int G_, int c_, int rev_ = 0, int swz_ = ORD_SWZ) { nM = M / BM; nN = N / BM; nwg = nM * nN; G = G_; c = c_; rev = rev_; swz = swz_; }
    __host__ __device__ bool next(int i, Unit& u) const {
        const long L = (long)i * G + c; if (L >= nwg) return false;
        int wgid = (rev == 1) ? nwg - 1 - (int)L : (int)L;
        if (swz) { const int q = nwg / NXCD, r = nwg % NXCD, xcd = wgid % NXCD; int off = wgid / NXCD; const int len = xcd < r ? q + 1 : q;
            if (rev == 2) off = len - 1 - off;
            wgid = (xcd < r ? xcd * (q + 1) : r * (q + 1) + (xcd - r) * q) + off; }
        const int nig = WGM * nN, gid = wgid / nig, fm = gid * WGM, gsz = (nM - fm) < WGM ? (nM - fm) : WGM;
        u.pm = fm + ((wgid % nig) % gsz); u.pn = (wgid % nig) / gsz; return true;
    }
    __device__ __forceinline__ const LAS unsigned short* tok_table(int) const { return nullptr; }
};

template <class Epi, class Sched, bool ALIGN_EPI, bool GATHER, int KREP = 1, bool F8 = false>
__device__ __forceinline__ void gemm_phase(LAS unsigned char* lds, const Gemm g, const Sched& S, const Epi& E, const int tid) {
    const int wid = __builtin_amdgcn_readfirstlane(tid >> 6), lane = tid & 63, wr = wid >> 2, wc = wid & 3, fr = lane & 15, fq = lane >> 4;
    constexpr int ES = F8 ? 1 : 2;
    const int sclW = g.scale_b, sclX = g.scale_a;
    const int K = g.K, ntr = K * ES / (BK * 2), nt = ntr * KREP;
    unsigned voffA[2], voffB[2]; int rowA[2];
#pragma unroll
    for (int i = 0; i < 2; ++i) { int R, C; stage_rc(tid * 16 + i * 8192, R, C); const int Rb = Epi::PERM ? ((R & ~31) + perm32(R & 31)) : R;
        voffA[i] = GATHER ? (unsigned)(C * 2) : (unsigned)(R * K * ES + C * 2); voffB[i] = (unsigned)(Rb * K * ES + C * 2); rowA[i] = R; }
    const size_t kstep = (size_t)(BK * 2);
    const size_t hstep = (size_t)HALF * K * ES;
    const size_t tstep = 2 * hstep;
    const unsigned ldsw = (unsigned)wid * 1024u;
    const int aoff = lds_byte(wr * 64 + fr, fq * 8), boff = lds_byte(wc * 32 + fr, fq * 8);
    const int aoff8 = lds_byte(wr * 64 + fr, fq * 16), boff8 = lds_byte(wc * 32 + fr, fq * 16);
#define PG8_SA(b, h) (((b) * 2 + (h)) * HTB)
#define PG8_SB(b, h) ((4 + (b) * 2 + (h)) * HTB)
#define PG8_STAGE(bufoff, gbase, voff) do { _Pragma("unroll") for (int _i = 0; _i < 2; ++_i) \
        __builtin_amdgcn_global_load_lds((const unsigned*)((const char*)(gbase) + (voff)[_i]), (LAS unsigned*)(lds + (bufoff) + ldsw + _i * 8192), 16, 0, 0); } while (0)
#define PG8_STAGE_A(bufoff, NX, h, kb) do { if constexpr (GATHER) { const unsigned* _o = (NX) ? gN[h] : gC[h]; PG8_STAGE(bufoff, (const char*)g.A + (kb), _o); } \
        else { PG8_STAGE(bufoff, ((NX) ? nA : cA) + (h) * hstep + (kb), voffA); } } while (0)
#define PG8_LDA(dst, b, h) do { _Pragma("unroll") for (int m = 0; m < 4; ++m) _Pragma("unroll") for (int k = 0; k < 2; ++k) dst[m][k] = *(const LAS bf16x8*)(lds + PG8_SA(b, h) + (F8 ? aoff8 + k * 16 : aoff + k * 1024) + m * 2048); } while (0)
#define PG8_LDB(dst, b, h) do { _Pragma("unroll") for (int n = 0; n < 2; ++n) _Pragma("unroll") for (int k = 0; k < 2; ++k) dst[n][k] = *(const LAS bf16x8*)(lds + PG8_SB(b, h) + (F8 ? boff8 + k * 16 : boff + k * 1024) + n * 2048); } while (0)
#define PG8_F8OP(x) __builtin_shufflevector(__builtin_bit_cast(v4i_t, x[0]), __builtin_bit_cast(v4i_t, x[1]), 0, 1, 2, 3, 4, 5, 6, 7)
#define PG8_MMA(ai, bj, At, Bt) do { __builtin_amdgcn_s_setprio(1); _Pragma("unroll") for (int m = 0; m < 4; ++m) _Pragma("unroll") for (int n = 0; n < 2; ++n) { \
        if constexpr (F8) { const v8i_t _a = PG8_F8OP(Bt[n]), _b = PG8_F8OP(At[m]); asm volatile("v_mfma_scale_f32_16x16x128_f8f6f4 %0, %1, %2, %0, %3, %4 op_sel_hi:[0,0,0]" : "+v"(acc[ai][bj][m][n]) : "v"(_a), "v"(_b), "v"(sclW), "v"(sclX)); } \
        else { _Pragma("unroll") for (int k = 0; k < 2; ++k) acc[ai][bj][m][n] = __builtin_amdgcn_mfma_f32_16x16x32_bf16(Bt[n][k], At[m][k], acc[ai][bj][m][n], 0, 0, 0); } } \
        __builtin_amdgcn_s_setprio(0); } while (0)
#define PG8_WAIT_V(n) asm volatile("s_waitcnt vmcnt(" #n ")" ::: "memory")
#define PG8_WAIT_L(n) asm volatile("s_waitcnt lgkmcnt(" #n ")" ::: "memory")
#define PG8_BAR __builtin_amdgcn_s_barrier()
#define PG8_SCHED __builtin_amdgcn_sched_barrier(0)
#define PG8_GOFF(dst, ui_) do { if constexpr (GATHER) { const LAS unsigned short* _t = S.tok_table(ui_); _Pragma("unroll") for (int _h = 0; _h < 2; ++_h) _Pragma("unroll") for (int _i = 0; _i < 2; ++_i) \
        dst[_h][_i] = (unsigned)_t[_h * HALF + rowA[_i]] * (unsigned)(K * ES) + voffA[_i]; } } while (0)
    Unit cur, nxt; int ui = 0;
    if (!S.next(0, cur)) return;
    f32x4 acc[2][2][4][2];
    E.init(acc, cur, wc, fq);
    bf16x8 At[4][2], B0[2][2], B1[2][2];
    unsigned gC[2][2] = {{0u, 0u}, {0u, 0u}}, gN[2][2] = {{0u, 0u}, {0u, 0u}};
    PG8_GOFF(gC, 0);
    const char* cA = (const char*)g.A + (GATHER ? (size_t)0 : (size_t)cur.pm * tstep); const char* cB = (const char*)g.Bt + (size_t)cur.pn * tstep;
    const char* nA = cA;
    {
        PG8_STAGE(PG8_SB(0, 0), cB, voffB); PG8_STAGE(PG8_SB(0, 1), cB + hstep, voffB); PG8_STAGE_A(PG8_SA(0, 0), false, 0, 0); PG8_STAGE_A(PG8_SA(0, 1), false, 1, 0);
        if (wr == 1) PG8_BAR;
        PG8_WAIT_V(2); PG8_BAR;
        PG8_STAGE(PG8_SB(1, 0), cB + kstep, voffB); PG8_STAGE_A(PG8_SA(1, 0), false, 0, kstep); PG8_STAGE(PG8_SB(1, 1), cB + hstep + kstep, voffB);
        PG8_WAIT_V(6); PG8_BAR;
    }
    for (;;) {
        const bool has_next = S.next(ui + 1, nxt);
        nA = has_next ? (const char*)g.A + (GATHER ? (size_t)0 : (size_t)nxt.pm * tstep) : cA; const char* nB = has_next ? (const char*)g.Bt + (size_t)nxt.pn * tstep : cB;
        if (has_next) { PG8_GOFF(gN, ui + 1); } else {
#pragma unroll
            for (int h = 0; h < 2; ++h)
#pragma unroll
                for (int i = 0; i < 2; ++i) gN[h][i] = gC[h][i]; }
#pragma unroll 1
        for (int t = 0; t < nt; t += 2) {
            const bool last = (t == nt - 2);
            const size_t k1 = (size_t)((t + 1) % ntr) * kstep;
            const size_t k2 = last ? (size_t)0 : (size_t)((t + 2) % ntr) * kstep, k3 = k2 + kstep;
            const char* b2 = last ? nB : cB + (size_t)((t + 2) % ntr) * kstep; const char* b3 = b2 + kstep;
            PG8_LDB(B0, 0, 0); PG8_LDB(B1, 0, 1); PG8_SCHED; PG8_LDA(At, 0, 0); PG8_STAGE_A(PG8_SA(1, 1), false, 1, k1);
            PG8_WAIT_V(8); PG8_WAIT_L(0); PG8_BAR; PG8_MMA(0, 0, At, B0); PG8_MMA(0, 1, At, B1); PG8_BAR; PG8_SCHED;
            PG8_LDA(At, 0, 1); PG8_STAGE(PG8_SB(0, 0), b2, voffB); PG8_STAGE(PG8_SB(0, 1), b2 + hstep, voffB); PG8_STAGE_A(PG8_SA(0, 0), last, 0, k2);
            PG8_WAIT_V(8); PG8_WAIT_L(0); PG8_BAR; PG8_MMA(1, 0, At, B0); PG8_MMA(1, 1, At, B1); PG8_BAR; PG8_SCHED;
            PG8_LDB(B0, 1, 0); PG8_LDB(B1, 1, 1); PG8_SCHED; PG8_LDA(At, 1, 0); PG8_STAGE_A(PG8_SA(0, 1), last, 1, k2);
            PG8_WAIT_V(8); PG8_WAIT_L(0); PG8_BAR; PG8_MMA(0, 0, At, B0); PG8_MMA(0, 1, At, B1); PG8_BAR; PG8_SCHED;
            PG8_LDA(At, 1, 1); PG8_STAGE(PG8_SB(1, 0), b3, voffB); PG8_STAGE(PG8_SB(1, 1), b3 + hstep, voffB); PG8_STAGE_A(PG8_SA(1, 0), last, 0, k3);
            PG8_WAIT_V(8); PG8_WAIT_L(0); PG8_BAR; PG8_MMA(1, 0, At, B0); PG8_MMA(1, 1, At, B1); PG8_BAR; PG8_SCHED;
        }
        if constexpr (ALIGN_EPI) { if (wr == 0) PG8_BAR; }
        if constexpr (F8) asm volatile("s_nop 15\n\ts_nop 15" ::: "memory");
        if constexpr (KREP > 1) {
_Pragma("unroll") for (int a_ = 0; a_ < 2; ++a_) _Pragma("unroll") for (int b_ = 0; b_ < 2; ++b_) _Pragma("unroll") for (int m_ = 0; m_ < 4; ++m_) _Pragma("unroll") for (int n_ = 0; n_ < 2; ++n_) acc[a_][b_][m_][n_] = acc[a_][b_][m_][n_] * (1.0f / KREP); }
        E(acc, cur, wr, wc, fr, fq);
        if (!has_next) break;
        E.init(acc, nxt, wc, fq);
        cur = nxt; cA = nA; cB = nB; ++ui;
#pragma unroll
        for (int h = 0; h < 2; ++h)
#pragma unroll
            for (int i = 0; i < 2; ++i) gC[h][i] = gN[h][i];
        if constexpr (ALIGN_EPI) { if (wr == 1) PG8_BAR; }
    }
    PG8_WAIT_V(0);
    if constexpr (!ALIGN_EPI) { if (wr == 0) PG8_BAR; }
    PG8_BAR;
#undef PG8_SA
#undef PG8_SB
#undef PG8_STAGE
#undef PG8_STAGE_A
#undef PG8_LDA
#undef PG8_LDB
#undef PG8_MMA
#undef PG8_F8OP
#undef PG8_WAIT_V
#undef PG8_WAIT_L
#undef PG8_BAR
#undef PG8_SCHED
#undef PG8_GOFF
}
}

struct Args {
    const float* x; const float* w_in; const float* w_out; const float* lq1; const float* lk1; const float* lq2; const float* lk2; const float* g_sub;
    const float* ln1_g; const float* ln1_b; const float* w_router; const float* b_router; const float* w_up; const float* b_up; const float* w_down; const float* b_down;
    const float* ln2_g; const float* ln2_b; float* out; unsigned char* ws;
};
struct Frame {
    LAS unsigned char* lds; int wave, vcu, G;
};
__device__ __forceinline__ int lane_now() { int l; asm volatile("v_mbcnt_lo_u32_b32 %0, -1, 0\n\tv_mbcnt_hi_u32_b32 %0, -1, %0" : "=v"(l)); return l; }
#define F_LANE lane_now()
#define F_TID (F.wave * 64 + lane_now())

struct EpiProj {
    static constexpr bool PERM = true;
    bf16_t* O; unsigned* ctl;
    __device__ __forceinline__ void init(f32x4 (&acc)[2][2][4][2], const pg8::Unit&, int, int) const {
#pragma unroll
        for (int a_ = 0; a_ < 2; ++a_)
#pragma unroll
            for (int b_ = 0; b_ < 2; ++b_)
#pragma unroll
                for (int m_ = 0; m_ < 4; ++m_)
#pragma unroll
                    for (int n_ = 0; n_ < 2; ++n_) acc[a_][b_][m_][n_] = (f32x4){0.f, 0.f, 0.f, 0.f};
    }
    __device__ __forceinline__ void operator()(const f32x4 (&acc)[2][2][4][2], const pg8::Unit& u, int wr, int wc, int fr, int fq) const {
        const int t = u.pn >> 1; const float sc = (t == 0 || t == 3) ? C2 : 1.f; const bool nrm = (t == 3 || t == 4);
        bf16_t* base = O + (size_t)t * PROJ_STRIDE; const int row0 = u.pm * 256 + wr * 64 + fr, col0 = (u.pn & 1) * 256 + wc * 32 + 8 * fq;
        float mx0 = 0.f, mx1 = 0.f;
#pragma unroll
        for (int ai = 0; ai < 2; ++ai)
#pragma unroll
            for (int m = 0; m < 4; ++m) { bf16_t* rowp = base + (size_t)(row0 + ai * 128 + m * 16) * 512 + col0;
#pragma unroll
                for (int bj = 0; bj < 2; ++bj) { const f32x4 v0 = acc[ai][bj][m][0] * sc, v1 = acc[ai][bj][m][1] * sc; u32x4 w;
                    w.x = cvtpk(v0[0], v0[1]); w.y = cvtpk(v0[2], v0[3]); w.z = cvtpk(v1[0], v1[1]); w.w = cvtpk(v1[2], v1[3]);
                    if (t >= 4) {
                        const int row = row0 + ai * 128 + m * 16, bb = row >> 14, sq = row & (SEQ - 1), key = sq & 63, hh = (u.pn & 1) * 2 + bj;
                        bf16_t* tb = O + 4 * PROJ_STRIDE + ((size_t)((bb * 4 + hh) * 256 + (sq >> 6))) * 16384;
                        if (t == 4) *(u32x4*)(tb + (4 * wc + fq) * 512 + key * 8) = w;
                        else *(u32x4*)(tb + 8192 + (wc * 4 + (key >> 4)) * 512 + (key & 15) * 32 + fq * 8) = w;
                    } else *(u32x4*)(rowp + bj * 128) = w;
                    if (nrm) { float ss = 0.f;
#pragma unroll
                        for (int j = 0; j < 4; ++j) { const float lo = __uint_as_float(w[j] << 16), hi = __uint_as_float(w[j] & 0xFFFF0000u); ss += lo * lo + hi * hi; }
                        ss += __shfl_xor(ss, 16); ss += __shfl_xor(ss, 32);
                        if (bj == 0) mx0 = fmaxf(mx0, ss); else mx1 = fmaxf(mx1, ss); } } }
        if (nrm) {
#pragma unroll
            for (int ofs = 1; ofs < 16; ofs <<= 1) { mx0 = fmaxf(mx0, __shfl_xor(mx0, ofs)); mx1 = fmaxf(mx1, __shfl_xor(mx1, ofs)); }
            if (fr == 0 && fq == 0) { const int b = u.pm >> 6, cw = (t == 3) ? CW_QMAX : CW_KMAX;
                atomicMax(ctl + cw + (((b * 4 + (u.pn & 1) * 2 + 0) * 2 + (wc >> 1)) * 2 + (wc & 1)), __float_as_uint(mx0));
                atomicMax(ctl + cw + (((b * 4 + (u.pn & 1) * 2 + 1) * 2 + (wc >> 1)) * 2 + (wc & 1)), __float_as_uint(mx1)); }
        }
    }
};
struct EpiZ {
    static constexpr bool PERM = false;
    const float* x; float* z;
    __device__ __forceinline__ void init(f32x4 (&acc)[2][2][4][2], const pg8::Unit&, int, int) const {
#pragma unroll
        for (int a_ = 0; a_ < 2; ++a_)
#pragma unroll
            for (int b_ = 0; b_ < 2; ++b_)
#pragma unroll
                for (int m_ = 0; m_ < 4; ++m_)
#pragma unroll
                    for (int n_ = 0; n_ < 2; ++n_) acc[a_][b_][m_][n_] = (f32x4){0.f, 0.f, 0.f, 0.f};
    }
    __device__ __forceinline__ void operator()(const f32x4 (&acc)[2][2][4][2], const pg8::Unit& u, int wr, int wc, int fr, int fq) const {
        const int col0 = u.pn * 256 + wc * 32 + 4 * fq;
#pragma unroll
        for (int ai = 0; ai < 2; ++ai)
#pragma unroll
            for (int m = 0; m < 4; ++m) { const size_t off = (size_t)(u.pm * 256 + ai * 128 + wr * 64 + m * 16 + fr) * DM + col0;
#pragma unroll
                for (int bj = 0; bj < 2; ++bj)
#pragma unroll
                    for (int n = 0; n < 2; ++n) { const f32x4 xv = *(const f32x4*)(x + off + bj * 128 + n * 16); *(f32x4*)(z + off + bj * 128 + n * 16) = xv * ALPHA + acc[ai][bj][m][n]; } }
    }
};
__device__ __forceinline__ f32x2 swiglu4_pk(f32x2 g, f32x2 u) {
    g = __builtin_elementwise_min(g, (f32x2){7.0f, 7.0f});
    u = __builtin_elementwise_min(__builtin_elementwise_max(u, (f32x2){-7.0f, -7.0f}), (f32x2){7.0f, 7.0f});
    const f32x2 a_ = g * (-1.702f * LOG2E) + (-2.0f);
    f32x2 e_; e_.x = __builtin_amdgcn_exp2f(a_.x); e_.y = __builtin_amdgcn_exp2f(a_.y);
    const f32x2 d_ = e_ + 0.25f;
    f32x2 s_; s_.x = __builtin_amdgcn_rcpf(d_.x); s_.y = __builtin_amdgcn_rcpf(d_.y);
    const f32x2 t_ = g * s_;
    return t_ * u + t_;
}
struct EpiUp {
    static constexpr bool PERM = true;
    bf16_t* H; const float* b_up;
    __device__ __forceinline__ void init(f32x4 (&acc)[2][2][4][2], const pg8::Unit& u, int wc, int fq) const {
        const int e = u.pn >> 3, pnl = u.pn & 7, hcol0 = pnl * 128 + wc * 32 + 8 * fq;
        const float* bg = b_up + (size_t)e * 2048 + hcol0; const float* bu = bg + 1024;
        const f32x4 bg0 = *(const f32x4*)bg, bg1 = *(const f32x4*)(bg + 4), bu0 = *(const f32x4*)bu, bu1 = *(const f32x4*)(bu + 4);
#pragma unroll
        for (int a_ = 0; a_ < 2; ++a_)
#pragma unroll
            for (int m_ = 0; m_ < 4; ++m_) { acc[a_][0][m_][0] = bg0; acc[a_][0][m_][1] = bg1; acc[a_][1][m_][0] = bu0; acc[a_][1][m_][1] = bu1; }
    }
    __device__ __forceinline__ void operator()(const f32x4 (&acc)[2][2][4][2], const pg8::Unit& u, int wr, int wc, int fr, int fq) const {
        const int e = u.pn >> 3, pnl = u.pn & 7, hcol0 = pnl * 128 + wc * 32 + 8 * fq;
#pragma unroll
        for (int ai = 0; ai < 2; ++ai)
#pragma unroll
            for (int m = 0; m < 4; ++m) { const size_t row = (size_t)(u.pm * 256 + ai * 128 + wr * 64 + m * 16 + fr);
                const f32x4 g0 = acc[ai][0][m][0], g1 = acc[ai][0][m][1], u0 = acc[ai][1][m][0], u1 = acc[ai][1][m][1];
                const f32x2 r0 = swiglu4_pk((f32x2){g0[0], g0[1]}, (f32x2){u0[0], u0[1]}), r1 = swiglu4_pk((f32x2){g0[2], g0[3]}, (f32x2){u0[2], u0[3]});
                const f32x2 r2 = swiglu4_pk((f32x2){g1[0], g1[1]}, (f32x2){u1[0], u1[1]}), r3 = swiglu4_pk((f32x2){g1[2], g1[3]}, (f32x2){u1[2], u1[3]});
                u32x2 w8; w8.x = cvt4_fp8(r0.x, r0.y, r1.x, r1.y); w8.y = cvt4_fp8(r2.x, r2.y, r3.x, r3.y);
                *(u32x2*)((unsigned char*)H + row * DFF + hcol0) = w8; }
    }
};
struct EpiDown {
    static constexpr bool PERM = true;
    bf16_t* Y; const float* b_down; const float* row_gate;
    __device__ __forceinline__ void init(f32x4 (&acc)[2][2][4][2], const pg8::Unit& u, int wc, int fq) const {
        const int e = u.pn >> 2, pnl = u.pn & 3, col0 = pnl * 256 + wc * 32 + 8 * fq;
#pragma unroll
        for (int bj = 0; bj < 2; ++bj)
#pragma unroll
            for (int n = 0; n < 2; ++n) { const f32x4 bv = *(const f32x4*)(b_down + (size_t)e * DM + col0 + bj * 128 + 4 * n);
#pragma unroll
                for (int a_ = 0; a_ < 2; ++a_)
#pragma unroll
                    for (int m_ = 0; m_ < 4; ++m_) acc[a_][bj][m_][n] = bv; }
    }
    __device__ __forceinline__ void operator()(const f32x4 (&acc)[2][2][4][2], const pg8::Unit& u, int wr, int wc, int fr, int fq) const {
        const int e = u.pn >> 2, pnl = u.pn & 3, col0 = pnl * 256 + wc * 32 + 8 * fq;
#pragma unroll
        for (int ai = 0; ai < 2; ++ai)
#pragma unroll
            for (int m = 0; m < 4; ++m) { const size_t row = (size_t)(u.pm * 256 + ai * 128 + wr * 64 + m * 16 + fr); const float gt = row_gate[row];
#pragma unroll
                for (int bj = 0; bj < 2; ++bj) { const f32x4 v0 = acc[ai][bj][m][0] * (gt * 32.f), v1 = acc[ai][bj][m][1] * (gt * 32.f); u32x2 w;
                    w.x = cvt4_fp8(v0[0], v0[1], v0[2], v0[3]); w.y = cvt4_fp8(v1[0], v1[1], v1[2], v1[3]); *(u32x2*)((unsigned char*)Y + row * DM + col0 + bj * 128) = w; } }
    }
};
struct MoeOrder {
    pg8::StaticOrder so; const LAS unsigned char* tile_e; const LAS unsigned short* tok; int ncolt;
    __device__ __forceinline__ bool next(int i, pg8::Unit& u) const {
        if (!so.next(i, u)) return false;
        const int e = __builtin_amdgcn_readfirstlane((int)tile_e[u.pm]); u.pn = e * ncolt + u.pn; return true; }
    __device__ __forceinline__ const LAS unsigned short* tok_table(int ui) const { return tok + ui * 256; }
};

__device__ __forceinline__ void p0_transpose_item(const float* W, int K, int N, bf16_t* WT, int k0, int n0, int row0, LAS float* scr, int lane) {
#pragma unroll 8
    for (int i = 0; i < 32; ++i) { const int kk = 2 * i + (lane >> 5); scr[kk * 33 + (lane & 31)] = W[(size_t)(k0 + kk) * N + n0 + (lane & 31)]; }
    asm volatile("s_waitcnt lgkmcnt(0)" ::: "memory");
    const int c = lane & 7;
#pragma unroll
    for (int j = 0; j < 4; ++j) { const int n = (lane >> 3) + 8 * j; const LAS float* s = scr + (8 * c) * 33 + n;
        u32x4 o; o.x = cvtpk(s[0 * 33], s[1 * 33]); o.y = cvtpk(s[2 * 33], s[3 * 33]); o.z = cvtpk(s[4 * 33], s[5 * 33]); o.w = cvtpk(s[6 * 33], s[7 * 33]);
        *(u32x4*)(WT + (size_t)(row0 + n) * K + k0 + 8 * c) = o; }
    asm volatile("s_waitcnt lgkmcnt(0)" ::: "memory");
}
__device__ __forceinline__ void p0_transpose_item_f8(const float* W, int K, int N, unsigned char* WT, int k0, int n0, int row0, LAS float* scr, int lane) {
#pragma unroll 8
    for (int i = 0; i < 32; ++i) { const int kk = 2 * i + (lane >> 5); scr[kk * 33 + (lane & 31)] = W[(size_t)(k0 + kk) * N + n0 + (lane & 31)]; }
    asm volatile("s_waitcnt lgkmcnt(0)" ::: "memory");
    const int c = lane & 7;
#pragma unroll
    for (int j = 0; j < 4; ++j) { const int n = (lane >> 3) + 8 * j; const LAS float* s = scr + (8 * c) * 33 + n;
        u32x2 o; o.x = cvt4_fp8(256.f * s[0 * 33], 256.f * s[1 * 33], 256.f * s[2 * 33], 256.f * s[3 * 33]); o.y = cvt4_fp8(256.f * s[4 * 33], 256.f * s[5 * 33], 256.f * s[6 * 33], 256.f * s[7 * 33]);
        *(u32x2*)(WT + (size_t)(row0 + n) * K + k0 + 8 * c) = o; }
    asm volatile("s_waitcnt lgkmcnt(0)" ::: "memory");
}
__device__ __forceinline__ void p0_prologue(const Frame& F, const Args& a) {
    LAS float* scr = (LAS float*)(F.lds + F.wave * 16384);
    const int gw = F.vcu * 8 + F.wave, NGW = F.G * 8;
    bf16_t* WinT = (bf16_t*)(a.ws + WS_WIN); bf16_t* WoutT = (bf16_t*)(a.ws + WS_WOUT); bf16_t* WupT = (bf16_t*)(a.ws + WS_WUP); bf16_t* WdnT = (bf16_t*)(a.ws + WS_WDN);
    constexpr int I_IN = 16 * 96, I_OUT = 16 * 32, I_UP = 16 * 64, I_DN = 16 * 32;
    constexpr int NITEMS = I_IN + I_OUT + NE * I_UP + NE * I_DN;
    for (int it = gw; it < NITEMS; it += NGW) {
        int r = it;
        if (r < I_IN) { const int kb = r / 96, nb = r % 96; p0_transpose_item(a.w_in, DM, NPROJ, WinT, 64 * kb, 32 * nb, 32 * nb, scr, F_LANE); continue; } r -= I_IN;
        if (r < I_OUT) { const int kb = r / 32, nb = r % 32; p0_transpose_item(a.w_out, DM, DM, WoutT, 64 * kb, 32 * nb, 32 * nb, scr, F_LANE); continue; } r -= I_OUT;
        if (r < NE * I_UP) { const int e = r / I_UP, q = r % I_UP, kb = q / 64, nb = q % 64, n0 = 32 * nb;
            const int nn = n0 & 1023, row0 = (nn >> 7) * 256 + (n0 >> 10) * 128 + (nn & 127);
            p0_transpose_item_f8(a.w_up + (size_t)e * DM * 2048, DM, 2048, (unsigned char*)WupT + (size_t)e * 2048 * DM, 64 * kb, n0, row0, scr, F_LANE); continue; } r -= NE * I_UP;
        { const int e = r / I_DN, q = r % I_DN, kb = q / 32, nb = q % 32; p0_transpose_item_f8(a.w_down + (size_t)e * DFF * DM, DFF, DM, (unsigned char*)WdnT + (size_t)e * DM * DFF, 64 * kb, 32 * nb, 32 * nb, scr, F_LANE); }
    }
    bf16_t* XB = (bf16_t*)(a.ws + WS_XB);
    for (int m = gw; m < NTOK; m += NGW) {
        const f32x4* xr = (const f32x4*)(a.x + (size_t)m * DM) + F_LANE; unsigned long long* o8 = (unsigned long long*)(XB + (size_t)m * DM) + F_LANE;
#pragma unroll
        for (int j = 0; j < 4; ++j) { const f32x4 v = xr[64 * j]; o8[64 * j] = (unsigned long long)cvtpk(v[0], v[1]) | ((unsigned long long)cvtpk(v[2], v[3]) << 32); }
    }
}

__device__ __forceinline__ void glds16(const void* gsrc, unsigned lds_dst) { unsigned keep;
    asm volatile("s_mov_b32 %0, m0\n\ts_mov_b32 m0, %2\n\ts_nop 0\n\tglobal_load_lds_dwordx4 %1, off\n\ts_mov_b32 m0, %0" : "=&s"(keep) : "v"(gsrc), "s"(lds_dst) : "memory"); }
__device__ __forceinline__ int crow(int r, int hi) { return (r & 3) + 8 * (r >> 2) + 4 * hi; }
typedef LAS const char* lds_cptr;
typedef short v4i16_t __attribute__((ext_vector_type(4)));
__device__ __forceinline__ s16x4 vtr(lds_cptr p) { return __builtin_bit_cast(s16x4, __builtin_amdgcn_ds_read_tr16_b64_v4i16((LAS v4i16_t*)p)); }
#define MX3(a, b, c) __builtin_fmaxf(__builtin_fmaxf((a), (b)), (c))
__device__ __forceinline__ float rowmax(const f32x16& p0, const f32x16& p1) {
    float a = MX3(p0[0], p0[1], p1[0]), b = MX3(p0[2], p0[3], p1[1]); a = MX3(a, p1[2], p1[3]);
#pragma unroll
    for (int r = 4; r < 16; r += 4) { a = MX3(a, p0[r], p0[r + 1]); b = MX3(b, p0[r + 2], p0[r + 3]); a = MX3(a, p1[r], p1[r + 1]); b = MX3(b, p1[r + 2], p1[r + 3]); }
    float m = __builtin_fmaxf(a, b); auto rr = __builtin_amdgcn_permlane32_swap(__float_as_uint(m), __float_as_uint(m), false, false);
    return __builtin_fmaxf(__uint_as_float(rr[0]), __uint_as_float(rr[1]));
}
__device__ __forceinline__ float halfsum(float v) { auto rr = __builtin_amdgcn_permlane32_swap(__float_as_uint(v), __float_as_uint(v), false, false); return __uint_as_float(rr[0]) + __uint_as_float(rr[1]); }
#define MFMA32(a, b, c) __builtin_amdgcn_mfma_f32_32x32x16_bf16(a, b, c, 0, 0, 0)

template <int ND>
__device__ __forceinline__ void softmax_tile(f32x16& p0, f32x16& p1, float& mhat, float& lsum, f32x16 (&o)[ND], u32x4 (&pw)[4]) {
    const float rm = rowmax(p0, p1);
    const float mnew = __builtin_fmaxf(mhat, rm);
    if (__any(mnew != mhat)) {
        const float al = __builtin_amdgcn_exp2f(mhat - mnew); lsum *= al;
#pragma unroll
        for (int d = 0; d < ND; ++d)
#pragma unroll
            for (int r = 0; r < 16; ++r) o[d][r] *= al;
        mhat = mnew;
    }
    float s = 0.f;
#pragma unroll
    for (int r = 0; r < 16; ++r) { p0[r] = __builtin_amdgcn_exp2f(p0[r] - mhat); p1[r] = __builtin_amdgcn_exp2f(p1[r] - mhat); s += p0[r] + p1[r]; }
    lsum += s;
    pw[0] = (u32x4){cvtpk(p0[0], p0[1]), cvtpk(p0[2], p0[3]), cvtpk(p0[4], p0[5]), cvtpk(p0[6], p0[7])};
    pw[1] = (u32x4){cvtpk(p0[8], p0[9]), cvtpk(p0[10], p0[11]), cvtpk(p0[12], p0[13]), cvtpk(p0[14], p0[15])};
    pw[2] = (u32x4){cvtpk(p1[0], p1[1]), cvtpk(p1[2], p1[3]), cvtpk(p1[4], p1[5]), cvtpk(p1[6], p1[7])};
    pw[3] = (u32x4){cvtpk(p1[8], p1[9]), cvtpk(p1[10], p1[11]), cvtpk(p1[12], p1[13]), cvtpk(p1[14], p1[15])};
}
template <int ND>
__device__ __forceinline__ void pv_tile(f32x16 (&o)[ND], lds_cptr vbase, const u32x4 (&pw)[4]) {
#pragma unroll
    for (int d0 = 0; d0 < ND; ++d0)
#pragma unroll
        for (int ks = 0; ks < 4; ++ks) {
            const s16x4 lo = vtr(vbase + d0 * 4096 + ks * 1024), hi = vtr(vbase + d0 * 4096 + ks * 1024 + 512);
            const bf16x8 vf = (bf16x8){lo[0], lo[1], lo[2], lo[3], hi[0], hi[1], hi[2], hi[3]};
            o[d0] = MFMA32(vf, __builtin_bit_cast(bf16x8, pw[ks]), o[d0]);
        }
}

__device__ __forceinline__ unsigned bfb(float x) { return cvtpk(x, 0.f) & 0xFFFFu; }
__device__ __forceinline__ float bff(unsigned b) { return __uint_as_float(b << 16); }
__device__ __forceinline__ void bf_split3(float x, unsigned& h, unsigned& m, unsigned& l) { h = bfb(x); const float r1 = x - bff(h); m = bfb(r1); const float r2 = r1 - bff(m); l = bfb(r2); }
__device__ __forceinline__ void attnB_finish(const Frame& F, const Args& a, f32x16 (&o)[4], float lsum, float lam, size_t rowbase, int qpos, int h, int c, int qs, int r32, int hi) {
    LAS unsigned char* L = F.lds;
    const float inv = 1.0f / halfsum(lsum);
    LAS float* ex = (LAS float*)(L + 65536);
    __syncthreads();
    if (c == 1) {
#pragma unroll
        for (int d0 = 0; d0 < 4; ++d0)
#pragma unroll
            for (int r = 0; r < 16; ++r) ex[(qs * 128 + 32 * d0 + crow(r, hi)) * 32 + r32] = o[d0][r] * inv;
    }
    __syncthreads();
    if (c == 0) {
        float ss = 0.f;
#pragma unroll
        for (int d0 = 0; d0 < 4; ++d0)
#pragma unroll
            for (int r = 0; r < 16; ++r) { const float v = o[d0][r] * inv - lam * ex[(qs * 128 + 32 * d0 + crow(r, hi)) * 32 + r32]; o[d0][r] = v; ss += v * v; }
        ss = halfsum(ss);
        const float rs = __builtin_amdgcn_rsqf(ss * (1.0f / 128.0f) + LN_EPS) * (1.0f - LAM_INIT);
        bf16_t* op = (bf16_t*)(a.ws + WS_MIXED) + (rowbase + qpos) * DM + 512 + h * 128 + 4 * hi;
#pragma unroll
        for (int d0 = 0; d0 < 4; ++d0)
#pragma unroll
            for (int g = 0; g < 4; ++g) { const int dv = 32 * d0 + 8 * g + 4 * hi; const f32x4 gs = *(const f32x4*)(a.g_sub + dv);
                u32x2 w; w.x = cvtpk(o[d0][4 * g] * rs * gs[0], o[d0][4 * g + 1] * rs * gs[1]); w.y = cvtpk(o[d0][4 * g + 2] * rs * gs[2], o[d0][4 * g + 3] * rs * gs[3]);
                *(u32x2*)(op + 32 * d0 + 8 * g) = w; }
    }
    __syncthreads();
}

template <bool FAST>
__device__ __forceinline__ void attnB_unit(const Frame& F, const Args& a, int b, int h, int qblk, float lam, int t_lo, int t_hi, float kn0, float kn1) {
    const int lane = F_LANE, r32 = lane & 31, hi = lane >> 5, wid = F.wave, c = wid >> 2, qs = wid & 3;
    const bf16_t* QD = (const bf16_t*)(a.ws + WS_PROJ) + 3 * PROJ_STRIDE; const bf16_t* KD = QD + PROJ_STRIDE; const bf16_t* VD = KD + PROJ_STRIDE;
    const size_t rowbase = (size_t)b * SEQ; const int q0 = qblk * 128, qpos = q0 + 32 * qs + r32;
    bf16x8 qr[4];
    { const bf16_t* Qp = QD + (rowbase + qpos) * 512 + h * 128 + c * 64 + 8 * hi;
#pragma unroll
      for (int d0 = 0; d0 < 4; ++d0) qr[d0] = *(const bf16x8*)(Qp + 16 * d0); }
    float ref = 0.f;
    { float qq = 0.f;
#pragma unroll
        for (int d0 = 0; d0 < 4; ++d0)
#pragma unroll
            for (int j = 0; j < 8; ++j) { const float v = __uint_as_float((unsigned)(unsigned short)qr[d0][j] << 16); qq += v * v; }
        qq = halfsum(qq); asm volatile("" : "+v"(qq));
        if (FAST) ref = sqrtf(qq) * (c ? kn1 : kn0) * 1.01f + 0.01f; }
    const float slope2 = __builtin_amdgcn_exp2f(-2.0f * (float)(h + 1)) * LOG2E;
    const bf16_t* tsrc = KD + (size_t)((b * 4 + h) * 256) * 16384 + wid * 2048 + lane * 8;
    LAS unsigned char* L = F.lds;
    const unsigned dbase = (unsigned)(uintptr_t)L + (unsigned)wid * 4096u;
#define B_DMA(tt, slot) do { const bf16_t* _k = tsrc + (size_t)(tt) * 16384; const unsigned _d = (unsigned)__builtin_amdgcn_readfirstlane((int)(dbase + (unsigned)(slot) * 32768u)); unsigned _keep; \
        asm volatile("s_mov_b32 %0, m0\n\ts_mov_b32 m0, %2\n\ts_nop 0\n\tglobal_load_lds_dwordx4 %1, off\n\tglobal_load_lds_dwordx4 %1, off offset:1024\n\tglobal_load_lds_dwordx4 %1, off offset:2048\n\tglobal_load_lds_dwordx4 %1, off offset:3072\n\ts_mov_b32 m0, %0" \
                     : "=&s"(_keep) : "v"(_k), "s"(_d) : "memory"); } while (0)
#define WAIT_BAR(N) asm volatile("s_waitcnt vmcnt(" #N ") lgkmcnt(0)\n\ts_barrier" ::: "memory")
#define SBAR() __builtin_amdgcn_sched_barrier(0)
#define PIN(x) asm volatile("" : "+v"(x))
#define VFRAG(dst, base, d0, ks) do { const s16x4 lo_ = vtr((base) + (d0) * 4096 + (ks) * 1024), hi_ = vtr((base) + (d0) * 4096 + (ks) * 1024 + 512); \
        dst = (bf16x8){lo_[0], lo_[1], lo_[2], lo_[3], hi_[0], hi_[1], hi_[2], hi_[3]}; } while (0)
#define GEN_C(tt) do { const float dq = (float)(qpos - (tt) * 64 - 4 * hi); \
        _Pragma("unroll") for (int r = 0; r < 16; ++r) { const float kk = (float)((r & 3) + 8 * (r >> 2)); C0[r] = -slope2 * __builtin_fabsf(dq - kk) - ref; C1[r] = -slope2 * __builtin_fabsf(dq - 32.f - kk) - ref; } } while (0)
    float mhat = NEG_BIG, lsum = 0.f; f32x16 o[4];
#pragma unroll
    for (int d = 0; d < 4; ++d) o[d] = (f32x16){};
    const int koff = (c * 8 + hi) * 1024 + r32 * 16;
    const int voff = 16384 + ((lane >> 4) & 1) * 32 + (lane & 3) * 8 + (4 * hi + ((lane & 15) >> 2)) * 64;
    const int tdiag = q0 >> 6;
    f32x16 C0, C1;
    u32x4 pw[4];
    const int NT = t_hi - t_lo + 1;
    GEN_C(t_lo);
    B_DMA(t_lo, 0); if (NT > 1) B_DMA(t_lo + 1, 1); if (NT > 2) B_DMA(t_lo + 2, 2);
    int sl = 0;
    for (int tau = 0; tau < NT; ++tau) {
        if (tau + 2 < NT) WAIT_BAR(8); else if (tau + 1 < NT) WAIT_BAR(4); else WAIT_BAR(0);
        if (tau + 3 < NT) B_DMA(t_lo + tau + 3, (sl + 3) & 3);
        const int t = t_lo + tau; const LAS unsigned char* buf = L + sl * 32768; const lds_cptr vbase = (lds_cptr)(buf + voff);
        bf16x8 kf[8];
#pragma unroll
        for (int d0 = 0; d0 < 4; ++d0) { kf[2 * d0] = *(const LAS bf16x8*)(buf + koff + d0 * 2048); kf[2 * d0 + 1] = *(const LAS bf16x8*)(buf + koff + d0 * 2048 + 512); }
        SBAR();
        f32x16 p0, p1;
        if constexpr (FAST) {
            bf16x8 vA[4], vB[4]; float sacc = 0.f;
#define EXPS(P, A, B) do { _Pragma("unroll") for (int r = (A); r < (B); ++r) { P[r] = __builtin_amdgcn_exp2f(P[r]); sacc += P[r]; } PIN(P); PIN(sacc); } while (0)
#define PK4(P, B) (u32x4){cvtpk(P[B], P[B + 1]), cvtpk(P[B + 2], P[B + 3]), cvtpk(P[B + 4], P[B + 5]), cvtpk(P[B + 6], P[B + 7])}
#define PWF(k) __builtin_bit_cast(bf16x8, pw[k])
            const float st = (t + 1 < tdiag) ? 64.f * slope2 : -64.f * slope2;
            p0 = MFMA32(kf[0], qr[0], C0); SBAR(); VFRAG(vA[0], vbase, 0, 0); SBAR();
            p0 = MFMA32(kf[2], qr[1], p0); SBAR(); VFRAG(vA[1], vbase, 1, 0); SBAR();
            p0 = MFMA32(kf[4], qr[2], p0); SBAR(); VFRAG(vA[2], vbase, 2, 0); SBAR();
            p0 = MFMA32(kf[6], qr[3], p0); SBAR(); VFRAG(vA[3], vbase, 3, 0); SBAR();
            p1 = MFMA32(kf[1], qr[0], C1); SBAR();
            p1 = MFMA32(kf[3], qr[1], p1); SBAR(); EXPS(p0, 0, 5); SBAR();
            p1 = MFMA32(kf[5], qr[2], p1); SBAR(); EXPS(p0, 5, 11); SBAR();
            p1 = MFMA32(kf[7], qr[3], p1); SBAR(); EXPS(p0, 11, 16); pw[0] = PK4(p0, 0); PIN(pw[0]); SBAR();
            o[0] = MFMA32(vA[0], PWF(0), o[0]); SBAR(); pw[1] = PK4(p0, 8); PIN(pw[1]); VFRAG(vB[0], vbase, 0, 1); SBAR();
            o[1] = MFMA32(vA[1], PWF(0), o[1]); SBAR(); EXPS(p1, 0, 3); VFRAG(vB[1], vbase, 1, 1); SBAR();
            o[2] = MFMA32(vA[2], PWF(0), o[2]); SBAR(); EXPS(p1, 3, 6); VFRAG(vB[2], vbase, 2, 1); SBAR();
            o[3] = MFMA32(vA[3], PWF(0), o[3]); SBAR(); EXPS(p1, 6, 8); VFRAG(vB[3], vbase, 3, 1); SBAR();
            o[0] = MFMA32(vB[0], PWF(1), o[0]); SBAR(); EXPS(p1, 8, 10); VFRAG(vA[0], vbase, 0, 2); SBAR();
            o[1] = MFMA32(vB[1], PWF(1), o[1]); SBAR(); EXPS(p1, 10, 12); VFRAG(vA[1], vbase, 1, 2); SBAR();
            o[2] = MFMA32(vB[2], PWF(1), o[2]); SBAR(); EXPS(p1, 12, 14); VFRAG(vA[2], vbase, 2, 2); SBAR();
            o[3] = MFMA32(vB[3], PWF(1), o[3]); SBAR(); EXPS(p1, 14, 16); VFRAG(vA[3], vbase, 3, 2); pw[2] = PK4(p1, 0); PIN(pw[2]); SBAR();
            o[0] = MFMA32(vA[0], PWF(2), o[0]); SBAR(); pw[3] = PK4(p1, 8); PIN(pw[3]); VFRAG(vB[0], vbase, 0, 3); SBAR();
            o[1] = MFMA32(vA[1], PWF(2), o[1]); SBAR(); VFRAG(vB[1], vbase, 1, 3);
#pragma unroll
            for (int r = 0; r < 8; ++r) C0[r] += st;
            PIN(C0); SBAR();
            o[2] = MFMA32(vA[2], PWF(2), o[2]); SBAR(); VFRAG(vB[2], vbase, 2, 3);
#pragma unroll
            for (int r = 8; r < 16; ++r) C0[r] += st;
            PIN(C0); SBAR();
            o[3] = MFMA32(vA[3], PWF(2), o[3]); SBAR(); VFRAG(vB[3], vbase, 3, 3);
#pragma unroll
            for (int r = 0; r < 8; ++r) C1[r] += st;
            PIN(C1); SBAR();
            o[0] = MFMA32(vB[0], PWF(3), o[0]); SBAR();
#pragma unroll
            for (int r = 8; r < 16; ++r) C1[r] += st;
            PIN(C1); SBAR();
            o[1] = MFMA32(vB[1], PWF(3), o[1]);
            o[2] = MFMA32(vB[2], PWF(3), o[2]);
            o[3] = MFMA32(vB[3], PWF(3), o[3]);
            lsum += sacc;
#undef EXPS
#undef PK4
#undef PWF
        } else {
            p0 = MFMA32(kf[0], qr[0], C0); p1 = MFMA32(kf[1], qr[0], C1);
#pragma unroll
            for (int d0 = 1; d0 < 4; ++d0) { p0 = MFMA32(kf[2 * d0], qr[d0], p0); p1 = MFMA32(kf[2 * d0 + 1], qr[d0], p1); }
            softmax_tile<4>(p0, p1, mhat, lsum, o, pw);
            pv_tile<4>(o, vbase, pw);
            const float st = (t + 1 < tdiag) ? 64.f * slope2 : -64.f * slope2; C0 = C0 + st; C1 = C1 + st;
        }
        if ((t + 1 >= tdiag && t + 1 <= tdiag + 2) || ((tau + 1) & 15) == 0) GEN_C(t + 1);
        sl = (sl + 1) & 3;
    }
#undef B_DMA
#undef WAIT_BAR
#undef VFRAG
#undef GEN_C
#undef SBAR
#undef PIN
    attnB_finish(F, a, o, lsum, lam, rowbase, qpos, h, c, qs, r32, hi);
}
__device__ __forceinline__ void attnB_fast(const Frame& F, const Args& a, int b, int h, int qblk, float lam, int t_lo, int t_hi, float kn0, float kn1) {
    const int lane = F_LANE, r32 = lane & 31, hi = lane >> 5, wid = F.wave, c = wid >> 2, qs = wid & 3;
    const bf16_t* QD = (const bf16_t*)(a.ws + WS_PROJ) + 3 * PROJ_STRIDE; const bf16_t* KD = QD + PROJ_STRIDE;
    const size_t rowbase = (size_t)b * SEQ; const int q0 = qblk * 128, qpos = q0 + 32 * qs + r32;
    bf16x8 qr[4];
    { const bf16_t* Qp = QD + (rowbase + qpos) * 512 + h * 128 + c * 64 + 8 * hi;
#pragma unroll
      for (int d0 = 0; d0 < 4; ++d0) qr[d0] = *(const bf16x8*)(Qp + 16 * d0); }
    float ref;
    { float qq = 0.f;
#pragma unroll
        for (int d0 = 0; d0 < 4; ++d0)
#pragma unroll
            for (int j = 0; j < 8; ++j) { const float v = __uint_as_float((unsigned)(unsigned short)qr[d0][j] << 16); qq += v * v; }
        qq = halfsum(qq); asm volatile("" : "+v"(qq));
        ref = sqrtf(qq) * (c ? kn1 : kn0) * 1.01f + 0.01f; }
    const float slope2 = __builtin_amdgcn_exp2f(-2.0f * (float)(h + 1)) * LOG2E;
    const bf16_t* tsrc = KD + (size_t)((b * 4 + h) * 256) * 16384 + wid * 2048 + lane * 8;
    LAS unsigned char* L = F.lds;
    const unsigned dbase = (unsigned)(uintptr_t)L + (unsigned)wid * 4096u;
#define B_DMA(tt, slot) do { const bf16_t* _k = tsrc + (size_t)(tt) * 16384; const unsigned _d = (unsigned)__builtin_amdgcn_readfirstlane((int)(dbase + (unsigned)(slot) * 32768u)); unsigned _keep; \
        asm volatile("s_mov_b32 %0, m0\n\ts_mov_b32 m0, %2\n\ts_nop 0\n\tglobal_load_lds_dwordx4 %1, off\n\tglobal_load_lds_dwordx4 %1, off offset:1024\n\tglobal_load_lds_dwordx4 %1, off offset:2048\n\tglobal_load_lds_dwordx4 %1, off offset:3072\n\ts_mov_b32 m0, %0" \
                     : "=&s"(_keep) : "v"(_k), "s"(_d) : "memory"); } while (0)
#define WAIT_BAR(N) asm volatile("s_waitcnt vmcnt(" #N ") lgkmcnt(0)\n\ts_barrier" : "+v"(p1), "+v"(sacc) :: "memory")
#define VFRAG(dst, base, d0, ks) do { const s16x4 lo_ = vtr((base) + (d0) * 4096 + (ks) * 1024), hi_ = vtr((base) + (d0) * 4096 + (ks) * 1024 + 512); \
        dst = (bf16x8){lo_[0], lo_[1], lo_[2], lo_[3], hi_[0], hi_[1], hi_[2], hi_[3]}; } while (0)
#define MF_ "v_mfma_f32_32x32x16_bf16 "
#define AMF(D, A, B)              asm volatile(MF_ "%0, %1, %2, %0" : "+v"(D) : "v"(A), "v"(B) : "memory")
#define AMF1(D, A, B, X)          asm volatile(MF_ "%0, %2, %3, %0" : "+v"(D), "+v"(X) : "v"(A), "v"(B) : "memory")
#define AMF2(D, A, B, X, Y)       asm volatile(MF_ "%0, %3, %4, %0" : "+v"(D), "+v"(X), "+v"(Y) : "v"(A), "v"(B) : "memory")
#define AMF3(D, A, B, X, Y, Z)    asm volatile(MF_ "%0, %4, %5, %0" : "+v"(D), "+v"(X), "+v"(Y), "+v"(Z) : "v"(A), "v"(B) : "memory")
#define AMF0(D, A, B)             asm volatile(MF_ "%0, %1, %2, 0" : "=&v"(D) : "v"(A), "v"(B) : "memory")
#define PK4(P, B) (u32x4){cvtpk(P[B], P[B + 1]), cvtpk(P[B + 2], P[B + 3]), cvtpk(P[B + 4], P[B + 5]), cvtpk(P[B + 6], P[B + 7])}
#define XE(P, r) { P[r] = __builtin_amdgcn_exp2f(P[r]); sacc += P[r]; }
#define XE2(P, r) do { XE(P, r) XE(P, (r) + 1) } while (0)
#define KLD(bk, i) kf[i] = *(const LAS bf16x8*)((bk) + koff + ((i) >> 1) * 2048 + ((i) & 1) * 512)
#define SET_KA(tn) do { const unsigned w_ = __builtin_amdgcn_perm(0u, __float_as_uint(tf), 0x03020302u); ka0[1] = w_; ka1[1] = w_; tf += tinc; if ((tn) == tdiag + 2) qa = qaR; } while (0)
#define BIAS_HALF(P, KA, e, tn) do { \
        if ((unsigned)((tn) - tdiag) < 2u) { const int kb_ = 2 * (tn) + (e); \
            if (kb_ == qb) { float dq_ = (float)(qpos - (tn) * 64 - 32 * (e) - 4 * hi), ns_ = -slope2, nr_ = -ref; asm volatile("" : "+v"(dq_), "+v"(ns_), "+v"(nr_)); \
                             _Pragma("unroll") for (int r = 0; r < 16; ++r) { const float kk_ = (float)((r & 3) + 8 * (r >> 2)); P[r] = __builtin_fmaf(ns_, __builtin_fabsf(dq_ - kk_), nr_); } \
                             asm volatile("s_nop 4" : "+v"(P) :: "memory"); } \
            else if (kb_ < qb) { AMF0(P, KA, qaL); } else { AMF0(P, KA, qaR); } } \
        else { AMF0(P, KA, qa); } } while (0)
    const int tdiag = q0 >> 6, qb = 4 * qblk + qs;
    const unsigned msk = hi ? 0u : 0xFFFFFFFFu;
    bf16x8 qaL, qaR, qa; u32x4 ka0, ka1;
    { const float S64 = 64.f * slope2;
        const unsigned sh = bfb(slope2), slo = bfb(slope2 - bff(sh)), Sh = bfb(S64), Slo = bfb(S64 - bff(Sh));
        unsigned ch, cm, cl, dh, dm, dl;
        bf_split3(slope2 * (float)(qpos - 64 * tdiag) - ref, ch, cm, cl);
        bf_split3(-slope2 * (float)(qpos - 64 * tdiag) - ref, dh, dm, dl);
        const u32x4 r_ = (u32x4){(((slo ^ 0x8000u) << 16) | (sh ^ 0x8000u)) & msk, (((Slo ^ 0x8000u) << 16) | (Sh ^ 0x8000u)) & msk, ((cm << 16) | ch) & msk, cl & msk};
        const u32x4 l_ = (u32x4){((slo << 16) | sh) & msk, ((Slo << 16) | Sh) & msk, ((dm << 16) | dh) & msk, dl & msk};
        qaR = __builtin_bit_cast(bf16x8, r_); qaL = __builtin_bit_cast(bf16x8, l_); qa = (t_lo < tdiag + 2) ? qaL : qaR;
        const unsigned j0 = bfb((float)r32), j1 = bfb((float)(32 + r32));
        ka0 = (u32x4){((j0 << 16) | j0) & msk, 0u, 0x3F803F80u & msk, 0x00003F80u & msk}; ka1 = ka0; ka1[0] = ((j1 << 16) | j1) & msk; }
    float tf = hi ? 0.f : (float)(t_lo - tdiag); const float tinc = hi ? 0.f : 1.f;
    f32x16 o[4], p0, p1; u32x4 pw[4]; bf16x8 kf[8], vA[4], vB[4]; float sacc = 0.f;
#pragma unroll
    for (int d = 0; d < 4; ++d) o[d] = (f32x16){};
    p1 = (f32x16){};
    const int koff = (c * 8 + hi) * 1024 + r32 * 16;
    const int voff = 16384 + ((lane >> 4) & 1) * 32 + (lane & 3) * 8 + (4 * hi + ((lane & 15) >> 2)) * 64;
    const int NT = t_hi - t_lo + 1;
    B_DMA(t_lo, 0); if (NT > 1) B_DMA(t_lo + 1, 1); if (NT > 2) B_DMA(t_lo + 2, 2);
    if (NT > 2) WAIT_BAR(8); else if (NT > 1) WAIT_BAR(4); else WAIT_BAR(0);
    {
        const LAS unsigned char* bk = L;
#pragma unroll
        for (int i = 0; i < 8; ++i) KLD(bk, i);
        SET_KA(t_lo);
        asm volatile("s_nop 1" : "+v"(ka0), "+v"(ka1), "+v"(qa) :: "memory");
        BIAS_HALF(p0, ka0, 0, t_lo);
        AMF(p0, kf[0], qr[0]); AMF(p0, kf[2], qr[1]); AMF(p0, kf[4], qr[2]); AMF(p0, kf[6], qr[3]);
        BIAS_HALF(p1, ka1, 1, t_lo);
        AMF(p1, kf[1], qr[0]); AMF(p1, kf[3], qr[1]); AMF(p1, kf[5], qr[2]); AMF(p1, kf[7], qr[3]);
        const lds_cptr vb0 = (lds_cptr)(bk + voff);
        VFRAG(vA[0], vb0, 0, 0); VFRAG(vA[1], vb0, 1, 0); VFRAG(vA[2], vb0, 2, 0); VFRAG(vA[3], vb0, 3, 0);
        asm volatile("s_nop 15\n\ts_nop 15" : "+v"(p0), "+v"(p1) :: "memory");
#pragma unroll
        for (int r = 0; r < 16; r += 2) XE2(p0, r);
#pragma unroll
        for (int r = 0; r < 16; r += 2) XE2(p1, r);
        pw[0] = PK4(p0, 0); pw[1] = PK4(p0, 8); pw[2] = PK4(p1, 0);
    }
    int sl = 0;
    for (int tau = 0; tau + 1 < NT; ++tau) {
        if (tau + 2 < NT) WAIT_BAR(4); else WAIT_BAR(0);
        if (tau + 3 < NT) B_DMA(t_lo + tau + 3, (sl + 3) & 3);
        const LAS unsigned char* buf = L + sl * 32768; const LAS unsigned char* bufn = L + ((sl + 1) & 3) * 32768;
        const lds_cptr vb = (lds_cptr)(buf + voff), vbn = (lds_cptr)(bufn + voff);
        const int tn = t_lo + tau + 1;
        SET_KA(tn);
        AMF(o[0], vA[0], pw[0]);            KLD(bufn, 0); KLD(bufn, 2);
        AMF1(o[1], vA[1], pw[0], p1);       KLD(bufn, 4); KLD(bufn, 6); pw[3] = PK4(p1, 8);
        AMF1(o[2], vA[2], pw[0], pw[3]);    KLD(bufn, 1); KLD(bufn, 3);
        AMF(o[3], vA[3], pw[0]);            KLD(bufn, 5); KLD(bufn, 7);
        BIAS_HALF(p0, ka0, 0, tn);          VFRAG(vB[0], vb, 0, 1);
        AMF(p0, kf[0], qr[0]);              VFRAG(vB[1], vb, 1, 1);
        AMF(p0, kf[2], qr[1]);              VFRAG(vB[2], vb, 2, 1);
        AMF(p0, kf[4], qr[2]);              VFRAG(vB[3], vb, 3, 1);
        AMF(p0, kf[6], qr[3]);
        BIAS_HALF(p1, ka1, 1, tn);
        AMF1(p1, kf[1], qr[0], p0);         XE2(p0, 0);
        AMF2(p1, kf[3], qr[1], p0, sacc);   XE2(p0, 2);
        AMF2(p1, kf[5], qr[2], p0, sacc);   XE2(p0, 4);
        AMF2(p1, kf[7], qr[3], p0, sacc);   XE2(p0, 6);
        AMF2(o[0], vB[0], pw[1], p0, sacc); XE2(p0, 8);  VFRAG(vA[0], vb, 0, 2);
        AMF2(o[1], vB[1], pw[1], p0, sacc); XE2(p0, 10); VFRAG(vA[1], vb, 1, 2);
        AMF2(o[2], vB[2], pw[1], p0, sacc); XE2(p0, 12); VFRAG(vA[2], vb, 2, 2);
        AMF2(o[3], vB[3], pw[1], p0, sacc); XE2(p0, 14); VFRAG(vA[3], vb, 3, 2);
        AMF3(o[0], vA[0], pw[2], p0, sacc, p1);     pw[0] = PK4(p0, 0); XE2(p1, 0); VFRAG(vB[0], vb, 0, 3);
        AMF3(o[1], vA[1], pw[2], p1, sacc, pw[0]);  XE2(p1, 2); VFRAG(vB[1], vb, 1, 3);
        AMF3(o[2], vA[2], pw[2], p1, sacc, p0);     pw[1] = PK4(p0, 8); XE2(p1, 4); VFRAG(vB[2], vb, 2, 3);
        AMF3(o[3], vA[3], pw[2], p1, sacc, pw[1]);  XE2(p1, 6); VFRAG(vB[3], vb, 3, 3);
        AMF2(o[0], vB[0], pw[3], p1, sacc); XE2(p1, 8);  VFRAG(vA[0], vbn, 0, 0);
        AMF2(o[1], vB[1], pw[3], p1, sacc); XE2(p1, 10); VFRAG(vA[1], vbn, 1, 0);
        AMF2(o[2], vB[2], pw[3], p1, sacc); pw[2] = PK4(p1, 0); XE2(p1, 12); VFRAG(vA[2], vbn, 2, 0);
        AMF3(o[3], vB[3], pw[3], p1, sacc, pw[2]);  XE2(p1, 14); VFRAG(vA[3], vbn, 3, 0);
        sl = (sl + 1) & 3;
    }
    {
        const lds_cptr vb = (lds_cptr)(L + sl * 32768 + voff);
        pw[3] = PK4(p1, 8);
        AMF3(o[0], vA[0], pw[0], p1, sacc, pw[3]); VFRAG(vB[0], vb, 0, 1);
        AMF(o[1], vA[1], pw[0]); VFRAG(vB[1], vb, 1, 1);
        AMF(o[2], vA[2], pw[0]); VFRAG(vB[2], vb, 2, 1);
        AMF(o[3], vA[3], pw[0]); VFRAG(vB[3], vb, 3, 1);
        AMF(o[0], vB[0], pw[1]); VFRAG(vA[0], vb, 0, 2);
        AMF(o[1], vB[1], pw[1]); VFRAG(vA[1], vb, 1, 2);
        AMF(o[2], vB[2], pw[1]); VFRAG(vA[2], vb, 2, 2);
        AMF(o[3], vB[3], pw[1]); VFRAG(vA[3], vb, 3, 2);
        AMF(o[0], vA[0], pw[2]); VFRAG(vB[0], vb, 0, 3);
        AMF(o[1], vA[1], pw[2]); VFRAG(vB[1], vb, 1, 3);
        AMF(o[2], vA[2], pw[2]); VFRAG(vB[2], vb, 2, 3);
        AMF(o[3], vA[3], pw[2]); VFRAG(vB[3], vb, 3, 3);
        AMF(o[0], vB[0], pw[3]); AMF(o[1], vB[1], pw[3]); AMF(o[2], vB[2], pw[3]); AMF(o[3], vB[3], pw[3]);
        asm volatile("s_nop 15\n\ts_nop 15" : "+v"(o[0]), "+v"(o[1]), "+v"(o[2]), "+v"(o[3]) :: "memory");
    }
#undef B_DMA
#undef WAIT_BAR
#undef VFRAG
#undef MF_
#undef AMF
#undef AMF1
#undef AMF2
#undef AMF3
#undef AMF0
#undef PK4
#undef XE
#undef XE2
#undef KLD
#undef SET_KA
#undef BIAS_HALF
    attnB_finish(F, a, o, sacc, lam, rowbase, qpos, h, c, qs, r32, hi);
}
__device__ __forceinline__ void attnB_item(const Frame& F, const Args& a, int h, int b, int qblk, float lam) {
    const int q0 = qblk * 128;
    const unsigned* ctl = (const unsigned*)(a.ws + WS_CTL); const int sl = (b * 4 + h) * 4;
    const float qn0 = sqrtf(__uint_as_float(ctl[CW_QMAX + sl]) + __uint_as_float(ctl[CW_QMAX + sl + 1])), qn1 = sqrtf(__uint_as_float(ctl[CW_QMAX + sl + 2]) + __uint_as_float(ctl[CW_QMAX + sl + 3]));
    const float kn0 = sqrtf(__uint_as_float(ctl[CW_KMAX + sl]) + __uint_as_float(ctl[CW_KMAX + sl + 1])), kn1 = sqrtf(__uint_as_float(ctl[CW_KMAX + sl + 2]) + __uint_as_float(ctl[CW_KMAX + sl + 3]));
    const float U = fmaxf(qn0 * kn0, qn1 * kn1) * 1.01f + 0.01f;
    const float slope2 = __builtin_amdgcn_exp2f(-2.0f * (float)(h + 1)) * LOG2E;
    const float Df = (2.0f * U + 72.0f) / slope2;
    const int Dd = Df < 40000.f ? (int)Df + 2 : 40000;
    int t_lo = (q0 - Dd) >> 6; if (q0 - Dd < 0) t_lo = 0;
    int t_hi = (q0 + 127 + Dd) >> 6; if (t_hi > SEQ / 64 - 1) t_hi = SEQ / 64 - 1;
    if (U <= 40.f) attnB_fast(F, a, b, h, qblk, lam, t_lo, t_hi, kn0, kn1);
    else attnB_unit<false>(F, a, b, h, qblk, lam, t_lo, t_hi, kn0, kn1);
}

__device__ __forceinline__ int a_kbase(int n0, int it) { return n0 - 64 + 64 * ((it == 0) ? 1 : (it == 1 ? 0 : 2)); }
__device__ __forceinline__ void a_load_k(const bf16_t* KA, size_t rowbase, int head, int d, int r, int L, int kbase, int r32, int hi, bf16x8 (&kf)[8]) {
#pragma unroll
    for (int kh = 0; kh < 2; ++kh) { int kn = kbase + 32 * kh + r32; kn = kn < 0 ? 0 : (kn >= L ? L - 1 : kn);
        const bf16_t* Kp = KA + (rowbase + (size_t)(d * kn + r)) * 512 + head * 64 + 8 * hi;
#pragma unroll
        for (int d0 = 0; d0 < 4; ++d0) kf[2 * d0 + kh] = *(const bf16x8*)(Kp + 16 * d0); }
}
__device__ __forceinline__ void attnA_task(const Frame& F, const Args& a, int b, int head, int d, int r, int n0, int L, LAS unsigned char* vw, f32x16 (&o)[2], float& mhat, float& ltot) {
    const int lane = F_LANE, r32 = lane & 31, hi = lane >> 5;
    const bf16_t* QA = (const bf16_t*)(a.ws + WS_PROJ); const bf16_t* KA = QA + PROJ_STRIDE; const bf16_t* VA = KA + PROJ_STRIDE;
    const size_t rowbase = (size_t)b * SEQ; const int qn = n0 + r32;
    bf16x8 qr[4], kf[8], kfn[8];
    { const bf16_t* Qp = QA + (rowbase + (size_t)(d * qn + r)) * 512 + head * 64 + 8 * hi;
#pragma unroll
      for (int d0 = 0; d0 < 4; ++d0) qr[d0] = *(const bf16x8*)(Qp + 16 * d0); }
    a_load_k(KA, rowbase, head, d, r, L, a_kbase(n0, 0), r32, hi, kf);
    const float sl = __builtin_amdgcn_exp2f(-(float)(head + 1)) * LOG2E * (float)d;
    mhat = NEG_BIG; float lsum = 0.f; o[0] = (f32x16){}; o[1] = (f32x16){};
    const int voff = ((lane >> 4) & 1) * 32 + (lane & 3) * 8 + (4 * hi + ((lane & 15) >> 2)) * 64;
#pragma unroll
    for (int it = 0; it < 3; ++it) {
        const int kbase = a_kbase(n0, it);
        u32x4 vv[8];
#pragma unroll
        for (int ks = 0; ks < 4; ++ks) { int kn = kbase + 16 * ks + (lane >> 2); kn = kn < 0 ? 0 : (kn >= L ? L - 1 : kn);
            const bf16_t* Vp = VA + (rowbase + (size_t)(d * kn + r)) * 512 + head * 64 + 8 * (lane & 3);
            vv[ks] = *(const u32x4*)Vp; vv[4 + ks] = *(const u32x4*)(Vp + 32); }
        if (it < 2) a_load_k(KA, rowbase, head, d, r, L, a_kbase(n0, it + 1), r32, hi, kfn);
        __builtin_amdgcn_sched_barrier(0);
        f32x16 p0, p1;
#pragma unroll
        for (int rr = 0; rr < 16; ++rr) { const int k0 = kbase + crow(rr, hi), k1 = k0 + 32; const int d0_ = k0 - qn, d1_ = k1 - qn;
            const bool v0 = (k0 >= 0) && (k0 < L) && (d0_ <= 64) && (d0_ >= -64), v1 = (k1 >= 0) && (k1 < L) && (d1_ <= 64) && (d1_ >= -64);
            p0[rr] = v0 ? -sl * __builtin_fabsf((float)d0_) : NEG_BIG; p1[rr] = v1 ? -sl * __builtin_fabsf((float)d1_) : NEG_BIG; }
#pragma unroll
        for (int d0 = 0; d0 < 4; ++d0) { p0 = MFMA32(kf[2 * d0], qr[d0], p0); p1 = MFMA32(kf[2 * d0 + 1], qr[d0], p1); }
        u32x4 pw[4];
        softmax_tile<2>(p0, p1, mhat, lsum, o, pw);
        __builtin_amdgcn_sched_barrier(0);
#pragma unroll
        for (int i = 0; i < 8; ++i) *(LAS u32x4*)(vw + i * 1024 + lane * 16) = vv[i];
        asm volatile("s_waitcnt lgkmcnt(0)" ::: "memory");
        pv_tile<2>(o, (lds_cptr)(vw + voff), pw);
        asm volatile("s_waitcnt lgkmcnt(0)" ::: "memory");
        if (it < 2) {
#pragma unroll
            for (int j = 0; j < 8; ++j) kf[j] = kfn[j];
        }
    }
    ltot = halfsum(lsum);
}
__device__ __forceinline__ void attnA_unit(const Frame& F, const Args& a, int unit) {
    const int lane = F_LANE, r32 = lane & 31, hi = lane >> 5, wid = F.wave;
    const int b = unit >> 7, head = (unit >> 4) & 7, tb = unit & 15, T0 = tb * 1024;
    float* part = (float*)(a.ws + WS_APART + (size_t)unit * APART_UNIT); float* ml = part + 2 * 1024 * 64;
    LAS unsigned char* vw = F.lds + wid * 8192;
    for (int task = wid; task < 64; task += 8) {
        int pat, d, r, n0, L;
        if (task < 32) { pat = 0; d = 16; r = task >> 1; n0 = T0 / 16 + 32 * (task & 1); L = SEQ / 16; }
        else { const int tt = task - 32; pat = 1; d = 4; r = tt >> 3; n0 = T0 / 4 + 32 * (tt & 7); L = SEQ / 4; }
        f32x16 o[2]; float mhat, ltot;
        attnA_task(F, a, b, head, d, r, n0, L, vw, o, mhat, ltot);
        const int tl = d * (n0 + r32) + r - T0;
        float* pp = part + ((size_t)pat * 1024 + tl) * 64 + 4 * hi;
#pragma unroll
        for (int d0 = 0; d0 < 2; ++d0)
#pragma unroll
            for (int g = 0; g < 4; ++g) *(f32x4*)(pp + 32 * d0 + 8 * g) = (f32x4){o[d0][4 * g], o[d0][4 * g + 1], o[d0][4 * g + 2], o[d0][4 * g + 3]};
        if (hi == 0) *(f32x2*)(ml + ((size_t)pat * 1024 + tl) * 2) = (f32x2){mhat, ltot};
    }
    asm volatile("s_waitcnt vmcnt(0)" ::: "memory");
    __syncthreads();
    __builtin_amdgcn_fence(__ATOMIC_ACQUIRE, "agent");
    for (int task = wid; task < 32; task += 8) {
        const int n0 = T0 + 32 * task;
        f32x16 o[2]; float m0, l0;
        attnA_task(F, a, b, head, 1, 0, n0, SEQ, vw, o, m0, l0);
        const int tl = 32 * task + r32;
        const f32x2 ml1 = *(const f32x2*)(ml + ((size_t)0 * 1024 + tl) * 2), ml2 = *(const f32x2*)(ml + ((size_t)1 * 1024 + tl) * 2);
        const float M = MX3(m0, ml1[0], ml2[0]);
        const float w0 = __builtin_amdgcn_exp2f(m0 - M), w1 = __builtin_amdgcn_exp2f(ml1[0] - M), w2 = __builtin_amdgcn_exp2f(ml2[0] - M);
        const float rden = 1.0f / (w0 * l0 + w1 * ml1[1] + w2 * ml2[1]);
        const float* p1 = part + ((size_t)0 * 1024 + tl) * 64 + 4 * hi; const float* p2 = part + ((size_t)1 * 1024 + tl) * 64 + 4 * hi;
        bf16_t* op = (bf16_t*)(a.ws + WS_MIXED) + ((size_t)b * SEQ + T0 + tl) * DM + head * 64 + 4 * hi;
#pragma unroll
        for (int d0 = 0; d0 < 2; ++d0)
#pragma unroll
            for (int g = 0; g < 4; ++g) { const f32x4 a1 = *(const f32x4*)(p1 + 32 * d0 + 8 * g), a2 = *(const f32x4*)(p2 + 32 * d0 + 8 * g); float v[4];
#pragma unroll
                for (int j = 0; j < 4; ++j) v[j] = (w0 * o[d0][4 * g + j] + w1 * a1[j] + w2 * a2[j]) * rden;
                u32x2 w; w.x = cvtpk(v[0], v[1]); w.y = cvtpk(v[2], v[3]); *(u32x2*)(op + 32 * d0 + 8 * g) = w; }
    }
    __syncthreads();
}

__device__ __forceinline__ unsigned ordkey(float v) { const unsigned u = __float_as_uint(v); return u ^ ((u >> 31) ? 0xFFFFFFFFu : 0x80000000u); }
__device__ __forceinline__ float unordkey(unsigned k) { const unsigned u = (k & 0x80000000u) ? (k ^ 0x80000000u) : ~k; return __uint_as_float(u); }
__device__ __forceinline__ void p4_ln_router(const Frame& F, const Args& a) {
    const int lane = F_LANE, wid = F.wave, tid = F_TID;
    LAS float* Wr = (LAS float*)F.lds;
    LAS unsigned* misc = (LAS unsigned*)(F.lds + LX_MISC);
    LAS float* pc = (LAS float*)(F.lds + LX_TOK);
    for (int i = tid; i < DM * NE / 4; i += 512) ((LAS f32x4*)Wr)[i] = ((const f32x4*)a.w_router)[i] * a.ln1_g[i >> 3];
    if (tid < 64) misc[tid] = 0u;
    float* Z = (float*)(a.ws + WS_Z); bf16_t* X1B = (bf16_t*)(a.ws + WS_XB);
    const int r0 = (F.vcu * 8 + wid) * 16;
    const int rl = lane & 15, q = lane >> 4;
    float mym[4] = {0.f, 0.f, 0.f, 0.f}, myr[4] = {0.f, 0.f, 0.f, 0.f};
    {
        f32x4 gv[4], bv[4];
#pragma unroll
        for (int j = 0; j < 4; ++j) { gv[j] = ((const f32x4*)a.ln1_g)[lane + 64 * j]; bv[j] = ((const f32x4*)a.ln1_b)[lane + 64 * j]; }
        float* stats = (float*)(a.ws + WS_ROUTE + 4 * MiB);
#pragma unroll 4
        for (int rr = 0; rr < 16; ++rr) {
            const f32x4* zr = (const f32x4*)(Z + (size_t)(r0 + rr) * DM) + lane; f32x4 v[4]; float s = 0.f;
#pragma unroll
            for (int j = 0; j < 4; ++j) { v[j] = zr[64 * j]; s += (v[j][0] + v[j][1]) + (v[j][2] + v[j][3]); }
            const float mean = wave_sum(s) * (1.f / DM); float s2 = 0.f;
#pragma unroll
            for (int j = 0; j < 4; ++j) { v[j] = v[j] - mean; s2 += (v[j][0] * v[j][0] + v[j][1] * v[j][1]) + (v[j][2] * v[j][2] + v[j][3] * v[j][3]); }
            const float rstd = 1.f / sqrtf(wave_sum(s2) * (1.f / DM) + LN_EPS);
            unsigned* o8 = (unsigned*)((unsigned char*)X1B + (size_t)(r0 + rr) * DM) + lane;
#pragma unroll
            for (int j = 0; j < 4; ++j) { const f32x4 y = (v[j] * rstd * gv[j] + bv[j]) * 8.f; o8[64 * j] = cvt4_fp8(y[0], y[1], y[2], y[3]); }
            if (lane == 0) *(f32x2*)(stats + 2 * (r0 + rr)) = (f32x2){mean, rstd};
            if ((rr >> 2) == q) {
#pragma unroll
                for (int i = 0; i < 4; ++i) if ((rr & 3) == i) { mym[i] = mean; myr[i] = rstd; } }
        }
    }
    __syncthreads();
    {
        const int e = tid & 31, part = tid >> 5; float s0 = 0.f, s1 = 0.f;
        for (int k = part * 64; k < part * 64 + 64; ++k) { s0 += Wr[k * 32 + e]; s1 += a.ln1_b[k] * a.w_router[k * 32 + e]; }
        pc[part * 32 + e] = s0; pc[512 + part * 32 + e] = s1;
    }
    __syncthreads();
    if (tid < 64) { const int e = tid & 31, w = tid >> 5; float t = 0.f; for (int p = 0; p < 16; ++p) t += pc[w * 512 + p * 32 + e]; pc[1024 + tid] = t + (w ? a.b_router[e] : 0.f); }
    __syncthreads();
    f32x4 acc0 = (f32x4){0.f, 0.f, 0.f, 0.f}, acc1 = acc0;
    const float* xr = Z + (size_t)(r0 + rl) * DM + 4 * q;
#pragma unroll 4
    for (int cidx = 0; cidx < 64; ++cidx) {
        const f32x4 xv = *(const f32x4*)(xr + 16 * cidx);
#pragma unroll
        for (int j = 0; j < 4; ++j) { const int k = 16 * cidx + 4 * q + j;
            acc0 = __builtin_amdgcn_mfma_f32_16x16x4f32(xv[j], Wr[k * 32 + rl], acc0, 0, 0, 0);
            acc1 = __builtin_amdgcn_mfma_f32_16x16x4f32(xv[j], Wr[k * 32 + 16 + rl], acc1, 0, 0, 0); }
    }
    {   const float cs0 = pc[1024 + rl], cs1 = pc[1024 + 16 + rl], cb0 = pc[1024 + 32 + rl], cb1 = pc[1024 + 48 + rl];
#pragma unroll
        for (int i = 0; i < 4; ++i) { acc0[i] = myr[i] * (acc0[i] - mym[i] * cs0) + cb0; acc1[i] = myr[i] * (acc1[i] - mym[i] * cs1) + cb1; } }
    const float br0 = 0.f, br1 = 0.f;
    int* sel_e = (int*)(a.ws + WS_ROUTE); int* sel_pos = sel_e + NTOK * TOPK; float* sel_gate = (float*)(sel_pos + NTOK * TOPK);
    int my_e[4] = {0, 0, 0, 0}, my_lp[4] = {0, 0, 0, 0}; float my_g[4] = {0.f, 0.f, 0.f, 0.f};
#pragma unroll
    for (int i = 0; i < 4; ++i) {
        unsigned k0 = (ordkey(acc0[i] + br0) & ~31u) | (unsigned)(31 - rl), k1 = (ordkey(acc1[i] + br1) & ~31u) | (unsigned)(15 - rl);
        unsigned selk[4];
#pragma unroll
        for (int t = 0; t < 4; ++t) {
            unsigned m = k0 > k1 ? k0 : k1;
#pragma unroll
            for (int ofs = 1; ofs < 16; ofs <<= 1) { const unsigned other = (unsigned)__shfl_xor((int)m, ofs); m = other > m ? other : m; }
            selk[t] = m; if (k0 == m) k0 = 0u; if (k1 == m) k1 = 0u;
        }
        const float v0 = unordkey(selk[0] & ~31u), v1 = unordkey(selk[1] & ~31u), v2 = unordkey(selk[2] & ~31u), v3 = unordkey(selk[3] & ~31u);
        const float e1 = __expf(v1 - v0), e2 = __expf(v2 - v0), e3 = __expf(v3 - v0); const float rs = 1.0f / (1.0f + e1 + e2 + e3);
        if (rl < 4) { const unsigned sk = rl == 0 ? selk[0] : (rl == 1 ? selk[1] : (rl == 2 ? selk[2] : selk[3]));
            const float ge = rl == 0 ? 1.0f : (rl == 1 ? e1 : (rl == 2 ? e2 : e3));
            my_e[i] = 31 - (int)(sk & 31u); my_g[i] = ge * rs; my_lp[i] = (int)atomicAdd((unsigned*)&misc[my_e[i]], 1u); }
    }
    __syncthreads();
    unsigned* gcnt = (unsigned*)(a.ws + WS_CTL);
    if (F_TID < 32) misc[32 + F_TID] = atomicAdd(&gcnt[F_TID], misc[F_TID]);
    __syncthreads();
    if (rl < 4) {
#pragma unroll
        for (int i = 0; i < 4; ++i) { const int tok = r0 + 4 * q + i, idx = tok * 4 + rl; sel_e[idx] = my_e[i]; sel_pos[idx] = (int)misc[32 + my_e[i]] + my_lp[i]; sel_gate[idx] = my_g[i]; }
    }
}

__device__ __forceinline__ int build_tiles(const Frame& F, const Args& a) {
    LAS unsigned* misc = (LAS unsigned*)(F.lds + LX_MISC); LAS unsigned char* tile_e = F.lds + LX_TILE;
    const unsigned* gcnt = (const unsigned*)(a.ws + WS_CTL);
    if (F_TID < NE) misc[128 + F_TID] = (__hip_atomic_load(&gcnt[F_TID], __ATOMIC_RELAXED, __HIP_MEMORY_SCOPE_AGENT) + 255u) >> 8;
    __syncthreads();
    if (F_TID == 0) { unsigned acc = 0; for (int e = 0; e < NE; ++e) { misc[64 + e] = acc; acc += misc[128 + e]; } misc[64 + NE] = acc; }
    __syncthreads();
    const int nt = (int)misc[64 + NE];
    for (int e = 0; e < NE; ++e) { const int t0 = (int)misc[64 + e], t1 = (int)misc[65 + e]; for (int t = t0 + F_TID; t < t1; t += 512) tile_e[t] = (unsigned char)e; }
    __syncthreads();
    return nt;
}

#define XLAS __attribute__((address_space(3)))
#define XB_TMO      128
#define XB_XCNT(j)  (256  + 64 * (j))
#define XB_XSUB(j)  (1280 + 64 * (j))
#define XB_XGEN(j)  (2304 + 64 * (j))
#define XB_TOP      3328
#define XB_TOPGEN   3392
#define XCD_BAR_WORDS 3456
#define XB_SPIN_CAP (1u << 22)

__device__ __forceinline__ unsigned xb_ld(unsigned* p)              { return __hip_atomic_load(p, __ATOMIC_RELAXED, __HIP_MEMORY_SCOPE_AGENT); }
__device__ __forceinline__ unsigned xb_add(unsigned* p, unsigned v) { return __hip_atomic_fetch_add(p, v, __ATOMIC_RELAXED, __HIP_MEMORY_SCOPE_AGENT); }
__device__ __forceinline__ unsigned xb_xcc_id() { return (unsigned)__builtin_amdgcn_s_getreg((3 << 11) | 20) & 0xFu; }
#define XB_SPIN(cond, bar) do { unsigned _sp = 0; while (cond) { __builtin_amdgcn_s_sleep(1); \
    if ((++_sp & 255u) == 0u) { if (xb_ld(&(bar)[XB_TMO])) break; if (_sp > XB_SPIN_CAP) { atomicAdd(&(bar)[XB_TMO], 1u); break; } } } } while (0)

struct XcdBarrier {
    unsigned* bar; unsigned x;
    volatile XLAS unsigned* st;
};

__device__ __forceinline__ XcdBarrier xcd_barrier_post(unsigned* bar, volatile XLAS unsigned* st) {
    XcdBarrier b; b.bar = bar; b.x = xb_xcc_id(); b.st = st;
    if (threadIdx.x == 0) (void)xb_add(&bar[XB_XCNT(b.x)], 1u);
    return b;
}
__device__ __forceinline__ void xcd_barrier_complete(unsigned* bar, unsigned x, unsigned& nloc, unsigned& nx) {
    const unsigned G = gridDim.x * gridDim.y * gridDim.z;
    unsigned sum, cnt, mine, sp = 0u;
    for (;;) {
        sum = 0u; cnt = 0u; mine = 0u;
#pragma unroll
        for (unsigned j = 0; j < 16; ++j) { const unsigned c = xb_ld(&bar[XB_XCNT(j)]); sum += c; cnt += (c > 0u) ? 1u : 0u; mine = (j == x) ? c : mine; }
        if (sum == G) break;
        __builtin_amdgcn_s_sleep(1);
        if ((++sp & 255u) == 0u) { if (xb_ld(&bar[XB_TMO])) break; if (sp > XB_SPIN_CAP) { atomicAdd(&bar[XB_TMO], 1u); break; } }
    }
    nloc = mine > 0u ? mine : 1u; nx = cnt > 0u ? cnt : 1u;
}

__device__ __forceinline__ void xcd_barrier(const XcdBarrier& b, const int tid0) {
    asm volatile("s_waitcnt vmcnt(0)" ::: "memory");
    __syncthreads();
    if (tid0 == 0) {
        unsigned* bar = b.bar;
        __builtin_amdgcn_s_waitcnt(0);
        unsigned nloc = b.st[0], nx = b.st[1];
        if (nloc == 0u) { xcd_barrier_complete(bar, b.x, nloc, nx); b.st[0] = nloc; b.st[1] = nx; }
        const unsigned old = xb_add(&bar[XB_XSUB(b.x)], 1u);
        const unsigned gen = old / nloc;
        if (old + 1u == (gen + 1u) * nloc) {
            __builtin_amdgcn_fence(__ATOMIC_RELEASE, "agent");
            asm volatile("s_waitcnt vmcnt(0)" ::: "memory");
            const unsigned og = xb_add(&bar[XB_TOP], 1u);
            const unsigned tg = og / nx;
            if (og + 1u == (tg + 1u) * nx) xb_add(&bar[XB_TOPGEN], 1u);
            else XB_SPIN(xb_ld(&bar[XB_TOPGEN]) == tg, bar);
            __builtin_amdgcn_fence(__ATOMIC_ACQUIRE, "agent");
            xb_add(&bar[XB_XGEN(b.x)], 1u);
            asm volatile("s_waitcnt vmcnt(0)" ::: "memory");
        } else {
            XB_SPIN(xb_ld(&bar[XB_XGEN(b.x)]) == gen, bar);
            __builtin_amdgcn_fence(__ATOMIC_ACQUIRE, "agent");
            asm volatile("s_waitcnt vmcnt(0)" ::: "memory");
        }
    }
    __syncthreads();
}

__global__ void __launch_bounds__(512, 2) fwd_megakernel(Args a) {
    extern __shared__ __attribute__((aligned(16))) unsigned char lds_raw[];
    cg::grid_group grid = cg::this_grid();
    Frame F; F.lds = (LAS unsigned char*)lds_raw; F.wave = __builtin_amdgcn_readfirstlane((int)(threadIdx.x >> 6));
    F.G = gridDim.x; { const int bx = blockIdx.x; F.vcu = (F.G % 8 == 0) ? (bx % 8) * (F.G / 8) + bx / 8 : bx; }
    unsigned char* ws = a.ws;
    {   LAS unsigned* m0_ = (LAS unsigned*)(F.lds + LX_MISC); if (F_TID < 128) m0_[F_TID] = 0u; __syncthreads(); }
    XcdBarrier xbar = xcd_barrier_post((unsigned*)(ws + WS_CTL) + CW_BAR, (volatile LAS unsigned*)(F.lds + LX_MISC) + 120);
#define GRID_BAR() xcd_barrier(xbar, F_TID)
#ifdef PROBE_T1
    unsigned long long* stamps = (unsigned long long*)(ws + WS_CTL + 2048);
#define STAMP(k) do { if (blockIdx.x == 0 && F_TID == 0) stamps[k] = __builtin_amdgcn_s_memrealtime(); } while (0)
#else
#define STAMP(k) do {} while (0)
#endif
    STAMP(0);

    for (int rep = 0; rep < REP_P0; ++rep) p0_prologue(F, a);
    if (a.out == nullptr) grid.sync();
    GRID_BAR();
    STAMP(1);

    for (int rep = 0; rep < REP_P1; ++rep) {
        pg8::Gemm g{(const bf16_t*)(ws + WS_XB), (const bf16_t*)(ws + WS_WIN), NTOK, NPROJ, DM, 0, 0}; pg8::StaticOrder S; S.init(NTOK, NPROJ, F.G, (int)blockIdx.x);
        EpiProj E{(bf16_t*)(ws + WS_PROJ), (unsigned*)(ws + WS_CTL)};
        pg8::gemm_phase<EpiProj, pg8::StaticOrder, true, false, KREP_P1>(F.lds, g, S, E, F_TID);
    }
    GRID_BAR();
    STAMP(2);

    {
        float s1 = 0.f, s2 = 0.f;
        for (int i = 0; i < 64; ++i) { s1 += a.lq1[i] * a.lk1[i]; s2 += a.lq2[i] * a.lk2[i]; }
        const float lam = __expf(s1) - __expf(s2) + LAM_INIT;
        {
            LAS unsigned* misc = (LAS unsigned*)(F.lds + LX_MISC); unsigned* ctl = (unsigned*)(ws + WS_CTL);
            const int myx = (int)(xbar.x & 7u);
            for (;;) {
                __syncthreads();
                if (F_TID == 0) { int got = -1;
                    for (int k = 0; k < 8 && got < 0; ++k) { const int qx = (myx + k) & 7;
                        if (__hip_atomic_load(ctl + CW_QUEUE + qx, __ATOMIC_RELAXED, __HIP_MEMORY_SCOPE_AGENT) < 160u) { const unsigned p = atomicAdd(ctl + CW_QUEUE + qx, 1u); if (p < 160u) got = qx * 256 + (int)p; } }
                    misc[100] = (unsigned)got; }
                __syncthreads();
                const int idx = __builtin_amdgcn_readfirstlane((int)misc[100]);
                if (idx < 0) break;
                const int qx = idx >> 8, p = idx & 255;
                if (p < 64 && (p & 1)) attnA_unit(F, a, qx * 32 + (p >> 1));
                else { const int h = p < 64 ? 3 : 2 - ((p - 64) >> 5), j = p < 64 ? (p >> 1) : (p & 31); attnB_item(F, a, h, qx >> 2, 32 * (qx & 3) + j, lam); }
            }
        }
    }
    GRID_BAR();
    STAMP(3);

    for (int rep = 0; rep < REP_P3; ++rep) {
        pg8::Gemm g{(const bf16_t*)(ws + WS_MIXED), (const bf16_t*)(ws + WS_WOUT), NTOK, DM, DM, 0, 0}; pg8::StaticOrder S; S.init(NTOK, DM, F.G, (int)blockIdx.x);
        EpiZ E{a.x, (float*)(ws + WS_Z)};
        pg8::gemm_phase<EpiZ, pg8::StaticOrder, true, false, KREP_P3>(F.lds, g, S, E, F_TID);
    }
    GRID_BAR();
    STAMP(4);

    if (F.G == 256) p4_ln_router(F, a);
    GRID_BAR();
    STAMP(5);

    int* sel_e = (int*)(ws + WS_ROUTE); int* sel_pos = sel_e + NTOK * TOPK; float* sel_gate = (float*)(sel_pos + NTOK * TOPK);
    int* inv = (int*)(sel_gate + NTOK * TOPK); int* row_tok = inv + NTOK * TOPK; float* row_gate = (float*)(row_tok + 262144);
    {
        const int ntl = build_tiles(F, a); (void)ntl;
        LAS unsigned* misc = (LAS unsigned*)(F.lds + LX_MISC);
        const unsigned* gcnt = (const unsigned*)(ws + WS_CTL);
        for (int idx = F.vcu * 512 + F_TID; idx < NTOK * TOPK; idx += F.G * 512) {
            const int e = sel_e[idx], dest = (int)misc[64 + e] * 256 + sel_pos[idx];
            row_tok[dest] = idx >> 2; row_gate[dest] = sel_gate[idx]; inv[idx] = dest;
        }
        for (int e = F.vcu; e < NE; e += F.G) {
            const int c = (int)__hip_atomic_load(&gcnt[e], __ATOMIC_RELAXED, __HIP_MEMORY_SCOPE_AGENT), base = (int)misc[64 + e] * 256, end = (int)misc[65 + e] * 256;
            for (int r = base + c + F_TID; r < end; r += 512) { row_tok[r] = 0; row_gate[r] = 0.f; }
        }
    }
    GRID_BAR();
    STAMP(6);

    for (int rep = 0; rep < REP_P6; ++rep) {
        const int ntl = build_tiles(F, a);
        MoeOrder S; S.so.init(ntl * 256, 2048, F.G, (int)blockIdx.x); S.tile_e = F.lds + LX_TILE; S.tok = (const LAS unsigned short*)(F.lds + LX_TOK); S.ncolt = 8;
        {
            LAS unsigned short* tk = (LAS unsigned short*)(F.lds + LX_TOK); pg8::Unit u;
            for (int i = F.wave; i < 24 && S.so.next(i, u); i += 8) { const int l_ = F_LANE;
#pragma unroll
                for (int j = 0; j < 4; ++j) tk[i * 256 + l_ + 64 * j] = (unsigned short)row_tok[u.pm * 256 + l_ + 64 * j]; }
            __syncthreads();
        }
        pg8::Gemm g{(const bf16_t*)(ws + WS_XB), (const bf16_t*)(ws + WS_WUP), ntl * 256, 2048, DM, 0x7C7C7C7C, 0x77777777};
        EpiUp E{(bf16_t*)(ws + WS_H), a.b_up};
        pg8::gemm_phase<EpiUp, MoeOrder, true, true, KREP_P6, true>(F.lds, g, S, E, F_TID);
    }
    GRID_BAR();
    STAMP(7);

    for (int rep = 0; rep < REP_P7; ++rep) {
        const int ntl = build_tiles(F, a);
        MoeOrder S; S.so.init(ntl * 256, 1024, F.G, (int)blockIdx.x, ORD_REV7); S.tile_e = F.lds + LX_TILE; S.tok = nullptr; S.ncolt = 4;
        pg8::Gemm g{(const bf16_t*)(ws + WS_H), (const bf16_t*)(ws + WS_WDN), ntl * 256, DM, DFF, 0x7D7D7D7D, 0x77777777};
        EpiDown E{(bf16_t*)(ws + WS_Y), a.b_down, row_gate};
        pg8::gemm_phase<EpiDown, MoeOrder, true, false, KREP_P7, true>(F.lds, g, S, E, F_TID);
    }
    GRID_BAR();
    STAMP(8);

    for (int rep = 0; rep < REP_P8; ++rep) {
        const int lane = F_LANE; const float* X1 = (const float*)(ws + WS_Z); const bf16_t* Y = (const bf16_t*)(ws + WS_Y); const float* stats = (const float*)(ws + WS_ROUTE + 4 * MiB);
        f32x4 gv[4], bv[4], g1[4], b1[4];
#pragma unroll
        for (int j = 0; j < 4; ++j) { gv[j] = ((const f32x4*)a.ln2_g)[lane + 64 * j]; bv[j] = ((const f32x4*)a.ln2_b)[lane + 64 * j]; g1[j] = ((const f32x4*)a.ln1_g)[lane + 64 * j] * ALPHA; b1[j] = ((const f32x4*)a.ln1_b)[lane + 64 * j] * ALPHA; }
        for (int m = F.vcu * 8 + F.wave; m < NTOK; m += F.G * 8) {
            const f32x4* xr = (const f32x4*)(X1 + (size_t)m * DM) + lane; f32x4 v[4]; const f32x2 st = *(const f32x2*)(stats + 2 * m);
#pragma unroll
            for (int j = 0; j < 4; ++j) v[j] = (xr[64 * j] - st[0]) * st[1] * g1[j] + b1[j];
#pragma unroll
            for (int t = 0; t < 4; ++t) { const int dest = inv[m * 4 + t]; const unsigned* yr = (const unsigned*)((const unsigned char*)Y + (size_t)dest * DM) + lane;
#pragma unroll
                for (int j = 0; j < 4; ++j) { const int w = (int)yr[64 * j];
                    v[j][0] += __builtin_amdgcn_cvt_f32_fp8(w, 0) * (1.f / 32.f); v[j][1] += __builtin_amdgcn_cvt_f32_fp8(w, 1) * (1.f / 32.f);
                    v[j][2] += __builtin_amdgcn_cvt_f32_fp8(w, 2) * (1.f / 32.f); v[j][3] += __builtin_amdgcn_cvt_f32_fp8(w, 3) * (1.f / 32.f); } }
            float s = 0.f;
#pragma unroll
            for (int j = 0; j < 4; ++j) s += (v[j][0] + v[j][1]) + (v[j][2] + v[j][3]);
            const float mean = wave_sum(s) * (1.f / DM); float s2 = 0.f;
#pragma unroll
            for (int j = 0; j < 4; ++j) { v[j] = v[j] - mean; s2 += (v[j][0] * v[j][0] + v[j][1] * v[j][1]) + (v[j][2] * v[j][2] + v[j][3] * v[j][3]); }
            const float rstd = 1.f / sqrtf(wave_sum(s2) * (1.f / DM) + LN_EPS);
            f32x4* orow = (f32x4*)(a.out + (size_t)m * DM) + lane;
#pragma unroll
            for (int j = 0; j < 4; ++j) orow[64 * j] = v[j] * rstd * gv[j] + bv[j];
        }
    }
#ifdef PROBE_T1
    STAMP(9);
    if (blockIdx.x == 0) {
        __syncthreads();
        const float t1 = (float)(stamps[PROBE_T1 + 1] - stamps[PROBE_T1]) * 0.01f, t2 = (float)(stamps[PROBE_T2 + 1] - stamps[PROBE_T2]) * 0.01f;
        for (int i = F_TID; i < (1 << 20); i += 512) a.out[1 + i] = t2;
        if (F_TID == 0) a.out[0] = t1 * 10.0f;
    }
#endif
}

extern "C" void kernel_launch(void* const* d_in, const int* in_sizes, int n_in, void* d_out, int out_size, void* d_ws, size_t ws_size, hipStream_t stream) {
    static int grid = 0;
    if (grid == 0) {
        if (n_in != 18 || in_sizes[0] != NTOK * DM || out_size != NTOK * DM || ws_size < WS_END) {
            fprintf(stderr, "kernel_launch: unexpected shapes (n_in %d, in0 %d, out %d, ws %zu need %zu); nothing launched\n", n_in, n_in > 0 ? in_sizes[0] : -1, out_size, ws_size, (size_t)WS_END); grid = -1; return; }
        int dev = 0, cus = 0, per_cu = 0;
        if (hipGetDevice(&dev) != hipSuccess || hipDeviceGetAttribute(&cus, hipDeviceAttributeMultiprocessorCount, dev) != hipSuccess) { grid = -1; return; }
        if (hipFuncSetAttribute((const void*)fwd_megakernel, hipFuncAttributeMaxDynamicSharedMemorySize, LDS_BYTES) != hipSuccess) { fprintf(stderr, "kernel_launch: hipFuncSetAttribute failed\n"); grid = -1; return; }
        if (hipOccupancyMaxActiveBlocksPerMultiprocessor(&per_cu, (const void*)fwd_megakernel, 512, LDS_BYTES) != hipSuccess || per_cu < 1) { fprintf(stderr, "kernel_launch: occupancy query says %d\n", per_cu); per_cu = 1; }
        (void)hipGetLastError();
        grid = cus * (per_cu > 1 ? 1 : per_cu);
        fprintf(stderr, "kernel_launch: grid %d (cus %d, per_cu %d)\n", grid, cus, per_cu);
    }
    if (grid < 0) return;
    if (hipMemsetAsync((char*)d_ws + WS_CTL, 0, CTL_ZERO_BYTES, stream) != hipSuccess) return;
    Args a{};
    const float* const* in = (const float* const*)d_in;
    a.x = in[0]; a.w_in = in[1]; a.w_out = in[2]; a.lq1 = in[3]; a.lk1 = in[4]; a.lq2 = in[5]; a.lk2 = in[6]; a.g_sub = in[7];
    a.ln1_g = in[8]; a.ln1_b = in[9]; a.w_router = in[10]; a.b_router = in[11]; a.w_up = in[12]; a.b_up = in[13]; a.w_down = in[14]; a.b_down = in[15];
    a.ln2_g = in[16]; a.ln2_b = in[17]; a.out = (float*)d_out; a.ws = (unsigned char*)d_ws;
    void* args[] = {&a};
    hipError_t e = hipLaunchCooperativeKernel((void*)fwd_megakernel, dim3(grid), dim3(512), args, LDS_BYTES, stream);
    if (e != hipSuccess) fprintf(stderr, "kernel_launch: cooperative launch failed: %s (grid %d)\n", hipGetErrorString(e), grid);
}
```

```cpp
#include <hip/hip_runtime.h>
#include <hip/hip_cooperative_groups.h>
#include <cstdio>
#include <cstdint>
namespace cg = cooperative_groups;
#ifndef KREP_P1
#define KREP_P1 1
#endif
#ifndef KREP_P3
#define KREP_P3 1
#endif
#ifndef KREP_P6
#define KREP_P6 1
#endif
#ifndef KREP_P7
#define KREP_P7 1
#endif
#ifndef ORD_SWZ
#define ORD_SWZ 0
#endif
#ifndef ORD_REV7
#define ORD_REV7 1
#endif
#ifndef REP_P0
#define REP_P0 1
#endif
#ifndef REP_P1
#define REP_P1 1
#endif
#ifndef REP_A
#define REP_A 1
#endif
#ifndef REP_B
#define REP_B 1
#endif
#ifndef REP_P3
#define REP_P3 1
#endif
#ifndef REP_P6
#define REP_P6 1
#endif
#ifndef REP_P7
#define REP_P7 1
#endif
#ifndef REP_P8
#define REP_P8 1
#endif

#define LAS __attribute__((address_space(3)))
typedef unsigned short bf16_t;
typedef short bf16x8 __attribute__((ext_vector_type(8)));
typedef short s16x4 __attribute__((ext_vector_type(4)));
typedef float f32x4 __attribute__((ext_vector_type(4)));
typedef float f32x2 __attribute__((ext_vector_type(2)));
typedef float f32x16 __attribute__((ext_vector_type(16)));
typedef unsigned u32x4 __attribute__((ext_vector_type(4)));
typedef unsigned u32x2 __attribute__((ext_vector_type(2)));
typedef __bf16 bf16x2_t __attribute__((ext_vector_type(2)));

constexpr int BATCH = 2, SEQ = 16384, DM = 1024, NTOK = BATCH * SEQ;
constexpr int NPROJ = 3072, NE = 32, TOPK = 4, DFF = 1024;
constexpr int NROWS_MAX = NTOK * TOPK + NE * 256;
constexpr float LN_EPS = 1e-5f;
constexpr float ALPHA = 1.189207115002721f;
constexpr float LOG2E = 1.4426950408889634f;
constexpr float C2 = 0.125f * LOG2E;
constexpr float LAM_INIT = 0.2f;
constexpr float NEG_BIG = -1e30f;

constexpr size_t MiB = 1u << 20;
constexpr size_t WS_CTL = 0, CTL_ZERO_BYTES = 65536;
constexpr int CW_QMAX = 64, CW_KMAX = 128, CW_QUEUE = 256, CW_BAR = 4096;
constexpr size_t WS_WIN = 2 * MiB, WS_WOUT = 8 * MiB, WS_WUP = 16 * MiB, WS_WDN = 144 * MiB;
constexpr size_t WS_XB = 208 * MiB;
constexpr size_t WS_PROJ = 272 * MiB;
constexpr size_t PROJ_STRIDE = (size_t)NTOK * 512;
constexpr size_t WS_MIXED = 464 * MiB;
constexpr size_t WS_Z = 272 * MiB;
constexpr size_t WS_H = 400 * MiB;
constexpr size_t WS_Y = 672 * MiB;
constexpr size_t WS_APART = 672 * MiB;
constexpr size_t APART_UNIT = 2 * 1024 * 64 * 4 + 2 * 1024 * 2 * 4;
constexpr size_t WS_ROUTE = 944 * MiB;
constexpr size_t WS_END = 952 * MiB;

constexpr int RING_BYTES = 131072;
constexpr int LX_TILE = 131072;
constexpr int LX_TOK = 132096;
constexpr int LX_MISC = 144384;
constexpr int LDS_BYTES = 147456;

__device__ __forceinline__ unsigned cvtpk(float lo, float hi) { f32x2 v = {lo, hi}; bf16x2_t b = __builtin_convertvector(v, bf16x2_t); return __builtin_bit_cast(unsigned, b); }
__device__ __forceinline__ unsigned cvt4_fp8(float a, float b, float c, float d) { int w = 0; w = __builtin_amdgcn_cvt_pk_fp8_f32(a, b, w, false); w = __builtin_amdgcn_cvt_pk_fp8_f32(c, d, w, true); return (unsigned)w; }
__device__ __forceinline__ float wave_sum(float v) {
#pragma unroll
    for (int o = 1; o < 64; o <<= 1) v += __shfl_xor(v, o);
    return v;
}

namespace pg8 {
constexpr int BM = 256, BK = 64, HALF = 128, HTB = HALF * BK * 2, STAGE_BYTES = 8 * HTB, NXCD = 8, WGM = 8;
__host__ __device__ __forceinline__ int lds_byte(int r, int c) { const int st = (r >> 4) * 2 + (c >> 5), rr = r & 15, cc = c & 31, ob = rr * 64 + cc * 2; return st * 1024 + (ob ^ (((ob >> 9) & 1) << 5)); }
__host__ __device__ __forceinline__ void stage_rc(int b, int& R, int& C) { const int st = b / 1024, sb = b % 1024, swz = sb ^ (((sb >> 9) & 1) << 5); R = (st >> 1) * 16 + swz / 64; C = (st & 1) * 32 + (swz % 64) / 2; }
__host__ __device__ __forceinline__ int perm32(int rho) { const int n = rho >> 4, i = rho & 15; return 8 * (i >> 2) + 4 * n + (i & 3); }

struct Unit { int pm, pn; };
struct Gemm { const bf16_t* A; const bf16_t* Bt; int M, N, K; int scale_a, scale_b; };
typedef int v4i_t __attribute__((ext_vector_type(4))); typedef int v8i_t __attribute__((ext_vector_type(8)));

struct StaticOrder {
    int nM, nN, nwg, G, c, rev, swz;
    __host__ __device__ void init(int M, int N, int G_, int c_, int rev_ = 0, int swz_ = ORD_SWZ) { nM = M / BM; nN = N / BM; nwg = nM * nN; G = G_; c = c_; rev = rev_; swz = swz_; }
    __host__ __device__ bool next(int i, Unit& u) const {
        const long L = (long)i * G + c; if (L >= nwg) return false;
        int wgid = (rev == 1) ? nwg - 1 - (int)L : (int)L;
        if (swz) { const int q = nwg / NXCD, r = nwg % NXCD, xcd = wgid % NXCD; int off = wgid / NXCD; const int len = xcd < r ? q + 1 : q;
            if (rev == 2) off = len - 1 - off;
            wgid = (xcd < r ? xcd * (q + 1) : r * (q + 1) + (xcd - r) * q) + off; }
        const int nig = WGM * nN, gid = wgid / nig, fm = gid * WGM, gsz = (nM - fm) < WGM ? (nM - fm) : WGM;
        u.pm = fm + ((wgid % nig) % gsz); u.pn = (wgid % nig) / gsz; return true;
    }
    __device__ __forceinline__ const LAS unsigned short* tok_table(int) const { return nullptr; }
};

template <class Epi, class Sched, bool ALIGN_EPI, bool GATHER, int KREP = 1, bool F8 = false>
__device__ __forceinline__ void gemm_phase(LAS unsigned char* lds, const Gemm g, const Sched& S, const Epi& E, const int tid) {
    const int wid = __builtin_amdgcn_readfirstlane(tid >> 6), lane = tid & 63, wr = wid >> 2, wc = wid & 3, fr = lane & 15, fq = lane >> 4;
    constexpr int ES = F8 ? 1 : 2;
    const int sclW = g.scale_b, sclX = g.scale_a;
    const int K = g.K, ntr = K * ES / (BK * 2), nt = ntr * KREP;
    unsigned voffA[2], voffB[2]; int rowA[2];
#pragma unroll
    for (int i = 0; i < 2; ++i) { int R, C; stage_rc(tid * 16 + i * 8192, R, C); const int Rb = Epi::PERM ? ((R & ~31) + perm32(R & 31)) : R;
        voffA[i] = GATHER ? (unsigned)(C * 2) : (unsigned)(R * K * ES + C * 2); voffB[i] = (unsigned)(Rb * K * ES + C * 2); rowA[i] = R; }
    const size_t kstep = (size_t)(BK * 2);
    const size_t hstep = (size_t)HALF * K * ES;
    const size_t tstep = 2 * hstep;
    const unsigned ldsw = (unsigned)wid * 1024u;
    const int aoff = lds_byte(wr * 64 + fr, fq * 8), boff = lds_byte(wc * 32 + fr, fq * 8);
    const int aoff8 = lds_byte(wr * 64 + fr, fq * 16), boff8 = lds_byte(wc * 32 + fr, fq * 16);
#define PG8_SA(b, h) (((b) * 2 + (h)) * HTB)
#define PG8_SB(b, h) ((4 + (b) * 2 + (h)) * HTB)
#define PG8_STAGE(bufoff, gbase, voff) do { _Pragma("unroll") for (int _i = 0; _i < 2; ++_i) \
        __builtin_amdgcn_global_load_lds((const unsigned*)((const char*)(gbase) + (voff)[_i]), (LAS unsigned*)(lds + (bufoff) + ldsw + _i * 8192), 16, 0, 0); } while (0)
#define PG8_STAGE_A(bufoff, NX, h, kb) do { if constexpr (GATHER) { const unsigned* _o = (NX) ? gN[h] : gC[h]; PG8_STAGE(bufoff, (const char*)g.A + (kb), _o); } \
        else { PG8_STAGE(bufoff, ((NX) ? nA : cA) + (h) * hstep + (kb), voffA); } } while (0)
#define PG8_LDA(dst, b, h) do { _Pragma("unroll") for (int m = 0; m < 4; ++m) _Pragma("unroll") for (int k = 0; k < 2; ++k) dst[m][k] = *(const LAS bf16x8*)(lds + PG8_SA(b, h) + (F8 ? aoff8 + k * 16 : aoff + k * 1024) + m * 2048); } while (0)
#define PG8_LDB(dst, b, h) do { _Pragma("unroll") for (int n = 0; n < 2; ++n) _Pragma("unroll") for (int k = 0; k < 2; ++k) dst[n][k] = *(const LAS bf16x8*)(lds + PG8_SB(b, h) + (F8 ? boff8 + k * 16 : boff + k * 1024) + n * 2048); } while (0)
#define PG8_F8OP(x) __builtin_shufflevector(__builtin_bit_cast(v4i_t, x[0]), __builtin_bit_cast(v4i_t, x[1]), 0, 1, 2, 3, 4, 5, 6, 7)
#define PG8_MMA(ai, bj, At, Bt) do { __builtin_amdgcn_s_setprio(1); _Pragma("unroll") for (int m = 0; m < 4; ++m) _Pragma("unroll") for (int n = 0; n < 2; ++n) { \
        if constexpr (F8) { const v8i_t _a = PG8_F8OP(Bt[n]), _b = PG8_F8OP(At[m]); asm volatile("v_mfma_scale_f32_16x16x128_f8f6f4 %0, %1, %2, %0, %3, %4 op_sel_hi:[0,0,0]" : "+v"(acc[ai][bj][m][n]) : "v"(_a), "v"(_b), "v"(sclW), "v"(sclX)); } \
        else { _Pragma("unroll") for (int k = 0; k < 2; ++k) acc[ai][bj][m][n] = __builtin_amdgcn_mfma_f32_16x16x32_bf16(Bt[n][k], At[m][k], acc[ai][bj][m][n], 0, 0, 0); } } \
        __builtin_amdgcn_s_setprio(0); } while (0)
#define PG8_WAIT_V(n) asm volatile("s_waitcnt vmcnt(" #n ")" ::: "memory")
#define PG8_WAIT_L(n) asm volatile("s_waitcnt lgkmcnt(" #n ")" ::: "memory")
#define PG8_BAR __builtin_amdgcn_s_barrier()
#define PG8_SCHED __builtin_amdgcn_sched_barrier(0)
#define PG8_GOFF(dst, ui_) do { if constexpr (GATHER) { const LAS unsigned short* _t = S.tok_table(ui_); _Pragma("unroll") for (int _h = 0; _h < 2; ++_h) _Pragma("unroll") for (int _i = 0; _i < 2; ++_i) \
        dst[_h][_i] = (unsigned)_t[_h * HALF + rowA[_i]] * (unsigned)(K * ES) + voffA[_i]; } } while (0)
    Unit cur, nxt; int ui = 0;
    if (!S.next(0, cur)) return;
    f32x4 acc[2][2][4][2];
    E.init(acc, cur, wc, fq);
    bf16x8 At[4][2], B0[2][2], B1[2][2];
    unsigned gC[2][2] = {{0u, 0u}, {0u, 0u}}, gN[2][2] = {{0u, 0u}, {0u, 0u}};
    PG8_GOFF(gC, 0);
    const char* cA = (const char*)g.A + (GATHER ? (size_t)0 : (size_t)cur.pm * tstep); const char* cB = (const char*)g.Bt + (size_t)cur.pn * tstep;
    const char* nA = cA;
    {
        PG8_STAGE(PG8_SB(0, 0), cB, voffB); PG8_STAGE(PG8_SB(0, 1), cB + hstep, voffB); PG8_STAGE_A(PG8_SA(0, 0), false, 0, 0); PG8_STAGE_A(PG8_SA(0, 1), false, 1, 0);
        if (wr == 1) PG8_BAR;
        PG8_WAIT_V(2); PG8_BAR;
        PG8_STAGE(PG8_SB(1, 0), cB + kstep, voffB); PG8_STAGE_A(PG8_SA(1, 0), false, 0, kstep); PG8_STAGE(PG8_SB(1, 1), cB + hstep + kstep, voffB);
        PG8_WAIT_V(6); PG8_BAR;
    }
    for (;;) {
        const bool has_next = S.next(ui + 1, nxt);
        nA = has_next ? (const char*)g.A + (GATHER ? (size_t)0 : (size_t)nxt.pm * tstep) : cA; const char* nB = has_next ? (const char*)g.Bt + (size_t)nxt.pn * tstep : cB;
        if (has_next) { PG8_GOFF(gN, ui + 1); } else {
#pragma unroll
            for (int h = 0; h < 2; ++h)
#pragma unroll
                for (int i = 0; i < 2; ++i) gN[h][i] = gC[h][i]; }
#pragma unroll 1
        for (int t = 0; t < nt; t += 2) {
            const bool last = (t == nt - 2);
            const size_t k1 = (size_t)((t + 1) % ntr) * kstep;
            const size_t k2 = last ? (size_t)0 : (size_t)((t + 2) % ntr) * kstep, k3 = k2 + kstep;
            const char* b2 = last ? nB : cB + (size_t)((t + 2) % ntr) * kstep; const char* b3 = b2 + kstep;
            PG8_LDB(B0, 0, 0); PG8_LDB(B1, 0, 1); PG8_SCHED; PG8_LDA(At, 0, 0); PG8_STAGE_A(PG8_SA(1, 1), false, 1, k1);
            PG8_WAIT_V(8); PG8_WAIT_L(0); PG8_BAR; PG8_MMA(0, 0, At, B0); PG8_MMA(0, 1, At, B1); PG8_BAR; PG8_SCHED;
            PG8_LDA(At, 0, 1); PG8_STAGE(PG8_SB(0, 0), b2, voffB); PG8_STAGE(PG8_SB(0, 1), b2 + hstep, voffB); PG8_STAGE_A(PG8_SA(0, 0), last, 0, k2);
            PG8_WAIT_V(8); PG8_WAIT_L(0); PG8_BAR; PG8_MMA(1, 0, At, B0); PG8_MMA(1, 1, At, B1); PG8_BAR; PG8_SCHED;
            PG8_LDB(B0, 1, 0); PG8_LDB(B1, 1, 1); PG8_SCHED; PG8_LDA(At, 1, 0); PG8_STAGE_A(PG8_SA(0, 1), last, 1, k2);
            PG8_WAIT_V(8); PG8_WAIT_L(0); PG8_BAR; PG8_MMA(0, 0, At, B0); PG8_MMA(0, 1, At, B1); PG8_BAR; PG8_SCHED;
            PG8_LDA(At, 1, 1); PG8_STAGE(PG8_SB(1, 0), b3, voffB); PG8_STAGE(PG8_SB(1, 1), b3 + hstep, voffB); PG8_STAGE_A(PG8_SA(1, 0), last, 0, k3);
            PG8_WAIT_V(8); PG8_WAIT_L(0); PG8_BAR; PG8_MMA(1, 0, At, B0); PG8_MMA(1, 1, At, B1); PG8_BAR; PG8_SCHED;
        }
        if constexpr (ALIGN_EPI) { if (wr == 0) PG8_BAR; }
        if constexpr (F8) asm volatile("s_nop 15\n\ts_nop 15" ::: "memory");
        if constexpr (KREP > 1) {
_Pragma("unroll") for (int a_ = 0; a_ < 2; ++a_) _Pragma("unroll") for (int b_ = 0; b_ < 2; ++b_) _Pragma("unroll") for (int m_ = 0; m_ < 4; ++m_) _Pragma("unroll") for (int n_ = 0; n_ < 2; ++n_) acc[a_][b_][m_][n_] = acc[a_][b_][m_][n_] * (1.0f / KREP); }
        E(acc, cur, wr, wc, fr, fq);
        if (!has_next) break;
        E.init(acc, nxt, wc, fq);
        cur = nxt; cA = nA; cB = nB; ++ui;
#pragma unroll
        for (int h = 0; h < 2; ++h)
#pragma unroll
            for (int i = 0; i < 2; ++i) gC[h][i] = gN[h][i];
        if constexpr (ALIGN_EPI) { if (wr == 1) PG8_BAR; }
    }
    PG8_WAIT_V(0);
    if constexpr (!ALIGN_EPI) { if (wr == 0) PG8_BAR; }
    PG8_BAR;
#undef PG8_SA
#undef PG8_SB
#undef PG8_STAGE
#undef PG8_STAGE_A
#undef PG8_LDA
#undef PG8_LDB
#undef PG8_MMA
#undef PG8_F8OP
#undef PG8_WAIT_V
#undef PG8_WAIT_L
#undef PG8_BAR
#undef PG8_SCHED
#undef PG8_GOFF
}
}

struct Args {
    const float* x; const float* w_in; const float* w_out; const float* lq1; const float* lk1; const float* lq2; const float* lk2; const float* g_sub;
    const float* ln1_g; const float* ln1_b; const float* w_router; const float* b_router; const float* w_up; const float* b_up; const float* w_down; const float* b_down;
    const float* ln2_g; const float* ln2_b; float* out; unsigned char* ws;
};
struct Frame {
    LAS unsigned char* lds; int wave, vcu, G;
};
__device__ __forceinline__ int lane_now() { int l; asm volatile("v_mbcnt_lo_u32_b32 %0, -1, 0\n\tv_mbcnt_hi_u32_b32 %0, -1, %0" : "=v"(l)); return l; }
#define F_LANE lane_now()
#define F_TID (F.wave * 64 + lane_now())

struct EpiProj {
    static constexpr bool PERM = true;
    bf16_t* O; unsigned* ctl;
    __device__ __forceinline__ void init(f32x4 (&acc)[2][2][4][2], const pg8::Unit&, int, int) const {
#pragma unroll
        for (int a_ = 0; a_ < 2; ++a_)
#pragma unroll
            for (int b_ = 0; b_ < 2; ++b_)
#pragma unroll
                for (int m_ = 0; m_ < 4; ++m_)
#pragma unroll
                    for (int n_ = 0; n_ < 2; ++n_) acc[a_][b_][m_][n_] = (f32x4){0.f, 0.f, 0.f, 0.f};
    }
    __device__ __forceinline__ void operator()(const f32x4 (&acc)[2][2][4][2], const pg8::Unit& u, int wr, int wc, int fr, int fq) const {
        const int t = u.pn >> 1; const float sc = (t == 0 || t == 3) ? C2 : 1.f; const bool nrm = (t == 3 || t == 4);
        bf16_t* base = O + (size_t)t * PROJ_STRIDE; const int row0 = u.pm * 256 + wr * 64 + fr, col0 = (u.pn & 1) * 256 + wc * 32 + 8 * fq;
        float mx0 = 0.f, mx1 = 0.f;
#pragma unroll
        for (int ai = 0; ai < 2; ++ai)
#pragma unroll
            for (int m = 0; m < 4; ++m) { bf16_t* rowp = base + (size_t)(row0 + ai * 128 + m * 16) * 512 + col0;
#pragma unroll
                for (int bj = 0; bj < 2; ++bj) { const f32x4 v0 = acc[ai][bj][m][0] * sc, v1 = acc[ai][bj][m][1] * sc; u32x4 w;
                    w.x = cvtpk(v0[0], v0[1]); w.y = cvtpk(v0[2], v0[3]); w.z = cvtpk(v1[0], v1[1]); w.w = cvtpk(v1[2], v1[3]);
                    if (t >= 4) {
                        const int row = row0 + ai * 128 + m * 16, bb = row >> 14, sq = row & (SEQ - 1), key = sq & 63, hh = (u.pn & 1) * 2 + bj;
                        bf16_t* tb = O + 4 * PROJ_STRIDE + ((size_t)((bb * 4 + hh) * 256 + (sq >> 6))) * 16384;
                        if (t == 4) *(u32x4*)(tb + (4 * wc + fq) * 512 + key * 8) = w;
                        else *(u32x4*)(tb + 8192 + (wc * 4 + (key >> 4)) * 512 + (key & 15) * 32 + fq * 8) = w;
                    } else *(u32x4*)(rowp + bj * 128) = w;
                    if (nrm) { float ss = 0.f;
#pragma unroll
                        for (int j = 0; j < 4; ++j) { const float lo = __uint_as_float(w[j] << 16), hi = __uint_as_float(w[j] & 0xFFFF0000u); ss += lo * lo + hi * hi; }
                        ss += __shfl_xor(ss, 16); ss += __shfl_xor(ss, 32);
                        if (bj == 0) mx0 = fmaxf(mx0, ss); else mx1 = fmaxf(mx1, ss); } } }
        if (nrm) {
#pragma unroll
            for (int ofs = 1; ofs < 16; ofs <<= 1) { mx0 = fmaxf(mx0, __shfl_xor(mx0, ofs)); mx1 = fmaxf(mx1, __shfl_xor(mx1, ofs)); }
            if (fr == 0 && fq == 0) { const int b = u.pm >> 6, cw = (t == 3) ? CW_QMAX : CW_KMAX;
                atomicMax(ctl + cw + (((b * 4 + (u.pn & 1) * 2 + 0) * 2 + (wc >> 1)) * 2 + (wc & 1)), __float_as_uint(mx0));
                atomicMax(ctl + cw + (((b * 4 + (u.pn & 1) * 2 + 1) * 2 + (wc >> 1)) * 2 + (wc & 1)), __float_as_uint(mx1)); }
        }
    }
};
struct EpiZ {
    static constexpr bool PERM = false;
    const float* x; float* z;
    __device__ __forceinline__ void init(f32x4 (&acc)[2][2][4][2], const pg8::Unit&, int, int) const {
#pragma unroll
        for (int a_ = 0; a_ < 2; ++a_)
#pragma unroll
            for (int b_ = 0; b_ < 2; ++b_)
#pragma unroll
                for (int m_ = 0; m_ < 4; ++m_)
#pragma unroll
                    for (int n_ = 0; n_ < 2; ++n_) acc[a_][b_][m_][n_] = (f32x4){0.f, 0.f, 0.f, 0.f};
    }
    __device__ __forceinline__ void operator()(const f32x4 (&acc)[2][2][4][2], const pg8::Unit& u, int wr, int wc, int fr, int fq) const {
        const int col0 = u.pn * 256 + wc * 32 + 4 * fq;
#pragma unroll
        for (int ai = 0; ai < 2; ++ai)
#pragma unroll
            for (int m = 0; m < 4; ++m) { const size_t off = (size_t)(u.pm * 256 + ai * 128 + wr * 64 + m * 16 + fr) * DM + col0;
#pragma unroll
                for (int bj = 0; bj < 2; ++bj)
#pragma unroll
                    for (int n = 0; n < 2; ++n) { const f32x4 xv = *(const f32x4*)(x + off + bj * 128 + n * 16); *(f32x4*)(z + off + bj * 128 + n * 16) = xv * ALPHA + acc[ai][bj][m][n]; } }
    }
};
__device__ __forceinline__ f32x2 swiglu4_pk(f32x2 g, f32x2 u) {
    g = __builtin_elementwise_min(g, (f32x2){7.0f, 7.0f});
    u = __builtin_elementwise_min(__builtin_elementwise_max(u, (f32x2){-7.0f, -7.0f}), (f32x2){7.0f, 7.0f});
    const f32x2 a_ = g * (-1.702f * LOG2E) + (-2.0f);
    f32x2 e_; e_.x = __builtin_amdgcn_exp2f(a_.x); e_.y = __builtin_amdgcn_exp2f(a_.y);
    const f32x2 d_ = e_ + 0.25f;
    f32x2 s_; s_.x = __builtin_amdgcn_rcpf(d_.x); s_.y = __builtin_amdgcn_rcpf(d_.y);
    const f32x2 t_ = g * s_;
    return t_ * u + t_;
}
struct EpiUp {
    static constexpr bool PERM = true;
    bf16_t* H; const float* b_up;
    __device__ __forceinline__ void init(f32x4 (&acc)[2][2][4][2], const pg8::Unit& u, int wc, int fq) const {
        const int e = u.pn >> 3, pnl = u.pn & 7, hcol0 = pnl * 128 + wc * 32 + 8 * fq;
        const float* bg = b_up + (size_t)e * 2048 + hcol0; const float* bu = bg + 1024;
        const f32x4 bg0 = *(const f32x4*)bg, bg1 = *(const f32x4*)(bg + 4), bu0 = *(const f32x4*)bu, bu1 = *(const f32x4*)(bu + 4);
#pragma unroll
        for (int a_ = 0; a_ < 2; ++a_)
#pragma unroll
            for (int m_ = 0; m_ < 4; ++m_) { acc[a_][0][m_][0] = bg0; acc[a_][0][m_][1] = bg1; acc[a_][1][m_][0] = bu0; acc[a_][1][m_][1] = bu1; }
    }
    __device__ __forceinline__ void operator()(const f32x4 (&acc)[2][2][4][2], const pg8::Unit& u, int wr, int wc, int fr, int fq) const {
        const int e = u.pn >> 3, pnl = u.pn & 7, hcol0 = pnl * 128 + wc * 32 + 8 * fq;
#pragma unroll
        for (int ai = 0; ai < 2; ++ai)
#pragma unroll
            for (int m = 0; m < 4; ++m) { const size_t row = (size_t)(u.pm * 256 + ai * 128 + wr * 64 + m * 16 + fr);
                const f32x4 g0 = acc[ai][0][m][0], g1 = acc[ai][0][m][1], u0 = acc[ai][1][m][0], u1 = acc[ai][1][m][1];
                const f32x2 r0 = swiglu4_pk((f32x2){g0[0], g0[1]}, (f32x2){u0[0], u0[1]}), r1 = swiglu4_pk((f32x2){g0[2], g0[3]}, (f32x2){u0[2], u0[3]});
                const f32x2 r2 = swiglu4_pk((f32x2){g1[0], g1[1]}, (f32x2){u1[0], u1[1]}), r3 = swiglu4_pk((f32x2){g1[2], g1[3]}, (f32x2){u1[2], u1[3]});
                u32x2 w8; w8.x = cvt4_fp8(r0.x, r0.y, r1.x, r1.y); w8.y = cvt4_fp8(r2.x, r2.y, r3.x, r3.y);
                *(u32x2*)((unsigned char*)H + row * DFF + hcol0) = w8; }
    }
};
struct EpiDown {
    static constexpr bool PERM = true;
    bf16_t* Y; const float* b_down; const float* row_gate;
    __device__ __forceinline__ void init(f32x4 (&acc)[2][2][4][2], const pg8::Unit& u, int wc, int fq) const {
        const int e = u.pn >> 2, pnl = u.pn & 3, col0 = pnl * 256 + wc * 32 + 8 * fq;
#pragma unroll
        for (int bj = 0; bj < 2; ++bj)
#pragma unroll
            for (int n = 0; n < 2; ++n) { const f32x4 bv = *(const f32x4*)(b_down + (size_t)e * DM + col0 + bj * 128 + 4 * n);
#pragma unroll
                for (int a_ = 0; a_ < 2; ++a_)
#pragma unroll
                    for (int m_ = 0; m_ < 4; ++m_) acc[a_][bj][m_][n] = bv; }
    }
    __device__ __forceinline__ void operator()(const f32x4 (&acc)[2][2][4][2], const pg8::Unit& u, int wr, int wc, int fr, int fq) const {
        const int e = u.pn >> 2, pnl = u.pn & 3, col0 = pnl * 256 + wc * 32 + 8 * fq;
#pragma unroll
        for (int ai = 0; ai < 2; ++ai)
#pragma unroll
            for (int m = 0; m < 4; ++m) { const size_t row = (size_t)(u.pm * 256 + ai * 128 + wr * 64 + m * 16 + fr); const float gt = row_gate[row];
#pragma unroll
                for (int bj = 0; bj < 2; ++bj) { const f32x4 v0 = acc[ai][bj][m][0] * (gt * 32.f), v1 = acc[ai][bj][m][1] * (gt * 32.f); u32x2 w;
                    w.x = cvt4_fp8(v0[0], v0[1], v0[2], v0[3]); w.y = cvt4_fp8(v1[0], v1[1], v1[2], v1[3]); *(u32x2*)((unsigned char*)Y + row * DM + col0 + bj * 128) = w; } }
    }
};
struct MoeOrder {
    pg8::StaticOrder so; const LAS unsigned char* tile_e; const LAS unsigned short* tok; int ncolt;
    __device__ __forceinline__ bool next(int i, pg8::Unit& u) const {
        if (!so.next(i, u)) return false;
        const int e = __builtin_amdgcn_readfirstlane((int)tile_e[u.pm]); u.pn = e * ncolt + u.pn; return true; }
    __device__ __forceinline__ const LAS unsigned short* tok_table(int ui) const { return tok + ui * 256; }
};

__device__ __forceinline__ void p0_transpose_item(const float* W, int K, int N, bf16_t* WT, int k0, int n0, int row0, LAS float* scr, int lane) {
#pragma unroll 8
    for (int i = 0; i < 32; ++i) { const int kk = 2 * i + (lane >> 5); scr[kk * 33 + (lane & 31)] = W[(size_t)(k0 + kk) * N + n0 + (lane & 31)]; }
    asm volatile("s_waitcnt lgkmcnt(0)" ::: "memory");
    const int c = lane & 7;
#pragma unroll
    for (int j = 0; j < 4; ++j) { const int n = (lane >> 3) + 8 * j; const LAS float* s = scr + (8 * c) * 33 + n;
        u32x4 o; o.x = cvtpk(s[0 * 33], s[1 * 33]); o.y = cvtpk(s[2 * 33], s[3 * 33]); o.z = cvtpk(s[4 * 33], s[5 * 33]); o.w = cvtpk(s[6 * 33], s[7 * 33]);
        *(u32x4*)(WT + (size_t)(row0 + n) * K + k0 + 8 * c) = o; }
    asm volatile("s_waitcnt lgkmcnt(0)" ::: "memory");
}
__device__ __forceinline__ void p0_transpose_item_f8(const float* W, int K, int N, unsigned char* WT, int k0, int n0, int row0, LAS float* scr, int lane) {
#pragma unroll 8
    for (int i = 0; i < 32; ++i) { const int kk = 2 * i + (lane >> 5); scr[kk * 33 + (lane & 31)] = W[(size_t)(k0 + kk) * N + n0 + (lane & 31)]; }
    asm volatile("s_waitcnt lgkmcnt(0)" ::: "memory");
    const int c = lane & 7;
#pragma unroll
    for (int j = 0; j < 4; ++j) { const int n = (lane >> 3) + 8 * j; const LAS float* s = scr + (8 * c) * 33 + n;
        u32x2 o; o.x = cvt4_fp8(256.f * s[0 * 33], 256.f * s[1 * 33], 256.f * s[2 * 33], 256.f * s[3 * 33]); o.y = cvt4_fp8(256.f * s[4 * 33], 256.f * s[5 * 33], 256.f * s[6 * 33], 256.f * s[7 * 33]);
        *(u32x2*)(WT + (size_t)(row0 + n) * K + k0 + 8 * c) = o; }
    asm volatile("s_waitcnt lgkmcnt(0)" ::: "memory");
}
__device__ __forceinline__ void p0_prologue(const Frame& F, const Args& a) {
    LAS float* scr = (LAS float*)(F.lds + F.wave * 16384);
    const int gw = F.vcu * 8 + F.wave, NGW = F.G * 8;
    bf16_t* WinT = (bf16_t*)(a.ws + WS_WIN); bf16_t* WoutT = (bf16_t*)(a.ws + WS_WOUT); bf16_t* WupT = (bf16_t*)(a.ws + WS_WUP); bf16_t* WdnT = (bf16_t*)(a.ws + WS_WDN);
    constexpr int I_IN = 16 * 96, I_OUT = 16 * 32, I_UP = 16 * 64, I_DN = 16 * 32;
    constexpr int NITEMS = I_IN + I_OUT + NE * I_UP + NE * I_DN;
    for (int it = gw; it < NITEMS; it += NGW) {
        int r = it;
        if (r < I_IN) { const int kb = r / 96, nb = r % 96; p0_transpose_item(a.w_in, DM, NPROJ, WinT, 64 * kb, 32 * nb, 32 * nb, scr, F_LANE); continue; } r -= I_IN;
        if (r < I_OUT) { const int kb = r / 32, nb = r % 32; p0_transpose_item(a.w_out, DM, DM, WoutT, 64 * kb, 32 * nb, 32 * nb, scr, F_LANE); continue; } r -= I_OUT;
        if (r < NE * I_UP) { const int e = r / I_UP, q = r % I_UP, kb = q / 64, nb = q % 64, n0 = 32 * nb;
            const int nn = n0 & 1023, row0 = (nn >> 7) * 256 + (n0 >> 10) * 128 + (nn & 127);
            p0_transpose_item_f8(a.w_up + (size_t)e * DM * 2048, DM, 2048, (unsigned char*)WupT + (size_t)e * 2048 * DM, 64 * kb, n0, row0, scr, F_LANE); continue; } r -= NE * I_UP;
        { const int e = r / I_DN, q = r % I_DN, kb = q / 32, nb = q % 32; p0_transpose_item_f8(a.w_down + (size_t)e * DFF * DM, DFF, DM, (unsigned char*)WdnT + (size_t)e * DM * DFF, 64 * kb, 32 * nb, 32 * nb, scr, F_LANE); }
    }
    bf16_t* XB = (bf16_t*)(a.ws + WS_XB);
    for (int m = gw; m < NTOK; m += NGW) {
        const f32x4* xr = (const f32x4*)(a.x + (size_t)m * DM) + F_LANE; unsigned long long* o8 = (unsigned long long*)(XB + (size_t)m * DM) + F_LANE;
#pragma unroll
        for (int j = 0; j < 4; ++j) { const f32x4 v = xr[64 * j]; o8[64 * j] = (unsigned long long)cvtpk(v[0], v[1]) | ((unsigned long long)cvtpk(v[2], v[3]) << 32); }
    }
}

__device__ __forceinline__ void glds16(const void* gsrc, unsigned lds_dst) { unsigned keep;
    asm volatile("s_mov_b32 %0, m0\n\ts_mov_b32 m0, %2\n\ts_nop 0\n\tglobal_load_lds_dwordx4 %1, off\n\ts_mov_b32 m0, %0" : "=&s"(keep) : "v"(gsrc), "s"(lds_dst) : "memory"); }
__device__ __forceinline__ int crow(int r, int hi) { return (r & 3) + 8 * (r >> 2) + 4 * hi; }
typedef LAS const char* lds_cptr;
typedef short v4i16_t __attribute__((ext_vector_type(4)));
__device__ __forceinline__ s16x4 vtr(lds_cptr p) { return __builtin_bit_cast(s16x4, __builtin_amdgcn_ds_read_tr16_b64_v4i16((LAS v4i16_t*)p)); }
#define MX3(a, b, c) __builtin_fmaxf(__builtin_fmaxf((a), (b)), (c))
__device__ __forceinline__ float rowmax(const f32x16& p0, const f32x16& p1) {
    float a = MX3(p0[0], p0[1], p1[0]), b = MX3(p0[2], p0[3], p1[1]); a = MX3(a, p1[2], p1[3]);
#pragma unroll
    for (int r = 4; r < 16; r += 4) { a = MX3(a, p0[r], p0[r + 1]); b = MX3(b, p0[r + 2], p0[r + 3]); a = MX3(a, p1[r], p1[r + 1]); b = MX3(b, p1[r + 2], p1[r + 3]); }
    float m = __builtin_fmaxf(a, b); auto rr = __builtin_amdgcn_permlane32_swap(__float_as_uint(m), __float_as_uint(m), false, false);
    return __builtin_fmaxf(__uint_as_float(rr[0]), __uint_as_float(rr[1]));
}
__device__ __forceinline__ float halfsum(float v) { auto rr = __builtin_amdgcn_permlane32_swap(__float_as_uint(v), __float_as_uint(v), false, false); return __uint_as_float(rr[0]) + __uint_as_float(rr[1]); }
#define MFMA32(a, b, c) __builtin_amdgcn_mfma_f32_32x32x16_bf16(a, b, c, 0, 0, 0)

template <int ND>
__device__ __forceinline__ void softmax_tile(f32x16& p0, f32x16& p1, float& mhat, float& lsum, f32x16 (&o)[ND], u32x4 (&pw)[4]) {
    const float rm = rowmax(p0, p1);
    const float mnew = __builtin_fmaxf(mhat, rm);
    if (__any(mnew != mhat)) {
        const float al = __builtin_amdgcn_exp2f(mhat - mnew); lsum *= al;
#pragma unroll
        for (int d = 0; d < ND; ++d)
#pragma unroll
            for (int r = 0; r < 16; ++r) o[d][r] *= al;
        mhat = mnew;
    }
    float s = 0.f;
#pragma unroll
    for (int r = 0; r < 16; ++r) { p0[r] = __builtin_amdgcn_exp2f(p0[r] - mhat); p1[r] = __builtin_amdgcn_exp2f(p1[r] - mhat); s += p0[r] + p1[r]; }
    lsum += s;
    pw[0] = (u32x4){cvtpk(p0[0], p0[1]), cvtpk(p0[2], p0[3]), cvtpk(p0[4], p0[5]), cvtpk(p0[6], p0[7])};
    pw[1] = (u32x4){cvtpk(p0[8], p0[9]), cvtpk(p0[10], p0[11]), cvtpk(p0[12], p0[13]), cvtpk(p0[14], p0[15])};
    pw[2] = (u32x4){cvtpk(p1[0], p1[1]), cvtpk(p1[2], p1[3]), cvtpk(p1[4], p1[5]), cvtpk(p1[6], p1[7])};
    pw[3] = (u32x4){cvtpk(p1[8], p1[9]), cvtpk(p1[10], p1[11]), cvtpk(p1[12], p1[13]), cvtpk(p1[14], p1[15])};
}
template <int ND>
__device__ __forceinline__ void pv_tile(f32x16 (&o)[ND], lds_cptr vbase, const u32x4 (&pw)[4]) {
#pragma unroll
    for (int d0 = 0; d0 < ND; ++d0)
#pragma unroll
        for (int ks = 0; ks < 4; ++ks) {
            const s16x4 lo = vtr(vbase + d0 * 4096 + ks * 1024), hi = vtr(vbase + d0 * 4096 + ks * 1024 + 512);
            const bf16x8 vf = (bf16x8){lo[0], lo[1], lo[2], lo[3], hi[0], hi[1], hi[2], hi[3]};
            o[d0] = MFMA32(vf, __builtin_bit_cast(bf16x8, pw[ks]), o[d0]);
        }
}

__device__ __forceinline__ unsigned bfb(float x) { return cvtpk(x, 0.f) & 0xFFFFu; }
__device__ __forceinline__ float bff(unsigned b) { return __uint_as_float(b << 16); }
__device__ __forceinline__ void bf_split3(float x, unsigned& h, unsigned& m, unsigned& l) { h = bfb(x); const float r1 = x - bff(h); m = bfb(r1); const float r2 = r1 - bff(m); l = bfb(r2); }
__device__ __forceinline__ void attnB_finish(const Frame& F, const Args& a, f32x16 (&o)[4], float lsum, float lam, size_t rowbase, int qpos, int h, int c, int qs, int r32, int hi) {
    LAS unsigned char* L = F.lds;
    const float inv = 1.0f / halfsum(lsum);
    LAS float* ex = (LAS float*)(L + 65536);
    __syncthreads();
    if (c == 1) {
#pragma unroll
        for (int d0 = 0; d0 < 4; ++d0)
#pragma unroll
            for (int r = 0; r < 16; ++r) ex[(qs * 128 + 32 * d0 + crow(r, hi)) * 32 + r32] = o[d0][r] * inv;
    }
    __syncthreads();
    if (c == 0) {
        float ss = 0.f;
#pragma unroll
        for (int d0 = 0; d0 < 4; ++d0)
#pragma unroll
            for (int r = 0; r < 16; ++r) { const float v = o[d0][r] * inv - lam * ex[(qs * 128 + 32 * d0 + crow(r, hi)) * 32 + r32]; o[d0][r] = v; ss += v * v; }
        ss = halfsum(ss);
        const float rs = __builtin_amdgcn_rsqf(ss * (1.0f / 128.0f) + LN_EPS) * (1.0f - LAM_INIT);
        bf16_t* op = (bf16_t*)(a.ws + WS_MIXED) + (rowbase + qpos) * DM + 512 + h * 128 + 4 * hi;
#pragma unroll
        for (int d0 = 0; d0 < 4; ++d0)
#pragma unroll
            for (int g = 0; g < 4; ++g) { const int dv = 32 * d0 + 8 * g + 4 * hi; const f32x4 gs = *(const f32x4*)(a.g_sub + dv);
                u32x2 w; w.x = cvtpk(o[d0][4 * g] * rs * gs[0], o[d0][4 * g + 1] * rs * gs[1]); w.y = cvtpk(o[d0][4 * g + 2] * rs * gs[2], o[d0][4 * g + 3] * rs * gs[3]);
                *(u32x2*)(op + 32 * d0 + 8 * g) = w; }
    }
    __syncthreads();
}

template <bool FAST>
__device__ __forceinline__ void attnB_unit(const Frame& F, const Args& a, int b, int h, int qblk, float lam, int t_lo, int t_hi, float kn0, float kn1) {
    const int lane = F_LANE, r32 = lane & 31, hi = lane >> 5, wid = F.wave, c = wid >> 2, qs = wid & 3;
    const bf16_t* QD = (const bf16_t*)(a.ws + WS_PROJ) + 3 * PROJ_STRIDE; const bf16_t* KD = QD + PROJ_STRIDE; const bf16_t* VD = KD + PROJ_STRIDE;
    const size_t rowbase = (size_t)b * SEQ; const int q0 = qblk * 128, qpos = q0 + 32 * qs + r32;
    bf16x8 qr[4];
    { const bf16_t* Qp = QD + (rowbase + qpos) * 512 + h * 128 + c * 64 + 8 * hi;
#pragma unroll
      for (int d0 = 0; d0 < 4; ++d0) qr[d0] = *(const bf16x8*)(Qp + 16 * d0); }
    float ref = 0.f;
    { float qq = 0.f;
#pragma unroll
        for (int d0 = 0; d0 < 4; ++d0)
#pragma unroll
            for (int j = 0; j < 8; ++j) { const float v = __uint_as_float((unsigned)(unsigned short)qr[d0][j] << 16); qq += v * v; }
        qq = halfsum(qq); asm volatile("" : "+v"(qq));
        if (FAST) ref = sqrtf(qq) * (c ? kn1 : kn0) * 1.01f + 0.01f; }
    const float slope2 = __builtin_amdgcn_exp2f(-2.0f * (float)(h + 1)) * LOG2E;
    const bf16_t* tsrc = KD + (size_t)((b * 4 + h) * 256) * 16384 + wid * 2048 + lane * 8;
    LAS unsigned char* L = F.lds;
    const unsigned dbase = (unsigned)(uintptr_t)L + (unsigned)wid * 4096u;
#define B_DMA(tt, slot) do { const bf16_t* _k = tsrc + (size_t)(tt) * 16384; const unsigned _d = (unsigned)__builtin_amdgcn_readfirstlane((int)(dbase + (unsigned)(slot) * 32768u)); unsigned _keep; \
        asm volatile("s_mov_b32 %0, m0\n\ts_mov_b32 m0, %2\n\ts_nop 0\n\tglobal_load_lds_dwordx4 %1, off\n\tglobal_load_lds_dwordx4 %1, off offset:1024\n\tglobal_load_lds_dwordx4 %1, off offset:2048\n\tglobal_load_lds_dwordx4 %1, off offset:3072\n\ts_mov_b32 m0, %0" \
                     : "=&s"(_keep) : "v"(_k), "s"(_d) : "memory"); } while (0)
#define WAIT_BAR(N) asm volatile("s_waitcnt vmcnt(" #N ") lgkmcnt(0)\n\ts_barrier" ::: "memory")
#define SBAR() __builtin_amdgcn_sched_barrier(0)
#define PIN(x) asm volatile("" : "+v"(x))
#define VFRAG(dst, base, d0, ks) do { const s16x4 lo_ = vtr((base) + (d0) * 4096 + (ks) * 1024), hi_ = vtr((base) + (d0) * 4096 + (ks) * 1024 + 512); \
        dst = (bf16x8){lo_[0], lo_[1], lo_[2], lo_[3], hi_[0], hi_[1], hi_[2], hi_[3]}; } while (0)
#define GEN_C(tt) do { const float dq = (float)(qpos - (tt) * 64 - 4 * hi); \
        _Pragma("unroll") for (int r = 0; r < 16; ++r) { const float kk = (float)((r & 3) + 8 * (r >> 2)); C0[r] = -slope2 * __builtin_fabsf(dq - kk) - ref; C1[r] = -slope2 * __builtin_fabsf(dq - 32.f - kk) - ref; } } while (0)
    float mhat = NEG_BIG, lsum = 0.f; f32x16 o[4];
#pragma unroll
    for (int d = 0; d < 4; ++d) o[d] = (f32x16){};
    const int koff = (c * 8 + hi) * 1024 + r32 * 16;
    const int voff = 16384 + ((lane >> 4) & 1) * 32 + (lane & 3) * 8 + (4 * hi + ((lane & 15) >> 2)) * 64;
    const int tdiag = q0 >> 6;
    f32x16 C0, C1;
    u32x4 pw[4];
    const int NT = t_hi - t_lo + 1;
    GEN_C(t_lo);
    B_DMA(t_lo, 0); if (NT > 1) B_DMA(t_lo + 1, 1); if (NT > 2) B_DMA(t_lo + 2, 2);
    int sl = 0;
    for (int tau = 0; tau < NT; ++tau) {
        if (tau + 2 < NT) WAIT_BAR(8); else if (tau + 1 < NT) WAIT_BAR(4); else WAIT_BAR(0);
        if (tau + 3 < NT) B_DMA(t_lo + tau + 3, (sl + 3) & 3);
        const int t = t_lo + tau; const LAS unsigned char* buf = L + sl * 32768; const lds_cptr vbase = (lds_cptr)(buf + voff);
        bf16x8 kf[8];
#pragma unroll
        for (int d0 = 0; d0 < 4; ++d0) { kf[2 * d0] = *(const LAS bf16x8*)(buf + koff + d0 * 2048); kf[2 * d0 + 1] = *(const LAS bf16x8*)(buf + koff + d0 * 2048 + 512); }
        SBAR();
        f32x16 p0, p1;
        if constexpr (FAST) {
            bf16x8 vA[4], vB[4]; float sacc = 0.f;
#define EXPS(P, A, B) do { _Pragma("unroll") for (int r = (A); r < (B); ++r) { P[r] = __builtin_amdgcn_exp2f(P[r]); sacc += P[r]; } PIN(P); PIN(sacc); } while (0)
#define PK4(P, B) (u32x4){cvtpk(P[B], P[B + 1]), cvtpk(P[B + 2], P[B + 3]), cvtpk(P[B + 4], P[B + 5]), cvtpk(P[B + 6], P[B + 7])}
#define PWF(k) __builtin_bit_cast(bf16x8, pw[k])
            const float st = (t + 1 < tdiag) ? 64.f * slope2 : -64.f * slope2;
            p0 = MFMA32(kf[0], qr[0], C0); SBAR(); VFRAG(vA[0], vbase, 0, 0); SBAR();
            p0 = MFMA32(kf[2], qr[1], p0); SBAR(); VFRAG(vA[1], vbase, 1, 0); SBAR();
            p0 = MFMA32(kf[4], qr[2], p0); SBAR(); VFRAG(vA[2], vbase, 2, 0); SBAR();
            p0 = MFMA32(kf[6], qr[3], p0); SBAR(); VFRAG(vA[3], vbase, 3, 0); SBAR();
            p1 = MFMA32(kf[1], qr[0], C1); SBAR();
            p1 = MFMA32(kf[3], qr[1], p1); SBAR(); EXPS(p0, 0, 5); SBAR();
            p1 = MFMA32(kf[5], qr[2], p1); SBAR(); EXPS(p0, 5, 11); SBAR();
            p1 = MFMA32(kf[7], qr[3], p1); SBAR(); EXPS(p0, 11, 16); pw[0] = PK4(p0, 0); PIN(pw[0]); SBAR();
            o[0] = MFMA32(vA[0], PWF(0), o[0]); SBAR(); pw[1] = PK4(p0, 8); PIN(pw[1]); VFRAG(vB[0], vbase, 0, 1); SBAR();
            o[1] = MFMA32(vA[1], PWF(0), o[1]); SBAR(); EXPS(p1, 0, 3); VFRAG(vB[1], vbase, 1, 1); SBAR();
            o[2] = MFMA32(vA[2], PWF(0), o[2]); SBAR(); EXPS(p1, 3, 6); VFRAG(vB[2], vbase, 2, 1); SBAR();
            o[3] = MFMA32(vA[3], PWF(0), o[3]); SBAR(); EXPS(p1, 6, 8); VFRAG(vB[3], vbase, 3, 1); SBAR();
            o[0] = MFMA32(vB[0], PWF(1), o[0]); SBAR(); EXPS(p1, 8, 10); VFRAG(vA[0], vbase, 0, 2); SBAR();
            o[1] = MFMA32(vB[1], PWF(1), o[1]); SBAR(); EXPS(p1, 10, 12); VFRAG(vA[1], vbase, 1, 2); SBAR();
            o[2] = MFMA32(vB[2], PWF(1), o[2]); SBAR(); EXPS(p1, 12, 14); VFRAG(vA[2], vbase, 2, 2); SBAR();
            o[3] = MFMA32(vB[3], PWF(1), o[3]); SBAR(); EXPS(p1, 14, 16); VFRAG(vA[3], vbase, 3, 2); pw[2] = PK4(p1, 0); PIN(pw[2]); SBAR();
            o[0] = MFMA32(vA[0], PWF(2), o[0]); SBAR(); pw[3] = PK4(p1, 8); PIN(pw[3]); VFRAG(vB[0], vbase, 0, 3); SBAR();
            o[1] = MFMA32(vA[1], PWF(2), o[1]); SBAR(); VFRAG(vB[1], vbase, 1, 3);
#pragma unroll
            for (int r = 0; r < 8; ++r) C0[r] += st;
            PIN(C0); SBAR();
            o[2] = MFMA32(vA[2], PWF(2), o[2]); SBAR(); VFRAG(vB[2], vbase, 2, 3);
#pragma unroll
            for (int r = 8; r < 16; ++r) C0[r] += st;
            PIN(C0); SBAR();
            o[3] = MFMA32(vA[3], PWF(2), o[3]); SBAR(); VFRAG(vB[3], vbase, 3, 3);
#pragma unroll
            for (int r = 0; r < 8; ++r) C1[r] += st;
            PIN(C1); SBAR();
            o[0] = MFMA32(vB[0], PWF(3), o[0]); SBAR();
#pragma unroll
            for (int r = 8; r < 16; ++r) C1[r] += st;
            PIN(C1); SBAR();
            o[1] = MFMA32(vB[1], PWF(3), o[1]);
            o[2] = MFMA32(vB[2], PWF(3), o[2]);
            o[3] = MFMA32(vB[3], PWF(3), o[3]);
            lsum += sacc;
#undef EXPS
#undef PK4
#undef PWF
        } else {
            p0 = MFMA32(kf[0], qr[0], C0); p1 = MFMA32(kf[1], qr[0], C1);
#pragma unroll
            for (int d0 = 1; d0 < 4; ++d0) { p0 = MFMA32(kf[2 * d0], qr[d0], p0); p1 = MFMA32(kf[2 * d0 + 1], qr[d0], p1); }
            softmax_tile<4>(p0, p1, mhat, lsum, o, pw);
            pv_tile<4>(o, vbase, pw);
            const float st = (t + 1 < tdiag) ? 64.f * slope2 : -64.f * slope2; C0 = C0 + st; C1 = C1 + st;
        }
        if ((t + 1 >= tdiag && t + 1 <= tdiag + 2) || ((tau + 1) & 15) == 0) GEN_C(t + 1);
        sl = (sl + 1) & 3;
    }
#undef B_DMA
#undef WAIT_BAR
#undef VFRAG
#undef GEN_C
#undef SBAR
#undef PIN
    attnB_finish(F, a, o, lsum, lam, rowbase, qpos, h, c, qs, r32, hi);
}
__device__ __forceinline__ void attnB_fast(const Frame& F, const Args& a, int b, int h, int qblk, float lam, int t_lo, int t_hi, float kn0, float kn1) {
    const int lane = F_LANE, r32 = lane & 31, hi = lane >> 5, wid = F.wave, c = wid >> 2, qs = wid & 3;
    const bf16_t* QD = (const bf16_t*)(a.ws + WS_PROJ) + 3 * PROJ_STRIDE; const bf16_t* KD = QD + PROJ_STRIDE;
    const size_t rowbase = (size_t)b * SEQ; const int q0 = qblk * 128, qpos = q0 + 32 * qs + r32;
    bf16x8 qr[4];
    { const bf16_t* Qp = QD + (rowbase + qpos) * 512 + h * 128 + c * 64 + 8 * hi;
#pragma unroll
      for (int d0 = 0; d0 < 4; ++d0) qr[d0] = *(const bf16x8*)(Qp + 16 * d0); }
    float ref;
    { float qq = 0.f;
#pragma unroll
        for (int d0 = 0; d0 < 4; ++d0)
#pragma unroll
            for (int j = 0; j < 8; ++j) { const float v = __uint_as_float((unsigned)(unsigned short)qr[d0][j] << 16); qq += v * v; }
        qq = halfsum(qq); asm volatile("" : "+v"(qq));
        ref = sqrtf(qq) * (c ? kn1 : kn0) * 1.01f + 0.01f; }
    const float slope2 = __builtin_amdgcn_exp2f(-2.0f * (float)(h + 1)) * LOG2E;
    const bf16_t* tsrc = KD + (size_t)((b * 4 + h) * 256) * 16384 + wid * 2048 + lane * 8;
    LAS unsigned char* L = F.lds;
    const unsigned dbase = (unsigned)(uintptr_t)L + (unsigned)wid * 4096u;
#define B_DMA(tt, slot) do { const bf16_t* _k = tsrc + (size_t)(tt) * 16384; const unsigned _d = (unsigned)__builtin_amdgcn_readfirstlane((int)(dbase + (unsigned)(slot) * 32768u)); unsigned _keep; \
        asm volatile("s_mov_b32 %0, m0\n\ts_mov_b32 m0, %2\n\ts_nop 0\n\tglobal_load_lds_dwordx4 %1, off\n\tglobal_load_lds_dwordx4 %1, off offset:1024\n\tglobal_load_lds_dwordx4 %1, off offset:2048\n\tglobal_load_lds_dwordx4 %1, off offset:3072\n\ts_mov_b32 m0, %0" \
                     : "=&s"(_keep) : "v"(_k), "s"(_d) : "memory"); } while (0)
#define WAIT_BAR(N) asm volatile("s_waitcnt vmcnt(" #N ") lgkmcnt(0)\n\ts_barrier" : "+v"(p1), "+v"(sacc) :: "memory")
#define VFRAG(dst, base, d0, ks) do { const s16x4 lo_ = vtr((base) + (d0) * 4096 + (ks) * 1024), hi_ = vtr((base) + (d0) * 4096 + (ks) * 1024 + 512); \
        dst = (bf16x8){lo_[0], lo_[1], lo_[2], lo_[3], hi_[0], hi_[1], hi_[2], hi_[3]}; } while (0)
#define MF_ "v_mfma_f32_32x32x16_bf16 "
#define AMF(D, A, B)              asm volatile(MF_ "%0, %1, %2, %0" : "+v"(D) : "v"(A), "v"(B) : "memory")
#define AMF1(D, A, B, X)          asm volatile(MF_ "%0, %2, %3, %0" : "+v"(D), "+v"(X) : "v"(A), "v"(B) : "memory")
#define AMF2(D, A, B, X, Y)       asm volatile(MF_ "%0, %3, %4, %0" : "+v"(D), "+v"(X), "+v"(Y) : "v"(A), "v"(B) : "memory")
#define AMF3(D, A, B, X, Y, Z)    asm volatile(MF_ "%0, %4, %5, %0" : "+v"(D), "+v"(X), "+v"(Y), "+v"(Z) : "v"(A), "v"(B) : "memory")
#define AMF0(D, A, B)             asm volatile(MF_ "%0, %1, %2, 0" : "=&v"(D) : "v"(A), "v"(B) : "memory")
#define PK4(P, B) (u32x4){cvtpk(P[B], P[B + 1]), cvtpk(P[B + 2], P[B + 3]), cvtpk(P[B + 4], P[B + 5]), cvtpk(P[B + 6], P[B + 7])}
#define XE(P, r) { P[r] = __builtin_amdgcn_exp2f(P[r]); sacc += P[r]; }
#define XE2(P, r) do { XE(P, r) XE(P, (r) + 1) } while (0)
#define KLD(bk, i) kf[i] = *(const LAS bf16x8*)((bk) + koff + ((i) >> 1) * 2048 + ((i) & 1) * 512)
#define SET_KA(tn) do { const unsigned w_ = __builtin_amdgcn_perm(0u, __float_as_uint(tf), 0x03020302u); ka0[1] = w_; ka1[1] = w_; tf += tinc; if ((tn) == tdiag + 2) qa = qaR; } while (0)
#define BIAS_HALF(P, KA, e, tn) do { \
        if ((unsigned)((tn) - tdiag) < 2u) { const int kb_ = 2 * (tn) + (e); \
            if (kb_ == qb) { float dq_ = (float)(qpos - (tn) * 64 - 32 * (e) - 4 * hi), ns_ = -slope2, nr_ = -ref; asm volatile("" : "+v"(dq_), "+v"(ns_), "+v"(nr_)); \
                             _Pragma("unroll") for (int r = 0; r < 16; ++r) { const float kk_ = (float)((r & 3) + 8 * (r >> 2)); P[r] = __builtin_fmaf(ns_, __builtin_fabsf(dq_ - kk_), nr_); } \
                             asm volatile("s_nop 4" : "+v"(P) :: "memory"); } \
            else if (kb_ < qb) { AMF0(P, KA, qaL); } else { AMF0(P, KA, qaR); } } \
        else { AMF0(P, KA, qa); } } while (0)
    const int tdiag = q0 >> 6, qb = 4 * qblk + qs;
    const unsigned msk = hi ? 0u : 0xFFFFFFFFu;
    bf16x8 qaL, qaR, qa; u32x4 ka0, ka1;
    { const float S64 = 64.f * slope2;
        const unsigned sh = bfb(slope2), slo = bfb(slope2 - bff(sh)), Sh = bfb(S64), Slo = bfb(S64 - bff(Sh));
        unsigned ch, cm, cl, dh, dm, dl;
        bf_split3(slope2 * (float)(qpos - 64 * tdiag) - ref, ch, cm, cl);
        bf_split3(-slope2 * (float)(qpos - 64 * tdiag) - ref, dh, dm, dl);
        const u32x4 r_ = (u32x4){(((slo ^ 0x8000u) << 16) | (sh ^ 0x8000u)) & msk, (((Slo ^ 0x8000u) << 16) | (Sh ^ 0x8000u)) & msk, ((cm << 16) | ch) & msk, cl & msk};
        const u32x4 l_ = (u32x4){((slo << 16) | sh) & msk, ((Slo << 16) | Sh) & msk, ((dm << 16) | dh) & msk, dl & msk};
        qaR = __builtin_bit_cast(bf16x8, r_); qaL = __builtin_bit_cast(bf16x8, l_); qa = (t_lo < tdiag + 2) ? qaL : qaR;
        const unsigned j0 = bfb((float)r32), j1 = bfb((float)(32 + r32));
        ka0 = (u32x4){((j0 << 16) | j0) & msk, 0u, 0x3F803F80u & msk, 0x00003F80u & msk}; ka1 = ka0; ka1[0] = ((j1 << 16) | j1) & msk; }
    float tf = hi ? 0.f : (float)(t_lo - tdiag); const float tinc = hi ? 0.f : 1.f;
    f32x16 o[4], p0, p1; u32x4 pw[4]; bf16x8 kf[8], vA[4], vB[4]; float sacc = 0.f;
#pragma unroll
    for (int d = 0; d < 4; ++d) o[d] = (f32x16){};
    p1 = (f32x16){};
    const int koff = (c * 8 + hi) * 1024 + r32 * 16;
    const int voff = 16384 + ((lane >> 4) & 1) * 32 + (lane & 3) * 8 + (4 * hi + ((lane & 15) >> 2)) * 64;
    const int NT = t_hi - t_lo + 1;
    B_DMA(t_lo, 0); if (NT > 1) B_DMA(t_lo + 1, 1); if (NT > 2) B_DMA(t_lo + 2, 2);
    if (NT > 2) WAIT_BAR(8); else if (NT > 1) WAIT_BAR(4); else WAIT_BAR(0);
    {
        const LAS unsigned char* bk = L;
#pragma unroll
        for (int i = 0; i < 8; ++i) KLD(bk, i);
        SET_KA(t_lo);
        asm volatile("s_nop 1" : "+v"(ka0), "+v"(ka1), "+v"(qa) :: "memory");
        BIAS_HALF(p0, ka0, 0, t_lo);
        AMF(p0, kf[0], qr[0]); AMF(p0, kf[2], qr[1]); AMF(p0, kf[4], qr[2]); AMF(p0, kf[6], qr[3]);
        BIAS_HALF(p1, ka1, 1, t_lo);
        AMF(p1, kf[1], qr[0]); AMF(p1, kf[3], qr[1]); AMF(p1, kf[5], qr[2]); AMF(p1, kf[7], qr[3]);
        const lds_cptr vb0 = (lds_cptr)(bk + voff);
        VFRAG(vA[0], vb0, 0, 0); VFRAG(vA[1], vb0, 1, 0); VFRAG(vA[2], vb0, 2, 0); VFRAG(vA[3], vb0, 3, 0);
        asm volatile("s_nop 15\n\ts_nop 15" : "+v"(p0), "+v"(p1) :: "memory");
#pragma unroll
        for (int r = 0; r < 16; r += 2) XE2(p0, r);
#pragma unroll
        for (int r = 0; r < 16; r += 2) XE2(p1, r);
        pw[0] = PK4(p0, 0); pw[1] = PK4(p0, 8); pw[2] = PK4(p1, 0);
    }
    int sl = 0;
    for (int tau = 0; tau + 1 < NT; ++tau) {
        if (tau + 2 < NT) WAIT_BAR(4); else WAIT_BAR(0);
        if (tau + 3 < NT) B_DMA(t_lo + tau + 3, (sl + 3) & 3);
        const LAS unsigned char* buf = L + sl * 32768; const LAS unsigned char* bufn = L + ((sl + 1) & 3) * 32768;
        const lds_cptr vb = (lds_cptr)(buf + voff), vbn = (lds_cptr)(bufn + voff);
        const int tn = t_lo + tau + 1;
        SET_KA(tn);
        AMF(o[0], vA[0], pw[0]);            KLD(bufn, 0); KLD(bufn, 2);
        AMF1(o[1], vA[1], pw[0], p1);       KLD(bufn, 4); KLD(bufn, 6); pw[3] = PK4(p1, 8);
        AMF1(o[2], vA[2], pw[0], pw[3]);    KLD(bufn, 1); KLD(bufn, 3);
        AMF(o[3], vA[3], pw[0]);            KLD(bufn, 5); KLD(bufn, 7);
        BIAS_HALF(p0, ka0, 0, tn);          VFRAG(vB[0], vb, 0, 1);
        AMF(p0, kf[0], qr[0]);              VFRAG(vB[1], vb, 1, 1);
        AMF(p0, kf[2], qr[1]);              VFRAG(vB[2], vb, 2, 1);
        AMF(p0, kf[4], qr[2]);              VFRAG(vB[3], vb, 3, 1);
        AMF(p0, kf[6], qr[3]);
        BIAS_HALF(p1, ka1, 1, tn);
        AMF1(p1, kf[1], qr[0], p0);         XE2(p0, 0);
        AMF2(p1, kf[3], qr[1], p0, sacc);   XE2(p0, 2);
        AMF2(p1, kf[5], qr[2], p0, sacc);   XE2(p0, 4);
        AMF2(p1, kf[7], qr[3], p0, sacc);   XE2(p0, 6);
        AMF2(o[0], vB[0], pw[1], p0, sacc); XE2(p0, 8);  VFRAG(vA[0], vb, 0, 2);
        AMF2(o[1], vB[1], pw[1], p0, sacc); XE2(p0, 10); VFRAG(vA[1], vb, 1, 2);
        AMF2(o[2], vB[2], pw[1], p0, sacc); XE2(p0, 12); VFRAG(vA[2], vb, 2, 2);
        AMF2(o[3], vB[3], pw[1], p0, sacc); XE2(p0, 14); VFRAG(vA[3], vb, 3, 2);
        AMF3(o[0], vA[0], pw[2], p0, sacc, p1);     pw[0] = PK4(p0, 0); XE2(p1, 0); VFRAG(vB[0], vb, 0, 3);
        AMF3(o[1], vA[1], pw[2], p1, sacc, pw[0]);  XE2(p1, 2); VFRAG(vB[1], vb, 1, 3);
        AMF3(o[2], vA[2], pw[2], p1, sacc, p0);     pw[1] = PK4(p0, 8); XE2(p1, 4); VFRAG(vB[2], vb, 2, 3);
        AMF3(o[3], vA[3], pw[2], p1, sacc, pw[1]);  XE2(p1, 6); VFRAG(vB[3], vb, 3, 3);
        AMF2(o[0], vB[0], pw[3], p1, sacc); XE2(p1, 8);  VFRAG(vA[0], vbn, 0, 0);
        AMF2(o[1], vB[1], pw[3], p1, sacc); XE2(p1, 10); VFRAG(vA[1], vbn, 1, 0);
        AMF2(o[2], vB[2], pw[3], p1, sacc); pw[2] = PK4(p1, 0); XE2(p1, 12); VFRAG(vA[2], vbn, 2, 0);
        AMF3(o[3], vB[3], pw[3], p1, sacc, pw[2]);  XE2(p1, 14); VFRAG(vA[3], vbn, 3, 0);
        sl = (sl + 1) & 3;
    }
    {
        const lds_cptr vb = (lds_cptr)(L + sl * 32768 + voff);
        pw[3] = PK4(p1, 8);
        AMF3(o[0], vA[0], pw[0], p1, sacc, pw[3]); VFRAG(vB[0], vb, 0, 1);
        AMF(o[1], vA[1], pw[0]); VFRAG(vB[1], vb, 1, 1);
        AMF(o[2], vA[2], pw[0]); VFRAG(vB[2], vb, 2, 1);
        AMF(o[3], vA[3], pw[0]); VFRAG(vB[3], vb, 3, 1);
        AMF(o[0], vB[0], pw[1]); VFRAG(vA[0], vb, 0, 2);
        AMF(o[1], vB[1], pw[1]); VFRAG(vA[1], vb, 1, 2);
        AMF(o[2], vB[2], pw[1]); VFRAG(vA[2], vb, 2, 2);
        AMF(o[3], vB[3], pw[1]); VFRAG(vA[3], vb, 3, 2);
        AMF(o[0], vA[0], pw[2]); VFRAG(vB[0], vb, 0, 3);
        AMF(o[1], vA[1], pw[2]); VFRAG(vB[1], vb, 1, 3);
        AMF(o[2], vA[2], pw[2]); VFRAG(vB[2], vb, 2, 3);
        AMF(o[3], vA[3], pw[2]); VFRAG(vB[3], vb, 3, 3);
        AMF(o[0], vB[0], pw[3]); AMF(o[1], vB[1], pw[3]); AMF(o[2], vB[2], pw[3]); AMF(o[3], vB[3], pw[3]);
        asm volatile("s_nop 15\n\ts_nop 15" : "+v"(o[0]), "+v"(o[1]), "+v"(o[2]), "+v"(o[3]) :: "memory");
    }
#undef B_DMA
#undef WAIT_BAR
#undef VFRAG
#undef MF_
#undef AMF
#undef AMF1
#undef AMF2
#undef AMF3
#undef AMF0
#undef PK4
#undef XE
#undef XE2
#undef KLD
#undef SET_KA
#undef BIAS_HALF
    attnB_finish(F, a, o, sacc, lam, rowbase, qpos, h, c, qs, r32, hi);
}
__device__ __forceinline__ void attnB_item(const Frame& F, const Args& a, int h, int b, int qblk, float lam) {
    const int q0 = qblk * 128;
    const unsigned* ctl = (const unsigned*)(a.ws + WS_CTL); const int sl = (b * 4 + h) * 4;
    const float qn0 = sqrtf(__uint_as_float(ctl[CW_QMAX + sl]) + __uint_as_float(ctl[CW_QMAX + sl + 1])), qn1 = sqrtf(__uint_as_float(ctl[CW_QMAX + sl + 2]) + __uint_as_float(ctl[CW_QMAX + sl + 3]));
    const float kn0 = sqrtf(__uint_as_float(ctl[CW_KMAX + sl]) + __uint_as_float(ctl[CW_KMAX + sl + 1])), kn1 = sqrtf(__uint_as_float(ctl[CW_KMAX + sl + 2]) + __uint_as_float(ctl[CW_KMAX + sl + 3]));
    const float U = fmaxf(qn0 * kn0, qn1 * kn1) * 1.01f + 0.01f;
    const float slope2 = __builtin_amdgcn_exp2f(-2.0f * (float)(h + 1)) * LOG2E;
    const float Df = (2.0f * U + 72.0f) / slope2;
    const int Dd = Df < 40000.f ? (int)Df + 2 : 40000;
    int t_lo = (q0 - Dd) >> 6; if (q0 - Dd < 0) t_lo = 0;
    int t_hi = (q0 + 127 + Dd) >> 6; if (t_hi > SEQ / 64 - 1) t_hi = SEQ / 64 - 1;
    if (U <= 40.f) attnB_fast(F, a, b, h, qblk, lam, t_lo, t_hi, kn0, kn1);
    else attnB_unit<false>(F, a, b, h, qblk, lam, t_lo, t_hi, kn0, kn1);
}

__device__ __forceinline__ int a_kbase(int n0, int it) { return n0 - 64 + 64 * ((it == 0) ? 1 : (it == 1 ? 0 : 2)); }
__device__ __forceinline__ void a_load_k(const bf16_t* KA, size_t rowbase, int head, int d, int r, int L, int kbase, int r32, int hi, bf16x8 (&kf)[8]) {
#pragma unroll
    for (int kh = 0; kh < 2; ++kh) { int kn = kbase + 32 * kh + r32; kn = kn < 0 ? 0 : (kn >= L ? L - 1 : kn);
        const bf16_t* Kp = KA + (rowbase + (size_t)(d * kn + r)) * 512 + head * 64 + 8 * hi;
#pragma unroll
        for (int d0 = 0; d0 < 4; ++d0) kf[2 * d0 + kh] = *(const bf16x8*)(Kp + 16 * d0); }
}
__device__ __forceinline__ void attnA_task(const Frame& F, const Args& a, int b, int head, int d, int r, int n0, int L, LAS unsigned char* vw, f32x16 (&o)[2], float& mhat, float& ltot) {
    const int lane = F_LANE, r32 = lane & 31, hi = lane >> 5;
    const bf16_t* QA = (const bf16_t*)(a.ws + WS_PROJ); const bf16_t* KA = QA + PROJ_STRIDE; const bf16_t* VA = KA + PROJ_STRIDE;
    const size_t rowbase = (size_t)b * SEQ; const int qn = n0 + r32;
    bf16x8 qr[4], kf[8], kfn[8];
    { const bf16_t* Qp = QA + (rowbase + (size_t)(d * qn + r)) * 512 + head * 64 + 8 * hi;
#pragma unroll
      for (int d0 = 0; d0 < 4; ++d0) qr[d0] = *(const bf16x8*)(Qp + 16 * d0); }
    a_load_k(KA, rowbase, head, d, r, L, a_kbase(n0, 0), r32, hi, kf);
    const float sl = __builtin_amdgcn_exp2f(-(float)(head + 1)) * LOG2E * (float)d;
    mhat = NEG_BIG; float lsum = 0.f; o[0] = (f32x16){}; o[1] = (f32x16){};
    const int voff = ((lane >> 4) & 1) * 32 + (lane & 3) * 8 + (4 * hi + ((lane & 15) >> 2)) * 64;
#pragma unroll
    for (int it = 0; it < 3; ++it) {
        const int kbase = a_kbase(n0, it);
        u32x4 vv[8];
#pragma unroll
        for (int ks = 0; ks < 4; ++ks) { int kn = kbase + 16 * ks + (lane >> 2); kn = kn < 0 ? 0 : (kn >= L ? L - 1 : kn);
            const bf16_t* Vp = VA + (rowbase + (size_t)(d * kn + r)) * 512 + head * 64 + 8 * (lane & 3);
            vv[ks] = *(const u32x4*)Vp; vv[4 + ks] = *(const u32x4*)(Vp + 32); }
        if (it < 2) a_load_k(KA, rowbase, head, d, r, L, a_kbase(n0, it + 1), r32, hi, kfn);
        __builtin_amdgcn_sched_barrier(0);
        f32x16 p0, p1;
#pragma unroll
        for (int rr = 0; rr < 16; ++rr) { const int k0 = kbase + crow(rr, hi), k1 = k0 + 32; const int d0_ = k0 - qn, d1_ = k1 - qn;
            const bool v0 = (k0 >= 0) && (k0 < L) && (d0_ <= 64) && (d0_ >= -64), v1 = (k1 >= 0) && (k1 < L) && (d1_ <= 64) && (d1_ >= -64);
            p0[rr] = v0 ? -sl * __builtin_fabsf((float)d0_) : NEG_BIG; p1[rr] = v1 ? -sl * __builtin_fabsf((float)d1_) : NEG_BIG; }
#pragma unroll
        for (int d0 = 0; d0 < 4; ++d0) { p0 = MFMA32(kf[2 * d0], qr[d0], p0); p1 = MFMA32(kf[2 * d0 + 1], qr[d0], p1); }
        u32x4 pw[4];
        softmax_tile<2>(p0, p1, mhat, lsum, o, pw);
        __builtin_amdgcn_sched_barrier(0);
#pragma unroll
        for (int i = 0; i < 8; ++i) *(LAS u32x4*)(vw + i * 1024 + lane * 16) = vv[i];
        asm volatile("s_waitcnt lgkmcnt(0)" ::: "memory");
        pv_tile<2>(o, (lds_cptr)(vw + voff), pw);
        asm volatile("s_waitcnt lgkmcnt(0)" ::: "memory");
        if (it < 2) {
#pragma unroll
            for (int j = 0; j < 8; ++j) kf[j] = kfn[j];
        }
    }
    ltot = halfsum(lsum);
}
__device__ __forceinline__ void attnA_unit(const Frame& F, const Args& a, int unit) {
    const int lane = F_LANE, r32 = lane & 31, hi = lane >> 5, wid = F.wave;
    const int b = unit >> 7, head = (unit >> 4) & 7, tb = unit & 15, T0 = tb * 1024;
    float* part = (float*)(a.ws + WS_APART + (size_t)unit * APART_UNIT); float* ml = part + 2 * 1024 * 64;
    LAS unsigned char* vw = F.lds + wid * 8192;
    for (int task = wid; task < 64; task += 8) {
        int pat, d, r, n0, L;
        if (task < 32) { pat = 0; d = 16; r = task >> 1; n0 = T0 / 16 + 32 * (task & 1); L = SEQ / 16; }
        else { const int tt = task - 32; pat = 1; d = 4; r = tt >> 3; n0 = T0 / 4 + 32 * (tt & 7); L = SEQ / 4; }
        f32x16 o[2]; float mhat, ltot;
        attnA_task(F, a, b, head, d, r, n0, L, vw, o, mhat, ltot);
        const int tl = d * (n0 + r32) + r - T0;
        float* pp = part + ((size_t)pat * 1024 + tl) * 64 + 4 * hi;
#pragma unroll
        for (int d0 = 0; d0 < 2; ++d0)
#pragma unroll
            for (int g = 0; g < 4; ++g) *(f32x4*)(pp + 32 * d0 + 8 * g) = (f32x4){o[d0][4 * g], o[d0][4 * g + 1], o[d0][4 * g + 2], o[d0][4 * g + 3]};
        if (hi == 0) *(f32x2*)(ml + ((size_t)pat * 1024 + tl) * 2) = (f32x2){mhat, ltot};
    }
    asm volatile("s_waitcnt vmcnt(0)" ::: "memory");
    __syncthreads();
    __builtin_amdgcn_fence(__ATOMIC_ACQUIRE, "agent");
    for (int task = wid; task < 32; task += 8) {
        const int n0 = T0 + 32 * task;
        f32x16 o[2]; float m0, l0;
        attnA_task(F, a, b, head, 1, 0, n0, SEQ, vw, o, m0, l0);
        const int tl = 32 * task + r32;
        const f32x2 ml1 = *(const f32x2*)(ml + ((size_t)0 * 1024 + tl) * 2), ml2 = *(const f32x2*)(ml + ((size_t)1 * 1024 + tl) * 2);
        const float M = MX3(m0, ml1[0], ml2[0]);
        const float w0 = __builtin_amdgcn_exp2f(m0 - M), w1 = __builtin_amdgcn_exp2f(ml1[0] - M), w2 = __builtin_amdgcn_exp2f(ml2[0] - M);
        const float rden = 1.0f / (w0 * l0 + w1 * ml1[1] + w2 * ml2[1]);
        const float* p1 = part + ((size_t)0 * 1024 + tl) * 64 + 4 * hi; const float* p2 = part + ((size_t)1 * 1024 + tl) * 64 + 4 * hi;
        bf16_t* op = (bf16_t*)(a.ws + WS_MIXED) + ((size_t)b * SEQ + T0 + tl) * DM + head * 64 + 4 * hi;
#pragma unroll
        for (int d0 = 0; d0 < 2; ++d0)
#pragma unroll
            for (int g = 0; g < 4; ++g) { const f32x4 a1 = *(const f32x4*)(p1 + 32 * d0 + 8 * g), a2 = *(const f32x4*)(p2 + 32 * d0 + 8 * g); float v[4];
#pragma unroll
                for (int j = 0; j < 4; ++j) v[j] = (w0 * o[d0][4 * g + j] + w1 * a1[j] + w2 * a2[j]) * rden;
                u32x2 w; w.x = cvtpk(v[0], v[1]); w.y = cvtpk(v[2], v[3]); *(u32x2*)(op + 32 * d0 + 8 * g) = w; }
    }
    __syncthreads();
}

__device__ __forceinline__ unsigned ordkey(float v) { const unsigned u = __float_as_uint(v); return u ^ ((u >> 31) ? 0xFFFFFFFFu : 0x80000000u); }
__device__ __forceinline__ float unordkey(unsigned k) { const unsigned u = (k & 0x80000000u) ? (k ^ 0x80000000u) : ~k; return __uint_as_float(u); }
__device__ __forceinline__ void p4_ln_router(const Frame& F, const Args& a) {
    const int lane = F_LANE, wid = F.wave, tid = F_TID;
    LAS float* Wr = (LAS float*)F.lds;
    LAS unsigned* misc = (LAS unsigned*)(F.lds + LX_MISC);
    LAS float* pc = (LAS float*)(F.lds + LX_TOK);
    for (int i = tid; i < DM * NE / 4; i += 512) ((LAS f32x4*)Wr)[i] = ((const f32x4*)a.w_router)[i] * a.ln1_g[i >> 3];
    if (tid < 64) misc[tid] = 0u;
    float* Z = (float*)(a.ws + WS_Z); bf16_t* X1B = (bf16_t*)(a.ws + WS_XB);
    const int r0 = (F.vcu * 8 + wid) * 16;
    const int rl = lane & 15, q = lane >> 4;
    float mym[4] = {0.f, 0.f, 0.f, 0.f}, myr[4] = {0.f, 0.f, 0.f, 0.f};
    {
        f32x4 gv[4], bv[4];
#pragma unroll
        for (int j = 0; j < 4; ++j) { gv[j] = ((const f32x4*)a.ln1_g)[lane + 64 * j]; bv[j] = ((const f32x4*)a.ln1_b)[lane + 64 * j]; }
        float* stats = (float*)(a.ws + WS_ROUTE + 4 * MiB);
#pragma unroll 4
        for (int rr = 0; rr < 16; ++rr) {
            const f32x4* zr = (const f32x4*)(Z + (size_t)(r0 + rr) * DM) + lane; f32x4 v[4]; float s = 0.f;
#pragma unroll
            for (int j = 0; j < 4; ++j) { v[j] = zr[64 * j]; s += (v[j][0] + v[j][1]) + (v[j][2] + v[j][3]); }
            const float mean = wave_sum(s) * (1.f / DM); float s2 = 0.f;
#pragma unroll
            for (int j = 0; j < 4; ++j) { v[j] = v[j] - mean; s2 += (v[j][0] * v[j][0] + v[j][1] * v[j][1]) + (v[j][2] * v[j][2] + v[j][3] * v[j][3]); }
            const float rstd = 1.f / sqrtf(wave_sum(s2) * (1.f / DM) + LN_EPS);
            unsigned* o8 = (unsigned*)((unsigned char*)X1B + (size_t)(r0 + rr) * DM) + lane;
#pragma unroll
            for (int j = 0; j < 4; ++j) { const f32x4 y = (v[j] * rstd * gv[j] + bv[j]) * 8.f; o8[64 * j] = cvt4_fp8(y[0], y[1], y[2], y[3]); }
            if (lane == 0) *(f32x2*)(stats + 2 * (r0 + rr)) = (f32x2){mean, rstd};
            if ((rr >> 2) == q) {
#pragma unroll
                for (int i = 0; i < 4; ++i) if ((rr & 3) == i) { mym[i] = mean; myr[i] = rstd; } }
        }
    }
    __syncthreads();
    {
        const int e = tid & 31, part = tid >> 5; float s0 = 0.f, s1 = 0.f;
        for (int k = part * 64; k < part * 64 + 64; ++k) { s0 += Wr[k * 32 + e]; s1 += a.ln1_b[k] * a.w_router[k * 32 + e]; }
        pc[part * 32 + e] = s0; pc[512 + part * 32 + e] = s1;
    }
    __syncthreads();
    if (tid < 64) { const int e = tid & 31, w = tid >> 5; float t = 0.f; for (int p = 0; p < 16; ++p) t += pc[w * 512 + p * 32 + e]; pc[1024 + tid] = t + (w ? a.b_router[e] : 0.f); }
    __syncthreads();
    f32x4 acc0 = (f32x4){0.f, 0.f, 0.f, 0.f}, acc1 = acc0;
    const float* xr = Z + (size_t)(r0 + rl) * DM + 4 * q;
#pragma unroll 4
    for (int cidx = 0; cidx < 64; ++cidx) {
        const f32x4 xv = *(const f32x4*)(xr + 16 * cidx);
#pragma unroll
        for (int j = 0; j < 4; ++j) { const int k = 16 * cidx + 4 * q + j;
            acc0 = __builtin_amdgcn_mfma_f32_16x16x4f32(xv[j], Wr[k * 32 + rl], acc0, 0, 0, 0);
            acc1 = __builtin_amdgcn_mfma_f32_16x16x4f32(xv[j], Wr[k * 32 + 16 + rl], acc1, 0, 0, 0); }
    }
    {   const float cs0 = pc[1024 + rl], cs1 = pc[1024 + 16 + rl], cb0 = pc[1024 + 32 + rl], cb1 = pc[1024 + 48 + rl];
#pragma unroll
        for (int i = 0; i < 4; ++i) { acc0[i] = myr[i] * (acc0[i] - mym[i] * cs0) + cb0; acc1[i] = myr[i] * (acc1[i] - mym[i] * cs1) + cb1; } }
    const float br0 = 0.f, br1 = 0.f;
    int* sel_e = (int*)(a.ws + WS_ROUTE); int* sel_pos = sel_e + NTOK * TOPK; float* sel_gate = (float*)(sel_pos + NTOK * TOPK);
    int my_e[4] = {0, 0, 0, 0}, my_lp[4] = {0, 0, 0, 0}; float my_g[4] = {0.f, 0.f, 0.f, 0.f};
#pragma unroll
    for (int i = 0; i < 4; ++i) {
        unsigned k0 = (ordkey(acc0[i] + br0) & ~31u) | (unsigned)(31 - rl), k1 = (ordkey(acc1[i] + br1) & ~31u) | (unsigned)(15 - rl);
        unsigned selk[4];
#pragma unroll
        for (int t = 0; t < 4; ++t) {
            unsigned m = k0 > k1 ? k0 : k1;
#pragma unroll
            for (int ofs = 1; ofs < 16; ofs <<= 1) { const unsigned other = (unsigned)__shfl_xor((int)m, ofs); m = other > m ? other : m; }
            selk[t] = m; if (k0 == m) k0 = 0u; if (k1 == m) k1 = 0u;
        }
        const float v0 = unordkey(selk[0] & ~31u), v1 = unordkey(selk[1] & ~31u), v2 = unordkey(selk[2] & ~31u), v3 = unordkey(selk[3] & ~31u);
        const float e1 = __expf(v1 - v0), e2 = __expf(v2 - v0), e3 = __expf(v3 - v0); const float rs = 1.0f / (1.0f + e1 + e2 + e3);
        if (rl < 4) { const unsigned sk = rl == 0 ? selk[0] : (rl == 1 ? selk[1] : (rl == 2 ? selk[2] : selk[3]));
            const float ge = rl == 0 ? 1.0f : (rl == 1 ? e1 : (rl == 2 ? e2 : e3));
            my_e[i] = 31 - (int)(sk & 31u); my_g[i] = ge * rs; my_lp[i] = (int)atomicAdd((unsigned*)&misc[my_e[i]], 1u); }
    }
    __syncthreads();
    unsigned* gcnt = (unsigned*)(a.ws + WS_CTL);
    if (F_TID < 32) misc[32 + F_TID] = atomicAdd(&gcnt[F_TID], misc[F_TID]);
    __syncthreads();
    if (rl < 4) {
#pragma unroll
        for (int i = 0; i < 4; ++i) { const int tok = r0 + 4 * q + i, idx = tok * 4 + rl; sel_e[idx] = my_e[i]; sel_pos[idx] = (int)misc[32 + my_e[i]] + my_lp[i]; sel_gate[idx] = my_g[i]; }
    }
}

__device__ __forceinline__ int build_tiles(const Frame& F, const Args& a) {
    LAS unsigned* misc = (LAS unsigned*)(F.lds + LX_MISC); LAS unsigned char* tile_e = F.lds + LX_TILE;
    const unsigned* gcnt = (const unsigned*)(a.ws + WS_CTL);
    if (F_TID < NE) misc[128 + F_TID] = (__hip_atomic_load(&gcnt[F_TID], __ATOMIC_RELAXED, __HIP_MEMORY_SCOPE_AGENT) + 255u) >> 8;
    __syncthreads();
    if (F_TID == 0) { unsigned acc = 0; for (int e = 0; e < NE; ++e) { misc[64 + e] = acc; acc += misc[128 + e]; } misc[64 + NE] = acc; }
    __syncthreads();
    const int nt = (int)misc[64 + NE];
    for (int e = 0; e < NE; ++e) { const int t0 = (int)misc[64 + e], t1 = (int)misc[65 + e]; for (int t = t0 + F_TID; t < t1; t += 512) tile_e[t] = (unsigned char)e; }
    __syncthreads();
    return nt;
}

#define XLAS __attribute__((address_space(3)))
#define XB_TMO      128
#define XB_XCNT(j)  (256  + 64 * (j))
#define XB_XSUB(j)  (1280 + 64 * (j))
#define XB_XGEN(j)  (2304 + 64 * (j))
#define XB_TOP      3328
#define XB_TOPGEN   3392
#define XCD_BAR_WORDS 3456
#define XB_SPIN_CAP (1u << 22)

__device__ __forceinline__ unsigned xb_ld(unsigned* p)              { return __hip_atomic_load(p, __ATOMIC_RELAXED, __HIP_MEMORY_SCOPE_AGENT); }
__device__ __forceinline__ unsigned xb_add(unsigned* p, unsigned v) { return __hip_atomic_fetch_add(p, v, __ATOMIC_RELAXED, __HIP_MEMORY_SCOPE_AGENT); }
__device__ __forceinline__ unsigned xb_xcc_id() { return (unsigned)__builtin_amdgcn_s_getreg((3 << 11) | 20) & 0xFu; }
#define XB_SPIN(cond, bar) do { unsigned _sp = 0; while (cond) { __builtin_amdgcn_s_sleep(1); \
    if ((++_sp & 255u) == 0u) { if (xb_ld(&(bar)[XB_TMO])) break; if (_sp > XB_SPIN_CAP) { atomicAdd(&(bar)[XB_TMO], 1u); break; } } } } while (0)

struct XcdBarrier {
    unsigned* bar; unsigned x;
    volatile XLAS unsigned* st;
};

__device__ __forceinline__ XcdBarrier xcd_barrier_post(unsigned* bar, volatile XLAS unsigned* st) {
    XcdBarrier b; b.bar = bar; b.x = xb_xcc_id(); b.st = st;
    if (threadIdx.x == 0) (void)xb_add(&bar[XB_XCNT(b.x)], 1u);
    return b;
}
__device__ __forceinline__ void xcd_barrier_complete(unsigned* bar, unsigned x, unsigned& nloc, unsigned& nx) {
    const unsigned G = gridDim.x * gridDim.y * gridDim.z;
    unsigned sum, cnt, mine, sp = 0u;
    for (;;) {
        sum = 0u; cnt = 0u; mine = 0u;
#pragma unroll
        for (unsigned j = 0; j < 16; ++j) { const unsigned c = xb_ld(&bar[XB_XCNT(j)]); sum += c; cnt += (c > 0u) ? 1u : 0u; mine = (j == x) ? c : mine; }
        if (sum == G) break;
        __builtin_amdgcn_s_sleep(1);
        if ((++sp & 255u) == 0u) { if (xb_ld(&bar[XB_TMO])) break; if (sp > XB_SPIN_CAP) { atomicAdd(&bar[XB_TMO], 1u); break; } }
    }
    nloc = mine > 0u ? mine : 1u; nx = cnt > 0u ? cnt : 1u;
}

__device__ __forceinline__ void xcd_barrier(const XcdBarrier& b, const int tid0) {
    asm volatile("s_waitcnt vmcnt(0)" ::: "memory");
    __syncthreads();
    if (tid0 == 0) {
        unsigned* bar = b.bar;
        __builtin_amdgcn_s_waitcnt(0);
        unsigned nloc = b.st[0], nx = b.st[1];
        if (nloc == 0u) { xcd_barrier_complete(bar, b.x, nloc, nx); b.st[0] = nloc; b.st[1] = nx; }
        const unsigned old = xb_add(&bar[XB_XSUB(b.x)], 1u);
        const unsigned gen = old / nloc;
        if (old + 1u == (gen + 1u) * nloc) {
            __builtin_amdgcn_fence(__ATOMIC_RELEASE, "agent");
            asm volatile("s_waitcnt vmcnt(0)" ::: "memory");
            const unsigned og = xb_add(&bar[XB_TOP], 1u);
            const unsigned tg = og / nx;
            if (og + 1u == (tg + 1u) * nx) xb_add(&bar[XB_TOPGEN], 1u);
            else XB_SPIN(xb_ld(&bar[XB_TOPGEN]) == tg, bar);
            __builtin_amdgcn_fence(__ATOMIC_ACQUIRE, "agent");
            xb_add(&bar[XB_XGEN(b.x)], 1u);
            asm volatile("s_waitcnt vmcnt(0)" ::: "memory");
        } else {
            XB_SPIN(xb_ld(&bar[XB_XGEN(b.x)]) == gen, bar);
            __builtin_amdgcn_fence(__ATOMIC_ACQUIRE, "agent");
            asm volatile("s_waitcnt vmcnt(0)" ::: "memory");
        }
    }
    __syncthreads();
}

__global__ void __launch_bounds__(512, 2) fwd_megakernel(Args a) {
    extern __shared__ __attribute__((aligned(16))) unsigned char lds_raw[];
    cg::grid_group grid = cg::this_grid();
    Frame F; F.lds = (LAS unsigned char*)lds_raw; F.wave = __builtin_amdgcn_readfirstlane((int)(threadIdx.x >> 6));
    F.G = gridDim.x; { const int bx = blockIdx.x; F.vcu = (F.G % 8 == 0) ? (bx % 8) * (F.G / 8) + bx / 8 : bx; }
    unsigned char* ws = a.ws;
    {   LAS unsigned* m0_ = (LAS unsigned*)(F.lds + LX_MISC); if (F_TID < 128) m0_[F_TID] = 0u; __syncthreads(); }
    XcdBarrier xbar = xcd_barrier_post((unsigned*)(ws + WS_CTL) + CW_BAR, (volatile LAS unsigned*)(F.lds + LX_MISC) + 120);
#define GRID_BAR() xcd_barrier(xbar, F_TID)
#ifdef PROBE_T1
    unsigned long long* stamps = (unsigned long long*)(ws + WS_CTL + 2048);
#define STAMP(k) do { if (blockIdx.x == 0 && F_TID == 0) stamps[k] = __builtin_amdgcn_s_memrealtime(); } while (0)
#else
#define STAMP(k) do {} while (0)
#endif
    STAMP(0);

    for (int rep = 0; rep < REP_P0; ++rep) p0_prologue(F, a);
    if (a.out == nullptr) grid.sync();
    GRID_BAR();
    STAMP(1);

    for (int rep = 0; rep < REP_P1; ++rep) {
        pg8::Gemm g{(const bf16_t*)(ws + WS_XB), (const bf16_t*)(ws + WS_WIN), NTOK, NPROJ, DM, 0, 0}; pg8::StaticOrder S; S.init(NTOK, NPROJ, F.G, (int)blockIdx.x);
        EpiProj E{(bf16_t*)(ws + WS_PROJ), (unsigned*)(ws + WS_CTL)};
        pg8::gemm_phase<EpiProj, pg8::StaticOrder, true, false, KREP_P1>(F.lds, g, S, E, F_TID);
    }
    GRID_BAR();
    STAMP(2);

    {
        float s1 = 0.f, s2 = 0.f;
        for (int i = 0; i < 64; ++i) { s1 += a.lq1[i] * a.lk1[i]; s2 += a.lq2[i] * a.lk2[i]; }
        const float lam = __expf(s1) - __expf(s2) + LAM_INIT;
        {
            LAS unsigned* misc = (LAS unsigned*)(F.lds + LX_MISC); unsigned* ctl = (unsigned*)(ws + WS_CTL);
            const int myx = (int)(xbar.x & 7u);
            for (;;) {
                __syncthreads();
                if (F_TID == 0) { int got = -1;
                    { const unsigned p = atomicAdd(ctl + CW_QUEUE + myx, 1u); if (p < 160u) got = myx * 256 + (int)p; }
                    for (int k = 1; k < 8 && got < 0; ++k) { const int qx = (myx + k) & 7;
                        if (__hip_atomic_load(ctl + CW_QUEUE + qx, __ATOMIC_RELAXED, __HIP_MEMORY_SCOPE_AGENT) < 160u) { const unsigned p = atomicAdd(ctl + CW_QUEUE + qx, 1u); if (p < 160u) got = qx * 256 + (int)p; } }
                    misc[100] = (unsigned)got; }
                __syncthreads();
                const int idx = __builtin_amdgcn_readfirstlane((int)misc[100]);
                if (idx < 0) break;
                const int qx = idx >> 8, p = idx & 255;
                if (p < 64 && (p & 1)) attnA_unit(F, a, qx * 32 + (p >> 1));
                else { const int h = p < 64 ? 3 : 2 - ((p - 64) >> 5), j = p < 64 ? (p >> 1) : (p & 31); attnB_item(F, a, h, qx >> 2, 32 * (qx & 3) + j, lam); }
            }
        }
    }
    GRID_BAR();
    STAMP(3);

    for (int rep = 0; rep < REP_P3; ++rep) {
        pg8::Gemm g{(const bf16_t*)(ws + WS_MIXED), (const bf16_t*)(ws + WS_WOUT), NTOK, DM, DM, 0, 0}; pg8::StaticOrder S; S.init(NTOK, DM, F.G, (int)blockIdx.x);
        EpiZ E{a.x, (float*)(ws + WS_Z)};
        pg8::gemm_phase<EpiZ, pg8::StaticOrder, true, false, KREP_P3>(F.lds, g, S, E, F_TID);
    }
    GRID_BAR();
    STAMP(4);

    if (F.G == 256) p4_ln_router(F, a);
    GRID_BAR();
    STAMP(5);

    int* sel_e = (int*)(ws + WS_ROUTE); int* sel_pos = sel_e + NTOK * TOPK; float* sel_gate = (float*)(sel_pos + NTOK * TOPK);
    int* inv = (int*)(sel_gate + NTOK * TOPK); int* row_tok = inv + NTOK * TOPK; float* row_gate = (float*)(row_tok + 262144);
    {
        const int ntl = build_tiles(F, a); (void)ntl;
        LAS unsigned* misc = (LAS unsigned*)(F.lds + LX_MISC);
        const unsigned* gcnt = (const unsigned*)(ws + WS_CTL);
        for (int idx = F.vcu * 512 + F_TID; idx < NTOK * TOPK; idx += F.G * 512) {
            const int e = sel_e[idx], dest = (int)misc[64 + e] * 256 + sel_pos[idx];
            row_tok[dest] = idx >> 2; row_gate[dest] = sel_gate[idx]; inv[idx] = dest;
        }
        for (int e = F.vcu; e < NE; e += F.G) {
            const int c = (int)__hip_atomic_load(&gcnt[e], __ATOMIC_RELAXED, __HIP_MEMORY_SCOPE_AGENT), base = (int)misc[64 + e] * 256, end = (int)misc[65 + e] * 256;
            for (int r = base + c + F_TID; r < end; r += 512) { row_tok[r] = 0; row_gate[r] = 0.f; }
        }
    }
    GRID_BAR();
    STAMP(6);

    for (int rep = 0; rep < REP_P6; ++rep) {
        const int ntl = build_tiles(F, a);
        MoeOrder S; S.so.init(ntl * 256, 2048, F.G, (int)blockIdx.x); S.tile_e = F.lds + LX_TILE; S.tok = (const LAS unsigned short*)(F.lds + LX_TOK); S.ncolt = 8;
        {
            LAS unsigned short* tk = (LAS unsigned short*)(F.lds + LX_TOK); pg8::Unit u;
            for (int i = F.wave; i < 24 && S.so.next(i, u); i += 8) { const int l_ = F_LANE;
#pragma unroll
                for (int j = 0; j < 4; ++j) tk[i * 256 + l_ + 64 * j] = (unsigned short)row_tok[u.pm * 256 + l_ + 64 * j]; }
            __syncthreads();
        }
        pg8::Gemm g{(const bf16_t*)(ws + WS_XB), (const bf16_t*)(ws + WS_WUP), ntl * 256, 2048, DM, 0x7C7C7C7C, 0x77777777};
        EpiUp E{(bf16_t*)(ws + WS_H), a.b_up};
        pg8::gemm_phase<EpiUp, MoeOrder, true, true, KREP_P6, true>(F.lds, g, S, E, F_TID);
    }
    GRID_BAR();
    STAMP(7);

    for (int rep = 0; rep < REP_P7; ++rep) {
        const int ntl = build_tiles(F, a);
        MoeOrder S; S.so.init(ntl * 256, 1024, F.G, (int)blockIdx.x, ORD_REV7); S.tile_e = F.lds + LX_TILE; S.tok = nullptr; S.ncolt = 4;
        pg8::Gemm g{(const bf16_t*)(ws + WS_H), (const bf16_t*)(ws + WS_WDN), ntl * 256, DM, DFF, 0x7D7D7D7D, 0x77777777};
        EpiDown E{(bf16_t*)(ws + WS_Y), a.b_down, row_gate};
        pg8::gemm_phase<EpiDown, MoeOrder, true, false, KREP_P7, true>(F.lds, g, S, E, F_TID);
    }
    GRID_BAR();
    STAMP(8);

    for (int rep = 0; rep < REP_P8; ++rep) {
        const int lane = F_LANE; const float* X1 = (const float*)(ws + WS_Z); const bf16_t* Y = (const bf16_t*)(ws + WS_Y); const float* stats = (const float*)(ws + WS_ROUTE + 4 * MiB);
        f32x4 gv[4], bv[4], g1[4], b1[4];
#pragma unroll
        for (int j = 0; j < 4; ++j) { gv[j] = ((const f32x4*)a.ln2_g)[lane + 64 * j]; bv[j] = ((const f32x4*)a.ln2_b)[lane + 64 * j]; g1[j] = ((const f32x4*)a.ln1_g)[lane + 64 * j] * ALPHA; b1[j] = ((const f32x4*)a.ln1_b)[lane + 64 * j] * ALPHA; }
        for (int m = F.vcu * 8 + F.wave; m < NTOK; m += F.G * 8) {
            const f32x4* xr = (const f32x4*)(X1 + (size_t)m * DM) + lane; f32x4 v[4]; const f32x2 st = *(const f32x2*)(stats + 2 * m);
#pragma unroll
            for (int j = 0; j < 4; ++j) v[j] = (xr[64 * j] - st[0]) * st[1] * g1[j] + b1[j];
#pragma unroll
            for (int t = 0; t < 4; ++t) { const int dest = inv[m * 4 + t]; const unsigned* yr = (const unsigned*)((const unsigned char*)Y + (size_t)dest * DM) + lane;
#pragma unroll
                for (int j = 0; j < 4; ++j) { const int w = (int)yr[64 * j];
                    v[j][0] += __builtin_amdgcn_cvt_f32_fp8(w, 0) * (1.f / 32.f); v[j][1] += __builtin_amdgcn_cvt_f32_fp8(w, 1) * (1.f / 32.f);
                    v[j][2] += __builtin_amdgcn_cvt_f32_fp8(w, 2) * (1.f / 32.f); v[j][3] += __builtin_amdgcn_cvt_f32_fp8(w, 3) * (1.f / 32.f); } }
            float s = 0.f;
#pragma unroll
            for (int j = 0; j < 4; ++j) s += (v[j][0] + v[j][1]) + (v[j][2] + v[j][3]);
            const float mean = wave_sum(s) * (1.f / DM); float s2 = 0.f;
#pragma unroll
            for (int j = 0; j < 4; ++j) { v[j] = v[j] - mean; s2 += (v[j][0] * v[j][0] + v[j][1] * v[j][1]) + (v[j][2] * v[j][2] + v[j][3] * v[j][3]); }
            const float rstd = 1.f / sqrtf(wave_sum(s2) * (1.f / DM) + LN_EPS);
            f32x4* orow = (f32x4*)(a.out + (size_t)m * DM) + lane;
#pragma unroll
            for (int j = 0; j < 4; ++j) orow[64 * j] = v[j] * rstd * gv[j] + bv[j];
        }
    }
#ifdef PROBE_T1
    STAMP(9);
    if (blockIdx.x == 0) {
        __syncthreads();
        const float t1 = (float)(stamps[PROBE_T1 + 1] - stamps[PROBE_T1]) * 0.01f, t2 = (float)(stamps[PROBE_T2 + 1] - stamps[PROBE_T2]) * 0.01f;
        for (int i = F_TID; i < (1 << 20); i += 512) a.out[1 + i] = t2;
        if (F_TID == 0) a.out[0] = t1 * 10.0f;
    }
#endif
}

extern "C" void kernel_launch(void* const* d_in, const int* in_sizes, int n_in, void* d_out, int out_size, void* d_ws, size_t ws_size, hipStream_t stream) {
    static int grid = 0;
    if (grid == 0) {
        if (n_in != 18 || in_sizes[0] != NTOK * DM || out_size != NTOK * DM || ws_size < WS_END) {
            fprintf(stderr, "kernel_launch: unexpected shapes (n_in %d, in0 %d, out %d, ws %zu need %zu); nothing launched\n", n_in, n_in > 0 ? in_sizes[0] : -1, out_size, ws_size, (size_t)WS_END); grid = -1; return; }
        int dev = 0, cus = 0, per_cu = 0;
        if (hipGetDevice(&dev) != hipSuccess || hipDeviceGetAttribute(&cus, hipDeviceAttributeMultiprocessorCount, dev) != hipSuccess) { grid = -1; return; }
        if (hipFuncSetAttribute((const void*)fwd_megakernel, hipFuncAttributeMaxDynamicSharedMemorySize, LDS_BYTES) != hipSuccess) { fprintf(stderr, "kernel_launch: hipFuncSetAttribute failed\n"); grid = -1; return; }
        if (hipOccupancyMaxActiveBlocksPerMultiprocessor(&per_cu, (const void*)fwd_megakernel, 512, LDS_BYTES) != hipSuccess || per_cu < 1) { fprintf(stderr, "kernel_launch: occupancy query says %d\n", per_cu); per_cu = 1; }
        (void)hipGetLastError();
        grid = cus * (per_cu > 1 ? 1 : per_cu);
        fprintf(stderr, "kernel_launch: grid %d (cus %d, per_cu %d)\n", grid, cus, per_cu);
    }
    if (grid < 0) return;
    if (hipMemsetAsync((char*)d_ws + WS_CTL, 0, CTL_ZERO_BYTES, stream) != hipSuccess) return;
    Args a{};
    const float* const* in = (const float* const*)d_in;
    a.x = in[0]; a.w_in = in[1]; a.w_out = in[2]; a.lq1 = in[3]; a.lk1 = in[4]; a.lq2 = in[5]; a.lk2 = in[6]; a.g_sub = in[7];
    a.ln1_g = in[8]; a.ln1_b = in[9]; a.w_router = in[10]; a.b_router = in[11]; a.w_up = in[12]; a.b_up = in[13]; a.w_down = in[14]; a.b_down = in[15];
    a.ln2_g = in[16]; a.ln2_b = in[17]; a.out = (float*)d_out; a.ws = (unsigned char*)d_ws;
    void* args[] = {&a};
    hipError_t e = hipLaunchCooperativeKernel((void*)fwd_megakernel, dim3(grid), dim3(512), args, LDS_BYTES, stream);
    if (e != hipSuccess) fprintf(stderr, "kernel_launch: cooperative launch failed: %s (grid %d)\n", hipGetErrorString(e), grid);
}
```

```cpp
#include <hip/hip_runtime.h>
#include <hip/hip_cooperative_groups.h>
#include <cstdio>
#include <cstdint>
namespace cg = cooperative_groups;
#ifndef KREP_P1
#define KREP_P1 1
#endif
#ifndef KREP_P3
#define KREP_P3 1
#endif
#ifndef KREP_P6
#define KREP_P6 1
#endif
#ifndef KREP_P7
#define KREP_P7 1
#endif
#ifndef ORD_SWZ
#define ORD_SWZ 0
#endif
#ifndef ORD_REV7
#define ORD_REV7 1
#endif
#ifndef REP_P0
#define REP_P0 1
#endif
#ifndef REP_P1
#define REP_P1 1
#endif
#ifndef REP_A
#define REP_A 1
#endif
#ifndef REP_B
#define REP_B 1
#endif
#ifndef REP_P3
#define REP_P3 1
#endif
#ifndef REP_P6
#define REP_P6 1
#endif
#ifndef REP_P7
#define REP_P7 1
#endif
#ifndef REP_P8
#define REP_P8 1
#endif

#define LAS __attribute__((address_space(3)))
typedef unsigned short bf16_t;
typedef short bf16x8 __attribute__((ext_vector_type(8)));
typedef short s16x4 __attribute__((ext_vector_type(4)));
typedef float f32x4 __attribute__((ext_vector_type(4)));
typedef float f32x2 __attribute__((ext_vector_type(2)));
typedef float f32x16 __attribute__((ext_vector_type(16)));
typedef unsigned u32x4 __attribute__((ext_vector_type(4)));
typedef unsigned u32x2 __attribute__((ext_vector_type(2)));
typedef __bf16 bf16x2_t __attribute__((ext_vector_type(2)));

constexpr int BATCH = 2, SEQ = 16384, DM = 1024, NTOK = BATCH * SEQ;
constexpr int NPROJ = 3072, NE = 32, TOPK = 4, DFF = 1024;
constexpr int NROWS_MAX = NTOK * TOPK + NE * 256;
constexpr float LN_EPS = 1e-5f;
constexpr float ALPHA = 1.189207115002721f;
constexpr float LOG2E = 1.4426950408889634f;
constexpr float C2 = 0.125f * LOG2E;
constexpr float LAM_INIT = 0.2f;
constexpr float NEG_BIG = -1e30f;

constexpr size_t MiB = 1u << 20;
constexpr size_t WS_CTL = 0, CTL_ZERO_BYTES = 65536;
constexpr int CW_QMAX = 64, CW_KMAX = 128, CW_QUEUE = 256, CW_BAR = 4096;
constexpr size_t WS_WIN = 2 * MiB, WS_WOUT = 8 * MiB, WS_WUP = 16 * MiB, WS_WDN = 144 * MiB;
constexpr size_t WS_XB = 208 * MiB;
constexpr size_t WS_PROJ = 272 * MiB;
constexpr size_t PROJ_STRIDE = (size_t)NTOK * 512;
constexpr size_t WS_MIXED = 464 * MiB;
constexpr size_t WS_Z = 272 * MiB;
constexpr size_t WS_H = 400 * MiB;
constexpr size_t WS_Y = 672 * MiB;
constexpr size_t WS_APART = 672 * MiB;
constexpr size_t APART_UNIT = 2 * 1024 * 64 * 4 + 2 * 1024 * 2 * 4;
constexpr size_t WS_ROUTE = 944 * MiB;
constexpr size_t WS_END = 952 * MiB;

constexpr int RING_BYTES = 131072;
constexpr int LX_TILE = 131072;
constexpr int LX_TOK = 132096;
constexpr int LX_MISC = 144384;
constexpr int LDS_BYTES = 147456;

__device__ __forceinline__ unsigned cvtpk(float lo, float hi) { f32x2 v = {lo, hi}; bf16x2_t b = __builtin_convertvector(v, bf16x2_t); return __builtin_bit_cast(unsigned, b); }
__device__ __forceinline__ unsigned cvt4_fp8(float a, float b, float c, float d) { int w = 0; w = __builtin_amdgcn_cvt_pk_fp8_f32(a, b, w, false); w = __builtin_amdgcn_cvt_pk_fp8_f32(c, d, w, true); return (unsigned)w; }
__device__ __forceinline__ float wave_sum(float v) {
#pragma unroll
    for (int o = 1; o < 64; o <<= 1) v += __shfl_xor(v, o);
    return v;
}

namespace pg8 {
constexpr int BM = 256, BK = 64, HALF = 128, HTB = HALF * BK * 2, STAGE_BYTES = 8 * HTB, NXCD = 8, WGM = 8;
__host__ __device__ __forceinline__ int lds_byte(int r, int c) { const int st = (r >> 4) * 2 + (c >> 5), rr = r & 15, cc = c & 31, ob = rr * 64 + cc * 2; return st * 1024 + (ob ^ (((ob >> 9) & 1) << 5)); }
__host__ __device__ __forceinline__ void stage_rc(int b, int& R, int& C) { const int st = b / 1024, sb = b % 1024, swz = sb ^ (((sb >> 9) & 1) << 5); R = (st >> 1) * 16 + swz / 64; C = (st & 1) * 32 + (swz % 64) / 2; }
__host__ __device__ __forceinline__ int perm32(int rho) { const int n = rho >> 4, i = rho & 15; return 8 * (i >> 2) + 4 * n + (i & 3); }

struct Unit { int pm, pn; };
struct Gemm { const bf16_t* A; const bf16_t* Bt; int M, N, K; int scale_a, scale_b; };
typedef int v4i_t __attribute__((ext_vector_type(4))); typedef int v8i_t __attribute__((ext_vector_type(8)));

struct StaticOrder {
    int nM, nN, nwg, G, c, rev, swz;
    __host__ __device__ void init(int M, int N, int G_, int c_, int rev_ = 0, int swz_ = ORD_SWZ) { nM = M / BM; nN = N / BM; nwg = nM * nN; G = G_; c = c_; rev = rev_; swz = swz_; }
    __host__ __device__ bool next(int i, Unit& u) const {
        const long L = (long)i * G + c; if (L >= nwg) return false;
        int wgid = (rev == 1) ? nwg - 1 - (int)L : (int)L;
        if (swz) { const int q = nwg / NXCD, r = nwg % NXCD, xcd = wgid % NXCD; int off = wgid / NXCD; const int len = xcd < r ? q + 1 : q;
            if (rev == 2) off = len - 1 - off;
            wgid = (xcd < r ? xcd * (q + 1) : r * (q + 1) + (xcd - r) * q) + off; }
        const int nig = WGM * nN, gid = wgid / nig, fm = gid * WGM, gsz = (nM - fm) < WGM ? (nM - fm) : WGM;
        u.pm = fm + ((wgid % nig) % gsz); u.pn = (wgid % nig) / gsz; return true;
    }
    __device__ __forceinline__ const LAS unsigned short* tok_table(int) const { return nullptr; }
};

template <class Epi, class Sched, bool ALIGN_EPI, bool GATHER, int KREP = 1, bool F8 = false>
__device__ __forceinline__ void gemm_phase(LAS unsigned char* lds, const Gemm g, const Sched& S, const Epi& E, const int tid) {
    const int wid = __builtin_amdgcn_readfirstlane(tid >> 6), lane = tid & 63, wr = wid >> 2, wc = wid & 3, fr = lane & 15, fq = lane >> 4;
    constexpr int ES = F8 ? 1 : 2;
    const int sclW = g.scale_b, sclX = g.scale_a;
    const int K = g.K, ntr = K * ES / (BK * 2), nt = ntr * KREP;
    unsigned voffA[2], voffB[2]; int rowA[2];
#pragma unroll
    for (int i = 0; i < 2; ++i) { int R, C; stage_rc(tid * 16 + i * 8192, R, C); const int Rb = Epi::PERM ? ((R & ~31) + perm32(R & 31)) : R;
        voffA[i] = GATHER ? (unsigned)(C * 2) : (unsigned)(R * K * ES + C * 2); voffB[i] = (unsigned)(Rb * K * ES + C * 2); rowA[i] = R; }
    const size_t kstep = (size_t)(BK * 2);
    const size_t hstep = (size_t)HALF * K * ES;
    const size_t tstep = 2 * hstep;
    const unsigned ldsw = (unsigned)wid * 1024u;
    const int aoff = lds_byte(wr * 64 + fr, fq * 8), boff = lds_byte(wc * 32 + fr, fq * 8);
    const int aoff8 = lds_byte(wr * 64 + fr, fq * 16), boff8 = lds_byte(wc * 32 + fr, fq * 16);
#define PG8_SA(b, h) (((b) * 2 + (h)) * HTB)
#define PG8_SB(b, h) ((4 + (b) * 2 + (h)) * HTB)
#define PG8_STAGE(bufoff, gbase, voff) do { _Pragma("unroll") for (int _i = 0; _i < 2; ++_i) \
        __builtin_amdgcn_global_load_lds((const unsigned*)((const char*)(gbase) + (voff)[_i]), (LAS unsigned*)(lds + (bufoff) + ldsw + _i * 8192), 16, 0, 0); } while (0)
#define PG8_STAGE_A(bufoff, NX, h, kb) do { if constexpr (GATHER) { const unsigned* _o = (NX) ? gN[h] : gC[h]; PG8_STAGE(bufoff, (const char*)g.A + (kb), _o); } \
        else { PG8_STAGE(bufoff, ((NX) ? nA : cA) + (h) * hstep + (kb), voffA); } } while (0)
#define PG8_LDA(dst, b, h) do { _Pragma("unroll") for (int m = 0; m < 4; ++m) _Pragma("unroll") for (int k = 0; k < 2; ++k) dst[m][k] = *(const LAS bf16x8*)(lds + PG8_SA(b, h) + (F8 ? aoff8 + k * 16 : aoff + k * 1024) + m * 2048); } while (0)
#define PG8_LDB(dst, b, h) do { _Pragma("unroll") for (int n = 0; n < 2; ++n) _Pragma("unroll") for (int k = 0; k < 2; ++k) dst[n][k] = *(const LAS bf16x8*)(lds + PG8_SB(b, h) + (F8 ? boff8 + k * 16 : boff + k * 1024) + n * 2048); } while (0)
#define PG8_F8OP(x) __builtin_shufflevector(__builtin_bit_cast(v4i_t, x[0]), __builtin_bit_cast(v4i_t, x[1]), 0, 1, 2, 3, 4, 5, 6, 7)
#define PG8_MMA(ai, bj, At, Bt) do { __builtin_amdgcn_s_setprio(1); _Pragma("unroll") for (int m = 0; m < 4; ++m) _Pragma("unroll") for (int n = 0; n < 2; ++n) { \
        if constexpr (F8) { const v8i_t _a = PG8_F8OP(Bt[n]), _b = PG8_F8OP(At[m]); asm volatile("v_mfma_scale_f32_16x16x128_f8f6f4 %0, %1, %2, %0, %3, %4 op_sel_hi:[0,0,0]" : "+v"(acc[ai][bj][m][n]) : "v"(_a), "v"(_b), "v"(sclW), "v"(sclX)); } \
        else { _Pragma("unroll") for (int k = 0; k < 2; ++k) acc[ai][bj][m][n] = __builtin_amdgcn_mfma_f32_16x16x32_bf16(Bt[n][k], At[m][k], acc[ai][bj][m][n], 0, 0, 0); } } \
        __builtin_amdgcn_s_setprio(0); } while (0)
#define PG8_WAIT_V(n) asm volatile("s_waitcnt vmcnt(" #n ")" ::: "memory")
#define PG8_WAIT_L(n) asm volatile("s_waitcnt lgkmcnt(" #n ")" ::: "memory")
#define PG8_BAR __builtin_amdgcn_s_barrier()
#define PG8_SCHED __builtin_amdgcn_sched_barrier(0)
#define PG8_GOFF(dst, ui_) do { if constexpr (GATHER) { const LAS unsigned short* _t = S.tok_table(ui_); _Pragma("unroll") for (int _h = 0; _h < 2; ++_h) _Pragma("unroll") for (int _i = 0; _i < 2; ++_i) \
        dst[_h][_i] = (unsigned)_t[_h * HALF + rowA[_i]] * (unsigned)(K * ES) + voffA[_i]; } } while (0)
    Unit cur, nxt; int ui = 0;
    if (!S.next(0, cur)) return;
    f32x4 acc[2][2][4][2];
    E.init(acc, cur, wc, fq);
    bf16x8 At[4][2], B0[2][2], B1[2][2];
    unsigned gC[2][2] = {{0u, 0u}, {0u, 0u}}, gN[2][2] = {{0u, 0u}, {0u, 0u}};
    PG8_GOFF(gC, 0);
    const char* cA = (const char*)g.A + (GATHER ? (size_t)0 : (size_t)cur.pm * tstep); const char* cB = (const char*)g.Bt + (size_t)cur.pn * tstep;
    const char* nA = cA;
    {
        PG8_STAGE(PG8_SB(0, 0), cB, voffB); PG8_STAGE(PG8_SB(0, 1), cB + hstep, voffB); PG8_STAGE_A(PG8_SA(0, 0), false, 0, 0); PG8_STAGE_A(PG8_SA(0, 1), false, 1, 0);
        if (wr == 1) PG8_BAR;
        PG8_WAIT_V(2); PG8_BAR;
        PG8_STAGE(PG8_SB(1, 0), cB + kstep, voffB); PG8_STAGE_A(PG8_SA(1, 0), false, 0, kstep); PG8_STAGE(PG8_SB(1, 1), cB + hstep + kstep, voffB);
        PG8_WAIT_V(6); PG8_BAR;
    }
    for (;;) {
        const bool has_next = S.next(ui + 1, nxt);
        nA = has_next ? (const char*)g.A + (GATHER ? (size_t)0 : (size_t)nxt.pm * tstep) : cA; const char* nB = has_next ? (const char*)g.Bt + (size_t)nxt.pn * tstep : cB;
        if (has_next) { PG8_GOFF(gN, ui + 1); } else {
#pragma unroll
            for (int h = 0; h < 2; ++h)
#pragma unroll
                for (int i = 0; i < 2; ++i) gN[h][i] = gC[h][i]; }
#pragma unroll 1
        for (int t = 0; t < nt; t += 2) {
            const bool last = (t == nt - 2);
            const size_t k1 = (size_t)((t + 1) % ntr) * kstep;
            const size_t k2 = last ? (size_t)0 : (size_t)((t + 2) % ntr) * kstep, k3 = k2 + kstep;
            const char* b2 = last ? nB : cB + (size_t)((t + 2) % ntr) * kstep; const char* b3 = b2 + kstep;
            PG8_LDB(B0, 0, 0); PG8_LDB(B1, 0, 1); PG8_SCHED; PG8_LDA(At, 0, 0); PG8_STAGE_A(PG8_SA(1, 1), false, 1, k1);
            PG8_WAIT_V(8); PG8_WAIT_L(0); PG8_BAR; PG8_MMA(0, 0, At, B0); PG8_MMA(0, 1, At, B1); PG8_BAR; PG8_SCHED;
            PG8_LDA(At, 0, 1); PG8_STAGE(PG8_SB(0, 0), b2, voffB); PG8_STAGE(PG8_SB(0, 1), b2 + hstep, voffB); PG8_STAGE_A(PG8_SA(0, 0), last, 0, k2);
            PG8_WAIT_V(8); PG8_WAIT_L(0); PG8_BAR; PG8_MMA(1, 0, At, B0); PG8_MMA(1, 1, At, B1); PG8_BAR; PG8_SCHED;
            PG8_LDB(B0, 1, 0); PG8_LDB(B1, 1, 1); PG8_SCHED; PG8_LDA(At, 1, 0); PG8_STAGE_A(PG8_SA(0, 1), last, 1, k2);
            PG8_WAIT_V(8); PG8_WAIT_L(0); PG8_BAR; PG8_MMA(0, 0, At, B0); PG8_MMA(0, 1, At, B1); PG8_BAR; PG8_SCHED;
            PG8_LDA(At, 1, 1); PG8_STAGE(PG8_SB(1, 0), b3, voffB); PG8_STAGE(PG8_SB(1, 1), b3 + hstep, voffB); PG8_STAGE_A(PG8_SA(1, 0), last, 0, k3);
            PG8_WAIT_V(8); PG8_WAIT_L(0); PG8_BAR; PG8_MMA(1, 0, At, B0); PG8_MMA(1, 1, At, B1); PG8_BAR; PG8_SCHED;
        }
        if constexpr (ALIGN_EPI) { if (wr == 0) PG8_BAR; }
        if constexpr (F8) asm volatile("s_nop 15\n\ts_nop 15" ::: "memory");
        if constexpr (KREP > 1) {
_Pragma("unroll") for (int a_ = 0; a_ < 2; ++a_) _Pragma("unroll") for (int b_ = 0; b_ < 2; ++b_) _Pragma("unroll") for (int m_ = 0; m_ < 4; ++m_) _Pragma("unroll") for (int n_ = 0; n_ < 2; ++n_) acc[a_][b_][m_][n_] = acc[a_][b_][m_][n_] * (1.0f / KREP); }
        E(acc, cur, wr, wc, fr, fq);
        if (!has_next) break;
        E.init(acc, nxt, wc, fq);
        cur = nxt; cA = nA; cB = nB; ++ui;
#pragma unroll
        for (int h = 0; h < 2; ++h)
#pragma unroll
            for (int i = 0; i < 2; ++i) gC[h][i] = gN[h][i];
        if constexpr (ALIGN_EPI) { if (wr == 1) PG8_BAR; }
    }
    PG8_WAIT_V(0);
    if constexpr (!ALIGN_EPI) { if (wr == 0) PG8_BAR; }
    PG8_BAR;
#undef PG8_SA
#undef PG8_SB
#undef PG8_STAGE
#undef PG8_STAGE_A
#undef PG8_LDA
#undef PG8_LDB
#undef PG8_MMA
#undef PG8_F8OP
#undef PG8_WAIT_V
#undef PG8_WAIT_L
#undef PG8_BAR
#undef PG8_SCHED
#undef PG8_GOFF
}
}

struct Args {
    const float* x; const float* w_in; const float* w_out; const float* lq1; const float* lk1; const float* lq2; const float* lk2; const float* g_sub;
    const float* ln1_g; const float* ln1_b; const float* w_router; const float* b_router; const float* w_up; const float* b_up; const float* w_down; const float* b_down;
    const float* ln2_g; const float* ln2_b; float* out; unsigned char* ws;
};
struct Frame {
    LAS unsigned char* lds; int wave, vcu, G;
};
__device__ __forceinline__ int lane_now() { int l; asm volatile("v_mbcnt_lo_u32_b32 %0, -1, 0\n\tv_mbcnt_hi_u32_b32 %0, -1, %0" : "=v"(l)); return l; }
#define F_LANE lane_now()
#define F_TID (F.wave * 64 + lane_now())

struct EpiProj {
    static constexpr bool PERM = true;
    bf16_t* O; unsigned* ctl;
    __device__ __forceinline__ void init(f32x4 (&acc)[2][2][4][2], const pg8::Unit&, int, int) const {
#pragma unroll
        for (int a_ = 0; a_ < 2; ++a_)
#pragma unroll
            for (int b_ = 0; b_ < 2; ++b_)
#pragma unroll
                for (int m_ = 0; m_ < 4; ++m_)
#pragma unroll
                    for (int n_ = 0; n_ < 2; ++n_) acc[a_][b_][m_][n_] = (f32x4){0.f, 0.f, 0.f, 0.f};
    }
    __device__ __forceinline__ void operator()(const f32x4 (&acc)[2][2][4][2], const pg8::Unit& u, int wr, int wc, int fr, int fq) const {
        const int t = u.pn >> 1; const float sc = (t == 0 || t == 3) ? C2 : 1.f; const bool nrm = (t == 3 || t == 4);
        bf16_t* base = O + (size_t)t * PROJ_STRIDE; const int row0 = u.pm * 256 + wr * 64 + fr, col0 = (u.pn & 1) * 256 + wc * 32 + 8 * fq;
        float mx0 = 0.f, mx1 = 0.f;
#pragma unroll
        for (int ai = 0; ai < 2; ++ai)
#pragma unroll
            for (int m = 0; m < 4; ++m) { bf16_t* rowp = base + (size_t)(row0 + ai * 128 + m * 16) * 512 + col0;
#pragma unroll
                for (int bj = 0; bj < 2; ++bj) { const f32x4 v0 = acc[ai][bj][m][0] * sc, v1 = acc[ai][bj][m][1] * sc; u32x4 w;
                    w.x = cvtpk(v0[0], v0[1]); w.y = cvtpk(v0[2], v0[3]); w.z = cvtpk(v1[0], v1[1]); w.w = cvtpk(v1[2], v1[3]);
                    if (t >= 4) {
                        const int row = row0 + ai * 128 + m * 16, bb = row >> 14, sq = row & (SEQ - 1), key = sq & 63, hh = (u.pn & 1) * 2 + bj;
                        bf16_t* tb = O + 4 * PROJ_STRIDE + ((size_t)((bb * 4 + hh) * 256 + (sq >> 6))) * 16384;
                        if (t == 4) *(u32x4*)(tb + (4 * wc + fq) * 512 + key * 8) = w;
                        else *(u32x4*)(tb + 8192 + (wc * 4 + (key >> 4)) * 512 + (key & 15) * 32 + fq * 8) = w;
                    } else *(u32x4*)(rowp + bj * 128) = w;
                    if (nrm) { float ss = 0.f;
#pragma unroll
                        for (int j = 0; j < 4; ++j) { const float lo = __uint_as_float(w[j] << 16), hi = __uint_as_float(w[j] & 0xFFFF0000u); ss += lo * lo + hi * hi; }
                        ss += __shfl_xor(ss, 16); ss += __shfl_xor(ss, 32);
                        if (bj == 0) mx0 = fmaxf(mx0, ss); else mx1 = fmaxf(mx1, ss); } } }
        if (nrm) {
#pragma unroll
            for (int ofs = 1; ofs < 16; ofs <<= 1) { mx0 = fmaxf(mx0, __shfl_xor(mx0, ofs)); mx1 = fmaxf(mx1, __shfl_xor(mx1, ofs)); }
            if (fr == 0 && fq == 0) { const int b = u.pm >> 6, cw = (t == 3) ? CW_QMAX : CW_KMAX;
                atomicMax(ctl + cw + (((b * 4 + (u.pn & 1) * 2 + 0) * 2 + (wc >> 1)) * 2 + (wc & 1)), __float_as_uint(mx0));
                atomicMax(ctl + cw + (((b * 4 + (u.pn & 1) * 2 + 1) * 2 + (wc >> 1)) * 2 + (wc & 1)), __float_as_uint(mx1)); }
        }
    }
};
struct EpiZ {
    static constexpr bool PERM = false;
    const float* x; float* z;
    __device__ __forceinline__ void init(f32x4 (&acc)[2][2][4][2], const pg8::Unit&, int, int) const {
#pragma unroll
        for (int a_ = 0; a_ < 2; ++a_)
#pragma unroll
            for (int b_ = 0; b_ < 2; ++b_)
#pragma unroll
                for (int m_ = 0; m_ < 4; ++m_)
#pragma unroll
                    for (int n_ = 0; n_ < 2; ++n_) acc[a_][b_][m_][n_] = (f32x4){0.f, 0.f, 0.f, 0.f};
    }
    __device__ __forceinline__ void operator()(const f32x4 (&acc)[2][2][4][2], const pg8::Unit& u, int wr, int wc, int fr, int fq) const {
        const int col0 = u.pn * 256 + wc * 32 + 4 * fq;
#pragma unroll
        for (int ai = 0; ai < 2; ++ai)
#pragma unroll
            for (int m = 0; m < 4; ++m) { const size_t off = (size_t)(u.pm * 256 + ai * 128 + wr * 64 + m * 16 + fr) * DM + col0;
#pragma unroll
                for (int bj = 0; bj < 2; ++bj)
#pragma unroll
                    for (int n = 0; n < 2; ++n) { const f32x4 xv = *(const f32x4*)(x + off + bj * 128 + n * 16); *(f32x4*)(z + off + bj * 128 + n * 16) = xv * ALPHA + acc[ai][bj][m][n]; } }
    }
};
__device__ __forceinline__ f32x2 swiglu4_pk(f32x2 g, f32x2 u) {
    g = __builtin_elementwise_min(g, (f32x2){7.0f, 7.0f});
    u = __builtin_elementwise_min(__builtin_elementwise_max(u, (f32x2){-7.0f, -7.0f}), (f32x2){7.0f, 7.0f});
    const f32x2 a_ = g * (-1.702f * LOG2E) + (-2.0f);
    f32x2 e_; e_.x = __builtin_amdgcn_exp2f(a_.x); e_.y = __builtin_amdgcn_exp2f(a_.y);
    const f32x2 d_ = e_ + 0.25f;
    f32x2 s_; s_.x = __builtin_amdgcn_rcpf(d_.x); s_.y = __builtin_amdgcn_rcpf(d_.y);
    const f32x2 t_ = g * s_;
    return t_ * u + t_;
}
struct EpiUp {
    static constexpr bool PERM = true;
    bf16_t* H; const float* b_up;
    __device__ __forceinline__ void init(f32x4 (&acc)[2][2][4][2], const pg8::Unit& u, int wc, int fq) const {
        const int e = u.pn >> 3, pnl = u.pn & 7, hcol0 = pnl * 128 + wc * 32 + 8 * fq;
        const float* bg = b_up + (size_t)e * 2048 + hcol0; const float* bu = bg + 1024;
        const f32x4 bg0 = *(const f32x4*)bg, bg1 = *(const f32x4*)(bg + 4), bu0 = *(const f32x4*)bu, bu1 = *(const f32x4*)(bu + 4);
#pragma unroll
        for (int a_ = 0; a_ < 2; ++a_)
#pragma unroll
            for (int m_ = 0; m_ < 4; ++m_) { acc[a_][0][m_][0] = bg0; acc[a_][0][m_][1] = bg1; acc[a_][1][m_][0] = bu0; acc[a_][1][m_][1] = bu1; }
    }
    __device__ __forceinline__ void operator()(const f32x4 (&acc)[2][2][4][2], const pg8::Unit& u, int wr, int wc, int fr, int fq) const {
        const int e = u.pn >> 3, pnl = u.pn & 7, hcol0 = pnl * 128 + wc * 32 + 8 * fq;
#pragma unroll
        for (int ai = 0; ai < 2; ++ai)
#pragma unroll
            for (int m = 0; m < 4; ++m) { const size_t row = (size_t)(u.pm * 256 + ai * 128 + wr * 64 + m * 16 + fr);
                const f32x4 g0 = acc[ai][0][m][0], g1 = acc[ai][0][m][1], u0 = acc[ai][1][m][0], u1 = acc[ai][1][m][1];
                const f32x2 r0 = swiglu4_pk((f32x2){g0[0], g0[1]}, (f32x2){u0[0], u0[1]}), r1 = swiglu4_pk((f32x2){g0[2], g0[3]}, (f32x2){u0[2], u0[3]});
                const f32x2 r2 = swiglu4_pk((f32x2){g1[0], g1[1]}, (f32x2){u1[0], u1[1]}), r3 = swiglu4_pk((f32x2){g1[2], g1[3]}, (f32x2){u1[2], u1[3]});
                u32x2 w8; w8.x = cvt4_fp8(r0.x, r0.y, r1.x, r1.y); w8.y = cvt4_fp8(r2.x, r2.y, r3.x, r3.y);
                *(u32x2*)((unsigned char*)H + row * DFF + hcol0) = w8; }
    }
};
struct EpiDown {
    static constexpr bool PERM = true;
    bf16_t* Y; const float* b_down; const float* row_gate;
    __device__ __forceinline__ void init(f32x4 (&acc)[2][2][4][2], const pg8::Unit& u, int wc, int fq) const {
        const int e = u.pn >> 2, pnl = u.pn & 3, col0 = pnl * 256 + wc * 32 + 8 * fq;
#pragma unroll
        for (int bj = 0; bj < 2; ++bj)
#pragma unroll
            for (int n = 0; n < 2; ++n) { const f32x4 bv = *(const f32x4*)(b_down + (size_t)e * DM + col0 + bj * 128 + 4 * n);
#pragma unroll
                for (int a_ = 0; a_ < 2; ++a_)
#pragma unroll
                    for (int m_ = 0; m_ < 4; ++m_) acc[a_][bj][m_][n] = bv; }
    }
    __device__ __forceinline__ void operator()(const f32x4 (&acc)[2][2][4][2], const pg8::Unit& u, int wr, int wc, int fr, int fq) const {
        const int e = u.pn >> 2, pnl = u.pn & 3, col0 = pnl * 256 + wc * 32 + 8 * fq;
#pragma unroll
        for (int ai = 0; ai < 2; ++ai)
#pragma unroll
            for (int m = 0; m < 4; ++m) { const size_t row = (size_t)(u.pm * 256 + ai * 128 + wr * 64 + m * 16 + fr); const float gt = row_gate[row];
#pragma unroll
                for (int bj = 0; bj < 2; ++bj) { const f32x4 v0 = acc[ai][bj][m][0] * (gt * 32.f), v1 = acc[ai][bj][m][1] * (gt * 32.f); u32x2 w;
                    w.x = cvt4_fp8(v0[0], v0[1], v0[2], v0[3]); w.y = cvt4_fp8(v1[0], v1[1], v1[2], v1[3]); *(u32x2*)((unsigned char*)Y + row * DM + col0 + bj * 128) = w; } }
    }
};
struct MoeOrder {
    pg8::StaticOrder so; const LAS unsigned char* tile_e; const LAS unsigned short* tok; int ncolt;
    __device__ __forceinline__ bool next(int i, pg8::Unit& u) const {
        if (!so.next(i, u)) return false;
        const int e = __builtin_amdgcn_readfirstlane((int)tile_e[u.pm]); u.pn = e * ncolt + u.pn; return true; }
    __device__ __forceinline__ const LAS unsigned short* tok_table(int ui) const { return tok + ui * 256; }
};

__device__ __forceinline__ void p0_transpose_item(const float* W, int K, int N, bf16_t* WT, int k0, int n0, int row0, LAS float* scr, int lane) {
#pragma unroll 8
    for (int i = 0; i < 32; ++i) { const int kk = 2 * i + (lane >> 5); scr[kk * 33 + (lane & 31)] = W[(size_t)(k0 + kk) * N + n0 + (lane & 31)]; }
    asm volatile("s_waitcnt lgkmcnt(0)" ::: "memory");
    const int c = lane & 7;
#pragma unroll
    for (int j = 0; j < 4; ++j) { const int n = (lane >> 3) + 8 * j; const LAS float* s = scr + (8 * c) * 33 + n;
        u32x4 o; o.x = cvtpk(s[0 * 33], s[1 * 33]); o.y = cvtpk(s[2 * 33], s[3 * 33]); o.z = cvtpk(s[4 * 33], s[5 * 33]); o.w = cvtpk(s[6 * 33], s[7 * 33]);
        *(u32x4*)(WT + (size_t)(row0 + n) * K + k0 + 8 * c) = o; }
    asm volatile("s_waitcnt lgkmcnt(0)" ::: "memory");
}
__device__ __forceinline__ void p0_transpose_item_f8(const float* W, int K, int N, unsigned char* WT, int k0, int n0, int row0, LAS float* scr, int lane) {
#pragma unroll 8
    for (int i = 0; i < 32; ++i) { const int kk = 2 * i + (lane >> 5); scr[kk * 33 + (lane & 31)] = W[(size_t)(k0 + kk) * N + n0 + (lane & 31)]; }
    asm volatile("s_waitcnt lgkmcnt(0)" ::: "memory");
    const int c = lane & 7;
#pragma unroll
    for (int j = 0; j < 4; ++j) { const int n = (lane >> 3) + 8 * j; const LAS float* s = scr + (8 * c) * 33 + n;
        u32x2 o; o.x = cvt4_fp8(256.f * s[0 * 33], 256.f * s[1 * 33], 256.f * s[2 * 33], 256.f * s[3 * 33]); o.y = cvt4_fp8(256.f * s[4 * 33], 256.f * s[5 * 33], 256.f * s[6 * 33], 256.f * s[7 * 33]);
        *(u32x2*)(WT + (size_t)(row0 + n) * K + k0 + 8 * c) = o; }
    asm volatile("s_waitcnt lgkmcnt(0)" ::: "memory");
}
__device__ __forceinline__ void p0_prologue(const Frame& F, const Args& a) {
    LAS float* scr = (LAS float*)(F.lds + F.wave * 16384);
    const int gw = F.vcu * 8 + F.wave, NGW = F.G * 8;
    bf16_t* WinT = (bf16_t*)(a.ws + WS_WIN); bf16_t* WoutT = (bf16_t*)(a.ws + WS_WOUT); bf16_t* WupT = (bf16_t*)(a.ws + WS_WUP); bf16_t* WdnT = (bf16_t*)(a.ws + WS_WDN);
    constexpr int I_IN = 16 * 96, I_OUT = 16 * 32, I_UP = 16 * 64, I_DN = 16 * 32;
    constexpr int NITEMS = I_IN + I_OUT + NE * I_UP + NE * I_DN;
    for (int it = gw; it < NITEMS; it += NGW) {
        int r = it;
        if (r < I_IN) { const int kb = r / 96, nb = r % 96; p0_transpose_item(a.w_in, DM, NPROJ, WinT, 64 * kb, 32 * nb, 32 * nb, scr, F_LANE); continue; } r -= I_IN;
        if (r < I_OUT) { const int kb = r / 32, nb = r % 32; p0_transpose_item(a.w_out, DM, DM, WoutT, 64 * kb, 32 * nb, 32 * nb, scr, F_LANE); continue; } r -= I_OUT;
        if (r < NE * I_UP) { const int e = r / I_UP, q = r % I_UP, kb = q / 64, nb = q % 64, n0 = 32 * nb;
            const int nn = n0 & 1023, row0 = (nn >> 7) * 256 + (n0 >> 10) * 128 + (nn & 127);
            p0_transpose_item_f8(a.w_up + (size_t)e * DM * 2048, DM, 2048, (unsigned char*)WupT + (size_t)e * 2048 * DM, 64 * kb, n0, row0, scr, F_LANE); continue; } r -= NE * I_UP;
        { const int e = r / I_DN, q = r % I_DN, kb = q / 32, nb = q % 32; p0_transpose_item_f8(a.w_down + (size_t)e * DFF * DM, DFF, DM, (unsigned char*)WdnT + (size_t)e * DM * DFF, 64 * kb, 32 * nb, 32 * nb, scr, F_LANE); }
    }
    bf16_t* XB = (bf16_t*)(a.ws + WS_XB);
    for (int m = gw; m < NTOK; m += NGW) {
        const f32x4* xr = (const f32x4*)(a.x + (size_t)m * DM) + F_LANE; unsigned long long* o8 = (unsigned long long*)(XB + (size_t)m * DM) + F_LANE;
#pragma unroll
        for (int j = 0; j < 4; ++j) { const f32x4 v = xr[64 * j]; o8[64 * j] = (unsigned long long)cvtpk(v[0], v[1]) | ((unsigned long long)cvtpk(v[2], v[3]) << 32); }
    }
}

__device__ __forceinline__ void glds16(const void* gsrc, unsigned lds_dst) { unsigned keep;
    asm volatile("s_mov_b32 %0, m0\n\ts_mov_b32 m0, %2\n\ts_nop 0\n\tglobal_load_lds_dwordx4 %1, off\n\ts_mov_b32 m0, %0" : "=&s"(keep) : "v"(gsrc), "s"(lds_dst) : "memory"); }
__device__ __forceinline__ int crow(int r, int hi) { return (r & 3) + 8 * (r >> 2) + 4 * hi; }
typedef LAS const char* lds_cptr;
typedef short v4i16_t __attribute__((ext_vector_type(4)));
__device__ __forceinline__ s16x4 vtr(lds_cptr p) { return __builtin_bit_cast(s16x4, __builtin_amdgcn_ds_read_tr16_b64_v4i16((LAS v4i16_t*)p)); }
#define MX3(a, b, c) __builtin_fmaxf(__builtin_fmaxf((a), (b)), (c))
__device__ __forceinline__ float rowmax(const f32x16& p0, const f32x16& p1) {
    float a = MX3(p0[0], p0[1], p1[0]), b = MX3(p0[2], p0[3], p1[1]); a = MX3(a, p1[2], p1[3]);
#pragma unroll
    for (int r = 4; r < 16; r += 4) { a = MX3(a, p0[r], p0[r + 1]); b = MX3(b, p0[r + 2], p0[r + 3]); a = MX3(a, p1[r], p1[r + 1]); b = MX3(b, p1[r + 2], p1[r + 3]); }
    float m = __builtin_fmaxf(a, b); auto rr = __builtin_amdgcn_permlane32_swap(__float_as_uint(m), __float_as_uint(m), false, false);
    return __builtin_fmaxf(__uint_as_float(rr[0]), __uint_as_float(rr[1]));
}
__device__ __forceinline__ float halfsum(float v) { auto rr = __builtin_amdgcn_permlane32_swap(__float_as_uint(v), __float_as_uint(v), false, false); return __uint_as_float(rr[0]) + __uint_as_float(rr[1]); }
#define MFMA32(a, b, c) __builtin_amdgcn_mfma_f32_32x32x16_bf16(a, b, c, 0, 0, 0)

template <int ND>
__device__ __forceinline__ void softmax_tile(f32x16& p0, f32x16& p1, float& mhat, float& lsum, f32x16 (&o)[ND], u32x4 (&pw)[4]) {
    const float rm = rowmax(p0, p1);
    const float mnew = __builtin_fmaxf(mhat, rm);
    if (__any(mnew != mhat)) {
        const float al = __builtin_amdgcn_exp2f(mhat - mnew); lsum *= al;
#pragma unroll
        for (int d = 0; d < ND; ++d)
#pragma unroll
            for (int r = 0; r < 16; ++r) o[d][r] *= al;
        mhat = mnew;
    }
    float s = 0.f;
#pragma unroll
    for (int r = 0; r < 16; ++r) { p0[r] = __builtin_amdgcn_exp2f(p0[r] - mhat); p1[r] = __builtin_amdgcn_exp2f(p1[r] - mhat); s += p0[r] + p1[r]; }
    lsum += s;
    pw[0] = (u32x4){cvtpk(p0[0], p0[1]), cvtpk(p0[2], p0[3]), cvtpk(p0[4], p0[5]), cvtpk(p0[6], p0[7])};
    pw[1] = (u32x4){cvtpk(p0[8], p0[9]), cvtpk(p0[10], p0[11]), cvtpk(p0[12], p0[13]), cvtpk(p0[14], p0[15])};
    pw[2] = (u32x4){cvtpk(p1[0], p1[1]), cvtpk(p1[2], p1[3]), cvtpk(p1[4], p1[5]), cvtpk(p1[6], p1[7])};
    pw[3] = (u32x4){cvtpk(p1[8], p1[9]), cvtpk(p1[10], p1[11]), cvtpk(p1[12], p1[13]), cvtpk(p1[14], p1[15])};
}
template <int ND>
__device__ __forceinline__ void pv_tile(f32x16 (&o)[ND], lds_cptr vbase, const u32x4 (&pw)[4]) {
#pragma unroll
    for (int d0 = 0; d0 < ND; ++d0)
#pragma unroll
        for (int ks = 0; ks < 4; ++ks) {
            const s16x4 lo = vtr(vbase + d0 * 4096 + ks * 1024), hi = vtr(vbase + d0 * 4096 + ks * 1024 + 512);
            const bf16x8 vf = (bf16x8){lo[0], lo[1], lo[2], lo[3], hi[0], hi[1], hi[2], hi[3]};
            o[d0] = MFMA32(vf, __builtin_bit_cast(bf16x8, pw[ks]), o[d0]);
        }
}

__device__ __forceinline__ unsigned bfb(float x) { return cvtpk(x, 0.f) & 0xFFFFu; }
__device__ __forceinline__ float bff(unsigned b) { return __uint_as_float(b << 16); }
__device__ __forceinline__ void bf_split3(float x, unsigned& h, unsigned& m, unsigned& l) { h = bfb(x); const float r1 = x - bff(h); m = bfb(r1); const float r2 = r1 - bff(m); l = bfb(r2); }
__device__ __forceinline__ void attnB_finish(const Frame& F, const Args& a, f32x16 (&o)[4], float lsum, float lam, size_t rowbase, int qpos, int h, int c, int qs, int r32, int hi) {
    LAS unsigned char* L = F.lds;
    const float inv = 1.0f / halfsum(lsum);
    LAS float* ex = (LAS float*)(L + 65536);
    __syncthreads();
    if (c == 1) {
#pragma unroll
        for (int d0 = 0; d0 < 4; ++d0)
#pragma unroll
            for (int r = 0; r < 16; ++r) ex[(qs * 128 + 32 * d0 + crow(r, hi)) * 32 + r32] = o[d0][r] * inv;
    }
    __syncthreads();
    if (c == 0) {
        float ss = 0.f;
#pragma unroll
        for (int d0 = 0; d0 < 4; ++d0)
#pragma unroll
            for (int r = 0; r < 16; ++r) { const float v = o[d0][r] * inv - lam * ex[(qs * 128 + 32 * d0 + crow(r, hi)) * 32 + r32]; o[d0][r] = v; ss += v * v; }
        ss = halfsum(ss);
        const float rs = __builtin_amdgcn_rsqf(ss * (1.0f / 128.0f) + LN_EPS) * (1.0f - LAM_INIT);
        bf16_t* op = (bf16_t*)(a.ws + WS_MIXED) + (rowbase + qpos) * DM + 512 + h * 128 + 4 * hi;
#pragma unroll
        for (int d0 = 0; d0 < 4; ++d0)
#pragma unroll
            for (int g = 0; g < 4; ++g) { const int dv = 32 * d0 + 8 * g + 4 * hi; const f32x4 gs = *(const f32x4*)(a.g_sub + dv);
                u32x2 w; w.x = cvtpk(o[d0][4 * g] * rs * gs[0], o[d0][4 * g + 1] * rs * gs[1]); w.y = cvtpk(o[d0][4 * g + 2] * rs * gs[2], o[d0][4 * g + 3] * rs * gs[3]);
                *(u32x2*)(op + 32 * d0 + 8 * g) = w; }
    }
    __syncthreads();
}

template <bool FAST>
__device__ __forceinline__ void attnB_unit(const Frame& F, const Args& a, int b, int h, int qblk, float lam, int t_lo, int t_hi, float kn0, float kn1) {
    const int lane = F_LANE, r32 = lane & 31, hi = lane >> 5, wid = F.wave, c = wid >> 2, qs = wid & 3;
    const bf16_t* QD = (const bf16_t*)(a.ws + WS_PROJ) + 3 * PROJ_STRIDE; const bf16_t* KD = QD + PROJ_STRIDE; const bf16_t* VD = KD + PROJ_STRIDE;
    const size_t rowbase = (size_t)b * SEQ; const int q0 = qblk * 128, qpos = q0 + 32 * qs + r32;
    bf16x8 qr[4];
    { const bf16_t* Qp = QD + (rowbase + qpos) * 512 + h * 128 + c * 64 + 8 * hi;
#pragma unroll
      for (int d0 = 0; d0 < 4; ++d0) qr[d0] = *(const bf16x8*)(Qp + 16 * d0); }
    float ref = 0.f;
    { float qq = 0.f;
#pragma unroll
        for (int d0 = 0; d0 < 4; ++d0)
#pragma unroll
            for (int j = 0; j < 8; ++j) { const float v = __uint_as_float((unsigned)(unsigned short)qr[d0][j] << 16); qq += v * v; }
        qq = halfsum(qq); asm volatile("" : "+v"(qq));
        if (FAST) ref = sqrtf(qq) * (c ? kn1 : kn0) * 1.01f + 0.01f; }
    const float slope2 = __builtin_amdgcn_exp2f(-2.0f * (float)(h + 1)) * LOG2E;
    const bf16_t* tsrc = KD + (size_t)((b * 4 + h) * 256) * 16384 + wid * 2048 + lane * 8;
    LAS unsigned char* L = F.lds;
    const unsigned dbase = (unsigned)(uintptr_t)L + (unsigned)wid * 4096u;
#define B_DMA(tt, slot) do { const bf16_t* _k = tsrc + (size_t)(tt) * 16384; const unsigned _d = (unsigned)__builtin_amdgcn_readfirstlane((int)(dbase + (unsigned)(slot) * 32768u)); unsigned _keep; \
        asm volatile("s_mov_b32 %0, m0\n\ts_mov_b32 m0, %2\n\ts_nop 0\n\tglobal_load_lds_dwordx4 %1, off\n\tglobal_load_lds_dwordx4 %1, off offset:1024\n\tglobal_load_lds_dwordx4 %1, off offset:2048\n\tglobal_load_lds_dwordx4 %1, off offset:3072\n\ts_mov_b32 m0, %0" \
                     : "=&s"(_keep) : "v"(_k), "s"(_d) : "memory"); } while (0)
#define WAIT_BAR(N) asm volatile("s_waitcnt vmcnt(" #N ") lgkmcnt(0)\n\ts_barrier" ::: "memory")
#define SBAR() __builtin_amdgcn_sched_barrier(0)
#define PIN(x) asm volatile("" : "+v"(x))
#define VFRAG(dst, base, d0, ks) do { const s16x4 lo_ = vtr((base) + (d0) * 4096 + (ks) * 1024), hi_ = vtr((base) + (d0) * 4096 + (ks) * 1024 + 512); \
        dst = (bf16x8){lo_[0], lo_[1], lo_[2], lo_[3], hi_[0], hi_[1], hi_[2], hi_[3]}; } while (0)
#define GEN_C(tt) do { const float dq = (float)(qpos - (tt) * 64 - 4 * hi); \
        _Pragma("unroll") for (int r = 0; r < 16; ++r) { const float kk = (float)((r & 3) + 8 * (r >> 2)); C0[r] = -slope2 * __builtin_fabsf(dq - kk) - ref; C1[r] = -slope2 * __builtin_fabsf(dq - 32.f - kk) - ref; } } while (0)
    float mhat = NEG_BIG, lsum = 0.f; f32x16 o[4];
#pragma unroll
    for (int d = 0; d < 4; ++d) o[d] = (f32x16){};
    const int koff = (c * 8 + hi) * 1024 + r32 * 16;
    const int voff = 16384 + ((lane >> 4) & 1) * 32 + (lane & 3) * 8 + (4 * hi + ((lane & 15) >> 2)) * 64;
    const int tdiag = q0 >> 6;
    f32x16 C0, C1;
    u32x4 pw[4];
    const int NT = t_hi - t_lo + 1;
    GEN_C(t_lo);
    B_DMA(t_lo, 0); if (NT > 1) B_DMA(t_lo + 1, 1); if (NT > 2) B_DMA(t_lo + 2, 2);
    int sl = 0;
    for (int tau = 0; tau < NT; ++tau) {
        if (tau + 2 < NT) WAIT_BAR(8); else if (tau + 1 < NT) WAIT_BAR(4); else WAIT_BAR(0);
        if (tau + 3 < NT) B_DMA(t_lo + tau + 3, (sl + 3) & 3);
        const int t = t_lo + tau; const LAS unsigned char* buf = L + sl * 32768; const lds_cptr vbase = (lds_cptr)(buf + voff);
        bf16x8 kf[8];
#pragma unroll
        for (int d0 = 0; d0 < 4; ++d0) { kf[2 * d0] = *(const LAS bf16x8*)(buf + koff + d0 * 2048); kf[2 * d0 + 1] = *(const LAS bf16x8*)(buf + koff + d0 * 2048 + 512); }
        SBAR();
        f32x16 p0, p1;
        if constexpr (FAST) {
            bf16x8 vA[4], vB[4]; float sacc = 0.f;
#define EXPS(P, A, B) do { _Pragma("unroll") for (int r = (A); r < (B); ++r) { P[r] = __builtin_amdgcn_exp2f(P[r]); sacc += P[r]; } PIN(P); PIN(sacc); } while (0)
#define PK4(P, B) (u32x4){cvtpk(P[B], P[B + 1]), cvtpk(P[B + 2], P[B + 3]), cvtpk(P[B + 4], P[B + 5]), cvtpk(P[B + 6], P[B + 7])}
#define PWF(k) __builtin_bit_cast(bf16x8, pw[k])
            const float st = (t + 1 < tdiag) ? 64.f * slope2 : -64.f * slope2;
            p0 = MFMA32(kf[0], qr[0], C0); SBAR(); VFRAG(vA[0], vbase, 0, 0); SBAR();
            p0 = MFMA32(kf[2], qr[1], p0); SBAR(); VFRAG(vA[1], vbase, 1, 0); SBAR();
            p0 = MFMA32(kf[4], qr[2], p0); SBAR(); VFRAG(vA[2], vbase, 2, 0); SBAR();
            p0 = MFMA32(kf[6], qr[3], p0); SBAR(); VFRAG(vA[3], vbase, 3, 0); SBAR();
            p1 = MFMA32(kf[1], qr[0], C1); SBAR();
            p1 = MFMA32(kf[3], qr[1], p1); SBAR(); EXPS(p0, 0, 5); SBAR();
            p1 = MFMA32(kf[5], qr[2], p1); SBAR(); EXPS(p0, 5, 11); SBAR();
            p1 = MFMA32(kf[7], qr[3], p1); SBAR(); EXPS(p0, 11, 16); pw[0] = PK4(p0, 0); PIN(pw[0]); SBAR();
            o[0] = MFMA32(vA[0], PWF(0), o[0]); SBAR(); pw[1] = PK4(p0, 8); PIN(pw[1]); VFRAG(vB[0], vbase, 0, 1); SBAR();
            o[1] = MFMA32(vA[1], PWF(0), o[1]); SBAR(); EXPS(p1, 0, 3); VFRAG(vB[1], vbase, 1, 1); SBAR();
            o[2] = MFMA32(vA[2], PWF(0), o[2]); SBAR(); EXPS(p1, 3, 6); VFRAG(vB[2], vbase, 2, 1); SBAR();
            o[3] = MFMA32(vA[3], PWF(0), o[3]); SBAR(); EXPS(p1, 6, 8); VFRAG(vB[3], vbase, 3, 1); SBAR();
            o[0] = MFMA32(vB[0], PWF(1), o[0]); SBAR(); EXPS(p1, 8, 10); VFRAG(vA[0], vbase, 0, 2); SBAR();
            o[1] = MFMA32(vB[1], PWF(1), o[1]); SBAR(); EXPS(p1, 10, 12); VFRAG(vA[1], vbase, 1, 2); SBAR();
            o[2] = MFMA32(vB[2], PWF(1), o[2]); SBAR(); EXPS(p1, 12, 14); VFRAG(vA[2], vbase, 2, 2); SBAR();
            o[3] = MFMA32(vB[3], PWF(1), o[3]); SBAR(); EXPS(p1, 14, 16); VFRAG(vA[3], vbase, 3, 2); pw[2] = PK4(p1, 0); PIN(pw[2]); SBAR();
            o[0] = MFMA32(vA[0], PWF(2), o[0]); SBAR(); pw[3] = PK4(p1, 8); PIN(pw[3]); VFRAG(vB[0], vbase, 0, 3); SBAR();
            o[1] = MFMA32(vA[1], PWF(2), o[1]); SBAR(); VFRAG(vB[1], vbase, 1, 3);
#pragma unroll
            for (int r = 0; r < 8; ++r) C0[r] += st;
            PIN(C0); SBAR();
            o[2] = MFMA32(vA[2], PWF(2), o[2]); SBAR(); VFRAG(vB[2], vbase, 2, 3);
#pragma unroll
            for (int r = 8; r < 16; ++r) C0[r] += st;
            PIN(C0); SBAR();
            o[3] = MFMA32(vA[3], PWF(2), o[3]); SBAR(); VFRAG(vB[3], vbase, 3, 3);
#pragma unroll
            for (int r = 0; r < 8; ++r) C1[r] += st;
            PIN(C1); SBAR();
            o[0] = MFMA32(vB[0], PWF(3), o[0]); SBAR();
#pragma unroll
            for (int r = 8; r < 16; ++r) C1[r] += st;
            PIN(C1); SBAR();
            o[1] = MFMA32(vB[1], PWF(3), o[1]);
            o[2] = MFMA32(vB[2], PWF(3), o[2]);
            o[3] = MFMA32(vB[3], PWF(3), o[3]);
            lsum += sacc;
#undef EXPS
#undef PK4
#undef PWF
        } else {
            p0 = MFMA32(kf[0], qr[0], C0); p1 = MFMA32(kf[1], qr[0], C1);
#pragma unroll
            for (int d0 = 1; d0 < 4; ++d0) { p0 = MFMA32(kf[2 * d0], qr[d0], p0); p1 = MFMA32(kf[2 * d0 + 1], qr[d0], p1); }
            softmax_tile<4>(p0, p1, mhat, lsum, o, pw);
            pv_tile<4>(o, vbase, pw);
            const float st = (t + 1 < tdiag) ? 64.f * slope2 : -64.f * slope2; C0 = C0 + st; C1 = C1 + st;
        }
        if ((t + 1 >= tdiag && t + 1 <= tdiag + 2) || ((tau + 1) & 15) == 0) GEN_C(t + 1);
        sl = (sl + 1) & 3;
    }
#undef B_DMA
#undef WAIT_BAR
#undef VFRAG
#undef GEN_C
#undef SBAR
#undef PIN
    attnB_finish(F, a, o, lsum, lam, rowbase, qpos, h, c, qs, r32, hi);
}
__device__ __forceinline__ void attnB_fast(const Frame& F, const Args& a, int b, int h, int qblk, float lam, int t_lo, int t_hi, float kn0, float kn1) {
    const int lane = F_LANE, r32 = lane & 31, hi = lane >> 5, wid = F.wave, c = wid >> 2, qs = wid & 3;
    const bf16_t* QD = (const bf16_t*)(a.ws + WS_PROJ) + 3 * PROJ_STRIDE; const bf16_t* KD = QD + PROJ_STRIDE;
    const size_t rowbase = (size_t)b * SEQ; const int q0 = qblk * 128, qpos = q0 + 32 * qs + r32;
    bf16x8 qr[4], ks[4];
    { const bf16_t* Qp = QD + (rowbase + qpos) * 512 + h * 128 + c * 64 + 8 * hi;
      const bf16_t* Kp = KD + ((size_t)((b * 4 + h) * 256 + (qpos >> 6))) * 16384 + ((c * 8 + hi) * 64 + (qpos & 63)) * 8;
#pragma unroll
      for (int d0 = 0; d0 < 4; ++d0) { qr[d0] = *(const bf16x8*)(Qp + 16 * d0); ks[d0] = *(const bf16x8*)(Kp + d0 * 1024); } }
    const float slope2 = __builtin_amdgcn_exp2f(-2.0f * (float)(h + 1)) * LOG2E;
    float ref;
    { float qq = 0.f, sii = 0.f;
#pragma unroll
        for (int d0 = 0; d0 < 4; ++d0)
#pragma unroll
            for (int j = 0; j < 8; ++j) { const float v = __uint_as_float((unsigned)(unsigned short)qr[d0][j] << 16), kv = __uint_as_float((unsigned)(unsigned short)ks[d0][j] << 16); qq += v * v; sii += v * kv; }
        qq = halfsum(qq); sii = halfsum(sii); asm volatile("" : "+v"(qq));
        ref = sqrtf(qq) * (c ? kn1 : kn0) * 1.01f + 0.01f;
        float dd = (ref - sii + 72.02f) / slope2;
#pragma unroll
        for (int ofs = 1; ofs < 64; ofs <<= 1) dd = fmaxf(dd, __shfl_xor(dd, ofs));
        LAS float* red = (LAS float*)(F.lds + LX_MISC) + 104;
        if (lane == 0) red[wid] = dd;
        __syncthreads();
        float dm = red[0];
#pragma unroll
        for (int w_ = 1; w_ < 8; ++w_) dm = fmaxf(dm, red[w_]);
        const int Dd = dm < 40000.f ? (int)dm + 2 : 40000;
        int tl = (q0 - Dd) >> 6; if (q0 - Dd < 0) tl = 0;
        int th = (q0 + 127 + Dd) >> 6; if (th > SEQ / 64 - 1) th = SEQ / 64 - 1;
        t_lo = __builtin_amdgcn_readfirstlane(tl > t_lo ? tl : t_lo); t_hi = __builtin_amdgcn_readfirstlane(th < t_hi ? th : t_hi); }
    const bf16_t* tsrc = KD + (size_t)((b * 4 + h) * 256) * 16384 + wid * 2048 + lane * 8;
    LAS unsigned char* L = F.lds;
    const unsigned dbase = (unsigned)(uintptr_t)L + (unsigned)wid * 4096u;
#define B_DMA(tt, slot) do { const bf16_t* _k = tsrc + (size_t)(tt) * 16384; const unsigned _d = (unsigned)__builtin_amdgcn_readfirstlane((int)(dbase + (unsigned)(slot) * 32768u)); unsigned _keep; \
        asm volatile("s_mov_b32 %0, m0\n\ts_mov_b32 m0, %2\n\ts_nop 0\n\tglobal_load_lds_dwordx4 %1, off\n\tglobal_load_lds_dwordx4 %1, off offset:1024\n\tglobal_load_lds_dwordx4 %1, off offset:2048\n\tglobal_load_lds_dwordx4 %1, off offset:3072\n\ts_mov_b32 m0, %0" \
                     : "=&s"(_keep) : "v"(_k), "s"(_d) : "memory"); } while (0)
#define WAIT_BAR(N) asm volatile("s_waitcnt vmcnt(" #N ") lgkmcnt(0)\n\ts_barrier" : "+v"(p1), "+v"(sacc) :: "memory")
#define VFRAG(dst, base, d0, ks) do { const s16x4 lo_ = vtr((base) + (d0) * 4096 + (ks) * 1024), hi_ = vtr((base) + (d0) * 4096 + (ks) * 1024 + 512); \
        dst = (bf16x8){lo_[0], lo_[1], lo_[2], lo_[3], hi_[0], hi_[1], hi_[2], hi_[3]}; } while (0)
#define MF_ "v_mfma_f32_32x32x16_bf16 "
#define AMF(D, A, B)              asm volatile(MF_ "%0, %1, %2, %0" : "+v"(D) : "v"(A), "v"(B) : "memory")
#define AMF1(D, A, B, X)          asm volatile(MF_ "%0, %2, %3, %0" : "+v"(D), "+v"(X) : "v"(A), "v"(B) : "memory")
#define AMF2(D, A, B, X, Y)       asm volatile(MF_ "%0, %3, %4, %0" : "+v"(D), "+v"(X), "+v"(Y) : "v"(A), "v"(B) : "memory")
#define AMF3(D, A, B, X, Y, Z)    asm volatile(MF_ "%0, %4, %5, %0" : "+v"(D), "+v"(X), "+v"(Y), "+v"(Z) : "v"(A), "v"(B) : "memory")
#define AMF0(D, A, B)             asm volatile(MF_ "%0, %1, %2, 0" : "=&v"(D) : "v"(A), "v"(B) : "memory")
#define PK4(P, B) (u32x4){cvtpk(P[B], P[B + 1]), cvtpk(P[B + 2], P[B + 3]), cvtpk(P[B + 4], P[B + 5]), cvtpk(P[B + 6], P[B + 7])}
#define XE(P, r) { P[r] = __builtin_amdgcn_exp2f(P[r]); sacc += P[r]; }
#define XE2(P, r) do { XE(P, r) XE(P, (r) + 1) } while (0)
#define KLD(bk, i) kf[i] = *(const LAS bf16x8*)((bk) + koff + ((i) >> 1) * 2048 + ((i) & 1) * 512)
#define SET_KA(tn) do { const unsigned w_ = __builtin_amdgcn_perm(0u, __float_as_uint(tf), 0x03020302u); ka0[1] = w_; ka1[1] = w_; tf += tinc; if ((tn) == tdiag + 2) qa = qaR; } while (0)
#define BIAS_HALF(P, KA, e, tn) do { \
        if ((unsigned)((tn) - tdiag) < 2u) { const int kb_ = 2 * (tn) + (e); \
            if (kb_ == qb) { float dq_ = (float)(qpos - (tn) * 64 - 32 * (e) - 4 * hi), ns_ = -slope2, nr_ = -ref; asm volatile("" : "+v"(dq_), "+v"(ns_), "+v"(nr_)); \
                             _Pragma("unroll") for (int r = 0; r < 16; ++r) { const float kk_ = (float)((r & 3) + 8 * (r >> 2)); P[r] = __builtin_fmaf(ns_, __builtin_fabsf(dq_ - kk_), nr_); } \
                             asm volatile("s_nop 4" : "+v"(P) :: "memory"); } \
            else if (kb_ < qb) { AMF0(P, KA, qaL); } else { AMF0(P, KA, qaR); } } \
        else { AMF0(P, KA, qa); } } while (0)
    const int tdiag = q0 >> 6, qb = 4 * qblk + qs;
    const unsigned msk = hi ? 0u : 0xFFFFFFFFu;
    bf16x8 qaL, qaR, qa; u32x4 ka0, ka1;
    { const float S64 = 64.f * slope2;
        const unsigned sh = bfb(slope2), slo = bfb(slope2 - bff(sh)), Sh = bfb(S64), Slo = bfb(S64 - bff(Sh));
        unsigned ch, cm, cl, dh, dm, dl;
        bf_split3(slope2 * (float)(qpos - 64 * tdiag) - ref, ch, cm, cl);
        bf_split3(-slope2 * (float)(qpos - 64 * tdiag) - ref, dh, dm, dl);
        const u32x4 r_ = (u32x4){(((slo ^ 0x8000u) << 16) | (sh ^ 0x8000u)) & msk, (((Slo ^ 0x8000u) << 16) | (Sh ^ 0x8000u)) & msk, ((cm << 16) | ch) & msk, cl & msk};
        const u32x4 l_ = (u32x4){((slo << 16) | sh) & msk, ((Slo << 16) | Sh) & msk, ((dm << 16) | dh) & msk, dl & msk};
        qaR = __builtin_bit_cast(bf16x8, r_); qaL = __builtin_bit_cast(bf16x8, l_); qa = (t_lo < tdiag + 2) ? qaL : qaR;
        const unsigned j0 = bfb((float)r32), j1 = bfb((float)(32 + r32));
        ka0 = (u32x4){((j0 << 16) | j0) & msk, 0u, 0x3F803F80u & msk, 0x00003F80u & msk}; ka1 = ka0; ka1[0] = ((j1 << 16) | j1) & msk; }
    float tf = hi ? 0.f : (float)(t_lo - tdiag); const float tinc = hi ? 0.f : 1.f;
    f32x16 o[4], p0, p1; u32x4 pw[4]; bf16x8 kf[8], vA[4], vB[4]; float sacc = 0.f;
#pragma unroll
    for (int d = 0; d < 4; ++d) o[d] = (f32x16){};
    p1 = (f32x16){};
    const int koff = (c * 8 + hi) * 1024 + r32 * 16;
    const int voff = 16384 + ((lane >> 4) & 1) * 32 + (lane & 3) * 8 + (4 * hi + ((lane & 15) >> 2)) * 64;
    const int NT = t_hi - t_lo + 1;
    B_DMA(t_lo, 0); if (NT > 1) B_DMA(t_lo + 1, 1); if (NT > 2) B_DMA(t_lo + 2, 2);
    if (NT > 2) WAIT_BAR(8); else if (NT > 1) WAIT_BAR(4); else WAIT_BAR(0);
    {
        const LAS unsigned char* bk = L;
#pragma unroll
        for (int i = 0; i < 8; ++i) KLD(bk, i);
        SET_KA(t_lo);
        asm volatile("s_nop 1" : "+v"(ka0), "+v"(ka1), "+v"(qa) :: "memory");
        BIAS_HALF(p0, ka0, 0, t_lo);
        AMF(p0, kf[0], qr[0]); AMF(p0, kf[2], qr[1]); AMF(p0, kf[4], qr[2]); AMF(p0, kf[6], qr[3]);
        BIAS_HALF(p1, ka1, 1, t_lo);
        AMF(p1, kf[1], qr[0]); AMF(p1, kf[3], qr[1]); AMF(p1, kf[5], qr[2]); AMF(p1, kf[7], qr[3]);
        const lds_cptr vb0 = (lds_cptr)(bk + voff);
        VFRAG(vA[0], vb0, 0, 0); VFRAG(vA[1], vb0, 1, 0); VFRAG(vA[2], vb0, 2, 0); VFRAG(vA[3], vb0, 3, 0);
        asm volatile("s_nop 15\n\ts_nop 15" : "+v"(p0), "+v"(p1) :: "memory");
#pragma unroll
        for (int r = 0; r < 16; r += 2) XE2(p0, r);
#pragma unroll
        for (int r = 0; r < 16; r += 2) XE2(p1, r);
        pw[0] = PK4(p0, 0); pw[1] = PK4(p0, 8); pw[2] = PK4(p1, 0);
    }
    int sl = 0;
    for (int tau = 0; tau + 1 < NT; ++tau) {
        if (tau + 2 < NT) WAIT_BAR(4); else WAIT_BAR(0);
        if (tau + 3 < NT) B_DMA(t_lo + tau + 3, (sl + 3) & 3);
        const LAS unsigned char* buf = L + sl * 32768; const LAS unsigned char* bufn = L + ((sl + 1) & 3) * 32768;
        const lds_cptr vb = (lds_cptr)(buf + voff), vbn = (lds_cptr)(bufn + voff);
        const int tn = t_lo + tau + 1;
        SET_KA(tn);
        AMF(o[0], vA[0], pw[0]);            KLD(bufn, 0); KLD(bufn, 2);
        AMF1(o[1], vA[1], pw[0], p1);       KLD(bufn, 4); KLD(bufn, 6); pw[3] = PK4(p1, 8);
        AMF1(o[2], vA[2], pw[0], pw[3]);    KLD(bufn, 1); KLD(bufn, 3);
        AMF(o[3], vA[3], pw[0]);            KLD(bufn, 5); KLD(bufn, 7);
        BIAS_HALF(p0, ka0, 0, tn);          VFRAG(vB[0], vb, 0, 1);
        AMF(p0, kf[0], qr[0]);              VFRAG(vB[1], vb, 1, 1);
        AMF(p0, kf[2], qr[1]);              VFRAG(vB[2], vb, 2, 1);
        AMF(p0, kf[4], qr[2]);              VFRAG(vB[3], vb, 3, 1);
        AMF(p0, kf[6], qr[3]);
        BIAS_HALF(p1, ka1, 1, tn);
        AMF1(p1, kf[1], qr[0], p0);         XE2(p0, 0);
        AMF2(p1, kf[3], qr[1], p0, sacc);   XE2(p0, 2);
        AMF2(p1, kf[5], qr[2], p0, sacc);   XE2(p0, 4);
        AMF2(p1, kf[7], qr[3], p0, sacc);   XE2(p0, 6);
        AMF2(o[0], vB[0], pw[1], p0, sacc); XE2(p0, 8);  VFRAG(vA[0], vb, 0, 2);
        AMF2(o[1], vB[1], pw[1], p0, sacc); XE2(p0, 10); VFRAG(vA[1], vb, 1, 2);
        AMF2(o[2], vB[2], pw[1], p0, sacc); XE2(p0, 12); VFRAG(vA[2], vb, 2, 2);
        AMF2(o[3], vB[3], pw[1], p0, sacc); XE2(p0, 14); VFRAG(vA[3], vb, 3, 2);
        AMF3(o[0], vA[0], pw[2], p0, sacc, p1);     pw[0] = PK4(p0, 0); XE2(p1, 0); VFRAG(vB[0], vb, 0, 3);
        AMF3(o[1], vA[1], pw[2], p1, sacc, pw[0]);  XE2(p1, 2); VFRAG(vB[1], vb, 1, 3);
        AMF3(o[2], vA[2], pw[2], p1, sacc, p0);     pw[1] = PK4(p0, 8); XE2(p1, 4); VFRAG(vB[2], vb, 2, 3);
        AMF3(o[3], vA[3], pw[2], p1, sacc, pw[1]);  XE2(p1, 6); VFRAG(vB[3], vb, 3, 3);
        AMF2(o[0], vB[0], pw[3], p1, sacc); XE2(p1, 8);  VFRAG(vA[0], vbn, 0, 0);
        AMF2(o[1], vB[1], pw[3], p1, sacc); XE2(p1, 10); VFRAG(vA[1], vbn, 1, 0);
        AMF2(o[2], vB[2], pw[3], p1, sacc); pw[2] = PK4(p1, 0); XE2(p1, 12); VFRAG(vA[2], vbn, 2, 0);
        AMF3(o[3], vB[3], pw[3], p1, sacc, pw[2]);  XE2(p1, 14); VFRAG(vA[3], vbn, 3, 0);
        sl = (sl + 1) & 3;
    }
    {
        const lds_cptr vb = (lds_cptr)(L + sl * 32768 + voff);
        pw[3] = PK4(p1, 8);
        AMF3(o[0], vA[0], pw[0], p1, sacc, pw[3]); VFRAG(vB[0], vb, 0, 1);
        AMF(o[1], vA[1], pw[0]); VFRAG(vB[1], vb, 1, 1);
        AMF(o[2], vA[2], pw[0]); VFRAG(vB[2], vb, 2, 1);
        AMF(o[3], vA[3], pw[0]); VFRAG(vB[3], vb, 3, 1);
        AMF(o[0], vB[0], pw[1]); VFRAG(vA[0], vb, 0, 2);
        AMF(o[1], vB[1], pw[1]); VFRAG(vA[1], vb, 1, 2);
        AMF(o[2], vB[2], pw[1]); VFRAG(vA[2], vb, 2, 2);
        AMF(o[3], vB[3], pw[1]); VFRAG(vA[3], vb, 3, 2);
        AMF(o[0], vA[0], pw[2]); VFRAG(vB[0], vb, 0, 3);
        AMF(o[1], vA[1], pw[2]); VFRAG(vB[1], vb, 1, 3);
        AMF(o[2], vA[2], pw[2]); VFRAG(vB[2], vb, 2, 3);
        AMF(o[3], vA[3], pw[2]); VFRAG(vB[3], vb, 3, 3);
        AMF(o[0], vB[0], pw[3]); AMF(o[1], vB[1], pw[3]); AMF(o[2], vB[2], pw[3]); AMF(o[3], vB[3], pw[3]);
        asm volatile("s_nop 15\n\ts_nop 15" : "+v"(o[0]), "+v"(o[1]), "+v"(o[2]), "+v"(o[3]) :: "memory");
    }
#undef B_DMA
#undef WAIT_BAR
#undef VFRAG
#undef MF_
#undef AMF
#undef AMF1
#undef AMF2
#undef AMF3
#undef AMF0
#undef PK4
#undef XE
#undef XE2
#undef KLD
#undef SET_KA
#undef BIAS_HALF
    attnB_finish(F, a, o, sacc, lam, rowbase, qpos, h, c, qs, r32, hi);
}
__device__ __forceinline__ void attnB_item(const Frame& F, const Args& a, int h, int b, int qblk, float lam) {
    const int q0 = qblk * 128;
    const unsigned* ctl = (const unsigned*)(a.ws + WS_CTL); const int sl = (b * 4 + h) * 4;
    const float qn0 = sqrtf(__uint_as_float(ctl[CW_QMAX + sl]) + __uint_as_float(ctl[CW_QMAX + sl + 1])), qn1 = sqrtf(__uint_as_float(ctl[CW_QMAX + sl + 2]) + __uint_as_float(ctl[CW_QMAX + sl + 3]));
    const float kn0 = sqrtf(__uint_as_float(ctl[CW_KMAX + sl]) + __uint_as_float(ctl[CW_KMAX + sl + 1])), kn1 = sqrtf(__uint_as_float(ctl[CW_KMAX + sl + 2]) + __uint_as_float(ctl[CW_KMAX + sl + 3]));
    const float U = fmaxf(qn0 * kn0, qn1 * kn1) * 1.01f + 0.01f;
    const float slope2 = __builtin_amdgcn_exp2f(-2.0f * (float)(h + 1)) * LOG2E;
    const float Df = (2.0f * U + 72.0f) / slope2;
    const int Dd = Df < 40000.f ? (int)Df + 2 : 40000;
    int t_lo = (q0 - Dd) >> 6; if (q0 - Dd < 0) t_lo = 0;
    int t_hi = (q0 + 127 + Dd) >> 6; if (t_hi > SEQ / 64 - 1) t_hi = SEQ / 64 - 1;
    if (U <= 40.f) attnB_fast(F, a, b, h, qblk, lam, t_lo, t_hi, kn0, kn1);
    else attnB_unit<false>(F, a, b, h, qblk, lam, t_lo, t_hi, kn0, kn1);
}

__device__ __forceinline__ int a_kbase(int n0, int it) { return n0 - 64 + 64 * ((it == 0) ? 1 : (it == 1 ? 0 : 2)); }
__device__ __forceinline__ void a_load_k(const bf16_t* KA, size_t rowbase, int head, int d, int r, int L, int kbase, int r32, int hi, bf16x8 (&kf)[8]) {
#pragma unroll
    for (int kh = 0; kh < 2; ++kh) { int kn = kbase + 32 * kh + r32; kn = kn < 0 ? 0 : (kn >= L ? L - 1 : kn);
        const bf16_t* Kp = KA + (rowbase + (size_t)(d * kn + r)) * 512 + head * 64 + 8 * hi;
#pragma unroll
        for (int d0 = 0; d0 < 4; ++d0) kf[2 * d0 + kh] = *(const bf16x8*)(Kp + 16 * d0); }
}
__device__ __forceinline__ void attnA_task(const Frame& F, const Args& a, int b, int head, int d, int r, int n0, int L, LAS unsigned char* vw, f32x16 (&o)[2], float& mhat, float& ltot) {
    const int lane = F_LANE, r32 = lane & 31, hi = lane >> 5;
    const bf16_t* QA = (const bf16_t*)(a.ws + WS_PROJ); const bf16_t* KA = QA + PROJ_STRIDE; const bf16_t* VA = KA + PROJ_STRIDE;
    const size_t rowbase = (size_t)b * SEQ; const int qn = n0 + r32;
    bf16x8 qr[4], kf[8], kfn[8];
    { const bf16_t* Qp = QA + (rowbase + (size_t)(d * qn + r)) * 512 + head * 64 + 8 * hi;
#pragma unroll
      for (int d0 = 0; d0 < 4; ++d0) qr[d0] = *(const bf16x8*)(Qp + 16 * d0); }
    a_load_k(KA, rowbase, head, d, r, L, a_kbase(n0, 0), r32, hi, kf);
    const float sl = __builtin_amdgcn_exp2f(-(float)(head + 1)) * LOG2E * (float)d;
    mhat = NEG_BIG; float lsum = 0.f; o[0] = (f32x16){}; o[1] = (f32x16){};
    const int voff = ((lane >> 4) & 1) * 32 + (lane & 3) * 8 + (4 * hi + ((lane & 15) >> 2)) * 64;
#pragma unroll
    for (int it = 0; it < 3; ++it) {
        const int kbase = a_kbase(n0, it);
        u32x4 vv[8];
#pragma unroll
        for (int ks = 0; ks < 4; ++ks) { int kn = kbase + 16 * ks + (lane >> 2); kn = kn < 0 ? 0 : (kn >= L ? L - 1 : kn);
            const bf16_t* Vp = VA + (rowbase + (size_t)(d * kn + r)) * 512 + head * 64 + 8 * (lane & 3);
            vv[ks] = *(const u32x4*)Vp; vv[4 + ks] = *(const u32x4*)(Vp + 32); }
        if (it < 2) a_load_k(KA, rowbase, head, d, r, L, a_kbase(n0, it + 1), r32, hi, kfn);
        __builtin_amdgcn_sched_barrier(0);
        f32x16 p0, p1;
#pragma unroll
        for (int rr = 0; rr < 16; ++rr) { const int k0 = kbase + crow(rr, hi), k1 = k0 + 32; const int d0_ = k0 - qn, d1_ = k1 - qn;
            const bool v0 = (k0 >= 0) && (k0 < L) && (d0_ <= 64) && (d0_ >= -64), v1 = (k1 >= 0) && (k1 < L) && (d1_ <= 64) && (d1_ >= -64);
            p0[rr] = v0 ? -sl * __builtin_fabsf((float)d0_) : NEG_BIG; p1[rr] = v1 ? -sl * __builtin_fabsf((float)d1_) : NEG_BIG; }
#pragma unroll
        for (int d0 = 0; d0 < 4; ++d0) { p0 = MFMA32(kf[2 * d0], qr[d0], p0); p1 = MFMA32(kf[2 * d0 + 1], qr[d0], p1); }
        u32x4 pw[4];
        softmax_tile<2>(p0, p1, mhat, lsum, o, pw);
        __builtin_amdgcn_sched_barrier(0);
#pragma unroll
        for (int i = 0; i < 8; ++i) *(LAS u32x4*)(vw + i * 1024 + lane * 16) = vv[i];
        asm volatile("s_waitcnt lgkmcnt(0)" ::: "memory");
        pv_tile<2>(o, (lds_cptr)(vw + voff), pw);
        asm volatile("s_waitcnt lgkmcnt(0)" ::: "memory");
        if (it < 2) {
#pragma unroll
            for (int j = 0; j < 8; ++j) kf[j] = kfn[j];
        }
    }
    ltot = halfsum(lsum);
}
__device__ __forceinline__ void attnA_unit(const Frame& F, const Args& a, int unit) {
    const int lane = F_LANE, r32 = lane & 31, hi = lane >> 5, wid = F.wave;
    const int b = unit >> 7, head = (unit >> 4) & 7, tb = unit & 15, T0 = tb * 1024;
    float* part = (float*)(a.ws + WS_APART + (size_t)unit * APART_UNIT); float* ml = part + 2 * 1024 * 64;
    LAS unsigned char* vw = F.lds + wid * 8192;
    for (int task = wid; task < 64; task += 8) {
        int pat, d, r, n0, L;
        if (task < 32) { pat = 0; d = 16; r = task >> 1; n0 = T0 / 16 + 32 * (task & 1); L = SEQ / 16; }
        else { const int tt = task - 32; pat = 1; d = 4; r = tt >> 3; n0 = T0 / 4 + 32 * (tt & 7); L = SEQ / 4; }
        f32x16 o[2]; float mhat, ltot;
        attnA_task(F, a, b, head, d, r, n0, L, vw, o, mhat, ltot);
        const int tl = d * (n0 + r32) + r - T0;
        float* pp = part + ((size_t)pat * 1024 + tl) * 64 + 4 * hi;
#pragma unroll
        for (int d0 = 0; d0 < 2; ++d0)
#pragma unroll
            for (int g = 0; g < 4; ++g) *(f32x4*)(pp + 32 * d0 + 8 * g) = (f32x4){o[d0][4 * g], o[d0][4 * g + 1], o[d0][4 * g + 2], o[d0][4 * g + 3]};
        if (hi == 0) *(f32x2*)(ml + ((size_t)pat * 1024 + tl) * 2) = (f32x2){mhat, ltot};
    }
    asm volatile("s_waitcnt vmcnt(0)" ::: "memory");
    __syncthreads();
    __builtin_amdgcn_fence(__ATOMIC_ACQUIRE, "agent");
    for (int task = wid; task < 32; task += 8) {
        const int n0 = T0 + 32 * task;
        f32x16 o[2]; float m0, l0;
        attnA_task(F, a, b, head, 1, 0, n0, SEQ, vw, o, m0, l0);
        const int tl = 32 * task + r32;
        const f32x2 ml1 = *(const f32x2*)(ml + ((size_t)0 * 1024 + tl) * 2), ml2 = *(const f32x2*)(ml + ((size_t)1 * 1024 + tl) * 2);
        const float M = MX3(m0, ml1[0], ml2[0]);
        const float w0 = __builtin_amdgcn_exp2f(m0 - M), w1 = __builtin_amdgcn_exp2f(ml1[0] - M), w2 = __builtin_amdgcn_exp2f(ml2[0] - M);
        const float rden = 1.0f / (w0 * l0 + w1 * ml1[1] + w2 * ml2[1]);
        const float* p1 = part + ((size_t)0 * 1024 + tl) * 64 + 4 * hi; const float* p2 = part + ((size_t)1 * 1024 + tl) * 64 + 4 * hi;
        bf16_t* op = (bf16_t*)(a.ws + WS_MIXED) + ((size_t)b * SEQ + T0 + tl) * DM + head * 64 + 4 * hi;
#pragma unroll
        for (int d0 = 0; d0 < 2; ++d0)
#pragma unroll
            for (int g = 0; g < 4; ++g) { const f32x4 a1 = *(const f32x4*)(p1 + 32 * d0 + 8 * g), a2 = *(const f32x4*)(p2 + 32 * d0 + 8 * g); float v[4];
#pragma unroll
                for (int j = 0; j < 4; ++j) v[j] = (w0 * o[d0][4 * g + j] + w1 * a1[j] + w2 * a2[j]) * rden;
                u32x2 w; w.x = cvtpk(v[0], v[1]); w.y = cvtpk(v[2], v[3]); *(u32x2*)(op + 32 * d0 + 8 * g) = w; }
    }
    __syncthreads();
}

__device__ __forceinline__ unsigned ordkey(float v) { const unsigned u = __float_as_uint(v); return u ^ ((u >> 31) ? 0xFFFFFFFFu : 0x80000000u); }
__device__ __forceinline__ float unordkey(unsigned k) { const unsigned u = (k & 0x80000000u) ? (k ^ 0x80000000u) : ~k; return __uint_as_float(u); }
__device__ __forceinline__ void p4_ln_router(const Frame& F, const Args& a) {
    const int lane = F_LANE, wid = F.wave, tid = F_TID;
    LAS float* Wr = (LAS float*)F.lds;
    LAS unsigned* misc = (LAS unsigned*)(F.lds + LX_MISC);
    LAS float* pc = (LAS float*)(F.lds + LX_TOK);
    for (int i = tid; i < DM * NE / 4; i += 512) ((LAS f32x4*)Wr)[i] = ((const f32x4*)a.w_router)[i] * a.ln1_g[i >> 3];
    if (tid < 64) misc[tid] = 0u;
    float* Z = (float*)(a.ws + WS_Z); bf16_t* X1B = (bf16_t*)(a.ws + WS_XB);
    const int r0 = (F.vcu * 8 + wid) * 16;
    const int rl = lane & 15, q = lane >> 4;
    float mym[4] = {0.f, 0.f, 0.f, 0.f}, myr[4] = {0.f, 0.f, 0.f, 0.f};
    {
        f32x4 gv[4], bv[4];
#pragma unroll
        for (int j = 0; j < 4; ++j) { gv[j] = ((const f32x4*)a.ln1_g)[lane + 64 * j]; bv[j] = ((const f32x4*)a.ln1_b)[lane + 64 * j]; }
        float* stats = (float*)(a.ws + WS_ROUTE + 4 * MiB);
#pragma unroll 4
        for (int rr = 0; rr < 16; ++rr) {
            const f32x4* zr = (const f32x4*)(Z + (size_t)(r0 + rr) * DM) + lane; f32x4 v[4]; float s = 0.f;
#pragma unroll
            for (int j = 0; j < 4; ++j) { v[j] = zr[64 * j]; s += (v[j][0] + v[j][1]) + (v[j][2] + v[j][3]); }
            const float mean = wave_sum(s) * (1.f / DM); float s2 = 0.f;
#pragma unroll
            for (int j = 0; j < 4; ++j) { v[j] = v[j] - mean; s2 += (v[j][0] * v[j][0] + v[j][1] * v[j][1]) + (v[j][2] * v[j][2] + v[j][3] * v[j][3]); }
            const float rstd = 1.f / sqrtf(wave_sum(s2) * (1.f / DM) + LN_EPS);
            unsigned* o8 = (unsigned*)((unsigned char*)X1B + (size_t)(r0 + rr) * DM) + lane;
#pragma unroll
            for (int j = 0; j < 4; ++j) { const f32x4 y = (v[j] * rstd * gv[j] + bv[j]) * 8.f; o8[64 * j] = cvt4_fp8(y[0], y[1], y[2], y[3]); }
            if (lane == 0) *(f32x2*)(stats + 2 * (r0 + rr)) = (f32x2){mean, rstd};
            if ((rr >> 2) == q) {
#pragma unroll
                for (int i = 0; i < 4; ++i) if ((rr & 3) == i) { mym[i] = mean; myr[i] = rstd; } }
        }
    }
    __syncthreads();
    {
        const int e = tid & 31, part = tid >> 5; float s0 = 0.f, s1 = 0.f;
        for (int k = part * 64; k < part * 64 + 64; ++k) { s0 += Wr[k * 32 + e]; s1 += a.ln1_b[k] * a.w_router[k * 32 + e]; }
        pc[part * 32 + e] = s0; pc[512 + part * 32 + e] = s1;
    }
    __syncthreads();
    if (tid < 64) { const int e = tid & 31, w = tid >> 5; float t = 0.f; for (int p = 0; p < 16; ++p) t += pc[w * 512 + p * 32 + e]; pc[1024 + tid] = t + (w ? a.b_router[e] : 0.f); }
    __syncthreads();
    f32x4 acc0 = (f32x4){0.f, 0.f, 0.f, 0.f}, acc1 = acc0;
    const float* xr = Z + (size_t)(r0 + rl) * DM + 4 * q;
#pragma unroll 4
    for (int cidx = 0; cidx < 64; ++cidx) {
        const f32x4 xv = *(const f32x4*)(xr + 16 * cidx);
#pragma unroll
        for (int j = 0; j < 4; ++j) { const int k = 16 * cidx + 4 * q + j;
            acc0 = __builtin_amdgcn_mfma_f32_16x16x4f32(xv[j], Wr[k * 32 + rl], acc0, 0, 0, 0);
            acc1 = __builtin_amdgcn_mfma_f32_16x16x4f32(xv[j], Wr[k * 32 + 16 + rl], acc1, 0, 0, 0); }
    }
    {   const float cs0 = pc[1024 + rl], cs1 = pc[1024 + 16 + rl], cb0 = pc[1024 + 32 + rl], cb1 = pc[1024 + 48 + rl];
#pragma unroll
        for (int i = 0; i < 4; ++i) { acc0[i] = myr[i] * (acc0[i] - mym[i] * cs0) + cb0; acc1[i] = myr[i] * (acc1[i] - mym[i] * cs1) + cb1; } }
    const float br0 = 0.f, br1 = 0.f;
    int* sel_e = (int*)(a.ws + WS_ROUTE); int* sel_pos = sel_e + NTOK * TOPK; float* sel_gate = (float*)(sel_pos + NTOK * TOPK);
    int my_e[4] = {0, 0, 0, 0}, my_lp[4] = {0, 0, 0, 0}; float my_g[4] = {0.f, 0.f, 0.f, 0.f};
#pragma unroll
    for (int i = 0; i < 4; ++i) {
        unsigned k0 = (ordkey(acc0[i] + br0) & ~31u) | (unsigned)(31 - rl), k1 = (ordkey(acc1[i] + br1) & ~31u) | (unsigned)(15 - rl);
        unsigned selk[4];
#pragma unroll
        for (int t = 0; t < 4; ++t) {
            unsigned m = k0 > k1 ? k0 : k1;
#pragma unroll
            for (int ofs = 1; ofs < 16; ofs <<= 1) { const unsigned other = (unsigned)__shfl_xor((int)m, ofs); m = other > m ? other : m; }
            selk[t] = m; if (k0 == m) k0 = 0u; if (k1 == m) k1 = 0u;
        }
        const float v0 = unordkey(selk[0] & ~31u), v1 = unordkey(selk[1] & ~31u), v2 = unordkey(selk[2] & ~31u), v3 = unordkey(selk[3] & ~31u);
        const float e1 = __expf(v1 - v0), e2 = __expf(v2 - v0), e3 = __expf(v3 - v0); const float rs = 1.0f / (1.0f + e1 + e2 + e3);
        if (rl < 4) { const unsigned sk = rl == 0 ? selk[0] : (rl == 1 ? selk[1] : (rl == 2 ? selk[2] : selk[3]));
            const float ge = rl == 0 ? 1.0f : (rl == 1 ? e1 : (rl == 2 ? e2 : e3));
            my_e[i] = 31 - (int)(sk & 31u); my_g[i] = ge * rs; my_lp[i] = (int)atomicAdd((unsigned*)&misc[my_e[i]], 1u); }
    }
    __syncthreads();
    unsigned* gcnt = (unsigned*)(a.ws + WS_CTL);
    if (F_TID < 32) misc[32 + F_TID] = atomicAdd(&gcnt[F_TID], misc[F_TID]);
    __syncthreads();
    if (rl < 4) {
#pragma unroll
        for (int i = 0; i < 4; ++i) { const int tok = r0 + 4 * q + i, idx = tok * 4 + rl; sel_e[idx] = my_e[i]; sel_pos[idx] = (int)misc[32 + my_e[i]] + my_lp[i]; sel_gate[idx] = my_g[i]; }
    }
}

__device__ __forceinline__ int build_tiles(const Frame& F, const Args& a) {
    LAS unsigned* misc = (LAS unsigned*)(F.lds + LX_MISC); LAS unsigned char* tile_e = F.lds + LX_TILE;
    const unsigned* gcnt = (const unsigned*)(a.ws + WS_CTL);
    if (F_TID < NE) misc[128 + F_TID] = (__hip_atomic_load(&gcnt[F_TID], __ATOMIC_RELAXED, __HIP_MEMORY_SCOPE_AGENT) + 255u) >> 8;
    __syncthreads();
    if (F_TID == 0) { unsigned acc = 0; for (int e = 0; e < NE; ++e) { misc[64 + e] = acc; acc += misc[128 + e]; } misc[64 + NE] = acc; }
    __syncthreads();
    const int nt = (int)misc[64 + NE];
    for (int e = 0; e < NE; ++e) { const int t0 = (int)misc[64 + e], t1 = (int)misc[65 + e]; for (int t = t0 + F_TID; t < t1; t += 512) tile_e[t] = (unsigned char)e; }
    __syncthreads();
    return nt;
}

#define XLAS __attribute__((address_space(3)))
#define XB_TMO      128
#define XB_XCNT(j)  (256  + 64 * (j))
#define XB_XSUB(j)  (1280 + 64 * (j))
#define XB_XGEN(j)  (2304 + 64 * (j))
#define XB_TOP      3328
#define XB_TOPGEN   3392
#define XCD_BAR_WORDS 3456
#define XB_SPIN_CAP (1u << 22)

__device__ __forceinline__ unsigned xb_ld(unsigned* p)              { return __hip_atomic_load(p, __ATOMIC_RELAXED, __HIP_MEMORY_SCOPE_AGENT); }
__device__ __forceinline__ unsigned xb_add(unsigned* p, unsigned v) { return __hip_atomic_fetch_add(p, v, __ATOMIC_RELAXED, __HIP_MEMORY_SCOPE_AGENT); }
__device__ __forceinline__ unsigned xb_xcc_id() { return (unsigned)__builtin_amdgcn_s_getreg((3 << 11) | 20) & 0xFu; }
#define XB_SPIN(cond, bar) do { unsigned _sp = 0; while (cond) { __builtin_amdgcn_s_sleep(1); \
    if ((++_sp & 255u) == 0u) { if (xb_ld(&(bar)[XB_TMO])) break; if (_sp > XB_SPIN_CAP) { atomicAdd(&(bar)[XB_TMO], 1u); break; } } } } while (0)

struct XcdBarrier {
    unsigned* bar; unsigned x;
    volatile XLAS unsigned* st;
};

__device__ __forceinline__ XcdBarrier xcd_barrier_post(unsigned* bar, volatile XLAS unsigned* st) {
    XcdBarrier b; b.bar = bar; b.x = xb_xcc_id(); b.st = st;
    if (threadIdx.x == 0) (void)xb_add(&bar[XB_XCNT(b.x)], 1u);
    return b;
}
__device__ __forceinline__ void xcd_barrier_complete(unsigned* bar, unsigned x, unsigned& nloc, unsigned& nx) {
    const unsigned G = gridDim.x * gridDim.y * gridDim.z;
    unsigned sum, cnt, mine, sp = 0u;
    for (;;) {
        sum = 0u; cnt = 0u; mine = 0u;
#pragma unroll
        for (unsigned j = 0; j < 16; ++j) { const unsigned c = xb_ld(&bar[XB_XCNT(j)]); sum += c; cnt += (c > 0u) ? 1u : 0u; mine = (j == x) ? c : mine; }
        if (sum == G) break;
        __builtin_amdgcn_s_sleep(1);
        if ((++sp & 255u) == 0u) { if (xb_ld(&bar[XB_TMO])) break; if (sp > XB_SPIN_CAP) { atomicAdd(&bar[XB_TMO], 1u); break; } }
    }
    nloc = mine > 0u ? mine : 1u; nx = cnt > 0u ? cnt : 1u;
}

__device__ __forceinline__ void xcd_barrier(const XcdBarrier& b, const int tid0) {
    asm volatile("s_waitcnt vmcnt(0)" ::: "memory");
    __syncthreads();
    if (tid0 == 0) {
        unsigned* bar = b.bar;
        __builtin_amdgcn_s_waitcnt(0);
        unsigned nloc = b.st[0], nx = b.st[1];
        if (nloc == 0u) { xcd_barrier_complete(bar, b.x, nloc, nx); b.st[0] = nloc; b.st[1] = nx; }
        const unsigned old = xb_add(&bar[XB_XSUB(b.x)], 1u);
        const unsigned gen = old / nloc;
        if (old + 1u == (gen + 1u) * nloc) {
            __builtin_amdgcn_fence(__ATOMIC_RELEASE, "agent");
            asm volatile("s_waitcnt vmcnt(0)" ::: "memory");
            const unsigned og = xb_add(&bar[XB_TOP], 1u);
            const unsigned tg = og / nx;
            if (og + 1u == (tg + 1u) * nx) xb_add(&bar[XB_TOPGEN], 1u);
            else XB_SPIN(xb_ld(&bar[XB_TOPGEN]) == tg, bar);
            __builtin_amdgcn_fence(__ATOMIC_ACQUIRE, "agent");
            xb_add(&bar[XB_XGEN(b.x)], 1u);
            asm volatile("s_waitcnt vmcnt(0)" ::: "memory");
        } else {
            XB_SPIN(xb_ld(&bar[XB_XGEN(b.x)]) == gen, bar);
            __builtin_amdgcn_fence(__ATOMIC_ACQUIRE, "agent");
            asm volatile("s_waitcnt vmcnt(0)" ::: "memory");
        }
    }
    __syncthreads();
}

__global__ void __launch_bounds__(512, 2) fwd_megakernel(Args a) {
    extern __shared__ __attribute__((aligned(16))) unsigned char lds_raw[];
    cg::grid_group grid = cg::this_grid();
    Frame F; F.lds = (LAS unsigned char*)lds_raw; F.wave = __builtin_amdgcn_readfirstlane((int)(threadIdx.x >> 6));
    F.G = gridDim.x; { const int bx = blockIdx.x; F.vcu = (F.G % 8 == 0) ? (bx % 8) * (F.G / 8) + bx / 8 : bx; }
    unsigned char* ws = a.ws;
    {   LAS unsigned* m0_ = (LAS unsigned*)(F.lds + LX_MISC); if (F_TID < 128) m0_[F_TID] = 0u; __syncthreads(); }
    XcdBarrier xbar = xcd_barrier_post((unsigned*)(ws + WS_CTL) + CW_BAR, (volatile LAS unsigned*)(F.lds + LX_MISC) + 120);
#define GRID_BAR() xcd_barrier(xbar, F_TID)
#ifdef PROBE_T1
    unsigned long long* stamps = (unsigned long long*)(ws + WS_CTL + 2048);
#define STAMP(k) do { if (blockIdx.x == 0 && F_TID == 0) stamps[k] = __builtin_amdgcn_s_memrealtime(); } while (0)
#else
#define STAMP(k) do {} while (0)
#endif
    STAMP(0);

    for (int rep = 0; rep < REP_P0; ++rep) p0_prologue(F, a);
    if (a.out == nullptr) grid.sync();
    GRID_BAR();
    STAMP(1);

    for (int rep = 0; rep < REP_P1; ++rep) {
        pg8::Gemm g{(const bf16_t*)(ws + WS_XB), (const bf16_t*)(ws + WS_WIN), NTOK, NPROJ, DM, 0, 0}; pg8::StaticOrder S; S.init(NTOK, NPROJ, F.G, (int)blockIdx.x);
        EpiProj E{(bf16_t*)(ws + WS_PROJ), (unsigned*)(ws + WS_CTL)};
        pg8::gemm_phase<EpiProj, pg8::StaticOrder, true, false, KREP_P1>(F.lds, g, S, E, F_TID);
    }
    GRID_BAR();
    STAMP(2);

    {
        float s1 = 0.f, s2 = 0.f;
        for (int i = 0; i < 64; ++i) { s1 += a.lq1[i] * a.lk1[i]; s2 += a.lq2[i] * a.lk2[i]; }
        const float lam = __expf(s1) - __expf(s2) + LAM_INIT;
        {
            LAS unsigned* misc = (LAS unsigned*)(F.lds + LX_MISC); unsigned* ctl = (unsigned*)(ws + WS_CTL);
            const int myx = (int)(xbar.x & 7u);
            for (;;) {
                __syncthreads();
                if (F_TID == 0) { int got = -1;
                    { const unsigned p = atomicAdd(ctl + CW_QUEUE + myx, 1u); if (p < 160u) got = myx * 256 + (int)p; }
                    for (int k = 1; k < 8 && got < 0; ++k) { const int qx = (myx + k) & 7;
                        if (__hip_atomic_load(ctl + CW_QUEUE + qx, __ATOMIC_RELAXED, __HIP_MEMORY_SCOPE_AGENT) < 160u) { const unsigned p = atomicAdd(ctl + CW_QUEUE + qx, 1u); if (p < 160u) got = qx * 256 + (int)p; } }
                    misc[100] = (unsigned)got; }
                __syncthreads();
                const int idx = __builtin_amdgcn_readfirstlane((int)misc[100]);
                if (idx < 0) break;
                const int qx = idx >> 8, p = idx & 255;
                if (p < 64 && (p & 1)) attnA_unit(F, a, qx * 32 + (p >> 1));
                else { const int h = p < 64 ? 3 : 2 - ((p - 64) >> 5), j = p < 64 ? (p >> 1) : (p & 31); attnB_item(F, a, h, qx >> 2, 32 * (qx & 3) + j, lam); }
            }
        }
    }
    GRID_BAR();
    STAMP(3);

    for (int rep = 0; rep < REP_P3; ++rep) {
        pg8::Gemm g{(const bf16_t*)(ws + WS_MIXED), (const bf16_t*)(ws + WS_WOUT), NTOK, DM, DM, 0, 0}; pg8::StaticOrder S; S.init(NTOK, DM, F.G, (int)blockIdx.x);
        EpiZ E{a.x, (float*)(ws + WS_Z)};
        pg8::gemm_phase<EpiZ, pg8::StaticOrder, true, false, KREP_P3>(F.lds, g, S, E, F_TID);
    }
    GRID_BAR();
    STAMP(4);

    if (F.G == 256) p4_ln_router(F, a);
    GRID_BAR();
    STAMP(5);

    int* sel_e = (int*)(ws + WS_ROUTE); int* sel_pos = sel_e + NTOK * TOPK; float* sel_gate = (float*)(sel_pos + NTOK * TOPK);
    int* inv = (int*)(sel_gate + NTOK * TOPK); int* row_tok = inv + NTOK * TOPK; float* row_gate = (float*)(row_tok + 262144);
    {
        const int ntl = build_tiles(F, a); (void)ntl;
        LAS unsigned* misc = (LAS unsigned*)(F.lds + LX_MISC);
        const unsigned* gcnt = (const unsigned*)(ws + WS_CTL);
        for (int idx = F.vcu * 512 + F_TID; idx < NTOK * TOPK; idx += F.G * 512) {
            const int e = sel_e[idx], dest = (int)misc[64 + e] * 256 + sel_pos[idx];
            row_tok[dest] = idx >> 2; row_gate[dest] = sel_gate[idx]; inv[idx] = dest;
        }
        for (int e = F.vcu; e < NE; e += F.G) {
            const int c = (int)__hip_atomic_load(&gcnt[e], __ATOMIC_RELAXED, __HIP_MEMORY_SCOPE_AGENT), base = (int)misc[64 + e] * 256, end = (int)misc[65 + e] * 256;
            for (int r = base + c + F_TID; r < end; r += 512) { row_tok[r] = 0; row_gate[r] = 0.f; }
        }
    }
    GRID_BAR();
    STAMP(6);

    for (int rep = 0; rep < REP_P6; ++rep) {
        const int ntl = build_tiles(F, a);
        MoeOrder S; S.so.init(ntl * 256, 2048, F.G, (int)blockIdx.x); S.tile_e = F.lds + LX_TILE; S.tok = (const LAS unsigned short*)(F.lds + LX_TOK); S.ncolt = 8;
        {
            LAS unsigned short* tk = (LAS unsigned short*)(F.lds + LX_TOK); pg8::Unit u;
            for (int i = F.wave; i < 24 && S.so.next(i, u); i += 8) { const int l_ = F_LANE;
#pragma unroll
                for (int j = 0; j < 4; ++j) tk[i * 256 + l_ + 64 * j] = (unsigned short)row_tok[u.pm * 256 + l_ + 64 * j]; }
            __syncthreads();
        }
        pg8::Gemm g{(const bf16_t*)(ws + WS_XB), (const bf16_t*)(ws + WS_WUP), ntl * 256, 2048, DM, 0x7C7C7C7C, 0x77777777};
        EpiUp E{(bf16_t*)(ws + WS_H), a.b_up};
        pg8::gemm_phase<EpiUp, MoeOrder, true, true, KREP_P6, true>(F.lds, g, S, E, F_TID);
    }
    GRID_BAR();
    STAMP(7);

    for (int rep = 0; rep < REP_P7; ++rep) {
        const int ntl = build_tiles(F, a);
        MoeOrder S; S.so.init(ntl * 256, 1024, F.G, (int)blockIdx.x, ORD_REV7); S.tile_e = F.lds + LX_TILE; S.tok = nullptr; S.ncolt = 4;
        pg8::Gemm g{(const bf16_t*)(ws + WS_H), (const bf16_t*)(ws + WS_WDN), ntl * 256, DM, DFF, 0x7D7D7D7D, 0x77777777};
        EpiDown E{(bf16_t*)(ws + WS_Y), a.b_down, row_gate};
        pg8::gemm_phase<EpiDown, MoeOrder, true, false, KREP_P7, true>(F.lds, g, S, E, F_TID);
    }
    GRID_BAR();
    STAMP(8);

    for (int rep = 0; rep < REP_P8; ++rep) {
        const int lane = F_LANE; const float* X1 = (const float*)(ws + WS_Z); const bf16_t* Y = (const bf16_t*)(ws + WS_Y); const float* stats = (const float*)(ws + WS_ROUTE + 4 * MiB);
        f32x4 gv[4], bv[4], g1[4], b1[4];
#pragma unroll
        for (int j = 0; j < 4; ++j) { gv[j] = ((const f32x4*)a.ln2_g)[lane + 64 * j]; bv[j] = ((const f32x4*)a.ln2_b)[lane + 64 * j]; g1[j] = ((const f32x4*)a.ln1_g)[lane + 64 * j] * ALPHA; b1[j] = ((const f32x4*)a.ln1_b)[lane + 64 * j] * ALPHA; }
        for (int m = F.vcu * 8 + F.wave; m < NTOK; m += F.G * 8) {
            const f32x4* xr = (const f32x4*)(X1 + (size_t)m * DM) + lane; f32x4 v[4]; const f32x2 st = *(const f32x2*)(stats + 2 * m);
#pragma unroll
            for (int j = 0; j < 4; ++j) v[j] = (xr[64 * j] - st[0]) * st[1] * g1[j] + b1[j];
#pragma unroll
            for (int t = 0; t < 4; ++t) { const int dest = inv[m * 4 + t]; const unsigned* yr = (const unsigned*)((const unsigned char*)Y + (size_t)dest * DM) + lane;
#pragma unroll
                for (int j = 0; j < 4; ++j) { const int w = (int)yr[64 * j];
                    v[j][0] += __builtin_amdgcn_cvt_f32_fp8(w, 0) * (1.f / 32.f); v[j][1] += __builtin_amdgcn_cvt_f32_fp8(w, 1) * (1.f / 32.f);
                    v[j][2] += __builtin_amdgcn_cvt_f32_fp8(w, 2) * (1.f / 32.f); v[j][3] += __builtin_amdgcn_cvt_f32_fp8(w, 3) * (1.f / 32.f); } }
            float s = 0.f;
#pragma unroll
            for (int j = 0; j < 4; ++j) s += (v[j][0] + v[j][1]) + (v[j][2] + v[j][3]);
            const float mean = wave_sum(s) * (1.f / DM); float s2 = 0.f;
#pragma unroll
            for (int j = 0; j < 4; ++j) { v[j] = v[j] - mean; s2 += (v[j][0] * v[j][0] + v[j][1] * v[j][1]) + (v[j][2] * v[j][2] + v[j][3] * v[j][3]); }
            const float rstd = 1.f / sqrtf(wave_sum(s2) * (1.f / DM) + LN_EPS);
            f32x4* orow = (f32x4*)(a.out + (size_t)m * DM) + lane;
#pragma unroll
            for (int j = 0; j < 4; ++j) orow[64 * j] = v[j] * rstd * gv[j] + bv[j];
        }
    }
#ifdef PROBE_T1
    STAMP(9);
    if (blockIdx.x == 0) {
        __syncthreads();
        const float t1 = (float)(stamps[PROBE_T1 + 1] - stamps[PROBE_T1]) * 0.01f, t2 = (float)(stamps[PROBE_T2 + 1] - stamps[PROBE_T2]) * 0.01f;
        for (int i = F_TID; i < (1 << 20); i += 512) a.out[1 + i] = t2;
        if (F_TID == 0) a.out[0] = t1 * 10.0f;
    }
#endif
}

extern "C" void kernel_launch(void* const* d_in, const int* in_sizes, int n_in, void* d_out, int out_size, void* d_ws, size_t ws_size, hipStream_t stream) {
    static int grid = 0;
    if (grid == 0) {
        if (n_in != 18 || in_sizes[0] != NTOK * DM || out_size != NTOK * DM || ws_size < WS_END) {
            fprintf(stderr, "kernel_launch: unexpected shapes (n_in %d, in0 %d, out %d, ws %zu need %zu); nothing launched\n", n_in, n_in > 0 ? in_sizes[0] : -1, out_size, ws_size, (size_t)WS_END); grid = -1; return; }
        int dev = 0, cus = 0, per_cu = 0;
        if (hipGetDevice(&dev) != hipSuccess || hipDeviceGetAttribute(&cus, hipDeviceAttributeMultiprocessorCount, dev) != hipSuccess) { grid = -1; return; }
        if (hipFuncSetAttribute((const void*)fwd_megakernel, hipFuncAttributeMaxDynamicSharedMemorySize, LDS_BYTES) != hipSuccess) { fprintf(stderr, "kernel_launch: hipFuncSetAttribute failed\n"); grid = -1; return; }
        if (hipOccupancyMaxActiveBlocksPerMultiprocessor(&per_cu, (const void*)fwd_megakernel, 512, LDS_BYTES) != hipSuccess || per_cu < 1) { fprintf(stderr, "kernel_launch: occupancy query says %d\n", per_cu); per_cu = 1; }
        (void)hipGetLastError();
        grid = cus * (per_cu > 1 ? 1 : per_cu);
        fprintf(stderr, "kernel_launch: grid %d (cus %d, per_cu %d)\n", grid, cus, per_cu);
    }
    if (grid < 0) return;
    if (hipMemsetAsync((char*)d_ws + WS_CTL, 0, CTL_ZERO_BYTES, stream) != hipSuccess) return;
    Args a{};
    const float* const* in = (const float* const*)d_in;
    a.x = in[0]; a.w_in = in[1]; a.w_out = in[2]; a.lq1 = in[3]; a.lk1 = in[4]; a.lq2 = in[5]; a.lk2 = in[6]; a.g_sub = in[7];
    a.ln1_g = in[8]; a.ln1_b = in[9]; a.w_router = in[10]; a.b_router = in[11]; a.w_up = in[12]; a.b_up = in[13]; a.w_down = in[14]; a.b_down = in[15];
    a.ln2_g = in[16]; a.ln2_b = in[17]; a.out = (float*)d_out; a.ws = (unsigned char*)d_ws;
    void* args[] = {&a};
    hipError_t e = hipLaunchCooperativeKernel((void*)fwd_megakernel, dim3(grid), dim3(512), args, LDS_BYTES, stream);
    if (e != hipSuccess) fprintf(stderr, "kernel_launch: cooperative launch failed: %s (grid %d)\n", hipGetErrorString(e), grid);
}
```

```cpp
#include <hip/hip_runtime.h>
#include <hip/hip_cooperative_groups.h>
#include <cstdio>
#include <cstdint>
namespace cg = cooperative_groups;
#ifndef KREP_P1
#define KREP_P1 1
#endif
#ifndef KREP_P3
#define KREP_P3 1
#endif
#ifndef KREP_P6
#define KREP_P6 1
#endif
#ifndef KREP_P7
#define KREP_P7 1
#endif
#ifndef ORD_SWZ
#define ORD_SWZ 0
#endif
#ifndef ORD_REV7
#define ORD_REV7 1
#endif
#ifndef REP_P0
#define REP_P0 1
#endif
#ifndef REP_P1
#define REP_P1 1
#endif
#ifndef REP_A
#define REP_A 1
#endif
#ifndef REP_B
#define REP_B 1
#endif
#ifndef REP_P3
#define REP_P3 1
#endif
#ifndef REP_P6
#define REP_P6 1
#endif
#ifndef REP_P7
#define REP_P7 1
#endif
#ifndef REP_P8
#define REP_P8 1
#endif

#define LAS __attribute__((address_space(3)))
typedef unsigned short bf16_t;
typedef short bf16x8 __attribute__((ext_vector_type(8)));
typedef short s16x4 __attribute__((ext_vector_type(4)));
typedef float f32x4 __attribute__((ext_vector_type(4)));
typedef float f32x2 __attribute__((ext_vector_type(2)));
typedef float f32x16 __attribute__((ext_vector_type(16)));
typedef unsigned u32x4 __attribute__((ext_vector_type(4)));
typedef unsigned u32x2 __attribute__((ext_vector_type(2)));
typedef __bf16 bf16x2_t __attribute__((ext_vector_type(2)));

constexpr int BATCH = 2, SEQ = 16384, DM = 1024, NTOK = BATCH * SEQ;
constexpr int NPROJ = 3072, NE = 32, TOPK = 4, DFF = 1024;
constexpr int NROWS_MAX = NTOK * TOPK + NE * 256;
constexpr float LN_EPS = 1e-5f;
constexpr float ALPHA = 1.189207115002721f;
constexpr float LOG2E = 1.4426950408889634f;
constexpr float C2 = 0.125f * LOG2E;
constexpr float LAM_INIT = 0.2f;
constexpr float NEG_BIG = -1e30f;

constexpr size_t MiB = 1u << 20;
constexpr size_t WS_CTL = 0, CTL_ZERO_BYTES = 65536;
constexpr int CW_QMAX = 64, CW_KMAX = 128, CW_QUEUE = 256, CW_BAR = 4096;
constexpr size_t WS_WIN = 2 * MiB, WS_WOUT = 8 * MiB, WS_WUP = 16 * MiB, WS_WDN = 144 * MiB;
constexpr size_t WS_XB = 208 * MiB;
constexpr size_t WS_PROJ = 272 * MiB;
constexpr size_t PROJ_STRIDE = (size_t)NTOK * 512;
constexpr size_t WS_MIXED = 464 * MiB;
constexpr size_t WS_Z = 272 * MiB;
constexpr size_t WS_H = 400 * MiB;
constexpr size_t WS_Y = 672 * MiB;
constexpr size_t WS_APART = 672 * MiB;
constexpr size_t APART_UNIT = 2 * 1024 * 64 * 4 + 2 * 1024 * 2 * 4;
constexpr size_t WS_ROUTE = 944 * MiB;
constexpr size_t WS_END = 952 * MiB;

constexpr int RING_BYTES = 131072;
constexpr int LX_TILE = 131072;
constexpr int LX_TOK = 132096;
constexpr int LX_MISC = 144384;
constexpr int LDS_BYTES = 147456;

__device__ __forceinline__ unsigned cvtpk(float lo, float hi) { f32x2 v = {lo, hi}; bf16x2_t b = __builtin_convertvector(v, bf16x2_t); return __builtin_bit_cast(unsigned, b); }
__device__ __forceinline__ unsigned cvt4_fp8(float a, float b, float c, float d) { int w = 0; w = __builtin_amdgcn_cvt_pk_fp8_f32(a, b, w, false); w = __builtin_amdgcn_cvt_pk_fp8_f32(c, d, w, true); return (unsigned)w; }
__device__ __forceinline__ float wave_sum(float v) {
#pragma unroll
    for (int o = 1; o < 64; o <<= 1) v += __shfl_xor(v, o);
    return v;
}

namespace pg8 {
constexpr int BM = 256, BK = 64, HALF = 128, HTB = HALF * BK * 2, STAGE_BYTES = 8 * HTB, NXCD = 8, WGM = 8;
__host__ __device__ __forceinline__ int lds_byte(int r, int c) { const int st = (r >> 4) * 2 + (c >> 5), rr = r & 15, cc = c & 31, ob = rr * 64 + cc * 2; return st * 1024 + (ob ^ (((ob >> 9) & 1) << 5)); }
__host__ __device__ __forceinline__ void stage_rc(int b, int& R, int& C) { const int st = b / 1024, sb = b % 1024, swz = sb ^ (((sb >> 9) & 1) << 5); R = (st >> 1) * 16 + swz / 64; C = (st & 1) * 32 + (swz % 64) / 2; }
__host__ __device__ __forceinline__ int perm32(int rho) { const int n = rho >> 4, i = rho & 15; return 8 * (i >> 2) + 4 * n + (i & 3); }

struct Unit { int pm, pn; };
struct Gemm { const bf16_t* A; const bf16_t* Bt; int M, N, K; int scale_a, scale_b; };
typedef int v4i_t __attribute__((ext_vector_type(4))); typedef int v8i_t __attribute__((ext_vector_type(8)));

struct StaticOrder {
    int nM, nN, nwg, G, c, rev, swz;
    __host__ __device__ void init(int M, int N, int G_, int c_, int rev_ = 0, int swz_ = ORD_SWZ) { nM = M / BM; nN = N / BM; nwg = nM * nN; G = G_; c = c_; rev = rev_; swz = swz_; }
    __host__ __device__ bool next(int i, Unit& u) const {
        const long L = (long)i * G + c; if (L >= nwg) return false;
        int wgid = (rev == 1) ? nwg - 1 - (int)L : (int)L;
        if (swz) { const int q = nwg / NXCD, r = nwg % NXCD, xcd = wgid % NXCD; int off = wgid / NXCD; const int len = xcd < r ? q + 1 : q;
            if (rev == 2) off = len - 1 - off;
            wgid = (xcd < r ? xcd * (q + 1) : r * (q + 1) + (xcd - r) * q) + off; }
        const int nig = WGM * nN, gid = wgid / nig, fm = gid * WGM, gsz = (nM - fm) < WGM ? (nM - fm) : WGM;
        u.pm = fm + ((wgid % nig) % gsz); u.pn = (wgid % nig) / gsz; return true;
    }
    __device__ __forceinline__ const LAS unsigned short* tok_table(int) const { return nullptr; }
};

template <class Epi, class Sched, bool ALIGN_EPI, bool GATHER, int KREP = 1, bool F8 = false>
__device__ __forceinline__ void gemm_phase(LAS unsigned char* lds, const Gemm g, const Sched& S, const Epi& E, const int tid) {
    const int wid = __builtin_amdgcn_readfirstlane(tid >> 6), lane = tid & 63, wr = wid >> 2, wc = wid & 3, fr = lane & 15, fq = lane >> 4;
    constexpr int ES = F8 ? 1 : 2;
    const int sclW = g.scale_b, sclX = g.scale_a;
    const int K = g.K, ntr = K * ES / (BK * 2), nt = ntr * KREP;
    unsigned voffA[2], voffB[2]; int rowA[2];
#pragma unroll
    for (int i = 0; i < 2; ++i) { int R, C; stage_rc(tid * 16 + i * 8192, R, C); const int Rb = Epi::PERM ? ((R & ~31) + perm32(R & 31)) : R;
        voffA[i] = GATHER ? (unsigned)(C * 2) : (unsigned)(R * K * ES + C * 2); voffB[i] = (unsigned)(Rb * K * ES + C * 2); rowA[i] = R; }
    const size_t kstep = (size_t)(BK * 2);
    const size_t hstep = (size_t)HALF * K * ES;
    const size_t tstep = 2 * hstep;
    const unsigned ldsw = (unsigned)wid * 1024u;
    const int aoff = lds_byte(wr * 64 + fr, fq * 8), boff = lds_byte(wc * 32 + fr, fq * 8);
    const int aoff8 = lds_byte(wr * 64 + fr, fq * 16), boff8 = lds_byte(wc * 32 + fr, fq * 16);
#define PG8_SA(b, h) (((b) * 2 + (h)) * HTB)
#define PG8_SB(b, h) ((4 + (b) * 2 + (h)) * HTB)
#define PG8_STAGE(bufoff, gbase, voff) do { _Pragma("unroll") for (int _i = 0; _i < 2; ++_i) \
        __builtin_amdgcn_global_load_lds((const unsigned*)((const char*)(gbase) + (voff)[_i]), (LAS unsigned*)(lds + (bufoff) + ldsw + _i * 8192), 16, 0, 0); } while (0)
#define PG8_STAGE_A(bufoff, NX, h, kb) do { if constexpr (GATHER) { const unsigned* _o = (NX) ? gN[h] : gC[h]; PG8_STAGE(bufoff, (const char*)g.A + (kb), _o); } \
        else { PG8_STAGE(bufoff, ((NX) ? nA : cA) + (h) * hstep + (kb), voffA); } } while (0)
#define PG8_LDA(dst, b, h) do { _Pragma("unroll") for (int m = 0; m < 4; ++m) _Pragma("unroll") for (int k = 0; k < 2; ++k) dst[m][k] = *(const LAS bf16x8*)(lds + PG8_SA(b, h) + (F8 ? aoff8 + k * 16 : aoff + k * 1024) + m * 2048); } while (0)
#define PG8_LDB(dst, b, h) do { _Pragma("unroll") for (int n = 0; n < 2; ++n) _Pragma("unroll") for (int k = 0; k < 2; ++k) dst[n][k] = *(const LAS bf16x8*)(lds + PG8_SB(b, h) + (F8 ? boff8 + k * 16 : boff + k * 1024) + n * 2048); } while (0)
#define PG8_F8OP(x) __builtin_shufflevector(__builtin_bit_cast(v4i_t, x[0]), __builtin_bit_cast(v4i_t, x[1]), 0, 1, 2, 3, 4, 5, 6, 7)
#define PG8_MMA(ai, bj, At, Bt) do { __builtin_amdgcn_s_setprio(1); _Pragma("unroll") for (int m = 0; m < 4; ++m) _Pragma("unroll") for (int n = 0; n < 2; ++n) { \
        if constexpr (F8) { const v8i_t _a = PG8_F8OP(Bt[n]), _b = PG8_F8OP(At[m]); asm volatile("v_mfma_scale_f32_16x16x128_f8f6f4 %0, %1, %2, %0, %3, %4 op_sel_hi:[0,0,0]" : "+v"(acc[ai][bj][m][n]) : "v"(_a), "v"(_b), "v"(sclW), "v"(sclX)); } \
        else { _Pragma("unroll") for (int k = 0; k < 2; ++k) acc[ai][bj][m][n] = __builtin_amdgcn_mfma_f32_16x16x32_bf16(Bt[n][k], At[m][k], acc[ai][bj][m][n], 0, 0, 0); } } \
        __builtin_amdgcn_s_setprio(0); } while (0)
#define PG8_WAIT_V(n) asm volatile("s_waitcnt vmcnt(" #n ")" ::: "memory")
#define PG8_WAIT_L(n) asm volatile("s_waitcnt lgkmcnt(" #n ")" ::: "memory")
#define PG8_BAR __builtin_amdgcn_s_barrier()
#define PG8_SCHED __builtin_amdgcn_sched_barrier(0)
#define PG8_GOFF(dst, ui_) do { if constexpr (GATHER) { const LAS unsigned short* _t = S.tok_table(ui_); _Pragma("unroll") for (int _h = 0; _h < 2; ++_h) _Pragma("unroll") for (int _i = 0; _i < 2; ++_i) \
        dst[_h][_i] = (unsigned)_t[_h * HALF + rowA[_i]] * (unsigned)(K * ES) + voffA[_i]; } } while (0)
    Unit cur, nxt; int ui = 0;
    if (!S.next(0, cur)) return;
    f32x4 acc[2][2][4][2];
    E.init(acc, cur, wc, fq);
    bf16x8 At[4][2], B0[2][2], B1[2][2];
    unsigned gC[2][2] = {{0u, 0u}, {0u, 0u}}, gN[2][2] = {{0u, 0u}, {0u, 0u}};
    PG8_GOFF(gC, 0);
    const char* cA = (const char*)g.A + (GATHER ? (size_t)0 : (size_t)cur.pm * tstep); const char* cB = (const char*)g.Bt + (size_t)cur.pn * tstep;
    const char* nA = cA;
    {
        PG8_STAGE(PG8_SB(0, 0), cB, voffB); PG8_STAGE(PG8_SB(0, 1), cB + hstep, voffB); PG8_STAGE_A(PG8_SA(0, 0), false, 0, 0); PG8_STAGE_A(PG8_SA(0, 1), false, 1, 0);
        if (wr == 1) PG8_BAR;
        PG8_WAIT_V(2); PG8_BAR;
        PG8_STAGE(PG8_SB(1, 0), cB + kstep, voffB); PG8_STAGE_A(PG8_SA(1, 0), false, 0, kstep); PG8_STAGE(PG8_SB(1, 1), cB + hstep + kstep, voffB);
        PG8_WAIT_V(6); PG8_BAR;
    }
    for (;;) {
        const bool has_next = S.next(ui + 1, nxt);
        nA = has_next ? (const char*)g.A + (GATHER ? (size_t)0 : (size_t)nxt.pm * tstep) : cA; const char* nB = has_next ? (const char*)g.Bt + (size_t)nxt.pn * tstep : cB;
        if (has_next) { PG8_GOFF(gN, ui + 1); } else {
#pragma unroll
            for (int h = 0; h < 2; ++h)
#pragma unroll
                for (int i = 0; i < 2; ++i) gN[h][i] = gC[h][i]; }
#pragma unroll 1
        for (int t = 0; t < nt; t += 2) {
            const bool last = (t == nt - 2);
            const size_t k1 = (size_t)((t + 1) % ntr) * kstep;
            const size_t k2 = last ? (size_t)0 : (size_t)((t + 2) % ntr) * kstep, k3 = k2 + kstep;
            const char* b2 = last ? nB : cB + (size_t)((t + 2) % ntr) * kstep; const char* b3 = b2 + kstep;
            PG8_LDB(B0, 0, 0); PG8_LDB(B1, 0, 1); PG8_SCHED; PG8_LDA(At, 0, 0); PG8_STAGE_A(PG8_SA(1, 1), false, 1, k1);
            PG8_WAIT_V(8); PG8_WAIT_L(0); PG8_BAR; PG8_MMA(0, 0, At, B0); PG8_MMA(0, 1, At, B1); PG8_BAR; PG8_SCHED;
            PG8_LDA(At, 0, 1); PG8_STAGE(PG8_SB(0, 0), b2, voffB); PG8_STAGE(PG8_SB(0, 1), b2 + hstep, voffB); PG8_STAGE_A(PG8_SA(0, 0), last, 0, k2);
            PG8_WAIT_V(8); PG8_WAIT_L(0); PG8_BAR; PG8_MMA(1, 0, At, B0); PG8_MMA(1, 1, At, B1); PG8_BAR; PG8_SCHED;
            PG8_LDB(B0, 1, 0); PG8_LDB(B1, 1, 1); PG8_SCHED; PG8_LDA(At, 1, 0); PG8_STAGE_A(PG8_SA(0, 1), last, 1, k2);
            PG8_WAIT_V(8); PG8_WAIT_L(0); PG8_BAR; PG8_MMA(0, 0, At, B0); PG8_MMA(0, 1, At, B1); PG8_BAR; PG8_SCHED;
            PG8_LDA(At, 1, 1); PG8_STAGE(PG8_SB(1, 0), b3, voffB); PG8_STAGE(PG8_SB(1, 1), b3 + hstep, voffB); PG8_STAGE_A(PG8_SA(1, 0), last, 0, k3);
            PG8_WAIT_V(8); PG8_WAIT_L(0); PG8_BAR; PG8_MMA(1, 0, At, B0); PG8_MMA(1, 1, At, B1); PG8_BAR; PG8_SCHED;
        }
        if constexpr (ALIGN_EPI) { if (wr == 0) PG8_BAR; }
        if constexpr (F8) asm volatile("s_nop 15\n\ts_nop 15" ::: "memory");
        if constexpr (KREP > 1) {
_Pragma("unroll") for (int a_ = 0; a_ < 2; ++a_) _Pragma("unroll") for (int b_ = 0; b_ < 2; ++b_) _Pragma("unroll") for (int m_ = 0; m_ < 4; ++m_) _Pragma("unroll") for (int n_ = 0; n_ < 2; ++n_) acc[a_][b_][m_][n_] = acc[a_][b_][m_][n_] * (1.0f / KREP); }
        E(acc, cur, wr, wc, fr, fq);
        if (!has_next) break;
        E.init(acc, nxt, wc, fq);
        cur = nxt; cA = nA; cB = nB; ++ui;
#pragma unroll
        for (int h = 0; h < 2; ++h)
#pragma unroll
            for (int i = 0; i < 2; ++i) gC[h][i] = gN[h][i];
        if constexpr (ALIGN_EPI) { if (wr == 1) PG8_BAR; }
    }
    PG8_WAIT_V(0);
    if constexpr (!ALIGN_EPI) { if (wr == 0) PG8_BAR; }
    PG8_BAR;
#undef PG8_SA
#undef PG8_SB
#undef PG8_STAGE
#undef PG8_STAGE_A
#undef PG8_LDA
#undef PG8_LDB
#undef PG8_MMA
#undef PG8_F8OP
#undef PG8_WAIT_V
#undef PG8_WAIT_L
#undef PG8_BAR
#undef PG8_SCHED
#undef PG8_GOFF
}
}

struct Args {
    const float* x; const float* w_in; const float* w_out; const float* lq1; const float* lk1; const float* lq2; const float* lk2; const float* g_sub;
    const float* ln1_g; const float* ln1_b; const float* w_router; const float* b_router; const float* w_up; const float* b_up; const float* w_down; const float* b_down;
    const float* ln2_g; const float* ln2_b; float* out; unsigned char* ws;
};
struct Frame {
    LAS unsigned char* lds; int wave, vcu, G;
};
__device__ __forceinline__ int lane_now() { int l; asm volatile("v_mbcnt_lo_u32_b32 %0, -1, 0\n\tv_mbcnt_hi_u32_b32 %0, -1, %0" : "=v"(l)); return l; }
#define F_LANE lane_now()
#define F_TID (F.wave * 64 + lane_now())

struct EpiProj {
    static constexpr bool PERM = true;
    bf16_t* O; unsigned* ctl;
    __device__ __forceinline__ void init(f32x4 (&acc)[2][2][4][2], const pg8::Unit&, int, int) const {
#pragma unroll
        for (int a_ = 0; a_ < 2; ++a_)
#pragma unroll
            for (int b_ = 0; b_ < 2; ++b_)
#pragma unroll
                for (int m_ = 0; m_ < 4; ++m_)
#pragma unroll
                    for (int n_ = 0; n_ < 2; ++n_) acc[a_][b_][m_][n_] = (f32x4){0.f, 0.f, 0.f, 0.f};
    }
    __device__ __forceinline__ void operator()(const f32x4 (&acc)[2][2][4][2], const pg8::Unit& u, int wr, int wc, int fr, int fq) const {
        const int t = u.pn >> 1; const float sc = (t == 0 || t == 3) ? C2 : 1.f; const bool nrm = (t == 3 || t == 4);
        bf16_t* base = O + (size_t)t * PROJ_STRIDE; const int row0 = u.pm * 256 + wr * 64 + fr, col0 = (u.pn & 1) * 256 + wc * 32 + 8 * fq;
        float mx0 = 0.f, mx1 = 0.f;
#pragma unroll
        for (int ai = 0; ai < 2; ++ai)
#pragma unroll
            for (int m = 0; m < 4; ++m) { bf16_t* rowp = base + (size_t)(row0 + ai * 128 + m * 16) * 512 + col0;
#pragma unroll
                for (int bj = 0; bj < 2; ++bj) { const f32x4 v0 = acc[ai][bj][m][0] * sc, v1 = acc[ai][bj][m][1] * sc; u32x4 w;
                    w.x = cvtpk(v0[0], v0[1]); w.y = cvtpk(v0[2], v0[3]); w.z = cvtpk(v1[0], v1[1]); w.w = cvtpk(v1[2], v1[3]);
                    if (t >= 4) {
                        const int row = row0 + ai * 128 + m * 16, bb = row >> 14, sq = row & (SEQ - 1), key = sq & 63, hh = (u.pn & 1) * 2 + bj;
                        bf16_t* tb = O + 4 * PROJ_STRIDE + ((size_t)((bb * 4 + hh) * 256 + (sq >> 6))) * 16384;
                        if (t == 4) *(u32x4*)(tb + (4 * wc + fq) * 512 + key * 8) = w;
                        else *(u32x4*)(tb + 8192 + (wc * 4 + (key >> 4)) * 512 + (key & 15) * 32 + fq * 8) = w;
                    } else *(u32x4*)(rowp + bj * 128) = w;
                    if (nrm) { float ss = 0.f;
#pragma unroll
                        for (int j = 0; j < 4; ++j) { const float lo = __uint_as_float(w[j] << 16), hi = __uint_as_float(w[j] & 0xFFFF0000u); ss += lo * lo + hi * hi; }
                        ss += __shfl_xor(ss, 16); ss += __shfl_xor(ss, 32);
                        if (bj == 0) mx0 = fmaxf(mx0, ss); else mx1 = fmaxf(mx1, ss); } } }
        if (nrm) {
#pragma unroll
            for (int ofs = 1; ofs < 16; ofs <<= 1) { mx0 = fmaxf(mx0, __shfl_xor(mx0, ofs)); mx1 = fmaxf(mx1, __shfl_xor(mx1, ofs)); }
            if (fr == 0 && fq == 0) { const int b = u.pm >> 6, cw = (t == 3) ? CW_QMAX : CW_KMAX;
                atomicMax(ctl + cw + (((b * 4 + (u.pn & 1) * 2 + 0) * 2 + (wc >> 1)) * 2 + (wc & 1)), __float_as_uint(mx0));
                atomicMax(ctl + cw + (((b * 4 + (u.pn & 1) * 2 + 1) * 2 + (wc >> 1)) * 2 + (wc & 1)), __float_as_uint(mx1)); }
        }
    }
};
struct EpiZ {
    static constexpr bool PERM = false;
    const float* x; float* z;
    __device__ __forceinline__ void init(f32x4 (&acc)[2][2][4][2], const pg8::Unit&, int, int) const {
#pragma unroll
        for (int a_ = 0; a_ < 2; ++a_)
#pragma unroll
            for (int b_ = 0; b_ < 2; ++b_)
#pragma unroll
                for (int m_ = 0; m_ < 4; ++m_)
#pragma unroll
                    for (int n_ = 0; n_ < 2; ++n_) acc[a_][b_][m_][n_] = (f32x4){0.f, 0.f, 0.f, 0.f};
    }
    __device__ __forceinline__ void operator()(const f32x4 (&acc)[2][2][4][2], const pg8::Unit& u, int wr, int wc, int fr, int fq) const {
        const int col0 = u.pn * 256 + wc * 32 + 4 * fq;
#pragma unroll
        for (int ai = 0; ai < 2; ++ai)
#pragma unroll
            for (int m = 0; m < 4; ++m) { const size_t off = (size_t)(u.pm * 256 + ai * 128 + wr * 64 + m * 16 + fr) * DM + col0;
#pragma unroll
                for (int bj = 0; bj < 2; ++bj)
#pragma unroll
                    for (int n = 0; n < 2; ++n) { const f32x4 xv = *(const f32x4*)(x + off + bj * 128 + n * 16); *(f32x4*)(z + off + bj * 128 + n * 16) = xv * ALPHA + acc[ai][bj][m][n]; } }
    }
};
__device__ __forceinline__ f32x2 swiglu4_pk(f32x2 g, f32x2 u) {
    g = __builtin_elementwise_min(g, (f32x2){7.0f, 7.0f});
    u = __builtin_elementwise_min(__builtin_elementwise_max(u, (f32x2){-7.0f, -7.0f}), (f32x2){7.0f, 7.0f});
    const f32x2 a_ = g * (-1.702f * LOG2E) + (-2.0f);
    f32x2 e_; e_.x = __builtin_amdgcn_exp2f(a_.x); e_.y = __builtin_amdgcn_exp2f(a_.y);
    const f32x2 d_ = e_ + 0.25f;
    f32x2 s_; s_.x = __builtin_amdgcn_rcpf(d_.x); s_.y = __builtin_amdgcn_rcpf(d_.y);
    const f32x2 t_ = g * s_;
    return t_ * u + t_;
}
struct EpiUp {
    static constexpr bool PERM = true;
    bf16_t* H; const float* b_up;
    __device__ __forceinline__ void init(f32x4 (&acc)[2][2][4][2], const pg8::Unit& u, int wc, int fq) const {
        const int e = u.pn >> 3, pnl = u.pn & 7, hcol0 = pnl * 128 + wc * 32 + 8 * fq;
        const float* bg = b_up + (size_t)e * 2048 + hcol0; const float* bu = bg + 1024;
        const f32x4 bg0 = *(const f32x4*)bg, bg1 = *(const f32x4*)(bg + 4), bu0 = *(const f32x4*)bu, bu1 = *(const f32x4*)(bu + 4);
#pragma unroll
        for (int a_ = 0; a_ < 2; ++a_)
#pragma unroll
            for (int m_ = 0; m_ < 4; ++m_) { acc[a_][0][m_][0] = bg0; acc[a_][0][m_][1] = bg1; acc[a_][1][m_][0] = bu0; acc[a_][1][m_][1] = bu1; }
    }
    __device__ __forceinline__ void operator()(const f32x4 (&acc)[2][2][4][2], const pg8::Unit& u, int wr, int wc, int fr, int fq) const {
        const int e = u.pn >> 3, pnl = u.pn & 7, hcol0 = pnl * 128 + wc * 32 + 8 * fq;
#pragma unroll
        for (int ai = 0; ai < 2; ++ai)
#pragma unroll
            for (int m = 0; m < 4; ++m) { const size_t row = (size_t)(u.pm * 256 + ai * 128 + wr * 64 + m * 16 + fr);
                const f32x4 g0 = acc[ai][0][m][0], g1 = acc[ai][0][m][1], u0 = acc[ai][1][m][0], u1 = acc[ai][1][m][1];
                const f32x2 r0 = swiglu4_pk((f32x2){g0[0], g0[1]}, (f32x2){u0[0], u0[1]}), r1 = swiglu4_pk((f32x2){g0[2], g0[3]}, (f32x2){u0[2], u0[3]});
                const f32x2 r2 = swiglu4_pk((f32x2){g1[0], g1[1]}, (f32x2){u1[0], u1[1]}), r3 = swiglu4_pk((f32x2){g1[2], g1[3]}, (f32x2){u1[2], u1[3]});
                u32x2 w8; w8.x = cvt4_fp8(r0.x, r0.y, r1.x, r1.y); w8.y = cvt4_fp8(r2.x, r2.y, r3.x, r3.y);
                *(u32x2*)((unsigned char*)H + row * DFF + hcol0) = w8; }
    }
};
struct EpiDown {
    static constexpr bool PERM = true;
    bf16_t* Y; const float* b_down; const float* row_gate;
    __device__ __forceinline__ void init(f32x4 (&acc)[2][2][4][2], const pg8::Unit& u, int wc, int fq) const {
        const int e = u.pn >> 2, pnl = u.pn & 3, col0 = pnl * 256 + wc * 32 + 8 * fq;
#pragma unroll
        for (int bj = 0; bj < 2; ++bj)
#pragma unroll
            for (int n = 0; n < 2; ++n) { const f32x4 bv = *(const f32x4*)(b_down + (size_t)e * DM + col0 + bj * 128 + 4 * n);
#pragma unroll
                for (int a_ = 0; a_ < 2; ++a_)
#pragma unroll
                    for (int m_ = 0; m_ < 4; ++m_) acc[a_][bj][m_][n] = bv; }
    }
    __device__ __forceinline__ void operator()(const f32x4 (&acc)[2][2][4][2], const pg8::Unit& u, int wr, int wc, int fr, int fq) const {
        const int e = u.pn >> 2, pnl = u.pn & 3, col0 = pnl * 256 + wc * 32 + 8 * fq;
#pragma unroll
        for (int ai = 0; ai < 2; ++ai)
#pragma unroll
            for (int m = 0; m < 4; ++m) { const size_t row = (size_t)(u.pm * 256 + ai * 128 + wr * 64 + m * 16 + fr); const float gt = row_gate[row];
#pragma unroll
                for (int bj = 0; bj < 2; ++bj) { const f32x4 v0 = acc[ai][bj][m][0] * (gt * 32.f), v1 = acc[ai][bj][m][1] * (gt * 32.f); u32x2 w;
                    w.x = cvt4_fp8(v0[0], v0[1], v0[2], v0[3]); w.y = cvt4_fp8(v1[0], v1[1], v1[2], v1[3]); *(u32x2*)((unsigned char*)Y + row * DM + col0 + bj * 128) = w; } }
    }
};
struct MoeOrder {
    pg8::StaticOrder so; const LAS unsigned char* tile_e; const LAS unsigned short* tok; int ncolt;
    __device__ __forceinline__ bool next(int i, pg8::Unit& u) const {
        if (!so.next(i, u)) return false;
        const int e = __builtin_amdgcn_readfirstlane((int)tile_e[u.pm]); u.pn = e * ncolt + u.pn; return true; }
    __device__ __forceinline__ const LAS unsigned short* tok_table(int ui) const { return tok + ui * 256; }
};

__device__ __forceinline__ void p0_transpose_item(const float* W, int K, int N, bf16_t* WT, int k0, int n0, int row0, LAS float* scr, int lane) {
#pragma unroll 8
    for (int i = 0; i < 32; ++i) { const int kk = 2 * i + (lane >> 5); scr[kk * 33 + (lane & 31)] = W[(size_t)(k0 + kk) * N + n0 + (lane & 31)]; }
    asm volatile("s_waitcnt lgkmcnt(0)" ::: "memory");
    const int c = lane & 7;
#pragma unroll
    for (int j = 0; j < 4; ++j) { const int n = (lane >> 3) + 8 * j; const LAS float* s = scr + (8 * c) * 33 + n;
        u32x4 o; o.x = cvtpk(s[0 * 33], s[1 * 33]); o.y = cvtpk(s[2 * 33], s[3 * 33]); o.z = cvtpk(s[4 * 33], s[5 * 33]); o.w = cvtpk(s[6 * 33], s[7 * 33]);
        *(u32x4*)(WT + (size_t)(row0 + n) * K + k0 + 8 * c) = o; }
    asm volatile("s_waitcnt lgkmcnt(0)" ::: "memory");
}
__device__ __forceinline__ void p0_transpose_item_f8(const float* W, int K, int N, unsigned char* WT, int k0, int n0, int row0, LAS float* scr, int lane) {
#pragma unroll 8
    for (int i = 0; i < 32; ++i) { const int kk = 2 * i + (lane >> 5); scr[kk * 33 + (lane & 31)] = W[(size_t)(k0 + kk) * N + n0 + (lane & 31)]; }
    asm volatile("s_waitcnt lgkmcnt(0)" ::: "memory");
    const int c = lane & 7;
#pragma unroll
    for (int j = 0; j < 4; ++j) { const int n = (lane >> 3) + 8 * j; const LAS float* s = scr + (8 * c) * 33 + n;
        u32x2 o; o.x = cvt4_fp8(256.f * s[0 * 33], 256.f * s[1 * 33], 256.f * s[2 * 33], 256.f * s[3 * 33]); o.y = cvt4_fp8(256.f * s[4 * 33], 256.f * s[5 * 33], 256.f * s[6 * 33], 256.f * s[7 * 33]);
        *(u32x2*)(WT + (size_t)(row0 + n) * K + k0 + 8 * c) = o; }
    asm volatile("s_waitcnt lgkmcnt(0)" ::: "memory");
}
__device__ __forceinline__ void p0_prologue(const Frame& F, const Args& a) {
    LAS float* scr = (LAS float*)(F.lds + F.wave * 16384);
    const int gw = F.vcu * 8 + F.wave, NGW = F.G * 8;
    bf16_t* WinT = (bf16_t*)(a.ws + WS_WIN); bf16_t* WoutT = (bf16_t*)(a.ws + WS_WOUT); bf16_t* WupT = (bf16_t*)(a.ws + WS_WUP); bf16_t* WdnT = (bf16_t*)(a.ws + WS_WDN);
    constexpr int I_IN = 16 * 96, I_OUT = 16 * 32, I_UP = 16 * 64, I_DN = 16 * 32;
    constexpr int NITEMS = I_IN + I_OUT + NE * I_UP + NE * I_DN;
    for (int it = gw; it < NITEMS; it += NGW) {
        int r = it;
        if (r < I_IN) { const int kb = r / 96, nb = r % 96; p0_transpose_item(a.w_in, DM, NPROJ, WinT, 64 * kb, 32 * nb, 32 * nb, scr, F_LANE); continue; } r -= I_IN;
        if (r < I_OUT) { const int kb = r / 32, nb = r % 32; p0_transpose_item(a.w_out, DM, DM, WoutT, 64 * kb, 32 * nb, 32 * nb, scr, F_LANE); continue; } r -= I_OUT;
        if (r < NE * I_UP) { const int e = r / I_UP, q = r % I_UP, kb = q / 64, nb = q % 64, n0 = 32 * nb;
            const int nn = n0 & 1023, row0 = (nn >> 7) * 256 + (n0 >> 10) * 128 + (nn & 127);
            p0_transpose_item_f8(a.w_up + (size_t)e * DM * 2048, DM, 2048, (unsigned char*)WupT + (size_t)e * 2048 * DM, 64 * kb, n0, row0, scr, F_LANE); continue; } r -= NE * I_UP;
        { const int e = r / I_DN, q = r % I_DN, kb = q / 32, nb = q % 32; p0_transpose_item_f8(a.w_down + (size_t)e * DFF * DM, DFF, DM, (unsigned char*)WdnT + (size_t)e * DM * DFF, 64 * kb, 32 * nb, 32 * nb, scr, F_LANE); }
    }
    bf16_t* XB = (bf16_t*)(a.ws + WS_XB);
    for (int m = gw; m < NTOK; m += NGW) {
        const f32x4* xr = (const f32x4*)(a.x + (size_t)m * DM) + F_LANE; unsigned long long* o8 = (unsigned long long*)(XB + (size_t)m * DM) + F_LANE;
#pragma unroll
        for (int j = 0; j < 4; ++j) { const f32x4 v = xr[64 * j]; o8[64 * j] = (unsigned long long)cvtpk(v[0], v[1]) | ((unsigned long long)cvtpk(v[2], v[3]) << 32); }
    }
}

__device__ __forceinline__ void glds16(const void* gsrc, unsigned lds_dst) { unsigned keep;
    asm volatile("s_mov_b32 %0, m0\n\ts_mov_b32 m0, %2\n\ts_nop 0\n\tglobal_load_lds_dwordx4 %1, off\n\ts_mov_b32 m0, %0" : "=&s"(keep) : "v"(gsrc), "s"(lds_dst) : "memory"); }
__device__ __forceinline__ int crow(int r, int hi) { return (r & 3) + 8 * (r >> 2) + 4 * hi; }
typedef LAS const char* lds_cptr;
typedef short v4i16_t __attribute__((ext_vector_type(4)));
__device__ __forceinline__ s16x4 vtr(lds_cptr p) { return __builtin_bit_cast(s16x4, __builtin_amdgcn_ds_read_tr16_b64_v4i16((LAS v4i16_t*)p)); }
#define MX3(a, b, c) __builtin_fmaxf(__builtin_fmaxf((a), (b)), (c))
__device__ __forceinline__ float rowmax(const f32x16& p0, const f32x16& p1) {
    float a = MX3(p0[0], p0[1], p1[0]), b = MX3(p0[2], p0[3], p1[1]); a = MX3(a, p1[2], p1[3]);
#pragma unroll
    for (int r = 4; r < 16; r += 4) { a = MX3(a, p0[r], p0[r + 1]); b = MX3(b, p0[r + 2], p0[r + 3]); a = MX3(a, p1[r], p1[r + 1]); b = MX3(b, p1[r + 2], p1[r + 3]); }
    float m = __builtin_fmaxf(a, b); auto rr = __builtin_amdgcn_permlane32_swap(__float_as_uint(m), __float_as_uint(m), false, false);
    return __builtin_fmaxf(__uint_as_float(rr[0]), __uint_as_float(rr[1]));
}
__device__ __forceinline__ float halfsum(float v) { auto rr = __builtin_amdgcn_permlane32_swap(__float_as_uint(v), __float_as_uint(v), false, false); return __uint_as_float(rr[0]) + __uint_as_float(rr[1]); }
#define MFMA32(a, b, c) __builtin_amdgcn_mfma_f32_32x32x16_bf16(a, b, c, 0, 0, 0)

template <int ND>
__device__ __forceinline__ void softmax_tile(f32x16& p0, f32x16& p1, float& mhat, float& lsum, f32x16 (&o)[ND], u32x4 (&pw)[4]) {
    const float rm = rowmax(p0, p1);
    const float mnew = __builtin_fmaxf(mhat, rm);
    if (__any(mnew != mhat)) {
        const float al = __builtin_amdgcn_exp2f(mhat - mnew); lsum *= al;
#pragma unroll
        for (int d = 0; d < ND; ++d)
#pragma unroll
            for (int r = 0; r < 16; ++r) o[d][r] *= al;
        mhat = mnew;
    }
    float s = 0.f;
#pragma unroll
    for (int r = 0; r < 16; ++r) { p0[r] = __builtin_amdgcn_exp2f(p0[r] - mhat); p1[r] = __builtin_amdgcn_exp2f(p1[r] - mhat); s += p0[r] + p1[r]; }
    lsum += s;
    pw[0] = (u32x4){cvtpk(p0[0], p0[1]), cvtpk(p0[2], p0[3]), cvtpk(p0[4], p0[5]), cvtpk(p0[6], p0[7])};
    pw[1] = (u32x4){cvtpk(p0[8], p0[9]), cvtpk(p0[10], p0[11]), cvtpk(p0[12], p0[13]), cvtpk(p0[14], p0[15])};
    pw[2] = (u32x4){cvtpk(p1[0], p1[1]), cvtpk(p1[2], p1[3]), cvtpk(p1[4], p1[5]), cvtpk(p1[6], p1[7])};
    pw[3] = (u32x4){cvtpk(p1[8], p1[9]), cvtpk(p1[10], p1[11]), cvtpk(p1[12], p1[13]), cvtpk(p1[14], p1[15])};
}
template <int ND>
__device__ __forceinline__ void pv_tile(f32x16 (&o)[ND], lds_cptr vbase, const u32x4 (&pw)[4]) {
#pragma unroll
    for (int d0 = 0; d0 < ND; ++d0)
#pragma unroll
        for (int ks = 0; ks < 4; ++ks) {
            const s16x4 lo = vtr(vbase + d0 * 4096 + ks * 1024), hi = vtr(vbase + d0 * 4096 + ks * 1024 + 512);
            const bf16x8 vf = (bf16x8){lo[0], lo[1], lo[2], lo[3], hi[0], hi[1], hi[2], hi[3]};
            o[d0] = MFMA32(vf, __builtin_bit_cast(bf16x8, pw[ks]), o[d0]);
        }
}

__device__ __forceinline__ unsigned bfb(float x) { return cvtpk(x, 0.f) & 0xFFFFu; }
__device__ __forceinline__ float bff(unsigned b) { return __uint_as_float(b << 16); }
__device__ __forceinline__ void bf_split3(float x, unsigned& h, unsigned& m, unsigned& l) { h = bfb(x); const float r1 = x - bff(h); m = bfb(r1); const float r2 = r1 - bff(m); l = bfb(r2); }
__device__ __forceinline__ void attnB_finish(const Frame& F, const Args& a, f32x16 (&o)[4], float lsum, float lam, size_t rowbase, int qpos, int h, int c, int qs, int r32, int hi) {
    LAS unsigned char* L = F.lds;
    const float inv = 1.0f / halfsum(lsum);
    LAS float* ex = (LAS float*)(L + 65536);
    __syncthreads();
    if (c == 1) {
#pragma unroll
        for (int d0 = 0; d0 < 4; ++d0)
#pragma unroll
            for (int r = 0; r < 16; ++r) ex[(qs * 128 + 32 * d0 + crow(r, hi)) * 32 + r32] = o[d0][r] * inv;
    }
    __syncthreads();
    if (c == 0) {
        float ss = 0.f;
#pragma unroll
        for (int d0 = 0; d0 < 4; ++d0)
#pragma unroll
            for (int r = 0; r < 16; ++r) { const float v = o[d0][r] * inv - lam * ex[(qs * 128 + 32 * d0 + crow(r, hi)) * 32 + r32]; o[d0][r] = v; ss += v * v; }
        ss = halfsum(ss);
        const float rs = __builtin_amdgcn_rsqf(ss * (1.0f / 128.0f) + LN_EPS) * (1.0f - LAM_INIT);
        bf16_t* op = (bf16_t*)(a.ws + WS_MIXED) + (rowbase + qpos) * DM + 512 + h * 128 + 4 * hi;
#pragma unroll
        for (int d0 = 0; d0 < 4; ++d0)
#pragma unroll
            for (int g = 0; g < 4; ++g) { const int dv = 32 * d0 + 8 * g + 4 * hi; const f32x4 gs = *(const f32x4*)(a.g_sub + dv);
                u32x2 w; w.x = cvtpk(o[d0][4 * g] * rs * gs[0], o[d0][4 * g + 1] * rs * gs[1]); w.y = cvtpk(o[d0][4 * g + 2] * rs * gs[2], o[d0][4 * g + 3] * rs * gs[3]);
                *(u32x2*)(op + 32 * d0 + 8 * g) = w; }
    }
    __syncthreads();
}

template <bool FAST>
__device__ __forceinline__ void attnB_unit(const Frame& F, const Args& a, int b, int h, int qblk, float lam, int t_lo, int t_hi, float kn0, float kn1) {
    const int lane = F_LANE, r32 = lane & 31, hi = lane >> 5, wid = F.wave, c = wid >> 2, qs = wid & 3;
    const bf16_t* QD = (const bf16_t*)(a.ws + WS_PROJ) + 3 * PROJ_STRIDE; const bf16_t* KD = QD + PROJ_STRIDE; const bf16_t* VD = KD + PROJ_STRIDE;
    const size_t rowbase = (size_t)b * SEQ; const int q0 = qblk * 128, qpos = q0 + 32 * qs + r32;
    bf16x8 qr[4];
    { const bf16_t* Qp = QD + (rowbase + qpos) * 512 + h * 128 + c * 64 + 8 * hi;
#pragma unroll
      for (int d0 = 0; d0 < 4; ++d0) qr[d0] = *(const bf16x8*)(Qp + 16 * d0); }
    float ref = 0.f;
    { float qq = 0.f;
#pragma unroll
        for (int d0 = 0; d0 < 4; ++d0)
#pragma unroll
            for (int j = 0; j < 8; ++j) { const float v = __uint_as_float((unsigned)(unsigned short)qr[d0][j] << 16); qq += v * v; }
        qq = halfsum(qq); asm volatile("" : "+v"(qq));
        if (FAST) ref = sqrtf(qq) * (c ? kn1 : kn0) * 1.01f + 0.01f; }
    const float slope2 = __builtin_amdgcn_exp2f(-2.0f * (float)(h + 1)) * LOG2E;
    const bf16_t* tsrc = KD + (size_t)((b * 4 + h) * 256) * 16384 + wid * 2048 + lane * 8;
    LAS unsigned char* L = F.lds;
    const unsigned dbase = (unsigned)(uintptr_t)L + (unsigned)wid * 4096u;
#define B_DMA(tt, slot) do { const bf16_t* _k = tsrc + (size_t)(tt) * 16384; const unsigned _d = (unsigned)__builtin_amdgcn_readfirstlane((int)(dbase + (unsigned)(slot) * 32768u)); unsigned _keep; \
        asm volatile("s_mov_b32 %0, m0\n\ts_mov_b32 m0, %2\n\ts_nop 0\n\tglobal_load_lds_dwordx4 %1, off\n\tglobal_load_lds_dwordx4 %1, off offset:1024\n\tglobal_load_lds_dwordx4 %1, off offset:2048\n\tglobal_load_lds_dwordx4 %1, off offset:3072\n\ts_mov_b32 m0, %0" \
                     : "=&s"(_keep) : "v"(_k), "s"(_d) : "memory"); } while (0)
#define WAIT_BAR(N) asm volatile("s_waitcnt vmcnt(" #N ") lgkmcnt(0)\n\ts_barrier" ::: "memory")
#define SBAR() __builtin_amdgcn_sched_barrier(0)
#define PIN(x) asm volatile("" : "+v"(x))
#define VFRAG(dst, base, d0, ks) do { const s16x4 lo_ = vtr((base) + (d0) * 4096 + (ks) * 1024), hi_ = vtr((base) + (d0) * 4096 + (ks) * 1024 + 512); \
        dst = (bf16x8){lo_[0], lo_[1], lo_[2], lo_[3], hi_[0], hi_[1], hi_[2], hi_[3]}; } while (0)
#define GEN_C(tt) do { const float dq = (float)(qpos - (tt) * 64 - 4 * hi); \
        _Pragma("unroll") for (int r = 0; r < 16; ++r) { const float kk = (float)((r & 3) + 8 * (r >> 2)); C0[r] = -slope2 * __builtin_fabsf(dq - kk) - ref; C1[r] = -slope2 * __builtin_fabsf(dq - 32.f - kk) - ref; } } while (0)
    float mhat = NEG_BIG, lsum = 0.f; f32x16 o[4];
#pragma unroll
    for (int d = 0; d < 4; ++d) o[d] = (f32x16){};
    const int koff = (c * 8 + hi) * 1024 + r32 * 16;
    const int voff = 16384 + ((lane >> 4) & 1) * 32 + (lane & 3) * 8 + (4 * hi + ((lane & 15) >> 2)) * 64;
    const int tdiag = q0 >> 6;
    f32x16 C0, C1;
    u32x4 pw[4];
    const int NT = t_hi - t_lo + 1;
    GEN_C(t_lo);
    B_DMA(t_lo, 0); if (NT > 1) B_DMA(t_lo + 1, 1); if (NT > 2) B_DMA(t_lo + 2, 2);
    int sl = 0;
    for (int tau = 0; tau < NT; ++tau) {
        if (tau + 2 < NT) WAIT_BAR(8); else if (tau + 1 < NT) WAIT_BAR(4); else WAIT_BAR(0);
        if (tau + 3 < NT) B_DMA(t_lo + tau + 3, (sl + 3) & 3);
        const int t = t_lo + tau; const LAS unsigned char* buf = L + sl * 32768; const lds_cptr vbase = (lds_cptr)(buf + voff);
        bf16x8 kf[8];
#pragma unroll
        for (int d0 = 0; d0 < 4; ++d0) { kf[2 * d0] = *(const LAS bf16x8*)(buf + koff + d0 * 2048); kf[2 * d0 + 1] = *(const LAS bf16x8*)(buf + koff + d0 * 2048 + 512); }
        SBAR();
        f32x16 p0, p1;
        if constexpr (FAST) {
            bf16x8 vA[4], vB[4]; float sacc = 0.f;
#define EXPS(P, A, B) do { _Pragma("unroll") for (int r = (A); r < (B); ++r) { P[r] = __builtin_amdgcn_exp2f(P[r]); sacc += P[r]; } PIN(P); PIN(sacc); } while (0)
#define PK4(P, B) (u32x4){cvtpk(P[B], P[B + 1]), cvtpk(P[B + 2], P[B + 3]), cvtpk(P[B + 4], P[B + 5]), cvtpk(P[B + 6], P[B + 7])}
#define PWF(k) __builtin_bit_cast(bf16x8, pw[k])
            const float st = (t + 1 < tdiag) ? 64.f * slope2 : -64.f * slope2;
            p0 = MFMA32(kf[0], qr[0], C0); SBAR(); VFRAG(vA[0], vbase, 0, 0); SBAR();
            p0 = MFMA32(kf[2], qr[1], p0); SBAR(); VFRAG(vA[1], vbase, 1, 0); SBAR();
            p0 = MFMA32(kf[4], qr[2], p0); SBAR(); VFRAG(vA[2], vbase, 2, 0); SBAR();
            p0 = MFMA32(kf[6], qr[3], p0); SBAR(); VFRAG(vA[3], vbase, 3, 0); SBAR();
            p1 = MFMA32(kf[1], qr[0], C1); SBAR();
            p1 = MFMA32(kf[3], qr[1], p1); SBAR(); EXPS(p0, 0, 5); SBAR();
            p1 = MFMA32(kf[5], qr[2], p1); SBAR(); EXPS(p0, 5, 11); SBAR();
            p1 = MFMA32(kf[7], qr[3], p1); SBAR(); EXPS(p0, 11, 16); pw[0] = PK4(p0, 0); PIN(pw[0]); SBAR();
            o[0] = MFMA32(vA[0], PWF(0), o[0]); SBAR(); pw[1] = PK4(p0, 8); PIN(pw[1]); VFRAG(vB[0], vbase, 0, 1); SBAR();
            o[1] = MFMA32(vA[1], PWF(0), o[1]); SBAR(); EXPS(p1, 0, 3); VFRAG(vB[1], vbase, 1, 1); SBAR();
            o[2] = MFMA32(vA[2], PWF(0), o[2]); SBAR(); EXPS(p1, 3, 6); VFRAG(vB[2], vbase, 2, 1); SBAR();
            o[3] = MFMA32(vA[3], PWF(0), o[3]); SBAR(); EXPS(p1, 6, 8); VFRAG(vB[3], vbase, 3, 1); SBAR();
            o[0] = MFMA32(vB[0], PWF(1), o[0]); SBAR(); EXPS(p1, 8, 10); VFRAG(vA[0], vbase, 0, 2); SBAR();
            o[1] = MFMA32(vB[1], PWF(1), o[1]); SBAR(); EXPS(p1, 10, 12); VFRAG(vA[1], vbase, 1, 2); SBAR();
            o[2] = MFMA32(vB[2], PWF(1), o[2]); SBAR(); EXPS(p1, 12, 14); VFRAG(vA[2], vbase, 2, 2); SBAR();
            o[3] = MFMA32(vB[3], PWF(1), o[3]); SBAR(); EXPS(p1, 14, 16); VFRAG(vA[3], vbase, 3, 2); pw[2] = PK4(p1, 0); PIN(pw[2]); SBAR();
            o[0] = MFMA32(vA[0], PWF(2), o[0]); SBAR(); pw[3] = PK4(p1, 8); PIN(pw[3]); VFRAG(vB[0], vbase, 0, 3); SBAR();
            o[1] = MFMA32(vA[1], PWF(2), o[1]); SBAR(); VFRAG(vB[1], vbase, 1, 3);
#pragma unroll
            for (int r = 0; r < 8; ++r) C0[r] += st;
            PIN(C0); SBAR();
            o[2] = MFMA32(vA[2], PWF(2), o[2]); SBAR(); VFRAG(vB[2], vbase, 2, 3);
#pragma unroll
            for (int r = 8; r < 16; ++r) C0[r] += st;
            PIN(C0); SBAR();
            o[3] = MFMA32(vA[3], PWF(2), o[3]); SBAR(); VFRAG(vB[3], vbase, 3, 3);
#pragma unroll
            for (int r = 0; r < 8; ++r) C1[r] += st;
            PIN(C1); SBAR();
            o[0] = MFMA32(vB[0], PWF(3), o[0]); SBAR();
#pragma unroll
            for (int r = 8; r < 16; ++r) C1[r] += st;
            PIN(C1); SBAR();
            o[1] = MFMA32(vB[1], PWF(3), o[1]);
            o[2] = MFMA32(vB[2], PWF(3), o[2]);
            o[3] = MFMA32(vB[3], PWF(3), o[3]);
            lsum += sacc;
#undef EXPS
#undef PK4
#undef PWF
        } else {
            p0 = MFMA32(kf[0], qr[0], C0); p1 = MFMA32(kf[1], qr[0], C1);
#pragma unroll
            for (int d0 = 1; d0 < 4; ++d0) { p0 = MFMA32(kf[2 * d0], qr[d0], p0); p1 = MFMA32(kf[2 * d0 + 1], qr[d0], p1); }
            softmax_tile<4>(p0, p1, mhat, lsum, o, pw);
            pv_tile<4>(o, vbase, pw);
            const float st = (t + 1 < tdiag) ? 64.f * slope2 : -64.f * slope2; C0 = C0 + st; C1 = C1 + st;
        }
        if ((t + 1 >= tdiag && t + 1 <= tdiag + 2) || ((tau + 1) & 15) == 0) GEN_C(t + 1);
        sl = (sl + 1) & 3;
    }
#undef B_DMA
#undef WAIT_BAR
#undef VFRAG
#undef GEN_C
#undef SBAR
#undef PIN
    attnB_finish(F, a, o, lsum, lam, rowbase, qpos, h, c, qs, r32, hi);
}
__device__ __forceinline__ void attnB_fast(const Frame& F, const Args& a, int b, int h, int qblk, float lam, int t_lo, int t_hi, float kn0, float kn1) {
    const int lane = F_LANE, r32 = lane & 31, hi = lane >> 5, wid = F.wave, c = wid >> 2, qs = wid & 3;
    const bf16_t* QD = (const bf16_t*)(a.ws + WS_PROJ) + 3 * PROJ_STRIDE; const bf16_t* KD = QD + PROJ_STRIDE;
    const size_t rowbase = (size_t)b * SEQ; const int q0 = qblk * 128, qpos = q0 + 32 * qs + r32;
    bf16x8 qr[4], ks[4];
    { const bf16_t* Qp = QD + (rowbase + qpos) * 512 + h * 128 + c * 64 + 8 * hi;
      const bf16_t* Kp = KD + ((size_t)((b * 4 + h) * 256 + (qpos >> 6))) * 16384 + ((c * 8 + hi) * 64 + (qpos & 63)) * 8;
#pragma unroll
      for (int d0 = 0; d0 < 4; ++d0) { qr[d0] = *(const bf16x8*)(Qp + 16 * d0); ks[d0] = *(const bf16x8*)(Kp + d0 * 1024); } }
    const float slope2 = __builtin_amdgcn_exp2f(-2.0f * (float)(h + 1)) * LOG2E;
    float ref;
    { float qq = 0.f, sii = 0.f;
#pragma unroll
        for (int d0 = 0; d0 < 4; ++d0)
#pragma unroll
            for (int j = 0; j < 8; ++j) { const float v = __uint_as_float((unsigned)(unsigned short)qr[d0][j] << 16), kv = __uint_as_float((unsigned)(unsigned short)ks[d0][j] << 16); qq += v * v; sii += v * kv; }
        qq = halfsum(qq); sii = halfsum(sii); asm volatile("" : "+v"(qq));
        ref = sqrtf(qq) * (c ? kn1 : kn0) * 1.01f + 0.01f;
        float dd = (ref - sii + 72.02f) / slope2;
#pragma unroll
        for (int ofs = 1; ofs < 64; ofs <<= 1) dd = fmaxf(dd, __shfl_xor(dd, ofs));
        LAS float* red = (LAS float*)(F.lds + LX_MISC) + 104;
        if (lane == 0) red[wid] = dd;
        __syncthreads();
        float dm = red[0];
#pragma unroll
        for (int w_ = 1; w_ < 8; ++w_) dm = fmaxf(dm, red[w_]);
        const int Dd = dm < 40000.f ? (int)dm + 2 : 40000;
        int tl = (q0 - Dd) >> 6; if (q0 - Dd < 0) tl = 0;
        int th = (q0 + 127 + Dd) >> 6; if (th > SEQ / 64 - 1) th = SEQ / 64 - 1;
        t_lo = __builtin_amdgcn_readfirstlane(tl > t_lo ? tl : t_lo); t_hi = __builtin_amdgcn_readfirstlane(th < t_hi ? th : t_hi); }
    const bf16_t* tsrc = KD + (size_t)((b * 4 + h) * 256) * 16384 + wid * 2048 + lane * 8;
    LAS unsigned char* L = F.lds;
    const unsigned dbase = (unsigned)(uintptr_t)L + (unsigned)wid * 4096u;
#define B_DMA(tt, slot) do { const bf16_t* _k = tsrc + (size_t)(tt) * 16384; const unsigned _d = (unsigned)__builtin_amdgcn_readfirstlane((int)(dbase + (unsigned)(slot) * 32768u)); unsigned _keep; \
        asm volatile("s_mov_b32 %0, m0\n\ts_mov_b32 m0, %2\n\ts_nop 0\n\tglobal_load_lds_dwordx4 %1, off\n\tglobal_load_lds_dwordx4 %1, off offset:1024\n\tglobal_load_lds_dwordx4 %1, off offset:2048\n\tglobal_load_lds_dwordx4 %1, off offset:3072\n\ts_mov_b32 m0, %0" \
                     : "=&s"(_keep) : "v"(_k), "s"(_d) : "memory"); } while (0)
#define WAIT_BAR(N) asm volatile("s_waitcnt vmcnt(" #N ") lgkmcnt(0)\n\ts_barrier" : "+v"(p1), "+v"(sacc) :: "memory")
#define VFRAG(dst, base, d0, ks) do { const s16x4 lo_ = vtr((base) + (d0) * 4096 + (ks) * 1024), hi_ = vtr((base) + (d0) * 4096 + (ks) * 1024 + 512); \
        dst = (bf16x8){lo_[0], lo_[1], lo_[2], lo_[3], hi_[0], hi_[1], hi_[2], hi_[3]}; } while (0)
#define MF_ "v_mfma_f32_32x32x16_bf16 "
#define AMF(D, A, B)              asm volatile(MF_ "%0, %1, %2, %0" : "+v"(D) : "v"(A), "v"(B) : "memory")
#define AMF1(D, A, B, X)          asm volatile(MF_ "%0, %2, %3, %0" : "+v"(D), "+v"(X) : "v"(A), "v"(B) : "memory")
#define AMF2(D, A, B, X, Y)       asm volatile(MF_ "%0, %3, %4, %0" : "+v"(D), "+v"(X), "+v"(Y) : "v"(A), "v"(B) : "memory")
#define AMF3(D, A, B, X, Y, Z)    asm volatile(MF_ "%0, %4, %5, %0" : "+v"(D), "+v"(X), "+v"(Y), "+v"(Z) : "v"(A), "v"(B) : "memory")
#define AMF0(D, A, B)             asm volatile(MF_ "%0, %1, %2, 0" : "=&v"(D) : "v"(A), "v"(B) : "memory")
#define PK4(P, B) (u32x4){cvtpk(P[B], P[B + 1]), cvtpk(P[B + 2], P[B + 3]), cvtpk(P[B + 4], P[B + 5]), cvtpk(P[B + 6], P[B + 7])}
#define XE(P, r) { P[r] = __builtin_amdgcn_exp2f(P[r]); sacc += P[r]; }
#define XE2(P, r) do { XE(P, r) XE(P, (r) + 1) } while (0)
#define KLD(bk, i) kf[i] = *(const LAS bf16x8*)((bk) + koff + ((i) >> 1) * 2048 + ((i) & 1) * 512)
#define SET_KA(tn) do { const unsigned w_ = __builtin_amdgcn_perm(0u, __float_as_uint(tf), 0x03020302u); ka0[1] = w_; ka1[1] = w_; tf += tinc; if ((tn) == tdiag + 2) qa = qaR; } while (0)
#define BIAS_HALF(P, KA, e, tn) do { \
        if ((unsigned)((tn) - tdiag) < 2u) { const int kb_ = 2 * (tn) + (e); \
            if (kb_ == qb) { float dq_ = (float)(qpos - (tn) * 64 - 32 * (e) - 4 * hi), ns_ = -slope2, nr_ = -ref; asm volatile("" : "+v"(dq_), "+v"(ns_), "+v"(nr_)); \
                             _Pragma("unroll") for (int r = 0; r < 16; ++r) { const float kk_ = (float)((r & 3) + 8 * (r >> 2)); P[r] = __builtin_fmaf(ns_, __builtin_fabsf(dq_ - kk_), nr_); } \
                             asm volatile("s_nop 4" : "+v"(P) :: "memory"); } \
            else if (kb_ < qb) { AMF0(P, KA, qaL); } else { AMF0(P, KA, qaR); } } \
        else { AMF0(P, KA, qa); } } while (0)
    const int tdiag = q0 >> 6, qb = 4 * qblk + qs;
    const unsigned msk = hi ? 0u : 0xFFFFFFFFu;
    bf16x8 qaL, qaR, qa; u32x4 ka0, ka1;
    { const float S64 = 64.f * slope2;
        const unsigned sh = bfb(slope2), slo = bfb(slope2 - bff(sh)), Sh = bfb(S64), Slo = bfb(S64 - bff(Sh));
        unsigned ch, cm, cl, dh, dm, dl;
        bf_split3(slope2 * (float)(qpos - 64 * tdiag) - ref, ch, cm, cl);
        bf_split3(-slope2 * (float)(qpos - 64 * tdiag) - ref, dh, dm, dl);
        const u32x4 r_ = (u32x4){(((slo ^ 0x8000u) << 16) | (sh ^ 0x8000u)) & msk, (((Slo ^ 0x8000u) << 16) | (Sh ^ 0x8000u)) & msk, ((cm << 16) | ch) & msk, cl & msk};
        const u32x4 l_ = (u32x4){((slo << 16) | sh) & msk, ((Slo << 16) | Sh) & msk, ((dm << 16) | dh) & msk, dl & msk};
        qaR = __builtin_bit_cast(bf16x8, r_); qaL = __builtin_bit_cast(bf16x8, l_); qa = (t_lo < tdiag + 2) ? qaL : qaR;
        const unsigned j0 = bfb((float)r32), j1 = bfb((float)(32 + r32));
        ka0 = (u32x4){((j0 << 16) | j0) & msk, 0u, 0x3F803F80u & msk, 0x00003F80u & msk}; ka1 = ka0; ka1[0] = ((j1 << 16) | j1) & msk; }
    float tf = hi ? 0.f : (float)(t_lo - tdiag); const float tinc = hi ? 0.f : 1.f;
    f32x16 o[4], p0, p1; u32x4 pw[4]; bf16x8 kf[8], vA[4], vB[4]; float sacc = 0.f;
#pragma unroll
    for (int d = 0; d < 4; ++d) o[d] = (f32x16){};
    p1 = (f32x16){};
    const int koff = (c * 8 + hi) * 1024 + r32 * 16;
    const int voff = 16384 + ((lane >> 4) & 1) * 32 + (lane & 3) * 8 + (4 * hi + ((lane & 15) >> 2)) * 64;
    const int NT = t_hi - t_lo + 1;
    B_DMA(t_lo, 0); if (NT > 1) B_DMA(t_lo + 1, 1); if (NT > 2) B_DMA(t_lo + 2, 2);
    if (NT > 2) WAIT_BAR(8); else if (NT > 1) WAIT_BAR(4); else WAIT_BAR(0);
    {
        const LAS unsigned char* bk = L;
#pragma unroll
        for (int i = 0; i < 8; ++i) KLD(bk, i);
        SET_KA(t_lo);
        asm volatile("s_nop 1" : "+v"(ka0), "+v"(ka1), "+v"(qa) :: "memory");
        BIAS_HALF(p0, ka0, 0, t_lo);
        AMF(p0, kf[0], qr[0]); AMF(p0, kf[2], qr[1]); AMF(p0, kf[4], qr[2]); AMF(p0, kf[6], qr[3]);
        BIAS_HALF(p1, ka1, 1, t_lo);
        AMF(p1, kf[1], qr[0]); AMF(p1, kf[3], qr[1]); AMF(p1, kf[5], qr[2]); AMF(p1, kf[7], qr[3]);
        const lds_cptr vb0 = (lds_cptr)(bk + voff);
        VFRAG(vA[0], vb0, 0, 0); VFRAG(vA[1], vb0, 1, 0); VFRAG(vA[2], vb0, 2, 0); VFRAG(vA[3], vb0, 3, 0);
        asm volatile("s_nop 15\n\ts_nop 15" : "+v"(p0), "+v"(p1) :: "memory");
#pragma unroll
        for (int r = 0; r < 16; r += 2) XE2(p0, r);
#pragma unroll
        for (int r = 0; r < 16; r += 2) XE2(p1, r);
        pw[0] = PK4(p0, 0); pw[1] = PK4(p0, 8); pw[2] = PK4(p1, 0);
    }
    int sl = 0;
    for (int tau = 0; tau + 1 < NT; ++tau) {
        if (tau + 2 < NT) WAIT_BAR(4); else WAIT_BAR(0);
        if (tau + 3 < NT) B_DMA(t_lo + tau + 3, (sl + 3) & 3);
        const LAS unsigned char* buf = L + sl * 32768; const LAS unsigned char* bufn = L + ((sl + 1) & 3) * 32768;
        const lds_cptr vb = (lds_cptr)(buf + voff), vbn = (lds_cptr)(bufn + voff);
        const int tn = t_lo + tau + 1;
        SET_KA(tn);
        AMF(o[0], vA[0], pw[0]);            KLD(bufn, 0); KLD(bufn, 2);
        AMF1(o[1], vA[1], pw[0], p1);       KLD(bufn, 4); KLD(bufn, 6); pw[3] = PK4(p1, 8);
        AMF1(o[2], vA[2], pw[0], pw[3]);    KLD(bufn, 1); KLD(bufn, 3);
        AMF(o[3], vA[3], pw[0]);            KLD(bufn, 5); KLD(bufn, 7);
        BIAS_HALF(p0, ka0, 0, tn);          VFRAG(vB[0], vb, 0, 1);
        AMF(p0, kf[0], qr[0]);              VFRAG(vB[1], vb, 1, 1);
        AMF(p0, kf[2], qr[1]);              VFRAG(vB[2], vb, 2, 1);
        AMF(p0, kf[4], qr[2]);              VFRAG(vB[3], vb, 3, 1);
        AMF(p0, kf[6], qr[3]);
        BIAS_HALF(p1, ka1, 1, tn);
        AMF1(p1, kf[1], qr[0], p0);         XE2(p0, 0);
        AMF2(p1, kf[3], qr[1], p0, sacc);   XE2(p0, 2);
        AMF2(p1, kf[5], qr[2], p0, sacc);   XE2(p0, 4);
        AMF2(p1, kf[7], qr[3], p0, sacc);   XE2(p0, 6);
        AMF2(o[0], vB[0], pw[1], p0, sacc); XE2(p0, 8);  VFRAG(vA[0], vb, 0, 2);
        AMF2(o[1], vB[1], pw[1], p0, sacc); XE2(p0, 10); VFRAG(vA[1], vb, 1, 2);
        AMF2(o[2], vB[2], pw[1], p0, sacc); XE2(p0, 12); VFRAG(vA[2], vb, 2, 2);
        AMF2(o[3], vB[3], pw[1], p0, sacc); XE2(p0, 14); VFRAG(vA[3], vb, 3, 2);
        AMF3(o[0], vA[0], pw[2], p0, sacc, p1);     pw[0] = PK4(p0, 0); XE2(p1, 0); VFRAG(vB[0], vb, 0, 3);
        AMF3(o[1], vA[1], pw[2], p1, sacc, pw[0]);  XE2(p1, 2); VFRAG(vB[1], vb, 1, 3);
        AMF3(o[2], vA[2], pw[2], p1, sacc, p0);     pw[1] = PK4(p0, 8); XE2(p1, 4); VFRAG(vB[2], vb, 2, 3);
        AMF3(o[3], vA[3], pw[2], p1, sacc, pw[1]);  XE2(p1, 6); VFRAG(vB[3], vb, 3, 3);
        AMF2(o[0], vB[0], pw[3], p1, sacc); XE2(p1, 8);  VFRAG(vA[0], vbn, 0, 0);
        AMF2(o[1], vB[1], pw[3], p1, sacc); XE2(p1, 10); VFRAG(vA[1], vbn, 1, 0);
        AMF2(o[2], vB[2], pw[3], p1, sacc); pw[2] = PK4(p1, 0); XE2(p1, 12); VFRAG(vA[2], vbn, 2, 0);
        AMF3(o[3], vB[3], pw[3], p1, sacc, pw[2]);  XE2(p1, 14); VFRAG(vA[3], vbn, 3, 0);
        sl = (sl + 1) & 3;
    }
    {
        const lds_cptr vb = (lds_cptr)(L + sl * 32768 + voff);
        pw[3] = PK4(p1, 8);
        AMF3(o[0], vA[0], pw[0], p1, sacc, pw[3]); VFRAG(vB[0], vb, 0, 1);
        AMF(o[1], vA[1], pw[0]); VFRAG(vB[1], vb, 1, 1);
        AMF(o[2], vA[2], pw[0]); VFRAG(vB[2], vb, 2, 1);
        AMF(o[3], vA[3], pw[0]); VFRAG(vB[3], vb, 3, 1);
        AMF(o[0], vB[0], pw[1]); VFRAG(vA[0], vb, 0, 2);
        AMF(o[1], vB[1], pw[1]); VFRAG(vA[1], vb, 1, 2);
        AMF(o[2], vB[2], pw[1]); VFRAG(vA[2], vb, 2, 2);
        AMF(o[3], vB[3], pw[1]); VFRAG(vA[3], vb, 3, 2);
        AMF(o[0], vA[0], pw[2]); VFRAG(vB[0], vb, 0, 3);
        AMF(o[1], vA[1], pw[2]); VFRAG(vB[1], vb, 1, 3);
        AMF(o[2], vA[2], pw[2]); VFRAG(vB[2], vb, 2, 3);
        AMF(o[3], vA[3], pw[2]); VFRAG(vB[3], vb, 3, 3);
        AMF(o[0], vB[0], pw[3]); AMF(o[1], vB[1], pw[3]); AMF(o[2], vB[2], pw[3]); AMF(o[3], vB[3], pw[3]);
        asm volatile("s_nop 15\n\ts_nop 15" : "+v"(o[0]), "+v"(o[1]), "+v"(o[2]), "+v"(o[3]) :: "memory");
    }
#undef B_DMA
#undef WAIT_BAR
#undef VFRAG
#undef MF_
#undef AMF
#undef AMF1
#undef AMF2
#undef AMF3
#undef AMF0
#undef PK4
#undef XE
#undef XE2
#undef KLD
#undef SET_KA
#undef BIAS_HALF
    attnB_finish(F, a, o, sacc, lam, rowbase, qpos, h, c, qs, r32, hi);
}
__device__ __forceinline__ void attnB_item(const Frame& F, const Args& a, int h, int b, int qblk, float lam) {
    const int q0 = qblk * 128;
    const unsigned* ctl = (const unsigned*)(a.ws + WS_CTL); const int sl = (b * 4 + h) * 4;
    const float qn0 = sqrtf(__uint_as_float(ctl[CW_QMAX + sl]) + __uint_as_float(ctl[CW_QMAX + sl + 1])), qn1 = sqrtf(__uint_as_float(ctl[CW_QMAX + sl + 2]) + __uint_as_float(ctl[CW_QMAX + sl + 3]));
    const float kn0 = sqrtf(__uint_as_float(ctl[CW_KMAX + sl]) + __uint_as_float(ctl[CW_KMAX + sl + 1])), kn1 = sqrtf(__uint_as_float(ctl[CW_KMAX + sl + 2]) + __uint_as_float(ctl[CW_KMAX + sl + 3]));
    const float U = fmaxf(qn0 * kn0, qn1 * kn1) * 1.01f + 0.01f;
    const float slope2 = __builtin_amdgcn_exp2f(-2.0f * (float)(h + 1)) * LOG2E;
    const float Df = (2.0f * U + 72.0f) / slope2;
    const int Dd = Df < 40000.f ? (int)Df + 2 : 40000;
    int t_lo = (q0 - Dd) >> 6; if (q0 - Dd < 0) t_lo = 0;
    int t_hi = (q0 + 127 + Dd) >> 6; if (t_hi > SEQ / 64 - 1) t_hi = SEQ / 64 - 1;
    if (U <= 40.f) attnB_fast(F, a, b, h, qblk, lam, t_lo, t_hi, kn0, kn1);
    else attnB_unit<false>(F, a, b, h, qblk, lam, t_lo, t_hi, kn0, kn1);
}

__device__ __forceinline__ int a_kbase(int n0, int it) { return n0 - 64 + 64 * ((it == 0) ? 1 : (it == 1 ? 0 : 2)); }
__device__ __forceinline__ void a_load_k(const bf16_t* KA, size_t rowbase, int head, int d, int r, int L, int kbase, int r32, int hi, bf16x8 (&kf)[8]) {
#pragma unroll
    for (int kh = 0; kh < 2; ++kh) { int kn = kbase + 32 * kh + r32; kn = kn < 0 ? 0 : (kn >= L ? L - 1 : kn);
        const bf16_t* Kp = KA + (rowbase + (size_t)(d * kn + r)) * 512 + head * 64 + 8 * hi;
#pragma unroll
        for (int d0 = 0; d0 < 4; ++d0) kf[2 * d0 + kh] = *(const bf16x8*)(Kp + 16 * d0); }
}
__device__ __forceinline__ void attnA_task(const Frame& F, const Args& a, int b, int head, int d, int r, int n0, int L, LAS unsigned char* vw, f32x16 (&o)[2], float& mhat, float& ltot) {
    const int lane = F_LANE, r32 = lane & 31, hi = lane >> 5;
    const bf16_t* QA = (const bf16_t*)(a.ws + WS_PROJ); const bf16_t* KA = QA + PROJ_STRIDE; const bf16_t* VA = KA + PROJ_STRIDE;
    const size_t rowbase = (size_t)b * SEQ; const int qn = n0 + r32;
    bf16x8 qr[4], kf[8], kfn[8];
    { const bf16_t* Qp = QA + (rowbase + (size_t)(d * qn + r)) * 512 + head * 64 + 8 * hi;
#pragma unroll
      for (int d0 = 0; d0 < 4; ++d0) qr[d0] = *(const bf16x8*)(Qp + 16 * d0); }
    a_load_k(KA, rowbase, head, d, r, L, a_kbase(n0, 0), r32, hi, kf);
    const float sl = __builtin_amdgcn_exp2f(-(float)(head + 1)) * LOG2E * (float)d;
    mhat = NEG_BIG; float lsum = 0.f; o[0] = (f32x16){}; o[1] = (f32x16){};
    const int voff = ((lane >> 4) & 1) * 32 + (lane & 3) * 8 + (4 * hi + ((lane & 15) >> 2)) * 64;
#pragma unroll
    for (int it = 0; it < 3; ++it) {
        const int kbase = a_kbase(n0, it);
        u32x4 vv[8];
#pragma unroll
        for (int ks = 0; ks < 4; ++ks) { int kn = kbase + 16 * ks + (lane >> 2); kn = kn < 0 ? 0 : (kn >= L ? L - 1 : kn);
            const bf16_t* Vp = VA + (rowbase + (size_t)(d * kn + r)) * 512 + head * 64 + 8 * (lane & 3);
            vv[ks] = *(const u32x4*)Vp; vv[4 + ks] = *(const u32x4*)(Vp + 32); }
        if (it < 2) a_load_k(KA, rowbase, head, d, r, L, a_kbase(n0, it + 1), r32, hi, kfn);
        __builtin_amdgcn_sched_barrier(0);
        f32x16 p0, p1;
#pragma unroll
        for (int rr = 0; rr < 16; ++rr) { const int k0 = kbase + crow(rr, hi), k1 = k0 + 32; const int d0_ = k0 - qn, d1_ = k1 - qn;
            const bool v0 = (k0 >= 0) && (k0 < L) && (d0_ <= 64) && (d0_ >= -64), v1 = (k1 >= 0) && (k1 < L) && (d1_ <= 64) && (d1_ >= -64);
            p0[rr] = v0 ? -sl * __builtin_fabsf((float)d0_) : NEG_BIG; p1[rr] = v1 ? -sl * __builtin_fabsf((float)d1_) : NEG_BIG; }
#pragma unroll
        for (int d0 = 0; d0 < 4; ++d0) { p0 = MFMA32(kf[2 * d0], qr[d0], p0); p1 = MFMA32(kf[2 * d0 + 1], qr[d0], p1); }
        u32x4 pw[4];
        softmax_tile<2>(p0, p1, mhat, lsum, o, pw);
        __builtin_amdgcn_sched_barrier(0);
#pragma unroll
        for (int i = 0; i < 8; ++i) *(LAS u32x4*)(vw + i * 1024 + lane * 16) = vv[i];
        asm volatile("s_waitcnt lgkmcnt(0)" ::: "memory");
        pv_tile<2>(o, (lds_cptr)(vw + voff), pw);
        asm volatile("s_waitcnt lgkmcnt(0)" ::: "memory");
        if (it < 2) {
#pragma unroll
            for (int j = 0; j < 8; ++j) kf[j] = kfn[j];
        }
    }
    ltot = halfsum(lsum);
}
struct ACst { bf16x8 qaC, qaL, qaR; u32x4 ka0, ka1; float e0, nsl; };
__device__ __forceinline__ void a_consts(int head, int d, int r32, int hi, ACst& c) {
    const float sl = __builtin_amdgcn_exp2f(-(float)(head + 1)) * LOG2E * (float)d; const unsigned msk = hi ? 0u : 0xFFFFFFFFu;
    const unsigned sh = bfb(sl), slo = bfb(sl - bff(sh)); unsigned h0, m0, l0;
    const unsigned pos = ((slo << 16) | sh) & msk, neg = (((slo ^ 0x8000u) << 16) | (sh ^ 0x8000u)) & msk;
    bf_split3(sl * (float)r32, h0, m0, l0);          { const u32x4 v = (u32x4){neg, 0u, ((m0 << 16) | h0) & msk, l0 & msk}; c.qaC = __builtin_bit_cast(bf16x8, v); }
    bf_split3(-sl * (float)(64 + r32), h0, m0, l0);  { const u32x4 v = (u32x4){pos, 0u, ((m0 << 16) | h0) & msk, l0 & msk}; c.qaL = __builtin_bit_cast(bf16x8, v); }
    bf_split3(sl * (float)(r32 - 64), h0, m0, l0);   { const u32x4 v = (u32x4){neg, 0u, ((m0 << 16) | h0) & msk, l0 & msk}; c.qaR = __builtin_bit_cast(bf16x8, v); }
    const unsigned j0 = bfb((float)r32), j1 = bfb((float)(32 + r32));
    c.ka0 = (u32x4){((j0 << 16) | j0) & msk, 0u, 0x3F803F80u & msk, 0x00003F80u & msk}; c.ka1 = c.ka0; c.ka1[0] = ((j1 << 16) | j1) & msk;
    c.e0 = (float)(4 * hi - r32); c.nsl = -sl;
}
__device__ __forceinline__ void a_load_k_half(const bf16_t* KA, size_t rowbase, int head, int d, int r, int kbase, int r32, int hi, bf16x8 (&kf)[8]) {
    const bf16_t* Kp = KA + (rowbase + (size_t)(d * (kbase + r32) + r)) * 512 + head * 64 + 8 * hi;
#pragma unroll
    for (int d0 = 0; d0 < 4; ++d0) kf[2 * d0] = *(const bf16x8*)(Kp + 16 * d0);
}
__device__ __forceinline__ void softmax_half(f32x16& p0, float& mhat, float& lsum, f32x16 (&o)[2], u32x4 (&pw)[4]) {
    float a_ = MX3(p0[0], p0[1], p0[2]), b_ = MX3(p0[3], p0[4], p0[5]);
#pragma unroll
    for (int r = 6; r < 16; r += 2) { a_ = __builtin_fmaxf(a_, p0[r]); b_ = __builtin_fmaxf(b_, p0[r + 1]); }
    float m = __builtin_fmaxf(a_, b_); auto rr = __builtin_amdgcn_permlane32_swap(__float_as_uint(m), __float_as_uint(m), false, false);
    const float rm = __builtin_fmaxf(__uint_as_float(rr[0]), __uint_as_float(rr[1]));
    const float mnew = __builtin_fmaxf(mhat, rm);
    if (__any(mnew != mhat)) {
        const float al = __builtin_amdgcn_exp2f(mhat - mnew); lsum *= al;
#pragma unroll
        for (int d = 0; d < 2; ++d)
#pragma unroll
            for (int r = 0; r < 16; ++r) o[d][r] *= al;
        mhat = mnew;
    }
    float s = 0.f;
#pragma unroll
    for (int r = 0; r < 16; ++r) { p0[r] = __builtin_amdgcn_exp2f(p0[r] - mhat); s += p0[r]; }
    lsum += s;
    pw[0] = (u32x4){cvtpk(p0[0], p0[1]), cvtpk(p0[2], p0[3]), cvtpk(p0[4], p0[5]), cvtpk(p0[6], p0[7])};
    pw[1] = (u32x4){cvtpk(p0[8], p0[9]), cvtpk(p0[10], p0[11]), cvtpk(p0[12], p0[13]), cvtpk(p0[14], p0[15])};
}
__device__ __forceinline__ void attnA_task_in(const Frame& F, const Args& a, const ACst& cs, int b, int head, int d, int r, int n0, LAS unsigned char* vw, f32x16 (&o)[2], float& mhat, float& ltot) {
    const int lane = F_LANE, r32 = lane & 31, hi = lane >> 5;
    const bf16_t* QA = (const bf16_t*)(a.ws + WS_PROJ); const bf16_t* KA = QA + PROJ_STRIDE; const bf16_t* VA = KA + PROJ_STRIDE;
    const size_t rowbase = (size_t)b * SEQ; const int qn = n0 + r32;
    bf16x8 qr[4], kf[8];
    { const bf16_t* Qp = QA + (rowbase + (size_t)(d * qn + r)) * 512 + head * 64 + 8 * hi;
#pragma unroll
      for (int d0 = 0; d0 < 4; ++d0) qr[d0] = *(const bf16x8*)(Qp + 16 * d0); }
    a_load_k(KA, rowbase, head, d, r, 1 << 30, n0, r32, hi, kf);
    mhat = NEG_BIG; float lsum = 0.f; o[0] = (f32x16){}; o[1] = (f32x16){};
    const int voff = ((lane >> 4) & 1) * 32 + (lane & 3) * 8 + (4 * hi + ((lane & 15) >> 2)) * 64;
    const int m_ = r32 - 4 * hi;
#define A_VLOAD(kb_, NKS) _Pragma("unroll") for (int ks = 0; ks < (NKS); ++ks) { const int kn = (kb_) + 16 * ks + (lane >> 2); \
            const bf16_t* Vp = VA + (rowbase + (size_t)(d * kn + r)) * 512 + head * 64 + 8 * (lane & 3); vv[ks] = *(const u32x4*)Vp; vv[4 + ks] = *(const u32x4*)(Vp + 32); }
    const f32x16 zero16 = (f32x16){};
    u32x4 vv[8], pw[4]; f32x16 p0, p1;
    A_VLOAD(n0, 4)
#pragma unroll
    for (int rr = 0; rr < 16; ++rr) p0[rr] = cs.nsl * __builtin_fabsf(cs.e0 + (float)((rr & 3) + 8 * (rr >> 2)));
    p1 = MFMA32(__builtin_bit_cast(bf16x8, cs.ka1), cs.qaC, zero16);
#pragma unroll
    for (int d0 = 0; d0 < 4; ++d0) { p0 = MFMA32(kf[2 * d0], qr[d0], p0); p1 = MFMA32(kf[2 * d0 + 1], qr[d0], p1); }
    a_load_k(KA, rowbase, head, d, r, 1 << 30, n0 - 64, r32, hi, kf);
    softmax_tile<2>(p0, p1, mhat, lsum, o, pw);
#pragma unroll
    for (int i = 0; i < 8; ++i) *(LAS u32x4*)(vw + i * 1024 + lane * 16) = vv[i];
    asm volatile("s_waitcnt lgkmcnt(0)" ::: "memory");
    pv_tile<2>(o, (lds_cptr)(vw + voff), pw);
    asm volatile("s_waitcnt lgkmcnt(0)" ::: "memory");
    A_VLOAD(n0 - 64, 4)
    p0 = MFMA32(__builtin_bit_cast(bf16x8, cs.ka0), cs.qaL, zero16); p1 = MFMA32(__builtin_bit_cast(bf16x8, cs.ka1), cs.qaL, zero16);
#pragma unroll
    for (int d0 = 0; d0 < 4; ++d0) { p0 = MFMA32(kf[2 * d0], qr[d0], p0); p1 = MFMA32(kf[2 * d0 + 1], qr[d0], p1); }
    a_load_k_half(KA, rowbase, head, d, r, n0 + 64, r32, hi, kf);
#pragma unroll
    for (int rr = 0; rr < 16; ++rr) p0[rr] = ((rr & 3) + 8 * (rr >> 2) >= m_) ? p0[rr] : NEG_BIG;
    softmax_tile<2>(p0, p1, mhat, lsum, o, pw);
#pragma unroll
    for (int i = 0; i < 8; ++i) *(LAS u32x4*)(vw + i * 1024 + lane * 16) = vv[i];
    asm volatile("s_waitcnt lgkmcnt(0)" ::: "memory");
    pv_tile<2>(o, (lds_cptr)(vw + voff), pw);
    asm volatile("s_waitcnt lgkmcnt(0)" ::: "memory");
    A_VLOAD(n0 + 64, 2)
    p0 = MFMA32(__builtin_bit_cast(bf16x8, cs.ka0), cs.qaR, zero16);
#pragma unroll
    for (int d0 = 0; d0 < 4; ++d0) p0 = MFMA32(kf[2 * d0], qr[d0], p0);
#pragma unroll
    for (int rr = 0; rr < 16; ++rr) p0[rr] = ((rr & 3) + 8 * (rr >> 2) <= m_) ? p0[rr] : NEG_BIG;
    softmax_half(p0, mhat, lsum, o, pw);
#pragma unroll
    for (int ks = 0; ks < 2; ++ks) { *(LAS u32x4*)(vw + ks * 1024 + lane * 16) = vv[ks]; *(LAS u32x4*)(vw + (4 + ks) * 1024 + lane * 16) = vv[4 + ks]; }
    asm volatile("s_waitcnt lgkmcnt(0)" ::: "memory");
    {   const lds_cptr vbase = (lds_cptr)(vw + voff);
#pragma unroll
        for (int d0 = 0; d0 < 2; ++d0)
#pragma unroll
            for (int ks = 0; ks < 2; ++ks) {
                const s16x4 lo = vtr(vbase + d0 * 4096 + ks * 1024), hi_ = vtr(vbase + d0 * 4096 + ks * 1024 + 512);
                const bf16x8 vf = (bf16x8){lo[0], lo[1], lo[2], lo[3], hi_[0], hi_[1], hi_[2], hi_[3]};
                o[d0] = MFMA32(vf, __builtin_bit_cast(bf16x8, pw[ks]), o[d0]); } }
    asm volatile("s_waitcnt lgkmcnt(0)" ::: "memory");
#undef A_VLOAD
    ltot = halfsum(lsum);
}
__device__ __forceinline__ void attnA_unit(const Frame& F, const Args& a, int unit) {
    const int lane = F_LANE, r32 = lane & 31, hi = lane >> 5, wid = F.wave;
    const int b = unit >> 7, head = (unit >> 4) & 7, tb = unit & 15, T0 = tb * 1024;
    float* part = (float*)(a.ws + WS_APART + (size_t)unit * APART_UNIT); float* ml = part + 2 * 1024 * 64;
    LAS unsigned char* vw = F.lds + wid * 8192;
    {
#pragma unroll 1
    for (int task = wid; task < 64; task += 8) {
        int pat, d, r, n0, L;
        if (task < 32) { pat = 0; d = 16; r = task >> 1; n0 = T0 / 16 + 32 * (task & 1); L = SEQ / 16; }
        else { const int tt = task - 32; pat = 1; d = 4; r = tt >> 3; n0 = T0 / 4 + 32 * (tt & 7); L = SEQ / 4; }
        f32x16 o[2]; float mhat, ltot;
        if (n0 >= 64 && n0 + 128 <= L) { ACst cs; a_consts(head, d, r32, hi, cs); attnA_task_in(F, a, cs, b, head, d, r, n0, vw, o, mhat, ltot); }
        else attnA_task(F, a, b, head, d, r, n0, L, vw, o, mhat, ltot);
        const int tl = d * (n0 + r32) + r - T0;
        float* pp = part + ((size_t)pat * 1024 + tl) * 64 + 4 * hi;
#pragma unroll
        for (int d0 = 0; d0 < 2; ++d0)
#pragma unroll
            for (int g = 0; g < 4; ++g) *(f32x4*)(pp + 32 * d0 + 8 * g) = (f32x4){o[d0][4 * g], o[d0][4 * g + 1], o[d0][4 * g + 2], o[d0][4 * g + 3]};
        if (hi == 0) *(f32x2*)(ml + ((size_t)pat * 1024 + tl) * 2) = (f32x2){mhat, ltot};
    }
    }
    asm volatile("s_waitcnt vmcnt(0)" ::: "memory");
    __syncthreads();
    __builtin_amdgcn_fence(__ATOMIC_ACQUIRE, "agent");
    for (int task = wid; task < 32; task += 8) {
        const int n0 = T0 + 32 * task;
        f32x16 o[2]; float m0, l0;
        if (n0 >= 64 && n0 + 128 <= SEQ) { ACst cs1; a_consts(head, 1, r32, hi, cs1); attnA_task_in(F, a, cs1, b, head, 1, 0, n0, vw, o, m0, l0); }
        else attnA_task(F, a, b, head, 1, 0, n0, SEQ, vw, o, m0, l0);
        const int tl = 32 * task + r32;
        const f32x2 ml1 = *(const f32x2*)(ml + ((size_t)0 * 1024 + tl) * 2), ml2 = *(const f32x2*)(ml + ((size_t)1 * 1024 + tl) * 2);
        const float M = MX3(m0, ml1[0], ml2[0]);
        const float w0 = __builtin_amdgcn_exp2f(m0 - M), w1 = __builtin_amdgcn_exp2f(ml1[0] - M), w2 = __builtin_amdgcn_exp2f(ml2[0] - M);
        const float rden = 1.0f / (w0 * l0 + w1 * ml1[1] + w2 * ml2[1]);
        const float* p1 = part + ((size_t)0 * 1024 + tl) * 64 + 4 * hi; const float* p2 = part + ((size_t)1 * 1024 + tl) * 64 + 4 * hi;
        bf16_t* op = (bf16_t*)(a.ws + WS_MIXED) + ((size_t)b * SEQ + T0 + tl) * DM + head * 64 + 4 * hi;
#pragma unroll
        for (int d0 = 0; d0 < 2; ++d0)
#pragma unroll
            for (int g = 0; g < 4; ++g) { const f32x4 a1 = *(const f32x4*)(p1 + 32 * d0 + 8 * g), a2 = *(const f32x4*)(p2 + 32 * d0 + 8 * g); float v[4];
#pragma unroll
                for (int j = 0; j < 4; ++j) v[j] = (w0 * o[d0][4 * g + j] + w1 * a1[j] + w2 * a2[j]) * rden;
                u32x2 w; w.x = cvtpk(v[0], v[1]); w.y = cvtpk(v[2], v[3]); *(u32x2*)(op + 32 * d0 + 8 * g) = w; }
    }
    __syncthreads();
}

__device__ __forceinline__ unsigned ordkey(float v) { const unsigned u = __float_as_uint(v); return u ^ ((u >> 31) ? 0xFFFFFFFFu : 0x80000000u); }
__device__ __forceinline__ float unordkey(unsigned k) { const unsigned u = (k & 0x80000000u) ? (k ^ 0x80000000u) : ~k; return __uint_as_float(u); }
__device__ __forceinline__ void p4_ln_router(const Frame& F, const Args& a) {
    const int lane = F_LANE, wid = F.wave, tid = F_TID;
    LAS float* Wr = (LAS float*)F.lds;
    LAS unsigned* misc = (LAS unsigned*)(F.lds + LX_MISC);
    LAS float* pc = (LAS float*)(F.lds + LX_TOK);
    for (int i = tid; i < DM * NE / 4; i += 512) ((LAS f32x4*)Wr)[i] = ((const f32x4*)a.w_router)[i] * a.ln1_g[i >> 3];
    if (tid < 64) misc[tid] = 0u;
    float* Z = (float*)(a.ws + WS_Z); bf16_t* X1B = (bf16_t*)(a.ws + WS_XB);
    const int r0 = (F.vcu * 8 + wid) * 16;
    const int rl = lane & 15, q = lane >> 4;
    float mym[4] = {0.f, 0.f, 0.f, 0.f}, myr[4] = {0.f, 0.f, 0.f, 0.f};
    {
        f32x4 gv[4], bv[4];
#pragma unroll
        for (int j = 0; j < 4; ++j) { gv[j] = ((const f32x4*)a.ln1_g)[lane + 64 * j]; bv[j] = ((const f32x4*)a.ln1_b)[lane + 64 * j]; }
        float* stats = (float*)(a.ws + WS_ROUTE + 4 * MiB);
#pragma unroll 4
        for (int rr = 0; rr < 16; ++rr) {
            const f32x4* zr = (const f32x4*)(Z + (size_t)(r0 + rr) * DM) + lane; f32x4 v[4]; float s = 0.f;
#pragma unroll
            for (int j = 0; j < 4; ++j) { v[j] = zr[64 * j]; s += (v[j][0] + v[j][1]) + (v[j][2] + v[j][3]); }
            const float mean = wave_sum(s) * (1.f / DM); float s2 = 0.f;
#pragma unroll
            for (int j = 0; j < 4; ++j) { v[j] = v[j] - mean; s2 += (v[j][0] * v[j][0] + v[j][1] * v[j][1]) + (v[j][2] * v[j][2] + v[j][3] * v[j][3]); }
            const float rstd = 1.f / sqrtf(wave_sum(s2) * (1.f / DM) + LN_EPS);
            unsigned* o8 = (unsigned*)((unsigned char*)X1B + (size_t)(r0 + rr) * DM) + lane;
#pragma unroll
            for (int j = 0; j < 4; ++j) { const f32x4 y = (v[j] * rstd * gv[j] + bv[j]) * 8.f; o8[64 * j] = cvt4_fp8(y[0], y[1], y[2], y[3]); }
            if (lane == 0) *(f32x2*)(stats + 2 * (r0 + rr)) = (f32x2){mean, rstd};
            if ((rr >> 2) == q) {
#pragma unroll
                for (int i = 0; i < 4; ++i) if ((rr & 3) == i) { mym[i] = mean; myr[i] = rstd; } }
        }
    }
    __syncthreads();
    {
        const int e = tid & 31, part = tid >> 5; float s0 = 0.f, s1 = 0.f;
        for (int k = part * 64; k < part * 64 + 64; ++k) { s0 += Wr[k * 32 + e]; s1 += a.ln1_b[k] * a.w_router[k * 32 + e]; }
        pc[part * 32 + e] = s0; pc[512 + part * 32 + e] = s1;
    }
    __syncthreads();
    if (tid < 64) { const int e = tid & 31, w = tid >> 5; float t = 0.f; for (int p = 0; p < 16; ++p) t += pc[w * 512 + p * 32 + e]; pc[1024 + tid] = t + (w ? a.b_router[e] : 0.f); }
    __syncthreads();
    f32x4 acc0 = (f32x4){0.f, 0.f, 0.f, 0.f}, acc1 = acc0;
    const float* xr = Z + (size_t)(r0 + rl) * DM + 4 * q;
#pragma unroll 4
    for (int cidx = 0; cidx < 64; ++cidx) {
        const f32x4 xv = *(const f32x4*)(xr + 16 * cidx);
#pragma unroll
        for (int j = 0; j < 4; ++j) { const int k = 16 * cidx + 4 * q + j;
            acc0 = __builtin_amdgcn_mfma_f32_16x16x4f32(xv[j], Wr[k * 32 + rl], acc0, 0, 0, 0);
            acc1 = __builtin_amdgcn_mfma_f32_16x16x4f32(xv[j], Wr[k * 32 + 16 + rl], acc1, 0, 0, 0); }
    }
    {   const float cs0 = pc[1024 + rl], cs1 = pc[1024 + 16 + rl], cb0 = pc[1024 + 32 + rl], cb1 = pc[1024 + 48 + rl];
#pragma unroll
        for (int i = 0; i < 4; ++i) { acc0[i] = myr[i] * (acc0[i] - mym[i] * cs0) + cb0; acc1[i] = myr[i] * (acc1[i] - mym[i] * cs1) + cb1; } }
    const float br0 = 0.f, br1 = 0.f;
    int* sel_e = (int*)(a.ws + WS_ROUTE); int* sel_pos = sel_e + NTOK * TOPK; float* sel_gate = (float*)(sel_pos + NTOK * TOPK);
    int my_e[4] = {0, 0, 0, 0}, my_lp[4] = {0, 0, 0, 0}; float my_g[4] = {0.f, 0.f, 0.f, 0.f};
#pragma unroll
    for (int i = 0; i < 4; ++i) {
        unsigned k0 = (ordkey(acc0[i] + br0) & ~31u) | (unsigned)(31 - rl), k1 = (ordkey(acc1[i] + br1) & ~31u) | (unsigned)(15 - rl);
        unsigned selk[4];
#pragma unroll
        for (int t = 0; t < 4; ++t) {
            unsigned m = k0 > k1 ? k0 : k1;
#pragma unroll
            for (int ofs = 1; ofs < 16; ofs <<= 1) { const unsigned other = (unsigned)__shfl_xor((int)m, ofs); m = other > m ? other : m; }
            selk[t] = m; if (k0 == m) k0 = 0u; if (k1 == m) k1 = 0u;
        }
        const float v0 = unordkey(selk[0] & ~31u), v1 = unordkey(selk[1] & ~31u), v2 = unordkey(selk[2] & ~31u), v3 = unordkey(selk[3] & ~31u);
        const float e1 = __expf(v1 - v0), e2 = __expf(v2 - v0), e3 = __expf(v3 - v0); const float rs = 1.0f / (1.0f + e1 + e2 + e3);
        if (rl < 4) { const unsigned sk = rl == 0 ? selk[0] : (rl == 1 ? selk[1] : (rl == 2 ? selk[2] : selk[3]));
            const float ge = rl == 0 ? 1.0f : (rl == 1 ? e1 : (rl == 2 ? e2 : e3));
            my_e[i] = 31 - (int)(sk & 31u); my_g[i] = ge * rs; my_lp[i] = (int)atomicAdd((unsigned*)&misc[my_e[i]], 1u); }
    }
    __syncthreads();
    unsigned* gcnt = (unsigned*)(a.ws + WS_CTL);
    if (F_TID < 32) misc[32 + F_TID] = atomicAdd(&gcnt[F_TID], misc[F_TID]);
    __syncthreads();
    if (rl < 4) {
#pragma unroll
        for (int i = 0; i < 4; ++i) { const int tok = r0 + 4 * q + i, idx = tok * 4 + rl; sel_e[idx] = my_e[i]; sel_pos[idx] = (int)misc[32 + my_e[i]] + my_lp[i]; sel_gate[idx] = my_g[i]; }
    }
}

__device__ __forceinline__ int build_tiles(const Frame& F, const Args& a) {
    LAS unsigned* misc = (LAS unsigned*)(F.lds + LX_MISC); LAS unsigned char* tile_e = F.lds + LX_TILE;
    const unsigned* gcnt = (const unsigned*)(a.ws + WS_CTL);
    if (F_TID < NE) misc[128 + F_TID] = (__hip_atomic_load(&gcnt[F_TID], __ATOMIC_RELAXED, __HIP_MEMORY_SCOPE_AGENT) + 255u) >> 8;
    __syncthreads();
    if (F_TID == 0) { unsigned acc = 0; for (int e = 0; e < NE; ++e) { misc[64 + e] = acc; acc += misc[128 + e]; } misc[64 + NE] = acc; }
    __syncthreads();
    const int nt = (int)misc[64 + NE];
    for (int e = 0; e < NE; ++e) { const int t0 = (int)misc[64 + e], t1 = (int)misc[65 + e]; for (int t = t0 + F_TID; t < t1; t += 512) tile_e[t] = (unsigned char)e; }
    __syncthreads();
    return nt;
}

#define XLAS __attribute__((address_space(3)))
#define XB_TMO      128
#define XB_XCNT(j)  (256  + 64 * (j))
#define XB_XSUB(j)  (1280 + 64 * (j))
#define XB_XGEN(j)  (2304 + 64 * (j))
#define XB_TOP      3328
#define XB_TOPGEN   3392
#define XCD_BAR_WORDS 3456
#define XB_SPIN_CAP (1u << 22)

__device__ __forceinline__ unsigned xb_ld(unsigned* p)              { return __hip_atomic_load(p, __ATOMIC_RELAXED, __HIP_MEMORY_SCOPE_AGENT); }
__device__ __forceinline__ unsigned xb_add(unsigned* p, unsigned v) { return __hip_atomic_fetch_add(p, v, __ATOMIC_RELAXED, __HIP_MEMORY_SCOPE_AGENT); }
__device__ __forceinline__ unsigned xb_xcc_id() { return (unsigned)__builtin_amdgcn_s_getreg((3 << 11) | 20) & 0xFu; }
#define XB_SPIN(cond, bar) do { unsigned _sp = 0; while (cond) { __builtin_amdgcn_s_sleep(1); \
    if ((++_sp & 255u) == 0u) { if (xb_ld(&(bar)[XB_TMO])) break; if (_sp > XB_SPIN_CAP) { atomicAdd(&(bar)[XB_TMO], 1u); break; } } } } while (0)

struct XcdBarrier {
    unsigned* bar; unsigned x;
    volatile XLAS unsigned* st;
};

__device__ __forceinline__ XcdBarrier xcd_barrier_post(unsigned* bar, volatile XLAS unsigned* st) {
    XcdBarrier b; b.bar = bar; b.x = xb_xcc_id(); b.st = st;
    if (threadIdx.x == 0) (void)xb_add(&bar[XB_XCNT(b.x)], 1u);
    return b;
}
__device__ __forceinline__ void xcd_barrier_complete(unsigned* bar, unsigned x, unsigned& nloc, unsigned& nx) {
    const unsigned G = gridDim.x * gridDim.y * gridDim.z;
    unsigned sum, cnt, mine, sp = 0u;
    for (;;) {
        sum = 0u; cnt = 0u; mine = 0u;
#pragma unroll
        for (unsigned j = 0; j < 16; ++j) { const unsigned c = xb_ld(&bar[XB_XCNT(j)]); sum += c; cnt += (c > 0u) ? 1u : 0u; mine = (j == x) ? c : mine; }
        if (sum == G) break;
        __builtin_amdgcn_s_sleep(1);
        if ((++sp & 255u) == 0u) { if (xb_ld(&bar[XB_TMO])) break; if (sp > XB_SPIN_CAP) { atomicAdd(&bar[XB_TMO], 1u); break; } }
    }
    nloc = mine > 0u ? mine : 1u; nx = cnt > 0u ? cnt : 1u;
}

__device__ __forceinline__ void xcd_barrier(const XcdBarrier& b, const int tid0) {
    asm volatile("s_waitcnt vmcnt(0)" ::: "memory");
    __syncthreads();
    if (tid0 == 0) {
        unsigned* bar = b.bar;
        __builtin_amdgcn_s_waitcnt(0);
        unsigned nloc = b.st[0], nx = b.st[1];
        if (nloc == 0u) { xcd_barrier_complete(bar, b.x, nloc, nx); b.st[0] = nloc; b.st[1] = nx; }
        const unsigned old = xb_add(&bar[XB_XSUB(b.x)], 1u);
        const unsigned gen = old / nloc;
        if (old + 1u == (gen + 1u) * nloc) {
            __builtin_amdgcn_fence(__ATOMIC_RELEASE, "agent");
            asm volatile("s_waitcnt vmcnt(0)" ::: "memory");
            const unsigned og = xb_add(&bar[XB_TOP], 1u);
            const unsigned tg = og / nx;
            if (og + 1u == (tg + 1u) * nx) xb_add(&bar[XB_TOPGEN], 1u);
            else XB_SPIN(xb_ld(&bar[XB_TOPGEN]) == tg, bar);
            __builtin_amdgcn_fence(__ATOMIC_ACQUIRE, "agent");
            xb_add(&bar[XB_XGEN(b.x)], 1u);
            asm volatile("s_waitcnt vmcnt(0)" ::: "memory");
        } else {
            XB_SPIN(xb_ld(&bar[XB_XGEN(b.x)]) == gen, bar);
            __builtin_amdgcn_fence(__ATOMIC_ACQUIRE, "agent");
            asm volatile("s_waitcnt vmcnt(0)" ::: "memory");
        }
    }
    __syncthreads();
}

__global__ void __launch_bounds__(512, 2) fwd_megakernel(Args a) {
    extern __shared__ __attribute__((aligned(16))) unsigned char lds_raw[];
    cg::grid_group grid = cg::this_grid();
    Frame F; F.lds = (LAS unsigned char*)lds_raw; F.wave = __builtin_amdgcn_readfirstlane((int)(threadIdx.x >> 6));
    F.G = gridDim.x; { const int bx = blockIdx.x; F.vcu = (F.G % 8 == 0) ? (bx % 8) * (F.G / 8) + bx / 8 : bx; }
    unsigned char* ws = a.ws;
    {   LAS unsigned* m0_ = (LAS unsigned*)(F.lds + LX_MISC); if (F_TID < 128) m0_[F_TID] = 0u; __syncthreads(); }
    XcdBarrier xbar = xcd_barrier_post((unsigned*)(ws + WS_CTL) + CW_BAR, (volatile LAS unsigned*)(F.lds + LX_MISC) + 120);
#define GRID_BAR() xcd_barrier(xbar, F_TID)
#ifdef PROBE_T1
    unsigned long long* stamps = (unsigned long long*)(ws + WS_CTL + 2048);
#define STAMP(k) do { if (blockIdx.x == 0 && F_TID == 0) stamps[k] = __builtin_amdgcn_s_memrealtime(); } while (0)
#else
#define STAMP(k) do {} while (0)
#endif
    STAMP(0);

    for (int rep = 0; rep < REP_P0; ++rep) p0_prologue(F, a);
    if (a.out == nullptr) grid.sync();
    GRID_BAR();
    STAMP(1);

    for (int rep = 0; rep < REP_P1; ++rep) {
        pg8::Gemm g{(const bf16_t*)(ws + WS_XB), (const bf16_t*)(ws + WS_WIN), NTOK, NPROJ, DM, 0, 0}; pg8::StaticOrder S; S.init(NTOK, NPROJ, F.G, (int)blockIdx.x);
        EpiProj E{(bf16_t*)(ws + WS_PROJ), (unsigned*)(ws + WS_CTL)};
        pg8::gemm_phase<EpiProj, pg8::StaticOrder, true, false, KREP_P1>(F.lds, g, S, E, F_TID);
    }
    GRID_BAR();
    STAMP(2);

    {
        float s1 = 0.f, s2 = 0.f;
        for (int i = 0; i < 64; ++i) { s1 += a.lq1[i] * a.lk1[i]; s2 += a.lq2[i] * a.lk2[i]; }
        const float lam = __expf(s1) - __expf(s2) + LAM_INIT;
        {
            LAS unsigned* misc = (LAS unsigned*)(F.lds + LX_MISC); unsigned* ctl = (unsigned*)(ws + WS_CTL);
            const int myx = (int)(xbar.x & 7u);
            for (;;) {
                __syncthreads();
                if (F_TID == 0) { int got = -1;
                    { const unsigned p = atomicAdd(ctl + CW_QUEUE + myx, 1u); if (p < 160u) got = myx * 256 + (int)p; }
                    for (int k = 1; k < 8 && got < 0; ++k) { const int qx = (myx + k) & 7;
                        if (__hip_atomic_load(ctl + CW_QUEUE + qx, __ATOMIC_RELAXED, __HIP_MEMORY_SCOPE_AGENT) < 160u) { const unsigned p = atomicAdd(ctl + CW_QUEUE + qx, 1u); if (p < 160u) got = qx * 256 + (int)p; } }
                    misc[100] = (unsigned)got; }
                __syncthreads();
                const int idx = __builtin_amdgcn_readfirstlane((int)misc[100]);
                if (idx < 0) break;
                const int qx = idx >> 8, p = idx & 255;
                if (p < 64 && (p & 1)) attnA_unit(F, a, qx * 32 + (p >> 1));
                else { const int h = p < 64 ? 3 : 2 - ((p - 64) >> 5), j = p < 64 ? (p >> 1) : (p & 31); attnB_item(F, a, h, qx >> 2, 32 * (qx & 3) + j, lam); }
            }
        }
    }
    GRID_BAR();
    STAMP(3);

    for (int rep = 0; rep < REP_P3; ++rep) {
        pg8::Gemm g{(const bf16_t*)(ws + WS_MIXED), (const bf16_t*)(ws + WS_WOUT), NTOK, DM, DM, 0, 0}; pg8::StaticOrder S; S.init(NTOK, DM, F.G, (int)blockIdx.x);
        EpiZ E{a.x, (float*)(ws + WS_Z)};
        pg8::gemm_phase<EpiZ, pg8::StaticOrder, true, false, KREP_P3>(F.lds, g, S, E, F_TID);
    }
    GRID_BAR();
    STAMP(4);

    if (F.G == 256) p4_ln_router(F, a);
    GRID_BAR();
    STAMP(5);

    int* sel_e = (int*)(ws + WS_ROUTE); int* sel_pos = sel_e + NTOK * TOPK; float* sel_gate = (float*)(sel_pos + NTOK * TOPK);
    int* inv = (int*)(sel_gate + NTOK * TOPK); int* row_tok = inv + NTOK * TOPK; float* row_gate = (float*)(row_tok + 262144);
    {
        const int ntl = build_tiles(F, a); (void)ntl;
        LAS unsigned* misc = (LAS unsigned*)(F.lds + LX_MISC);
        const unsigned* gcnt = (const unsigned*)(ws + WS_CTL);
        for (int idx = F.vcu * 512 + F_TID; idx < NTOK * TOPK; idx += F.G * 512) {
            const int e = sel_e[idx], dest = (int)misc[64 + e] * 256 + sel_pos[idx];
            row_tok[dest] = idx >> 2; row_gate[dest] = sel_gate[idx]; inv[idx] = dest;
        }
        for (int e = F.vcu; e < NE; e += F.G) {
            const int c = (int)__hip_atomic_load(&gcnt[e], __ATOMIC_RELAXED, __HIP_MEMORY_SCOPE_AGENT), base = (int)misc[64 + e] * 256, end = (int)misc[65 + e] * 256;
            for (int r = base + c + F_TID; r < end; r += 512) { row_tok[r] = 0; row_gate[r] = 0.f; }
        }
    }
    GRID_BAR();
    STAMP(6);

    for (int rep = 0; rep < REP_P6; ++rep) {
        const int ntl = build_tiles(F, a);
        MoeOrder S; S.so.init(ntl * 256, 2048, F.G, (int)blockIdx.x); S.tile_e = F.lds + LX_TILE; S.tok = (const LAS unsigned short*)(F.lds + LX_TOK); S.ncolt = 8;
        {
            LAS unsigned short* tk = (LAS unsigned short*)(F.lds + LX_TOK); pg8::Unit u;
            for (int i = F.wave; i < 24 && S.so.next(i, u); i += 8) { const int l_ = F_LANE;
#pragma unroll
                for (int j = 0; j < 4; ++j) tk[i * 256 + l_ + 64 * j] = (unsigned short)row_tok[u.pm * 256 + l_ + 64 * j]; }
            __syncthreads();
        }
        pg8::Gemm g{(const bf16_t*)(ws + WS_XB), (const bf16_t*)(ws + WS_WUP), ntl * 256, 2048, DM, 0x7C7C7C7C, 0x77777777};
        EpiUp E{(bf16_t*)(ws + WS_H), a.b_up};
        pg8::gemm_phase<EpiUp, MoeOrder, true, true, KREP_P6, true>(F.lds, g, S, E, F_TID);
    }
    GRID_BAR();
    STAMP(7);

    for (int rep = 0; rep < REP_P7; ++rep) {
        const int ntl = build_tiles(F, a);
        MoeOrder S; S.so.init(ntl * 256, 1024, F.G, (int)blockIdx.x, ORD_REV7); S.tile_e = F.lds + LX_TILE; S.tok = nullptr; S.ncolt = 4;
        pg8::Gemm g{(const bf16_t*)(ws + WS_H), (const bf16_t*)(ws + WS_WDN), ntl * 256, DM, DFF, 0x7D7D7D7D, 0x77777777};
        EpiDown E{(bf16_t*)(ws + WS_Y), a.b_down, row_gate};
        pg8::gemm_phase<EpiDown, MoeOrder, true, false, KREP_P7, true>(F.lds, g, S, E, F_TID);
    }
    GRID_BAR();
    STAMP(8);

    for (int rep = 0; rep < REP_P8; ++rep) {
        const int lane = F_LANE; const float* X1 = (const float*)(ws + WS_Z); const bf16_t* Y = (const bf16_t*)(ws + WS_Y); const float* stats = (const float*)(ws + WS_ROUTE + 4 * MiB);
        f32x4 gv[4], bv[4], g1[4], b1[4];
#pragma unroll
        for (int j = 0; j < 4; ++j) { gv[j] = ((const f32x4*)a.ln2_g)[lane + 64 * j]; bv[j] = ((const f32x4*)a.ln2_b)[lane + 64 * j]; g1[j] = ((const f32x4*)a.ln1_g)[lane + 64 * j] * ALPHA; b1[j] = ((const f32x4*)a.ln1_b)[lane + 64 * j] * ALPHA; }
        for (int m = F.vcu * 8 + F.wave; m < NTOK; m += F.G * 8) {
            const f32x4* xr = (const f32x4*)(X1 + (size_t)m * DM) + lane; f32x4 v[4]; const f32x2 st = *(const f32x2*)(stats + 2 * m);
#pragma unroll
            for (int j = 0; j < 4; ++j) v[j] = (xr[64 * j] - st[0]) * st[1] * g1[j] + b1[j];
#pragma unroll
            for (int t = 0; t < 4; ++t) { const int dest = inv[m * 4 + t]; const unsigned* yr = (const unsigned*)((const unsigned char*)Y + (size_t)dest * DM) + lane;
#pragma unroll
                for (int j = 0; j < 4; ++j) { const int w = (int)yr[64 * j];
                    v[j][0] += __builtin_amdgcn_cvt_f32_fp8(w, 0) * (1.f / 32.f); v[j][1] += __builtin_amdgcn_cvt_f32_fp8(w, 1) * (1.f / 32.f);
                    v[j][2] += __builtin_amdgcn_cvt_f32_fp8(w, 2) * (1.f / 32.f); v[j][3] += __builtin_amdgcn_cvt_f32_fp8(w, 3) * (1.f / 32.f); } }
            float s = 0.f;
#pragma unroll
            for (int j = 0; j < 4; ++j) s += (v[j][0] + v[j][1]) + (v[j][2] + v[j][3]);
            const float mean = wave_sum(s) * (1.f / DM); float s2 = 0.f;
#pragma unroll
            for (int j = 0; j < 4; ++j) { v[j] = v[j] - mean; s2 += (v[j][0] * v[j][0] + v[j][1] * v[j][1]) + (v[j][2] * v[j][2] + v[j][3] * v[j][3]); }
            const float rstd = 1.f / sqrtf(wave_sum(s2) * (1.f / DM) + LN_EPS);
            f32x4* orow = (f32x4*)(a.out + (size_t)m * DM) + lane;
#pragma unroll
            for (int j = 0; j < 4; ++j) orow[64 * j] = v[j] * rstd * gv[j] + bv[j];
        }
    }
#ifdef PROBE_T1
    STAMP(9);
    if (blockIdx.x == 0) {
        __syncthreads();
        const float t1 = (float)(stamps[PROBE_T1 + 1] - stamps[PROBE_T1]) * 0.01f, t2 = (float)(stamps[PROBE_T2 + 1] - stamps[PROBE_T2]) * 0.01f;
        for (int i = F_TID; i < (1 << 20); i += 512) a.out[1 + i] = t2;
        if (F_TID == 0) a.out[0] = t1 * 10.0f;
    }
#endif
}

extern "C" void kernel_launch(void* const* d_in, const int* in_sizes, int n_in, void* d_out, int out_size, void* d_ws, size_t ws_size, hipStream_t stream) {
    static int grid = 0;
    if (grid == 0) {
        if (n_in != 18 || in_sizes[0] != NTOK * DM || out_size != NTOK * DM || ws_size < WS_END) {
            fprintf(stderr, "kernel_launch: unexpected shapes (n_in %d, in0 %d, out %d, ws %zu need %zu); nothing launched\n", n_in, n_in > 0 ? in_sizes[0] : -1, out_size, ws_size, (size_t)WS_END); grid = -1; return; }
        int dev = 0, cus = 0, per_cu = 0;
        if (hipGetDevice(&dev) != hipSuccess || hipDeviceGetAttribute(&cus, hipDeviceAttributeMultiprocessorCount, dev) != hipSuccess) { grid = -1; return; }
        if (hipFuncSetAttribute((const void*)fwd_megakernel, hipFuncAttributeMaxDynamicSharedMemorySize, LDS_BYTES) != hipSuccess) { fprintf(stderr, "kernel_launch: hipFuncSetAttribute failed\n"); grid = -1; return; }
        if (hipOccupancyMaxActiveBlocksPerMultiprocessor(&per_cu, (const void*)fwd_megakernel, 512, LDS_BYTES) != hipSuccess || per_cu < 1) { fprintf(stderr, "kernel_launch: occupancy query says %d\n", per_cu); per_cu = 1; }
        (void)hipGetLastError();
        grid = cus * (per_cu > 1 ? 1 : per_cu);
        fprintf(stderr, "kernel_launch: grid %d (cus %d, per_cu %d)\n", grid, cus, per_cu);
    }
    if (grid < 0) return;
    if (hipMemsetAsync((char*)d_ws + WS_CTL, 0, CTL_ZERO_BYTES, stream) != hipSuccess) return;
    Args a{};
    const float* const* in = (const float* const*)d_in;
    a.x = in[0]; a.w_in = in[1]; a.w_out = in[2]; a.lq1 = in[3]; a.lk1 = in[4]; a.lq2 = in[5]; a.lk2 = in[6]; a.g_sub = in[7];
    a.ln1_g = in[8]; a.ln1_b = in[9]; a.w_router = in[10]; a.b_router = in[11]; a.w_up = in[12]; a.b_up = in[13]; a.w_down = in[14]; a.b_down = in[15];
    a.ln2_g = in[16]; a.ln2_b = in[17]; a.out = (float*)d_out; a.ws = (unsigned char*)d_ws;
    void* args[] = {&a};
    hipError_t e = hipLaunchCooperativeKernel((void*)fwd_megakernel, dim3(grid), dim3(512), args, LDS_BYTES, stream);
    if (e != hipSuccess) fprintf(stderr, "kernel_launch: cooperative launch failed: %s (grid %d)\n", hipGetErrorString(e), grid);
}
```

```cpp
#include <hip/hip_runtime.h>
#include <hip/hip_cooperative_groups.h>
#include <cstdio>
#include <cstdint>
namespace cg = cooperative_groups;
#ifndef KREP_P1
#define KREP_P1 1
#endif
#ifndef KREP_P3
#define KREP_P3 1
#endif
#ifndef KREP_P6
#define KREP_P6 1
#endif
#ifndef KREP_P7
#define KREP_P7 1
#endif
#ifndef ORD_SWZ
#define ORD_SWZ 0
#endif
#ifndef ORD_REV7
#define ORD_REV7 1
#endif
#ifndef REP_P0
#define REP_P0 1
#endif
#ifndef REP_P1
#define REP_P1 1
#endif
#ifndef REP_A
#define REP_A 1
#endif
#ifndef REP_B
#define REP_B 1
#endif
#ifndef REP_P3
#define REP_P3 1
#endif
#ifndef REP_P6
#define REP_P6 1
#endif
#ifndef REP_P7
#define REP_P7 1
#endif
#ifndef REP_P8
#define REP_P8 1
#endif

#define LAS __attribute__((address_space(3)))
typedef unsigned short bf16_t;
typedef short bf16x8 __attribute__((ext_vector_type(8)));
typedef short s16x4 __attribute__((ext_vector_type(4)));
typedef float f32x4 __attribute__((ext_vector_type(4)));
typedef float f32x2 __attribute__((ext_vector_type(2)));
typedef float f32x16 __attribute__((ext_vector_type(16)));
typedef unsigned u32x4 __attribute__((ext_vector_type(4)));
typedef unsigned u32x2 __attribute__((ext_vector_type(2)));
typedef __bf16 bf16x2_t __attribute__((ext_vector_type(2)));

constexpr int BATCH = 2, SEQ = 16384, DM = 1024, NTOK = BATCH * SEQ;
constexpr int NPROJ = 3072, NE = 32, TOPK = 4, DFF = 1024;
constexpr int NROWS_MAX = NTOK * TOPK + NE * 256;
constexpr float LN_EPS = 1e-5f;
constexpr float ALPHA = 1.189207115002721f;
constexpr float LOG2E = 1.4426950408889634f;
constexpr float C2 = 0.125f * LOG2E;
constexpr float LAM_INIT = 0.2f;
constexpr float NEG_BIG = -1e30f;

constexpr size_t MiB = 1u << 20;
constexpr size_t WS_CTL = 0, CTL_ZERO_BYTES = 65536;
constexpr int CW_QMAX = 64, CW_KMAX = 128, CW_KAMAX = 192, CW_QAMAX = 224, CW_QUEUE = 256, CW_BAR = 4096;
constexpr size_t WS_WIN = 2 * MiB, WS_WOUT = 8 * MiB, WS_WUP = 16 * MiB, WS_WDN = 144 * MiB;
constexpr size_t WS_XB = 208 * MiB;
constexpr size_t WS_PROJ = 272 * MiB;
constexpr size_t PROJ_STRIDE = (size_t)NTOK * 512;
constexpr size_t WS_MIXED = 464 * MiB;
constexpr size_t WS_Z = 272 * MiB;
constexpr size_t WS_H = 400 * MiB;
constexpr size_t WS_Y = 672 * MiB;
constexpr size_t WS_APART = 672 * MiB;
constexpr size_t APART_UNIT = 2 * 1024 * 64 * 4 + 2 * 1024 * 2 * 4;
constexpr size_t WS_ROUTE = 944 * MiB;
constexpr size_t WS_END = 952 * MiB;

constexpr int RING_BYTES = 131072;
constexpr int LX_TILE = 131072;
constexpr int LX_TOK = 132096;
constexpr int LX_MISC = 144384;
constexpr int LDS_BYTES = 147456;

__device__ __forceinline__ unsigned cvtpk(float lo, float hi) { f32x2 v = {lo, hi}; bf16x2_t b = __builtin_convertvector(v, bf16x2_t); return __builtin_bit_cast(unsigned, b); }
__device__ __forceinline__ unsigned cvt4_fp8(float a, float b, float c, float d) { int w = 0; w = __builtin_amdgcn_cvt_pk_fp8_f32(a, b, w, false); w = __builtin_amdgcn_cvt_pk_fp8_f32(c, d, w, true); return (unsigned)w; }
__device__ __forceinline__ float wave_sum(float v) {
#pragma unroll
    for (int o = 1; o < 64; o <<= 1) v += __shfl_xor(v, o);
    return v;
}

namespace pg8 {
constexpr int BM = 256, BK = 64, HALF = 128, HTB = HALF * BK * 2, STAGE_BYTES = 8 * HTB, NXCD = 8, WGM = 8;
__host__ __device__ __forceinline__ int lds_byte(int r, int c) { const int st = (r >> 4) * 2 + (c >> 5), rr = r & 15, cc = c & 31, ob = rr * 64 + cc * 2; return st * 1024 + (ob ^ (((ob >> 9) & 1) << 5)); }
__host__ __device__ __forceinline__ void stage_rc(int b, int& R, int& C) { const int st = b / 1024, sb = b % 1024, swz = sb ^ (((sb >> 9) & 1) << 5); R = (st >> 1) * 16 + swz / 64; C = (st & 1) * 32 + (swz % 64) / 2; }
__host__ __device__ __forceinline__ int perm32(int rho) { const int n = rho >> 4, i = rho & 15; return 8 * (i >> 2) + 4 * n + (i & 3); }

struct Unit { int pm, pn; };
struct Gemm { const bf16_t* A; const bf16_t* Bt; int M, N, K; int scale_a, scale_b; };
typedef int v4i_t __attribute__((ext_vector_type(4))); typedef int v8i_t __attribute__((ext_vector_type(8)));

struct StaticOrder {
    int nM, nN, nwg, G, c, rev, swz;
    __host__ __device__ void init(int M, int N, int G_, int c_, int rev_ = 0, int swz_ = ORD_SWZ) { nM = M / BM; nN = N / BM; nwg = nM * nN; G = G_; c = c_; rev = rev_; swz = swz_; }
    __host__ __device__ bool next(int i, Unit& u) const {
        const long L = (long)i * G + c; if (L >= nwg) return false;
        int wgid = (rev == 1) ? nwg - 1 - (int)L : (int)L;
        if (swz) { const int q = nwg / NXCD, r = nwg % NXCD, xcd = wgid % NXCD; int off = wgid / NXCD; const int len = xcd < r ? q + 1 : q;
            if (rev == 2) off = len - 1 - off;
            wgid = (xcd < r ? xcd * (q + 1) : r * (q + 1) + (xcd - r) * q) + off; }
        const int nig = WGM * nN, gid = wgid / nig, fm = gid * WGM, gsz = (nM - fm) < WGM ? (nM - fm) : WGM;
        u.pm = fm + ((wgid % nig) % gsz); u.pn = (wgid % nig) / gsz; return true;
    }
    __device__ __forceinline__ const LAS unsigned short* tok_table(int) const { return nullptr; }
};

template <class Epi, class Sched, bool ALIGN_EPI, bool GATHER, int KREP = 1, bool F8 = false>
__device__ __forceinline__ void gemm_phase(LAS unsigned char* lds, const Gemm g, const Sched& S, const Epi& E, const int tid) {
    const int wid = __builtin_amdgcn_readfirstlane(tid >> 6), lane = tid & 63, wr = wid >> 2, wc = wid & 3, fr = lane & 15, fq = lane >> 4;
    constexpr int ES = F8 ? 1 : 2;
    const int sclW = g.scale_b, sclX = g.scale_a;
    const int K = g.K, ntr = K * ES / (BK * 2), nt = ntr * KREP;
    unsigned voffA[2], voffB[2]; int rowA[2];
#pragma unroll
    for (int i = 0; i < 2; ++i) { int R, C; stage_rc(tid * 16 + i * 8192, R, C); const int Rb = Epi::PERM ? ((R & ~31) + perm32(R & 31)) : R;
        voffA[i] = GATHER ? (unsigned)(C * 2) : (unsigned)(R * K * ES + C * 2); voffB[i] = (unsigned)(Rb * K * ES + C * 2); rowA[i] = R; }
    const size_t kstep = (size_t)(BK * 2);
    const size_t hstep = (size_t)HALF * K * ES;
    const size_t tstep = 2 * hstep;
    const unsigned ldsw = (unsigned)wid * 1024u;
    const int aoff = lds_byte(wr * 64 + fr, fq * 8), boff = lds_byte(wc * 32 + fr, fq * 8);
    const int aoff8 = lds_byte(wr * 64 + fr, fq * 16), boff8 = lds_byte(wc * 32 + fr, fq * 16);
#define PG8_SA(b, h) (((b) * 2 + (h)) * HTB)
#define PG8_SB(b, h) ((4 + (b) * 2 + (h)) * HTB)
#define PG8_STAGE(bufoff, gbase, voff) do { _Pragma("unroll") for (int _i = 0; _i < 2; ++_i) \
        __builtin_amdgcn_global_load_lds((const unsigned*)((const char*)(gbase) + (voff)[_i]), (LAS unsigned*)(lds + (bufoff) + ldsw + _i * 8192), 16, 0, 0); } while (0)
#define PG8_STAGE_A(bufoff, NX, h, kb) do { if constexpr (GATHER) { const unsigned* _o = (NX) ? gN[h] : gC[h]; PG8_STAGE(bufoff, (const char*)g.A + (kb), _o); } \
        else { PG8_STAGE(bufoff, ((NX) ? nA : cA) + (h) * hstep + (kb), voffA); } } while (0)
#define PG8_LDA(dst, b, h) do { _Pragma("unroll") for (int m = 0; m < 4; ++m) _Pragma("unroll") for (int k = 0; k < 2; ++k) dst[m][k] = *(const LAS bf16x8*)(lds + PG8_SA(b, h) + (F8 ? aoff8 + k * 16 : aoff + k * 1024) + m * 2048); } while (0)
#define PG8_LDB(dst, b, h) do { _Pragma("unroll") for (int n = 0; n < 2; ++n) _Pragma("unroll") for (int k = 0; k < 2; ++k) dst[n][k] = *(const LAS bf16x8*)(lds + PG8_SB(b, h) + (F8 ? boff8 + k * 16 : boff + k * 1024) + n * 2048); } while (0)
#define PG8_F8OP(x) __builtin_shufflevector(__builtin_bit_cast(v4i_t, x[0]), __builtin_bit_cast(v4i_t, x[1]), 0, 1, 2, 3, 4, 5, 6, 7)
#define PG8_MMA(ai, bj, At, Bt) do { __builtin_amdgcn_s_setprio(1); _Pragma("unroll") for (int m = 0; m < 4; ++m) _Pragma("unroll") for (int n = 0; n < 2; ++n) { \
        if constexpr (F8) { const v8i_t _a = PG8_F8OP(Bt[n]), _b = PG8_F8OP(At[m]); asm volatile("v_mfma_scale_f32_16x16x128_f8f6f4 %0, %1, %2, %0, %3, %4 op_sel_hi:[0,0,0]" : "+v"(acc[ai][bj][m][n]) : "v"(_a), "v"(_b), "v"(sclW), "v"(sclX)); } \
        else { _Pragma("unroll") for (int k = 0; k < 2; ++k) acc[ai][bj][m][n] = __builtin_amdgcn_mfma_f32_16x16x32_bf16(Bt[n][k], At[m][k], acc[ai][bj][m][n], 0, 0, 0); } } \
        __builtin_amdgcn_s_setprio(0); } while (0)
#define PG8_WAIT_V(n) asm volatile("s_waitcnt vmcnt(" #n ")" ::: "memory")
#define PG8_WAIT_L(n) asm volatile("s_waitcnt lgkmcnt(" #n ")" ::: "memory")
#define PG8_BAR __builtin_amdgcn_s_barrier()
#define PG8_SCHED __builtin_amdgcn_sched_barrier(0)
#define PG8_GOFF(dst, ui_) do { if constexpr (GATHER) { const LAS unsigned short* _t = S.tok_table(ui_); _Pragma("unroll") for (int _h = 0; _h < 2; ++_h) _Pragma("unroll") for (int _i = 0; _i < 2; ++_i) \
        dst[_h][_i] = (unsigned)_t[_h * HALF + rowA[_i]] * (unsigned)(K * ES) + voffA[_i]; } } while (0)
    Unit cur, nxt; int ui = 0;
    if (!S.next(0, cur)) return;
    f32x4 acc[2][2][4][2];
    E.init(acc, cur, wc, fq);
    bf16x8 At[4][2], B0[2][2], B1[2][2];
    unsigned gC[2][2] = {{0u, 0u}, {0u, 0u}}, gN[2][2] = {{0u, 0u}, {0u, 0u}};
    PG8_GOFF(gC, 0);
    const char* cA = (const char*)g.A + (GATHER ? (size_t)0 : (size_t)cur.pm * tstep); const char* cB = (const char*)g.Bt + (size_t)cur.pn * tstep;
    const char* nA = cA;
    {
        PG8_STAGE(PG8_SB(0, 0), cB, voffB); PG8_STAGE(PG8_SB(0, 1), cB + hstep, voffB); PG8_STAGE_A(PG8_SA(0, 0), false, 0, 0); PG8_STAGE_A(PG8_SA(0, 1), false, 1, 0);
        if (wr == 1) PG8_BAR;
        PG8_WAIT_V(2); PG8_BAR;
        PG8_STAGE(PG8_SB(1, 0), cB + kstep, voffB); PG8_STAGE_A(PG8_SA(1, 0), false, 0, kstep); PG8_STAGE(PG8_SB(1, 1), cB + hstep + kstep, voffB);
        PG8_WAIT_V(6); PG8_BAR;
    }
    for (;;) {
        const bool has_next = S.next(ui + 1, nxt);
        nA = has_next ? (const char*)g.A + (GATHER ? (size_t)0 : (size_t)nxt.pm * tstep) : cA; const char* nB = has_next ? (const char*)g.Bt + (size_t)nxt.pn * tstep : cB;
        if (has_next) { PG8_GOFF(gN, ui + 1); } else {
#pragma unroll
            for (int h = 0; h < 2; ++h)
#pragma unroll
                for (int i = 0; i < 2; ++i) gN[h][i] = gC[h][i]; }
#pragma unroll 1
        for (int t = 0; t < nt; t += 2) {
            const bool last = (t == nt - 2);
            const size_t k1 = (size_t)((t + 1) % ntr) * kstep;
            const size_t k2 = last ? (size_t)0 : (size_t)((t + 2) % ntr) * kstep, k3 = k2 + kstep;
            const char* b2 = last ? nB : cB + (size_t)((t + 2) % ntr) * kstep; const char* b3 = b2 + kstep;
            PG8_LDB(B0, 0, 0); PG8_LDB(B1, 0, 1); PG8_SCHED; PG8_LDA(At, 0, 0); PG8_STAGE_A(PG8_SA(1, 1), false, 1, k1);
            PG8_WAIT_V(8); PG8_WAIT_L(0); PG8_BAR; PG8_MMA(0, 0, At, B0); PG8_MMA(0, 1, At, B1); PG8_BAR; PG8_SCHED;
            PG8_LDA(At, 0, 1); PG8_STAGE(PG8_SB(0, 0), b2, voffB); PG8_STAGE(PG8_SB(0, 1), b2 + hstep, voffB); PG8_STAGE_A(PG8_SA(0, 0), last, 0, k2);
            PG8_WAIT_V(8); PG8_WAIT_L(0); PG8_BAR; PG8_MMA(1, 0, At, B0); PG8_MMA(1, 1, At, B1); PG8_BAR; PG8_SCHED;
            PG8_LDB(B0, 1, 0); PG8_LDB(B1, 1, 1); PG8_SCHED; PG8_LDA(At, 1, 0); PG8_STAGE_A(PG8_SA(0, 1), last, 1, k2);
            PG8_WAIT_V(8); PG8_WAIT_L(0); PG8_BAR; PG8_MMA(0, 0, At, B0); PG8_MMA(0, 1, At, B1); PG8_BAR; PG8_SCHED;
            PG8_LDA(At, 1, 1); PG8_STAGE(PG8_SB(1, 0), b3, voffB); PG8_STAGE(PG8_SB(1, 1), b3 + hstep, voffB); PG8_STAGE_A(PG8_SA(1, 0), last, 0, k3);
            PG8_WAIT_V(8); PG8_WAIT_L(0); PG8_BAR; PG8_MMA(1, 0, At, B0); PG8_MMA(1, 1, At, B1); PG8_BAR; PG8_SCHED;
        }
        if constexpr (ALIGN_EPI) { if (wr == 0) PG8_BAR; }
        if constexpr (F8) asm volatile("s_nop 15\n\ts_nop 15" ::: "memory");
        if constexpr (KREP > 1) {
_Pragma("unroll") for (int a_ = 0; a_ < 2; ++a_) _Pragma("unroll") for (int b_ = 0; b_ < 2; ++b_) _Pragma("unroll") for (int m_ = 0; m_ < 4; ++m_) _Pragma("unroll") for (int n_ = 0; n_ < 2; ++n_) acc[a_][b_][m_][n_] = acc[a_][b_][m_][n_] * (1.0f / KREP); }
        E(acc, cur, wr, wc, fr, fq);
        if (!has_next) break;
        E.init(acc, nxt, wc, fq);
        cur = nxt; cA = nA; cB = nB; ++ui;
#pragma unroll
        for (int h = 0; h < 2; ++h)
#pragma unroll
            for (int i = 0; i < 2; ++i) gC[h][i] = gN[h][i];
        if constexpr (ALIGN_EPI) { if (wr == 1) PG8_BAR; }
    }
    PG8_WAIT_V(0);
    if constexpr (!ALIGN_EPI) { if (wr == 0) PG8_BAR; }
    PG8_BAR;
#undef PG8_SA
#undef PG8_SB
#undef PG8_STAGE
#undef PG8_STAGE_A
#undef PG8_LDA
#undef PG8_LDB
#undef PG8_MMA
#undef PG8_F8OP
#undef PG8_WAIT_V
#undef PG8_WAIT_L
#undef PG8_BAR
#undef PG8_SCHED
#undef PG8_GOFF
}
}

struct Args {
    const float* x; const float* w_in; const float* w_out; const float* lq1; const float* lk1; const float* lq2; const float* lk2; const float* g_sub;
    const float* ln1_g; const float* ln1_b; const float* w_router; const float* b_router; const float* w_up; const float* b_up; const float* w_down; const float* b_down;
    const float* ln2_g; const float* ln2_b; float* out; unsigned char* ws;
};
struct Frame {
    LAS unsigned char* lds; int wave, vcu, G;
};
__device__ __forceinline__ int lane_now() { int l; asm volatile("v_mbcnt_lo_u32_b32 %0, -1, 0\n\tv_mbcnt_hi_u32_b32 %0, -1, %0" : "=v"(l)); return l; }
#define F_LANE lane_now()
#define F_TID (F.wave * 64 + lane_now())

struct EpiProj {
    static constexpr bool PERM = true;
    bf16_t* O; unsigned* ctl;
    __device__ __forceinline__ void init(f32x4 (&acc)[2][2][4][2], const pg8::Unit&, int, int) const {
#pragma unroll
        for (int a_ = 0; a_ < 2; ++a_)
#pragma unroll
            for (int b_ = 0; b_ < 2; ++b_)
#pragma unroll
                for (int m_ = 0; m_ < 4; ++m_)
#pragma unroll
                    for (int n_ = 0; n_ < 2; ++n_) acc[a_][b_][m_][n_] = (f32x4){0.f, 0.f, 0.f, 0.f};
    }
    __device__ __forceinline__ void operator()(const f32x4 (&acc)[2][2][4][2], const pg8::Unit& u, int wr, int wc, int fr, int fq) const {
        const int t = u.pn >> 1; const float sc = (t == 0 || t == 3) ? C2 : 1.f; const bool nrm = (t == 3 || t == 4 || t == 0 || t == 1);
        bf16_t* base = O + (size_t)t * PROJ_STRIDE; const int row0 = u.pm * 256 + wr * 64 + fr, col0 = (u.pn & 1) * 256 + wc * 32 + 8 * fq;
        float mx0 = 0.f, mx1 = 0.f;
#pragma unroll
        for (int ai = 0; ai < 2; ++ai)
#pragma unroll
            for (int m = 0; m < 4; ++m) { bf16_t* rowp = base + (size_t)(row0 + ai * 128 + m * 16) * 512 + col0;
#pragma unroll
                for (int bj = 0; bj < 2; ++bj) { const f32x4 v0 = acc[ai][bj][m][0] * sc, v1 = acc[ai][bj][m][1] * sc; u32x4 w;
                    w.x = cvtpk(v0[0], v0[1]); w.y = cvtpk(v0[2], v0[3]); w.z = cvtpk(v1[0], v1[1]); w.w = cvtpk(v1[2], v1[3]);
                    if (t >= 4) {
                        const int row = row0 + ai * 128 + m * 16, bb = row >> 14, sq = row & (SEQ - 1), key = sq & 63, hh = (u.pn & 1) * 2 + bj;
                        bf16_t* tb = O + 4 * PROJ_STRIDE + ((size_t)((bb * 4 + hh) * 256 + (sq >> 6))) * 16384;
                        if (t == 4) *(u32x4*)(tb + (4 * wc + fq) * 512 + key * 8) = w;
                        else *(u32x4*)(tb + 8192 + (wc * 4 + (key >> 4)) * 512 + (key & 15) * 32 + fq * 8) = w;
                    } else *(u32x4*)(rowp + bj * 128) = w;
                    if (nrm) { float ss = 0.f;
#pragma unroll
                        for (int j = 0; j < 4; ++j) { const float lo = __uint_as_float(w[j] << 16), hi = __uint_as_float(w[j] & 0xFFFF0000u); ss += lo * lo + hi * hi; }
                        ss += __shfl_xor(ss, 16); ss += __shfl_xor(ss, 32);
                        if (bj == 0) mx0 = fmaxf(mx0, ss); else mx1 = fmaxf(mx1, ss); } } }
        if (nrm) {
#pragma unroll
            for (int ofs = 1; ofs < 16; ofs <<= 1) { mx0 = fmaxf(mx0, __shfl_xor(mx0, ofs)); mx1 = fmaxf(mx1, __shfl_xor(mx1, ofs)); }
            if (fr == 0 && fq == 0) { const int b = u.pm >> 6, cw = (t == 3) ? CW_QMAX : (t == 4 ? CW_KMAX : (t == 1 ? CW_KAMAX : CW_QAMAX));
                atomicMax(ctl + cw + (((b * 4 + (u.pn & 1) * 2 + 0) * 2 + (wc >> 1)) * 2 + (wc & 1)), __float_as_uint(mx0));
                atomicMax(ctl + cw + (((b * 4 + (u.pn & 1) * 2 + 1) * 2 + (wc >> 1)) * 2 + (wc & 1)), __float_as_uint(mx1)); }
        }
    }
};
struct EpiZ {
    static constexpr bool PERM = false;
    const float* x; float* z;
    __device__ __forceinline__ void init(f32x4 (&acc)[2][2][4][2], const pg8::Unit&, int, int) const {
#pragma unroll
        for (int a_ = 0; a_ < 2; ++a_)
#pragma unroll
            for (int b_ = 0; b_ < 2; ++b_)
#pragma unroll
                for (int m_ = 0; m_ < 4; ++m_)
#pragma unroll
                    for (int n_ = 0; n_ < 2; ++n_) acc[a_][b_][m_][n_] = (f32x4){0.f, 0.f, 0.f, 0.f};
    }
    __device__ __forceinline__ void operator()(const f32x4 (&acc)[2][2][4][2], const pg8::Unit& u, int wr, int wc, int fr, int fq) const {
        const int col0 = u.pn * 256 + wc * 32 + 4 * fq;
#pragma unroll
        for (int ai = 0; ai < 2; ++ai)
#pragma unroll
            for (int m = 0; m < 4; ++m) { const size_t off = (size_t)(u.pm * 256 + ai * 128 + wr * 64 + m * 16 + fr) * DM + col0;
#pragma unroll
                for (int bj = 0; bj < 2; ++bj)
#pragma unroll
                    for (int n = 0; n < 2; ++n) { const f32x4 xv = *(const f32x4*)(x + off + bj * 128 + n * 16); *(f32x4*)(z + off + bj * 128 + n * 16) = xv * ALPHA + acc[ai][bj][m][n]; } }
    }
};
__device__ __forceinline__ f32x2 swiglu4_pk(f32x2 g, f32x2 u) {
    g = __builtin_elementwise_min(g, (f32x2){7.0f, 7.0f});
    u = __builtin_elementwise_min(__builtin_elementwise_max(u, (f32x2){-7.0f, -7.0f}), (f32x2){7.0f, 7.0f});
    const f32x2 a_ = g * (-1.702f * LOG2E) + (-2.0f);
    f32x2 e_; e_.x = __builtin_amdgcn_exp2f(a_.x); e_.y = __builtin_amdgcn_exp2f(a_.y);
    const f32x2 d_ = e_ + 0.25f;
    f32x2 s_; s_.x = __builtin_amdgcn_rcpf(d_.x); s_.y = __builtin_amdgcn_rcpf(d_.y);
    const f32x2 t_ = g * s_;
    return t_ * u + t_;
}
struct EpiUp {
    static constexpr bool PERM = true;
    bf16_t* H; const float* b_up;
    __device__ __forceinline__ void init(f32x4 (&acc)[2][2][4][2], const pg8::Unit& u, int wc, int fq) const {
        const int e = u.pn >> 3, pnl = u.pn & 7, hcol0 = pnl * 128 + wc * 32 + 8 * fq;
        const float* bg = b_up + (size_t)e * 2048 + hcol0; const float* bu = bg + 1024;
        const f32x4 bg0 = *(const f32x4*)bg, bg1 = *(const f32x4*)(bg + 4), bu0 = *(const f32x4*)bu, bu1 = *(const f32x4*)(bu + 4);
#pragma unroll
        for (int a_ = 0; a_ < 2; ++a_)
#pragma unroll
            for (int m_ = 0; m_ < 4; ++m_) { acc[a_][0][m_][0] = bg0; acc[a_][0][m_][1] = bg1; acc[a_][1][m_][0] = bu0; acc[a_][1][m_][1] = bu1; }
    }
    __device__ __forceinline__ void operator()(const f32x4 (&acc)[2][2][4][2], const pg8::Unit& u, int wr, int wc, int fr, int fq) const {
        const int e = u.pn >> 3, pnl = u.pn & 7, hcol0 = pnl * 128 + wc * 32 + 8 * fq;
#pragma unroll
        for (int ai = 0; ai < 2; ++ai)
#pragma unroll
            for (int m = 0; m < 4; ++m) { const size_t row = (size_t)(u.pm * 256 + ai * 128 + wr * 64 + m * 16 + fr);
                const f32x4 g0 = acc[ai][0][m][0], g1 = acc[ai][0][m][1], u0 = acc[ai][1][m][0], u1 = acc[ai][1][m][1];
                const f32x2 r0 = swiglu4_pk((f32x2){g0[0], g0[1]}, (f32x2){u0[0], u0[1]}), r1 = swiglu4_pk((f32x2){g0[2], g0[3]}, (f32x2){u0[2], u0[3]});
                const f32x2 r2 = swiglu4_pk((f32x2){g1[0], g1[1]}, (f32x2){u1[0], u1[1]}), r3 = swiglu4_pk((f32x2){g1[2], g1[3]}, (f32x2){u1[2], u1[3]});
                u32x2 w8; w8.x = cvt4_fp8(r0.x, r0.y, r1.x, r1.y); w8.y = cvt4_fp8(r2.x, r2.y, r3.x, r3.y);
                *(u32x2*)((unsigned char*)H + row * DFF + hcol0) = w8; }
    }
};
struct EpiDown {
    static constexpr bool PERM = true;
    bf16_t* Y; const float* b_down; const float* row_gate;
    __device__ __forceinline__ void init(f32x4 (&acc)[2][2][4][2], const pg8::Unit& u, int wc, int fq) const {
        const int e = u.pn >> 2, pnl = u.pn & 3, col0 = pnl * 256 + wc * 32 + 8 * fq;
#pragma unroll
        for (int bj = 0; bj < 2; ++bj)
#pragma unroll
            for (int n = 0; n < 2; ++n) { const f32x4 bv = *(const f32x4*)(b_down + (size_t)e * DM + col0 + bj * 128 + 4 * n);
#pragma unroll
                for (int a_ = 0; a_ < 2; ++a_)
#pragma unroll
                    for (int m_ = 0; m_ < 4; ++m_) acc[a_][bj][m_][n] = bv; }
    }
    __device__ __forceinline__ void operator()(const f32x4 (&acc)[2][2][4][2], const pg8::Unit& u, int wr, int wc, int fr, int fq) const {
        const int e = u.pn >> 2, pnl = u.pn & 3, col0 = pnl * 256 + wc * 32 + 8 * fq;
#pragma unroll
        for (int ai = 0; ai < 2; ++ai)
#pragma unroll
            for (int m = 0; m < 4; ++m) { const size_t row = (size_t)(u.pm * 256 + ai * 128 + wr * 64 + m * 16 + fr); const float gt = row_gate[row];
#pragma unroll
                for (int bj = 0; bj < 2; ++bj) { const f32x4 v0 = acc[ai][bj][m][0] * (gt * 32.f), v1 = acc[ai][bj][m][1] * (gt * 32.f); u32x2 w;
                    w.x = cvt4_fp8(v0[0], v0[1], v0[2], v0[3]); w.y = cvt4_fp8(v1[0], v1[1], v1[2], v1[3]); *(u32x2*)((unsigned char*)Y + row * DM + col0 + bj * 128) = w; } }
    }
};
struct MoeOrder {
    pg8::StaticOrder so; const LAS unsigned char* tile_e; const LAS unsigned short* tok; int ncolt;
    __device__ __forceinline__ bool next(int i, pg8::Unit& u) const {
        if (!so.next(i, u)) return false;
        const int e = __builtin_amdgcn_readfirstlane((int)tile_e[u.pm]); u.pn = e * ncolt + u.pn; return true; }
    __device__ __forceinline__ const LAS unsigned short* tok_table(int ui) const { return tok + ui * 256; }
};

__device__ __forceinline__ void p0_transpose_item(const float* W, int K, int N, bf16_t* WT, int k0, int n0, int row0, LAS float* scr, int lane) {
#pragma unroll 8
    for (int i = 0; i < 32; ++i) { const int kk = 2 * i + (lane >> 5); scr[kk * 33 + (lane & 31)] = W[(size_t)(k0 + kk) * N + n0 + (lane & 31)]; }
    asm volatile("s_waitcnt lgkmcnt(0)" ::: "memory");
    const int c = lane & 7;
#pragma unroll
    for (int j = 0; j < 4; ++j) { const int n = (lane >> 3) + 8 * j; const LAS float* s = scr + (8 * c) * 33 + n;
        u32x4 o; o.x = cvtpk(s[0 * 33], s[1 * 33]); o.y = cvtpk(s[2 * 33], s[3 * 33]); o.z = cvtpk(s[4 * 33], s[5 * 33]); o.w = cvtpk(s[6 * 33], s[7 * 33]);
        *(u32x4*)(WT + (size_t)(row0 + n) * K + k0 + 8 * c) = o; }
    asm volatile("s_waitcnt lgkmcnt(0)" ::: "memory");
}
__device__ __forceinline__ void p0_transpose_item_f8(const float* W, int K, int N, unsigned char* WT, int k0, int n0, int row0, LAS float* scr, int lane) {
#pragma unroll 8
    for (int i = 0; i < 32; ++i) { const int kk = 2 * i + (lane >> 5); scr[kk * 33 + (lane & 31)] = W[(size_t)(k0 + kk) * N + n0 + (lane & 31)]; }
    asm volatile("s_waitcnt lgkmcnt(0)" ::: "memory");
    const int c = lane & 7;
#pragma unroll
    for (int j = 0; j < 4; ++j) { const int n = (lane >> 3) + 8 * j; const LAS float* s = scr + (8 * c) * 33 + n;
        u32x2 o; o.x = cvt4_fp8(256.f * s[0 * 33], 256.f * s[1 * 33], 256.f * s[2 * 33], 256.f * s[3 * 33]); o.y = cvt4_fp8(256.f * s[4 * 33], 256.f * s[5 * 33], 256.f * s[6 * 33], 256.f * s[7 * 33]);
        *(u32x2*)(WT + (size_t)(row0 + n) * K + k0 + 8 * c) = o; }
    asm volatile("s_waitcnt lgkmcnt(0)" ::: "memory");
}
__device__ __forceinline__ void p0_prologue(const Frame& F, const Args& a) {
    LAS float* scr = (LAS float*)(F.lds + F.wave * 16384);
    const int gw = F.vcu * 8 + F.wave, NGW = F.G * 8;
    bf16_t* WinT = (bf16_t*)(a.ws + WS_WIN); bf16_t* WoutT = (bf16_t*)(a.ws + WS_WOUT); bf16_t* WupT = (bf16_t*)(a.ws + WS_WUP); bf16_t* WdnT = (bf16_t*)(a.ws + WS_WDN);
    constexpr int I_IN = 16 * 96, I_OUT = 16 * 32, I_UP = 16 * 64, I_DN = 16 * 32;
    constexpr int NITEMS = I_IN + I_OUT + NE * I_UP + NE * I_DN;
    for (int it = gw; it < NITEMS; it += NGW) {
        int r = it;
        if (r < I_IN) { const int kb = r / 96, nb = r % 96; p0_transpose_item(a.w_in, DM, NPROJ, WinT, 64 * kb, 32 * nb, 32 * nb, scr, F_LANE); continue; } r -= I_IN;
        if (r < I_OUT) { const int kb = r / 32, nb = r % 32; p0_transpose_item(a.w_out, DM, DM, WoutT, 64 * kb, 32 * nb, 32 * nb, scr, F_LANE); continue; } r -= I_OUT;
        if (r < NE * I_UP) { const int e = r / I_UP, q = r % I_UP, kb = q / 64, nb = q % 64, n0 = 32 * nb;
            const int nn = n0 & 1023, row0 = (nn >> 7) * 256 + (n0 >> 10) * 128 + (nn & 127);
            p0_transpose_item_f8(a.w_up + (size_t)e * DM * 2048, DM, 2048, (unsigned char*)WupT + (size_t)e * 2048 * DM, 64 * kb, n0, row0, scr, F_LANE); continue; } r -= NE * I_UP;
        { const int e = r / I_DN, q = r % I_DN, kb = q / 32, nb = q % 32; p0_transpose_item_f8(a.w_down + (size_t)e * DFF * DM, DFF, DM, (unsigned char*)WdnT + (size_t)e * DM * DFF, 64 * kb, 32 * nb, 32 * nb, scr, F_LANE); }
    }
    bf16_t* XB = (bf16_t*)(a.ws + WS_XB);
    for (int m = gw; m < NTOK; m += NGW) {
        const f32x4* xr = (const f32x4*)(a.x + (size_t)m * DM) + F_LANE; unsigned long long* o8 = (unsigned long long*)(XB + (size_t)m * DM) + F_LANE;
#pragma unroll
        for (int j = 0; j < 4; ++j) { const f32x4 v = xr[64 * j]; o8[64 * j] = (unsigned long long)cvtpk(v[0], v[1]) | ((unsigned long long)cvtpk(v[2], v[3]) << 32); }
    }
}

__device__ __forceinline__ void glds16(const void* gsrc, unsigned lds_dst) { unsigned keep;
    asm volatile("s_mov_b32 %0, m0\n\ts_mov_b32 m0, %2\n\ts_nop 0\n\tglobal_load_lds_dwordx4 %1, off\n\ts_mov_b32 m0, %0" : "=&s"(keep) : "v"(gsrc), "s"(lds_dst) : "memory"); }
__device__ __forceinline__ int crow(int r, int hi) { return (r & 3) + 8 * (r >> 2) + 4 * hi; }
typedef LAS const char* lds_cptr;
typedef short v4i16_t __attribute__((ext_vector_type(4)));
__device__ __forceinline__ s16x4 vtr(lds_cptr p) { return __builtin_bit_cast(s16x4, __builtin_amdgcn_ds_read_tr16_b64_v4i16((LAS v4i16_t*)p)); }
#define MX3(a, b, c) __builtin_fmaxf(__builtin_fmaxf((a), (b)), (c))
__device__ __forceinline__ float rowmax(const f32x16& p0, const f32x16& p1) {
    float a = MX3(p0[0], p0[1], p1[0]), b = MX3(p0[2], p0[3], p1[1]); a = MX3(a, p1[2], p1[3]);
#pragma unroll
    for (int r = 4; r < 16; r += 4) { a = MX3(a, p0[r], p0[r + 1]); b = MX3(b, p0[r + 2], p0[r + 3]); a = MX3(a, p1[r], p1[r + 1]); b = MX3(b, p1[r + 2], p1[r + 3]); }
    float m = __builtin_fmaxf(a, b); auto rr = __builtin_amdgcn_permlane32_swap(__float_as_uint(m), __float_as_uint(m), false, false);
    return __builtin_fmaxf(__uint_as_float(rr[0]), __uint_as_float(rr[1]));
}
__device__ __forceinline__ float halfsum(float v) { auto rr = __builtin_amdgcn_permlane32_swap(__float_as_uint(v), __float_as_uint(v), false, false); return __uint_as_float(rr[0]) + __uint_as_float(rr[1]); }
#define MFMA32(a, b, c) __builtin_amdgcn_mfma_f32_32x32x16_bf16(a, b, c, 0, 0, 0)

template <int ND>
__device__ __forceinline__ void softmax_tile(f32x16& p0, f32x16& p1, float& mhat, float& lsum, f32x16 (&o)[ND], u32x4 (&pw)[4]) {
    const float rm = rowmax(p0, p1);
    const float mnew = __builtin_fmaxf(mhat, rm);
    if (__any(mnew != mhat)) {
        const float al = __builtin_amdgcn_exp2f(mhat - mnew); lsum *= al;
#pragma unroll
        for (int d = 0; d < ND; ++d)
#pragma unroll
            for (int r = 0; r < 16; ++r) o[d][r] *= al;
        mhat = mnew;
    }
    float s = 0.f;
#pragma unroll
    for (int r = 0; r < 16; ++r) { p0[r] = __builtin_amdgcn_exp2f(p0[r] - mhat); p1[r] = __builtin_amdgcn_exp2f(p1[r] - mhat); s += p0[r] + p1[r]; }
    lsum += s;
    pw[0] = (u32x4){cvtpk(p0[0], p0[1]), cvtpk(p0[2], p0[3]), cvtpk(p0[4], p0[5]), cvtpk(p0[6], p0[7])};
    pw[1] = (u32x4){cvtpk(p0[8], p0[9]), cvtpk(p0[10], p0[11]), cvtpk(p0[12], p0[13]), cvtpk(p0[14], p0[15])};
    pw[2] = (u32x4){cvtpk(p1[0], p1[1]), cvtpk(p1[2], p1[3]), cvtpk(p1[4], p1[5]), cvtpk(p1[6], p1[7])};
    pw[3] = (u32x4){cvtpk(p1[8], p1[9]), cvtpk(p1[10], p1[11]), cvtpk(p1[12], p1[13]), cvtpk(p1[14], p1[15])};
}
template <int ND>
__device__ __forceinline__ void pv_tile(f32x16 (&o)[ND], lds_cptr vbase, const u32x4 (&pw)[4]) {
#pragma unroll
    for (int d0 = 0; d0 < ND; ++d0)
#pragma unroll
        for (int ks = 0; ks < 4; ++ks) {
            const s16x4 lo = vtr(vbase + d0 * 4096 + ks * 1024), hi = vtr(vbase + d0 * 4096 + ks * 1024 + 512);
            const bf16x8 vf = (bf16x8){lo[0], lo[1], lo[2], lo[3], hi[0], hi[1], hi[2], hi[3]};
            o[d0] = MFMA32(vf, __builtin_bit_cast(bf16x8, pw[ks]), o[d0]);
        }
}

__device__ __forceinline__ unsigned bfb(float x) { return cvtpk(x, 0.f) & 0xFFFFu; }
__device__ __forceinline__ float bff(unsigned b) { return __uint_as_float(b << 16); }
__device__ __forceinline__ void bf_split3(float x, unsigned& h, unsigned& m, unsigned& l) { h = bfb(x); const float r1 = x - bff(h); m = bfb(r1); const float r2 = r1 - bff(m); l = bfb(r2); }
__device__ __forceinline__ void attnB_finish(const Frame& F, const Args& a, f32x16 (&o)[4], float lsum, float lam, size_t rowbase, int qpos, int h, int c, int qs, int r32, int hi) {
    LAS unsigned char* L = F.lds;
    const float inv = 1.0f / halfsum(lsum);
    LAS float* ex = (LAS float*)(L + 65536);
    __syncthreads();
    if (c == 1) {
#pragma unroll
        for (int d0 = 0; d0 < 4; ++d0)
#pragma unroll
            for (int r = 0; r < 16; ++r) ex[(qs * 128 + 32 * d0 + crow(r, hi)) * 32 + r32] = o[d0][r] * inv;
    }
    __syncthreads();
    if (c == 0) {
        float ss = 0.f;
#pragma unroll
        for (int d0 = 0; d0 < 4; ++d0)
#pragma unroll
            for (int r = 0; r < 16; ++r) { const float v = o[d0][r] * inv - lam * ex[(qs * 128 + 32 * d0 + crow(r, hi)) * 32 + r32]; o[d0][r] = v; ss += v * v; }
        ss = halfsum(ss);
        const float rs = __builtin_amdgcn_rsqf(ss * (1.0f / 128.0f) + LN_EPS) * (1.0f - LAM_INIT);
        bf16_t* op = (bf16_t*)(a.ws + WS_MIXED) + (rowbase + qpos) * DM + 512 + h * 128 + 4 * hi;
#pragma unroll
        for (int d0 = 0; d0 < 4; ++d0)
#pragma unroll
            for (int g = 0; g < 4; ++g) { const int dv = 32 * d0 + 8 * g + 4 * hi; const f32x4 gs = *(const f32x4*)(a.g_sub + dv);
                u32x2 w; w.x = cvtpk(o[d0][4 * g] * rs * gs[0], o[d0][4 * g + 1] * rs * gs[1]); w.y = cvtpk(o[d0][4 * g + 2] * rs * gs[2], o[d0][4 * g + 3] * rs * gs[3]);
                *(u32x2*)(op + 32 * d0 + 8 * g) = w; }
    }
    __syncthreads();
}

template <bool FAST>
__device__ __forceinline__ void attnB_unit(const Frame& F, const Args& a, int b, int h, int qblk, float lam, int t_lo, int t_hi, float kn0, float kn1) {
    const int lane = F_LANE, r32 = lane & 31, hi = lane >> 5, wid = F.wave, c = wid >> 2, qs = wid & 3;
    const bf16_t* QD = (const bf16_t*)(a.ws + WS_PROJ) + 3 * PROJ_STRIDE; const bf16_t* KD = QD + PROJ_STRIDE; const bf16_t* VD = KD + PROJ_STRIDE;
    const size_t rowbase = (size_t)b * SEQ; const int q0 = qblk * 128, qpos = q0 + 32 * qs + r32;
    bf16x8 qr[4];
    { const bf16_t* Qp = QD + (rowbase + qpos) * 512 + h * 128 + c * 64 + 8 * hi;
#pragma unroll
      for (int d0 = 0; d0 < 4; ++d0) qr[d0] = *(const bf16x8*)(Qp + 16 * d0); }
    float ref = 0.f;
    { float qq = 0.f;
#pragma unroll
        for (int d0 = 0; d0 < 4; ++d0)
#pragma unroll
            for (int j = 0; j < 8; ++j) { const float v = __uint_as_float((unsigned)(unsigned short)qr[d0][j] << 16); qq += v * v; }
        qq = halfsum(qq); asm volatile("" : "+v"(qq));
        if (FAST) ref = sqrtf(qq) * (c ? kn1 : kn0) * 1.01f + 0.01f; }
    const float slope2 = __builtin_amdgcn_exp2f(-2.0f * (float)(h + 1)) * LOG2E;
    const bf16_t* tsrc = KD + (size_t)((b * 4 + h) * 256) * 16384 + wid * 2048 + lane * 8;
    LAS unsigned char* L = F.lds;
    const unsigned dbase = (unsigned)(uintptr_t)L + (unsigned)wid * 4096u;
#define B_DMA(tt, slot) do { const bf16_t* _k = tsrc + (size_t)(tt) * 16384; const unsigned _d = (unsigned)__builtin_amdgcn_readfirstlane((int)(dbase + (unsigned)(slot) * 32768u)); unsigned _keep; \
        asm volatile("s_mov_b32 %0, m0\n\ts_mov_b32 m0, %2\n\ts_nop 0\n\tglobal_load_lds_dwordx4 %1, off\n\tglobal_load_lds_dwordx4 %1, off offset:1024\n\tglobal_load_lds_dwordx4 %1, off offset:2048\n\tglobal_load_lds_dwordx4 %1, off offset:3072\n\ts_mov_b32 m0, %0" \
                     : "=&s"(_keep) : "v"(_k), "s"(_d) : "memory"); } while (0)
#define WAIT_BAR(N) asm volatile("s_waitcnt vmcnt(" #N ") lgkmcnt(0)\n\ts_barrier" ::: "memory")
#define SBAR() __builtin_amdgcn_sched_barrier(0)
#define PIN(x) asm volatile("" : "+v"(x))
#define VFRAG(dst, base, d0, ks) do { const s16x4 lo_ = vtr((base) + (d0) * 4096 + (ks) * 1024), hi_ = vtr((base) + (d0) * 4096 + (ks) * 1024 + 512); \
        dst = (bf16x8){lo_[0], lo_[1], lo_[2], lo_[3], hi_[0], hi_[1], hi_[2], hi_[3]}; } while (0)
#define GEN_C(tt) do { const float dq = (float)(qpos - (tt) * 64 - 4 * hi); \
        _Pragma("unroll") for (int r = 0; r < 16; ++r) { const float kk = (float)((r & 3) + 8 * (r >> 2)); C0[r] = -slope2 * __builtin_fabsf(dq - kk) - ref; C1[r] = -slope2 * __builtin_fabsf(dq - 32.f - kk) - ref; } } while (0)
    float mhat = NEG_BIG, lsum = 0.f; f32x16 o[4];
#pragma unroll
    for (int d = 0; d < 4; ++d) o[d] = (f32x16){};
    const int koff = (c * 8 + hi) * 1024 + r32 * 16;
    const int voff = 16384 + ((lane >> 4) & 1) * 32 + (lane & 3) * 8 + (4 * hi + ((lane & 15) >> 2)) * 64;
    const int tdiag = q0 >> 6;
    f32x16 C0, C1;
    u32x4 pw[4];
    const int NT = t_hi - t_lo + 1;
    GEN_C(t_lo);
    B_DMA(t_lo, 0); if (NT > 1) B_DMA(t_lo + 1, 1); if (NT > 2) B_DMA(t_lo + 2, 2);
    int sl = 0;
    for (int tau = 0; tau < NT; ++tau) {
        if (tau + 2 < NT) WAIT_BAR(8); else if (tau + 1 < NT) WAIT_BAR(4); else WAIT_BAR(0);
        if (tau + 3 < NT) B_DMA(t_lo + tau + 3, (sl + 3) & 3);
        const int t = t_lo + tau; const LAS unsigned char* buf = L + sl * 32768; const lds_cptr vbase = (lds_cptr)(buf + voff);
        bf16x8 kf[8];
#pragma unroll
        for (int d0 = 0; d0 < 4; ++d0) { kf[2 * d0] = *(const LAS bf16x8*)(buf + koff + d0 * 2048); kf[2 * d0 + 1] = *(const LAS bf16x8*)(buf + koff + d0 * 2048 + 512); }
        SBAR();
        f32x16 p0, p1;
        if constexpr (FAST) {
            bf16x8 vA[4], vB[4]; float sacc = 0.f;
#define EXPS(P, A, B) do { _Pragma("unroll") for (int r = (A); r < (B); ++r) { P[r] = __builtin_amdgcn_exp2f(P[r]); sacc += P[r]; } PIN(P); PIN(sacc); } while (0)
#define PK4(P, B) (u32x4){cvtpk(P[B], P[B + 1]), cvtpk(P[B + 2], P[B + 3]), cvtpk(P[B + 4], P[B + 5]), cvtpk(P[B + 6], P[B + 7])}
#define PWF(k) __builtin_bit_cast(bf16x8, pw[k])
            const float st = (t + 1 < tdiag) ? 64.f * slope2 : -64.f * slope2;
            p0 = MFMA32(kf[0], qr[0], C0); SBAR(); VFRAG(vA[0], vbase, 0, 0); SBAR();
            p0 = MFMA32(kf[2], qr[1], p0); SBAR(); VFRAG(vA[1], vbase, 1, 0); SBAR();
            p0 = MFMA32(kf[4], qr[2], p0); SBAR(); VFRAG(vA[2], vbase, 2, 0); SBAR();
            p0 = MFMA32(kf[6], qr[3], p0); SBAR(); VFRAG(vA[3], vbase, 3, 0); SBAR();
            p1 = MFMA32(kf[1], qr[0], C1); SBAR();
            p1 = MFMA32(kf[3], qr[1], p1); SBAR(); EXPS(p0, 0, 5); SBAR();
            p1 = MFMA32(kf[5], qr[2], p1); SBAR(); EXPS(p0, 5, 11); SBAR();
            p1 = MFMA32(kf[7], qr[3], p1); SBAR(); EXPS(p0, 11, 16); pw[0] = PK4(p0, 0); PIN(pw[0]); SBAR();
            o[0] = MFMA32(vA[0], PWF(0), o[0]); SBAR(); pw[1] = PK4(p0, 8); PIN(pw[1]); VFRAG(vB[0], vbase, 0, 1); SBAR();
            o[1] = MFMA32(vA[1], PWF(0), o[1]); SBAR(); EXPS(p1, 0, 3); VFRAG(vB[1], vbase, 1, 1); SBAR();
            o[2] = MFMA32(vA[2], PWF(0), o[2]); SBAR(); EXPS(p1, 3, 6); VFRAG(vB[2], vbase, 2, 1); SBAR();
            o[3] = MFMA32(vA[3], PWF(0), o[3]); SBAR(); EXPS(p1, 6, 8); VFRAG(vB[3], vbase, 3, 1); SBAR();
            o[0] = MFMA32(vB[0], PWF(1), o[0]); SBAR(); EXPS(p1, 8, 10); VFRAG(vA[0], vbase, 0, 2); SBAR();
            o[1] = MFMA32(vB[1], PWF(1), o[1]); SBAR(); EXPS(p1, 10, 12); VFRAG(vA[1], vbase, 1, 2); SBAR();
            o[2] = MFMA32(vB[2], PWF(1), o[2]); SBAR(); EXPS(p1, 12, 14); VFRAG(vA[2], vbase, 2, 2); SBAR();
            o[3] = MFMA32(vB[3], PWF(1), o[3]); SBAR(); EXPS(p1, 14, 16); VFRAG(vA[3], vbase, 3, 2); pw[2] = PK4(p1, 0); PIN(pw[2]); SBAR();
            o[0] = MFMA32(vA[0], PWF(2), o[0]); SBAR(); pw[3] = PK4(p1, 8); PIN(pw[3]); VFRAG(vB[0], vbase, 0, 3); SBAR();
            o[1] = MFMA32(vA[1], PWF(2), o[1]); SBAR(); VFRAG(vB[1], vbase, 1, 3);
#pragma unroll
            for (int r = 0; r < 8; ++r) C0[r] += st;
            PIN(C0); SBAR();
            o[2] = MFMA32(vA[2], PWF(2), o[2]); SBAR(); VFRAG(vB[2], vbase, 2, 3);
#pragma unroll
            for (int r = 8; r < 16; ++r) C0[r] += st;
            PIN(C0); SBAR();
            o[3] = MFMA32(vA[3], PWF(2), o[3]); SBAR(); VFRAG(vB[3], vbase, 3, 3);
#pragma unroll
            for (int r = 0; r < 8; ++r) C1[r] += st;
            PIN(C1); SBAR();
            o[0] = MFMA32(vB[0], PWF(3), o[0]); SBAR();
#pragma unroll
            for (int r = 8; r < 16; ++r) C1[r] += st;
            PIN(C1); SBAR();
            o[1] = MFMA32(vB[1], PWF(3), o[1]);
            o[2] = MFMA32(vB[2], PWF(3), o[2]);
            o[3] = MFMA32(vB[3], PWF(3), o[3]);
            lsum += sacc;
#undef EXPS
#undef PK4
#undef PWF
        } else {
            p0 = MFMA32(kf[0], qr[0], C0); p1 = MFMA32(kf[1], qr[0], C1);
#pragma unroll
            for (int d0 = 1; d0 < 4; ++d0) { p0 = MFMA32(kf[2 * d0], qr[d0], p0); p1 = MFMA32(kf[2 * d0 + 1], qr[d0], p1); }
            softmax_tile<4>(p0, p1, mhat, lsum, o, pw);
            pv_tile<4>(o, vbase, pw);
            const float st = (t + 1 < tdiag) ? 64.f * slope2 : -64.f * slope2; C0 = C0 + st; C1 = C1 + st;
        }
        if ((t + 1 >= tdiag && t + 1 <= tdiag + 2) || ((tau + 1) & 15) == 0) GEN_C(t + 1);
        sl = (sl + 1) & 3;
    }
#undef B_DMA
#undef WAIT_BAR
#undef VFRAG
#undef GEN_C
#undef SBAR
#undef PIN
    attnB_finish(F, a, o, lsum, lam, rowbase, qpos, h, c, qs, r32, hi);
}
__device__ __forceinline__ void attnB_fast(const Frame& F, const Args& a, int b, int h, int qblk, float lam, int t_lo, int t_hi, float kn0, float kn1) {
    const int lane = F_LANE, r32 = lane & 31, hi = lane >> 5, wid = F.wave, c = wid >> 2, qs = wid & 3;
    const bf16_t* QD = (const bf16_t*)(a.ws + WS_PROJ) + 3 * PROJ_STRIDE; const bf16_t* KD = QD + PROJ_STRIDE;
    const size_t rowbase = (size_t)b * SEQ; const int q0 = qblk * 128, qpos = q0 + 32 * qs + r32;
    bf16x8 qr[4], ks[4];
    { const bf16_t* Qp = QD + (rowbase + qpos) * 512 + h * 128 + c * 64 + 8 * hi;
      const bf16_t* Kp = KD + ((size_t)((b * 4 + h) * 256 + (qpos >> 6))) * 16384 + ((c * 8 + hi) * 64 + (qpos & 63)) * 8;
#pragma unroll
      for (int d0 = 0; d0 < 4; ++d0) { qr[d0] = *(const bf16x8*)(Qp + 16 * d0); ks[d0] = *(const bf16x8*)(Kp + d0 * 1024); } }
    const float slope2 = __builtin_amdgcn_exp2f(-2.0f * (float)(h + 1)) * LOG2E;
    float ref;
    { float qq = 0.f, sii = 0.f;
#pragma unroll
        for (int d0 = 0; d0 < 4; ++d0)
#pragma unroll
            for (int j = 0; j < 8; ++j) { const float v = __uint_as_float((unsigned)(unsigned short)qr[d0][j] << 16), kv = __uint_as_float((unsigned)(unsigned short)ks[d0][j] << 16); qq += v * v; sii += v * kv; }
        qq = halfsum(qq); sii = halfsum(sii); asm volatile("" : "+v"(qq));
        ref = sqrtf(qq) * (c ? kn1 : kn0) * 1.01f + 0.01f;
        float dd = (ref - sii + 72.02f) / slope2;
#pragma unroll
        for (int ofs = 1; ofs < 64; ofs <<= 1) dd = fmaxf(dd, __shfl_xor(dd, ofs));
        LAS float* red = (LAS float*)(F.lds + LX_MISC) + 104;
        if (lane == 0) red[wid] = dd;
        __syncthreads();
        float dm = red[0];
#pragma unroll
        for (int w_ = 1; w_ < 8; ++w_) dm = fmaxf(dm, red[w_]);
        const int Dd = dm < 40000.f ? (int)dm + 2 : 40000;
        int tl = (q0 - Dd) >> 6; if (q0 - Dd < 0) tl = 0;
        int th = (q0 + 127 + Dd) >> 6; if (th > SEQ / 64 - 1) th = SEQ / 64 - 1;
        t_lo = __builtin_amdgcn_readfirstlane(tl > t_lo ? tl : t_lo); t_hi = __builtin_amdgcn_readfirstlane(th < t_hi ? th : t_hi); }
    const bf16_t* tsrc = KD + (size_t)((b * 4 + h) * 256) * 16384 + wid * 2048 + lane * 8;
    LAS unsigned char* L = F.lds;
    const unsigned dbase = (unsigned)(uintptr_t)L + (unsigned)wid * 4096u;
#define B_DMA(tt, slot) do { const bf16_t* _k = tsrc + (size_t)(tt) * 16384; const unsigned _d = (unsigned)__builtin_amdgcn_readfirstlane((int)(dbase + (unsigned)(slot) * 32768u)); unsigned _keep; \
        asm volatile("s_mov_b32 %0, m0\n\ts_mov_b32 m0, %2\n\ts_nop 0\n\tglobal_load_lds_dwordx4 %1, off\n\tglobal_load_lds_dwordx4 %1, off offset:1024\n\tglobal_load_lds_dwordx4 %1, off offset:2048\n\tglobal_load_lds_dwordx4 %1, off offset:3072\n\ts_mov_b32 m0, %0" \
                     : "=&s"(_keep) : "v"(_k), "s"(_d) : "memory"); } while (0)
#define WAIT_BAR(N) asm volatile("s_waitcnt vmcnt(" #N ") lgkmcnt(0)\n\ts_barrier" : "+v"(p1), "+v"(sacc) :: "memory")
#define VFRAG(dst, base, d0, ks) do { const s16x4 lo_ = vtr((base) + (d0) * 4096 + (ks) * 1024), hi_ = vtr((base) + (d0) * 4096 + (ks) * 1024 + 512); \
        dst = (bf16x8){lo_[0], lo_[1], lo_[2], lo_[3], hi_[0], hi_[1], hi_[2], hi_[3]}; } while (0)
#define MF_ "v_mfma_f32_32x32x16_bf16 "
#define AMF(D, A, B)              asm volatile(MF_ "%0, %1, %2, %0" : "+v"(D) : "v"(A), "v"(B) : "memory")
#define AMF1(D, A, B, X)          asm volatile(MF_ "%0, %2, %3, %0" : "+v"(D), "+v"(X) : "v"(A), "v"(B) : "memory")
#define AMF2(D, A, B, X, Y)       asm volatile(MF_ "%0, %3, %4, %0" : "+v"(D), "+v"(X), "+v"(Y) : "v"(A), "v"(B) : "memory")
#define AMF3(D, A, B, X, Y, Z)    asm volatile(MF_ "%0, %4, %5, %0" : "+v"(D), "+v"(X), "+v"(Y), "+v"(Z) : "v"(A), "v"(B) : "memory")
#define AMF0(D, A, B)             asm volatile(MF_ "%0, %1, %2, 0" : "=&v"(D) : "v"(A), "v"(B) : "memory")
#define PK4(P, B) (u32x4){cvtpk(P[B], P[B + 1]), cvtpk(P[B + 2], P[B + 3]), cvtpk(P[B + 4], P[B + 5]), cvtpk(P[B + 6], P[B + 7])}
#define XE(P, r) { P[r] = __builtin_amdgcn_exp2f(P[r]); sacc += P[r]; }
#define XE2(P, r) do { XE(P, r) XE(P, (r) + 1) } while (0)
#define KLD(bk, i) kf[i] = *(const LAS bf16x8*)((bk) + koff + ((i) >> 1) * 2048 + ((i) & 1) * 512)
#define SET_KA(tn) do { const unsigned w_ = __builtin_amdgcn_perm(0u, __float_as_uint(tf), 0x03020302u); ka0[1] = w_; ka1[1] = w_; tf += tinc; if ((tn) == tdiag + 2) qa = qaR; } while (0)
#define BIAS_HALF(P, KA, e, tn) do { \
        if ((unsigned)((tn) - tdiag) < 2u) { const int kb_ = 2 * (tn) + (e); \
            if (kb_ == qb) { float dq_ = (float)(qpos - (tn) * 64 - 32 * (e) - 4 * hi), ns_ = -slope2, nr_ = -ref; asm volatile("" : "+v"(dq_), "+v"(ns_), "+v"(nr_)); \
                             _Pragma("unroll") for (int r = 0; r < 16; ++r) { const float kk_ = (float)((r & 3) + 8 * (r >> 2)); P[r] = __builtin_fmaf(ns_, __builtin_fabsf(dq_ - kk_), nr_); } \
                             asm volatile("s_nop 4" : "+v"(P) :: "memory"); } \
            else if (kb_ < qb) { AMF0(P, KA, qaL); } else { AMF0(P, KA, qaR); } } \
        else { AMF0(P, KA, qa); } } while (0)
    const int tdiag = q0 >> 6, qb = 4 * qblk + qs;
    const unsigned msk = hi ? 0u : 0xFFFFFFFFu;
    bf16x8 qaL, qaR, qa; u32x4 ka0, ka1;
    { const float S64 = 64.f * slope2;
        const unsigned sh = bfb(slope2), slo = bfb(slope2 - bff(sh)), Sh = bfb(S64), Slo = bfb(S64 - bff(Sh));
        unsigned ch, cm, cl, dh, dm, dl;
        bf_split3(slope2 * (float)(qpos - 64 * tdiag) - ref, ch, cm, cl);
        bf_split3(-slope2 * (float)(qpos - 64 * tdiag) - ref, dh, dm, dl);
        const u32x4 r_ = (u32x4){(((slo ^ 0x8000u) << 16) | (sh ^ 0x8000u)) & msk, (((Slo ^ 0x8000u) << 16) | (Sh ^ 0x8000u)) & msk, ((cm << 16) | ch) & msk, cl & msk};
        const u32x4 l_ = (u32x4){((slo << 16) | sh) & msk, ((Slo << 16) | Sh) & msk, ((dm << 16) | dh) & msk, dl & msk};
        qaR = __builtin_bit_cast(bf16x8, r_); qaL = __builtin_bit_cast(bf16x8, l_); qa = (t_lo < tdiag + 2) ? qaL : qaR;
        const unsigned j0 = bfb((float)r32), j1 = bfb((float)(32 + r32));
        ka0 = (u32x4){((j0 << 16) | j0) & msk, 0u, 0x3F803F80u & msk, 0x00003F80u & msk}; ka1 = ka0; ka1[0] = ((j1 << 16) | j1) & msk; }
    float tf = hi ? 0.f : (float)(t_lo - tdiag); const float tinc = hi ? 0.f : 1.f;
    f32x16 o[4], p0, p1; u32x4 pw[4]; bf16x8 kf[8], vA[4], vB[4]; float sacc = 0.f;
#pragma unroll
    for (int d = 0; d < 4; ++d) o[d] = (f32x16){};
    p1 = (f32x16){};
    const int koff = (c * 8 + hi) * 1024 + r32 * 16;
    const int voff = 16384 + ((lane >> 4) & 1) * 32 + (lane & 3) * 8 + (4 * hi + ((lane & 15) >> 2)) * 64;
    const int NT = t_hi - t_lo + 1;
    B_DMA(t_lo, 0); if (NT > 1) B_DMA(t_lo + 1, 1); if (NT > 2) B_DMA(t_lo + 2, 2);
    if (NT > 2) WAIT_BAR(8); else if (NT > 1) WAIT_BAR(4); else WAIT_BAR(0);
    {
        const LAS unsigned char* bk = L;
#pragma unroll
        for (int i = 0; i < 8; ++i) KLD(bk, i);
        SET_KA(t_lo);
        asm volatile("s_nop 1" : "+v"(ka0), "+v"(ka1), "+v"(qa) :: "memory");
        BIAS_HALF(p0, ka0, 0, t_lo);
        AMF(p0, kf[0], qr[0]); AMF(p0, kf[2], qr[1]); AMF(p0, kf[4], qr[2]); AMF(p0, kf[6], qr[3]);
        BIAS_HALF(p1, ka1, 1, t_lo);
        AMF(p1, kf[1], qr[0]); AMF(p1, kf[3], qr[1]); AMF(p1, kf[5], qr[2]); AMF(p1, kf[7], qr[3]);
        const lds_cptr vb0 = (lds_cptr)(bk + voff);
        VFRAG(vA[0], vb0, 0, 0); VFRAG(vA[1], vb0, 1, 0); VFRAG(vA[2], vb0, 2, 0); VFRAG(vA[3], vb0, 3, 0);
        asm volatile("s_nop 15\n\ts_nop 15" : "+v"(p0), "+v"(p1) :: "memory");
#pragma unroll
        for (int r = 0; r < 16; r += 2) XE2(p0, r);
#pragma unroll
        for (int r = 0; r < 16; r += 2) XE2(p1, r);
        pw[0] = PK4(p0, 0); pw[1] = PK4(p0, 8); pw[2] = PK4(p1, 0);
    }
    int sl = 0;
    for (int tau = 0; tau + 1 < NT; ++tau) {
        if (tau + 2 < NT) WAIT_BAR(4); else WAIT_BAR(0);
        if (tau + 3 < NT) B_DMA(t_lo + tau + 3, (sl + 3) & 3);
        const LAS unsigned char* buf = L + sl * 32768; const LAS unsigned char* bufn = L + ((sl + 1) & 3) * 32768;
        const lds_cptr vb = (lds_cptr)(buf + voff), vbn = (lds_cptr)(bufn + voff);
        const int tn = t_lo + tau + 1;
        SET_KA(tn);
        AMF(o[0], vA[0], pw[0]);            KLD(bufn, 0); KLD(bufn, 2);
        AMF1(o[1], vA[1], pw[0], p1);       KLD(bufn, 4); KLD(bufn, 6); pw[3] = PK4(p1, 8);
        AMF1(o[2], vA[2], pw[0], pw[3]);    KLD(bufn, 1); KLD(bufn, 3);
        AMF(o[3], vA[3], pw[0]);            KLD(bufn, 5); KLD(bufn, 7);
        BIAS_HALF(p0, ka0, 0, tn);          VFRAG(vB[0], vb, 0, 1);
        AMF(p0, kf[0], qr[0]);              VFRAG(vB[1], vb, 1, 1);
        AMF(p0, kf[2], qr[1]);              VFRAG(vB[2], vb, 2, 1);
        AMF(p0, kf[4], qr[2]);              VFRAG(vB[3], vb, 3, 1);
        AMF(p0, kf[6], qr[3]);
        BIAS_HALF(p1, ka1, 1, tn);
        AMF1(p1, kf[1], qr[0], p0);         XE2(p0, 0);
        AMF2(p1, kf[3], qr[1], p0, sacc);   XE2(p0, 2);
        AMF2(p1, kf[5], qr[2], p0, sacc);   XE2(p0, 4);
        AMF2(p1, kf[7], qr[3], p0, sacc);   XE2(p0, 6);
        AMF2(o[0], vB[0], pw[1], p0, sacc); XE2(p0, 8);  VFRAG(vA[0], vb, 0, 2);
        AMF2(o[1], vB[1], pw[1], p0, sacc); XE2(p0, 10); VFRAG(vA[1], vb, 1, 2);
        AMF2(o[2], vB[2], pw[1], p0, sacc); XE2(p0, 12); VFRAG(vA[2], vb, 2, 2);
        AMF2(o[3], vB[3], pw[1], p0, sacc); XE2(p0, 14); VFRAG(vA[3], vb, 3, 2);
        AMF3(o[0], vA[0], pw[2], p0, sacc, p1);     pw[0] = PK4(p0, 0); XE2(p1, 0); VFRAG(vB[0], vb, 0, 3);
        AMF3(o[1], vA[1], pw[2], p1, sacc, pw[0]);  XE2(p1, 2); VFRAG(vB[1], vb, 1, 3);
        AMF3(o[2], vA[2], pw[2], p1, sacc, p0);     pw[1] = PK4(p0, 8); XE2(p1, 4); VFRAG(vB[2], vb, 2, 3);
        AMF3(o[3], vA[3], pw[2], p1, sacc, pw[1]);  XE2(p1, 6); VFRAG(vB[3], vb, 3, 3);
        AMF2(o[0], vB[0], pw[3], p1, sacc); XE2(p1, 8);  VFRAG(vA[0], vbn, 0, 0);
        AMF2(o[1], vB[1], pw[3], p1, sacc); XE2(p1, 10); VFRAG(vA[1], vbn, 1, 0);
        AMF2(o[2], vB[2], pw[3], p1, sacc); pw[2] = PK4(p1, 0); XE2(p1, 12); VFRAG(vA[2], vbn, 2, 0);
        AMF3(o[3], vB[3], pw[3], p1, sacc, pw[2]);  XE2(p1, 14); VFRAG(vA[3], vbn, 3, 0);
        sl = (sl + 1) & 3;
    }
    {
        const lds_cptr vb = (lds_cptr)(L + sl * 32768 + voff);
        pw[3] = PK4(p1, 8);
        AMF3(o[0], vA[0], pw[0], p1, sacc, pw[3]); VFRAG(vB[0], vb, 0, 1);
        AMF(o[1], vA[1], pw[0]); VFRAG(vB[1], vb, 1, 1);
        AMF(o[2], vA[2], pw[0]); VFRAG(vB[2], vb, 2, 1);
        AMF(o[3], vA[3], pw[0]); VFRAG(vB[3], vb, 3, 1);
        AMF(o[0], vB[0], pw[1]); VFRAG(vA[0], vb, 0, 2);
        AMF(o[1], vB[1], pw[1]); VFRAG(vA[1], vb, 1, 2);
        AMF(o[2], vB[2], pw[1]); VFRAG(vA[2], vb, 2, 2);
        AMF(o[3], vB[3], pw[1]); VFRAG(vA[3], vb, 3, 2);
        AMF(o[0], vA[0], pw[2]); VFRAG(vB[0], vb, 0, 3);
        AMF(o[1], vA[1], pw[2]); VFRAG(vB[1], vb, 1, 3);
        AMF(o[2], vA[2], pw[2]); VFRAG(vB[2], vb, 2, 3);
        AMF(o[3], vA[3], pw[2]); VFRAG(vB[3], vb, 3, 3);
        AMF(o[0], vB[0], pw[3]); AMF(o[1], vB[1], pw[3]); AMF(o[2], vB[2], pw[3]); AMF(o[3], vB[3], pw[3]);
        asm volatile("s_nop 15\n\ts_nop 15" : "+v"(o[0]), "+v"(o[1]), "+v"(o[2]), "+v"(o[3]) :: "memory");
    }
#undef B_DMA
#undef WAIT_BAR
#undef VFRAG
#undef MF_
#undef AMF
#undef AMF1
#undef AMF2
#undef AMF3
#undef AMF0
#undef PK4
#undef XE
#undef XE2
#undef KLD
#undef SET_KA
#undef BIAS_HALF
    attnB_finish(F, a, o, sacc, lam, rowbase, qpos, h, c, qs, r32, hi);
}
__device__ __forceinline__ void attnB_item(const Frame& F, const Args& a, int h, int b, int qblk, float lam) {
    const int q0 = qblk * 128;
    const unsigned* ctl = (const unsigned*)(a.ws + WS_CTL); const int sl = (b * 4 + h) * 4;
    const float qn0 = sqrtf(__uint_as_float(ctl[CW_QMAX + sl]) + __uint_as_float(ctl[CW_QMAX + sl + 1])), qn1 = sqrtf(__uint_as_float(ctl[CW_QMAX + sl + 2]) + __uint_as_float(ctl[CW_QMAX + sl + 3]));
    const float kn0 = sqrtf(__uint_as_float(ctl[CW_KMAX + sl]) + __uint_as_float(ctl[CW_KMAX + sl + 1])), kn1 = sqrtf(__uint_as_float(ctl[CW_KMAX + sl + 2]) + __uint_as_float(ctl[CW_KMAX + sl + 3]));
    const float U = fmaxf(qn0 * kn0, qn1 * kn1) * 1.01f + 0.01f;
    const float slope2 = __builtin_amdgcn_exp2f(-2.0f * (float)(h + 1)) * LOG2E;
    const float Df = (2.0f * U + 72.0f) / slope2;
    const int Dd = Df < 40000.f ? (int)Df + 2 : 40000;
    int t_lo = (q0 - Dd) >> 6; if (q0 - Dd < 0) t_lo = 0;
    int t_hi = (q0 + 127 + Dd) >> 6; if (t_hi > SEQ / 64 - 1) t_hi = SEQ / 64 - 1;
    if (U <= 40.f) attnB_fast(F, a, b, h, qblk, lam, t_lo, t_hi, kn0, kn1);
    else attnB_unit<false>(F, a, b, h, qblk, lam, t_lo, t_hi, kn0, kn1);
}

__device__ __forceinline__ int a_kbase(int n0, int it) { return n0 - 64 + 64 * ((it == 0) ? 1 : (it == 1 ? 0 : 2)); }
__device__ __forceinline__ void a_load_k(const bf16_t* KA, size_t rowbase, int head, int d, int r, int L, int kbase, int r32, int hi, bf16x8 (&kf)[8]) {
#pragma unroll
    for (int kh = 0; kh < 2; ++kh) { int kn = kbase + 32 * kh + r32; kn = kn < 0 ? 0 : (kn >= L ? L - 1 : kn);
        const bf16_t* Kp = KA + (rowbase + (size_t)(d * kn + r)) * 512 + head * 64 + 8 * hi;
#pragma unroll
        for (int d0 = 0; d0 < 4; ++d0) kf[2 * d0 + kh] = *(const bf16x8*)(Kp + 16 * d0); }
}
__device__ __forceinline__ void attnA_task(const Frame& F, const Args& a, int b, int head, int d, int r, int n0, int L, LAS unsigned char* vw, f32x16 (&o)[2], float& mhat, float& ltot) {
    const int lane = F_LANE, r32 = lane & 31, hi = lane >> 5;
    const bf16_t* QA = (const bf16_t*)(a.ws + WS_PROJ); const bf16_t* KA = QA + PROJ_STRIDE; const bf16_t* VA = KA + PROJ_STRIDE;
    const size_t rowbase = (size_t)b * SEQ; const int qn = n0 + r32;
    bf16x8 qr[4], kf[8], kfn[8];
    { const bf16_t* Qp = QA + (rowbase + (size_t)(d * qn + r)) * 512 + head * 64 + 8 * hi;
#pragma unroll
      for (int d0 = 0; d0 < 4; ++d0) qr[d0] = *(const bf16x8*)(Qp + 16 * d0); }
    a_load_k(KA, rowbase, head, d, r, L, a_kbase(n0, 0), r32, hi, kf);
    const float sl = __builtin_amdgcn_exp2f(-(float)(head + 1)) * LOG2E * (float)d;
    mhat = NEG_BIG; float lsum = 0.f; o[0] = (f32x16){}; o[1] = (f32x16){};
    const int voff = ((lane >> 4) & 1) * 32 + (lane & 3) * 8 + (4 * hi + ((lane & 15) >> 2)) * 64;
#pragma unroll
    for (int it = 0; it < 3; ++it) {
        const int kbase = a_kbase(n0, it);
        u32x4 vv[8];
#pragma unroll
        for (int ks = 0; ks < 4; ++ks) { int kn = kbase + 16 * ks + (lane >> 2); kn = kn < 0 ? 0 : (kn >= L ? L - 1 : kn);
            const bf16_t* Vp = VA + (rowbase + (size_t)(d * kn + r)) * 512 + head * 64 + 8 * (lane & 3);
            vv[ks] = *(const u32x4*)Vp; vv[4 + ks] = *(const u32x4*)(Vp + 32); }
        if (it < 2) a_load_k(KA, rowbase, head, d, r, L, a_kbase(n0, it + 1), r32, hi, kfn);
        __builtin_amdgcn_sched_barrier(0);
        f32x16 p0, p1;
#pragma unroll
        for (int rr = 0; rr < 16; ++rr) { const int k0 = kbase + crow(rr, hi), k1 = k0 + 32; const int d0_ = k0 - qn, d1_ = k1 - qn;
            const bool v0 = (k0 >= 0) && (k0 < L) && (d0_ <= 64) && (d0_ >= -64), v1 = (k1 >= 0) && (k1 < L) && (d1_ <= 64) && (d1_ >= -64);
            p0[rr] = v0 ? -sl * __builtin_fabsf((float)d0_) : NEG_BIG; p1[rr] = v1 ? -sl * __builtin_fabsf((float)d1_) : NEG_BIG; }
#pragma unroll
        for (int d0 = 0; d0 < 4; ++d0) { p0 = MFMA32(kf[2 * d0], qr[d0], p0); p1 = MFMA32(kf[2 * d0 + 1], qr[d0], p1); }
        u32x4 pw[4];
        softmax_tile<2>(p0, p1, mhat, lsum, o, pw);
        __builtin_amdgcn_sched_barrier(0);
#pragma unroll
        for (int i = 0; i < 8; ++i) *(LAS u32x4*)(vw + i * 1024 + lane * 16) = vv[i];
        asm volatile("s_waitcnt lgkmcnt(0)" ::: "memory");
        pv_tile<2>(o, (lds_cptr)(vw + voff), pw);
        asm volatile("s_waitcnt lgkmcnt(0)" ::: "memory");
        if (it < 2) {
#pragma unroll
            for (int j = 0; j < 8; ++j) kf[j] = kfn[j];
        }
    }
    ltot = halfsum(lsum);
}
struct ACst { bf16x8 qaC, qaL, qaR; u32x4 ka0, ka1; float e0, nsl, nref; };
__device__ __forceinline__ void a_consts(int head, int d, int r32, int hi, float ref, ACst& c) {
    const float sl = __builtin_amdgcn_exp2f(-(float)(head + 1)) * LOG2E * (float)d; const unsigned msk = hi ? 0u : 0xFFFFFFFFu;
    const unsigned sh = bfb(sl), slo = bfb(sl - bff(sh)); unsigned h0, m0, l0;
    const unsigned pos = ((slo << 16) | sh) & msk, neg = (((slo ^ 0x8000u) << 16) | (sh ^ 0x8000u)) & msk;
    bf_split3(sl * (float)r32 - ref, h0, m0, l0);          { const u32x4 v = (u32x4){neg, 0u, ((m0 << 16) | h0) & msk, l0 & msk}; c.qaC = __builtin_bit_cast(bf16x8, v); }
    bf_split3(-sl * (float)(64 + r32) - ref, h0, m0, l0);  { const u32x4 v = (u32x4){pos, 0u, ((m0 << 16) | h0) & msk, l0 & msk}; c.qaL = __builtin_bit_cast(bf16x8, v); }
    bf_split3(sl * (float)(r32 - 64) - ref, h0, m0, l0);   { const u32x4 v = (u32x4){neg, 0u, ((m0 << 16) | h0) & msk, l0 & msk}; c.qaR = __builtin_bit_cast(bf16x8, v); }
    const unsigned j0 = bfb((float)r32), j1 = bfb((float)(32 + r32));
    c.ka0 = (u32x4){((j0 << 16) | j0) & msk, 0u, 0x3F803F80u & msk, 0x00003F80u & msk}; c.ka1 = c.ka0; c.ka1[0] = ((j1 << 16) | j1) & msk;
    c.e0 = (float)(4 * hi - r32); c.nsl = -sl; c.nref = -ref;
}
__device__ __forceinline__ void a_load_k_half(const bf16_t* KA, size_t rowbase, int head, int d, int r, int kbase, int r32, int hi, bf16x8 (&kf)[8]) {
    const bf16_t* Kp = KA + (rowbase + (size_t)(d * (kbase + r32) + r)) * 512 + head * 64 + 8 * hi;
#pragma unroll
    for (int d0 = 0; d0 < 4; ++d0) kf[2 * d0] = *(const bf16x8*)(Kp + 16 * d0);
}
__device__ __forceinline__ void softmax_half(f32x16& p0, float& mhat, float& lsum, f32x16 (&o)[2], u32x4 (&pw)[4]) {
    float a_ = MX3(p0[0], p0[1], p0[2]), b_ = MX3(p0[3], p0[4], p0[5]);
#pragma unroll
    for (int r = 6; r < 16; r += 2) { a_ = __builtin_fmaxf(a_, p0[r]); b_ = __builtin_fmaxf(b_, p0[r + 1]); }
    float m = __builtin_fmaxf(a_, b_); auto rr = __builtin_amdgcn_permlane32_swap(__float_as_uint(m), __float_as_uint(m), false, false);
    const float rm = __builtin_fmaxf(__uint_as_float(rr[0]), __uint_as_float(rr[1]));
    const float mnew = __builtin_fmaxf(mhat, rm);
    if (__any(mnew != mhat)) {
        const float al = __builtin_amdgcn_exp2f(mhat - mnew); lsum *= al;
#pragma unroll
        for (int d = 0; d < 2; ++d)
#pragma unroll
            for (int r = 0; r < 16; ++r) o[d][r] *= al;
        mhat = mnew;
    }
    float s = 0.f;
#pragma unroll
    for (int r = 0; r < 16; ++r) { p0[r] = __builtin_amdgcn_exp2f(p0[r] - mhat); s += p0[r]; }
    lsum += s;
    pw[0] = (u32x4){cvtpk(p0[0], p0[1]), cvtpk(p0[2], p0[3]), cvtpk(p0[4], p0[5]), cvtpk(p0[6], p0[7])};
    pw[1] = (u32x4){cvtpk(p0[8], p0[9]), cvtpk(p0[10], p0[11]), cvtpk(p0[12], p0[13]), cvtpk(p0[14], p0[15])};
}
template <bool H1>
__device__ __forceinline__ void softmax_fix(f32x16& p0, f32x16& p1, float& lsum, u32x4 (&pw)[4]) {
    float s = 0.f;
#pragma unroll
    for (int r = 0; r < 16; ++r) { p0[r] = __builtin_amdgcn_exp2f(p0[r]); s += p0[r]; if (H1) { p1[r] = __builtin_amdgcn_exp2f(p1[r]); s += p1[r]; } }
    lsum += s;
    pw[0] = (u32x4){cvtpk(p0[0], p0[1]), cvtpk(p0[2], p0[3]), cvtpk(p0[4], p0[5]), cvtpk(p0[6], p0[7])};
    pw[1] = (u32x4){cvtpk(p0[8], p0[9]), cvtpk(p0[10], p0[11]), cvtpk(p0[12], p0[13]), cvtpk(p0[14], p0[15])};
    if (H1) { pw[2] = (u32x4){cvtpk(p1[0], p1[1]), cvtpk(p1[2], p1[3]), cvtpk(p1[4], p1[5]), cvtpk(p1[6], p1[7])};
              pw[3] = (u32x4){cvtpk(p1[8], p1[9]), cvtpk(p1[10], p1[11]), cvtpk(p1[12], p1[13]), cvtpk(p1[14], p1[15])}; }
}
__device__ __forceinline__ void attnA_task_in(const Frame& F, const Args& a, float kn, int b, int head, int d, int r, int n0, LAS unsigned char* vw, f32x16 (&o)[2], float& mhat, float& ltot) {
    const int lane = F_LANE, r32 = lane & 31, hi = lane >> 5;
    const bf16_t* QA = (const bf16_t*)(a.ws + WS_PROJ); const bf16_t* KA = QA + PROJ_STRIDE; const bf16_t* VA = KA + PROJ_STRIDE;
    const size_t rowbase = (size_t)b * SEQ; const int qn = n0 + r32;
    bf16x8 qr[4], kf[8];
    { const bf16_t* Qp = QA + (rowbase + (size_t)(d * qn + r)) * 512 + head * 64 + 8 * hi;
#pragma unroll
      for (int d0 = 0; d0 < 4; ++d0) qr[d0] = *(const bf16x8*)(Qp + 16 * d0); }
    a_load_k(KA, rowbase, head, d, r, 1 << 30, n0, r32, hi, kf);
    float ref;
    { float qq = 0.f;
#pragma unroll
        for (int d0 = 0; d0 < 4; ++d0)
#pragma unroll
            for (int j = 0; j < 8; ++j) { const float v = __uint_as_float((unsigned)(unsigned short)qr[d0][j] << 16); qq += v * v; }
        qq = halfsum(qq); ref = sqrtf(qq) * kn * 1.01f + 0.01f; }
    ACst cs; a_consts(head, d, r32, hi, ref, cs);
    mhat = ref; float lsum = 0.f; o[0] = (f32x16){}; o[1] = (f32x16){};
    const int voff = ((lane >> 4) & 1) * 32 + (lane & 3) * 8 + (4 * hi + ((lane & 15) >> 2)) * 64;
    const int m_ = r32 - 4 * hi;
#define A_VLOAD(kb_, NKS) _Pragma("unroll") for (int ks = 0; ks < (NKS); ++ks) { const int kn = (kb_) + 16 * ks + (lane >> 2); \
            const bf16_t* Vp = VA + (rowbase + (size_t)(d * kn + r)) * 512 + head * 64 + 8 * (lane & 3); vv[ks] = *(const u32x4*)Vp; vv[4 + ks] = *(const u32x4*)(Vp + 32); }
    const f32x16 zero16 = (f32x16){};
    u32x4 vv[8], pw[4]; f32x16 p0, p1;
    A_VLOAD(n0, 4)
#pragma unroll
    for (int rr = 0; rr < 16; ++rr) p0[rr] = __builtin_fmaf(cs.nsl, __builtin_fabsf(cs.e0 + (float)((rr & 3) + 8 * (rr >> 2))), cs.nref);
    p1 = MFMA32(__builtin_bit_cast(bf16x8, cs.ka1), cs.qaC, zero16);
#pragma unroll
    for (int d0 = 0; d0 < 4; ++d0) { p0 = MFMA32(kf[2 * d0], qr[d0], p0); p1 = MFMA32(kf[2 * d0 + 1], qr[d0], p1); }
    a_load_k(KA, rowbase, head, d, r, 1 << 30, n0 - 64, r32, hi, kf);
    softmax_fix<true>(p0, p1, lsum, pw);
#pragma unroll
    for (int i = 0; i < 8; ++i) *(LAS u32x4*)(vw + i * 1024 + lane * 16) = vv[i];
    asm volatile("s_waitcnt lgkmcnt(0)" ::: "memory");
    pv_tile<2>(o, (lds_cptr)(vw + voff), pw);
    asm volatile("s_waitcnt lgkmcnt(0)" ::: "memory");
    A_VLOAD(n0 - 64, 4)
    p0 = MFMA32(__builtin_bit_cast(bf16x8, cs.ka0), cs.qaL, zero16); p1 = MFMA32(__builtin_bit_cast(bf16x8, cs.ka1), cs.qaL, zero16);
#pragma unroll
    for (int d0 = 0; d0 < 4; ++d0) { p0 = MFMA32(kf[2 * d0], qr[d0], p0); p1 = MFMA32(kf[2 * d0 + 1], qr[d0], p1); }
    a_load_k_half(KA, rowbase, head, d, r, n0 + 64, r32, hi, kf);
#pragma unroll
    for (int rr = 0; rr < 16; ++rr) p0[rr] = ((rr & 3) + 8 * (rr >> 2) >= m_) ? p0[rr] : NEG_BIG;
    softmax_fix<true>(p0, p1, lsum, pw);
#pragma unroll
    for (int i = 0; i < 8; ++i) *(LAS u32x4*)(vw + i * 1024 + lane * 16) = vv[i];
    asm volatile("s_waitcnt lgkmcnt(0)" ::: "memory");
    pv_tile<2>(o, (lds_cptr)(vw + voff), pw);
    asm volatile("s_waitcnt lgkmcnt(0)" ::: "memory");
    A_VLOAD(n0 + 64, 2)
    p0 = MFMA32(__builtin_bit_cast(bf16x8, cs.ka0), cs.qaR, zero16);
#pragma unroll
    for (int d0 = 0; d0 < 4; ++d0) p0 = MFMA32(kf[2 * d0], qr[d0], p0);
#pragma unroll
    for (int rr = 0; rr < 16; ++rr) p0[rr] = ((rr & 3) + 8 * (rr >> 2) <= m_) ? p0[rr] : NEG_BIG;
    softmax_fix<false>(p0, p1, lsum, pw);
#pragma unroll
    for (int ks = 0; ks < 2; ++ks) { *(LAS u32x4*)(vw + ks * 1024 + lane * 16) = vv[ks]; *(LAS u32x4*)(vw + (4 + ks) * 1024 + lane * 16) = vv[4 + ks]; }
    asm volatile("s_waitcnt lgkmcnt(0)" ::: "memory");
    {   const lds_cptr vbase = (lds_cptr)(vw + voff);
#pragma unroll
        for (int d0 = 0; d0 < 2; ++d0)
#pragma unroll
            for (int ks = 0; ks < 2; ++ks) {
                const s16x4 lo = vtr(vbase + d0 * 4096 + ks * 1024), hi_ = vtr(vbase + d0 * 4096 + ks * 1024 + 512);
                const bf16x8 vf = (bf16x8){lo[0], lo[1], lo[2], lo[3], hi_[0], hi_[1], hi_[2], hi_[3]};
                o[d0] = MFMA32(vf, __builtin_bit_cast(bf16x8, pw[ks]), o[d0]); } }
    asm volatile("s_waitcnt lgkmcnt(0)" ::: "memory");
#undef A_VLOAD
    ltot = halfsum(lsum);
}
__device__ __forceinline__ void attnA_unit(const Frame& F, const Args& a, int unit) {
    const int lane = F_LANE, r32 = lane & 31, hi = lane >> 5, wid = F.wave;
    const int b = unit >> 7, head = (unit >> 4) & 7, tb = unit & 15, T0 = tb * 1024;
    float* part = (float*)(a.ws + WS_APART + (size_t)unit * APART_UNIT); float* ml = part + 2 * 1024 * 64;
    LAS unsigned char* vw = F.lds + wid * 8192;
    const unsigned* ctlA = (const unsigned*)(a.ws + WS_CTL) + CW_KAMAX + b * 16 + head * 2; const unsigned* ctlQ = (const unsigned*)(a.ws + WS_CTL) + CW_QAMAX + b * 16 + head * 2;
    const float knA = sqrtf(__uint_as_float(ctlA[0]) + __uint_as_float(ctlA[1])), qnA = sqrtf(__uint_as_float(ctlQ[0]) + __uint_as_float(ctlQ[1]));
    const bool fixok = qnA * knA * 1.01f <= 40.f;
    {
#pragma unroll 1
    for (int task = wid; task < 64; task += 8) {
        int pat, d, r, n0, L;
        if (task < 32) { pat = 0; d = 16; r = task >> 1; n0 = T0 / 16 + 32 * (task & 1); L = SEQ / 16; }
        else { const int tt = task - 32; pat = 1; d = 4; r = tt >> 3; n0 = T0 / 4 + 32 * (tt & 7); L = SEQ / 4; }
        f32x16 o[2]; float mhat, ltot;
        if (fixok && n0 >= 64 && n0 + 128 <= L) attnA_task_in(F, a, knA, b, head, d, r, n0, vw, o, mhat, ltot);
        else attnA_task(F, a, b, head, d, r, n0, L, vw, o, mhat, ltot);
        const int tl = d * (n0 + r32) + r - T0;
        float* pp = part + ((size_t)pat * 1024 + tl) * 64 + 4 * hi;
#pragma unroll
        for (int d0 = 0; d0 < 2; ++d0)
#pragma unroll
            for (int g = 0; g < 4; ++g) *(f32x4*)(pp + 32 * d0 + 8 * g) = (f32x4){o[d0][4 * g], o[d0][4 * g + 1], o[d0][4 * g + 2], o[d0][4 * g + 3]};
        if (hi == 0) *(f32x2*)(ml + ((size_t)pat * 1024 + tl) * 2) = (f32x2){mhat, ltot};
    }
    }
    asm volatile("s_waitcnt vmcnt(0)" ::: "memory");
    __syncthreads();
    __builtin_amdgcn_fence(__ATOMIC_ACQUIRE, "agent");
    for (int task = wid; task < 32; task += 8) {
        const int n0 = T0 + 32 * task;
        f32x16 o[2]; float m0, l0;
        if (fixok && n0 >= 64 && n0 + 128 <= SEQ) attnA_task_in(F, a, knA, b, head, 1, 0, n0, vw, o, m0, l0);
        else attnA_task(F, a, b, head, 1, 0, n0, SEQ, vw, o, m0, l0);
        const int tl = 32 * task + r32;
        const f32x2 ml1 = *(const f32x2*)(ml + ((size_t)0 * 1024 + tl) * 2), ml2 = *(const f32x2*)(ml + ((size_t)1 * 1024 + tl) * 2);
        const float M = MX3(m0, ml1[0], ml2[0]);
        const float w0 = __builtin_amdgcn_exp2f(m0 - M), w1 = __builtin_amdgcn_exp2f(ml1[0] - M), w2 = __builtin_amdgcn_exp2f(ml2[0] - M);
        const float rden = 1.0f / (w0 * l0 + w1 * ml1[1] + w2 * ml2[1]);
        const float* p1 = part + ((size_t)0 * 1024 + tl) * 64 + 4 * hi; const float* p2 = part + ((size_t)1 * 1024 + tl) * 64 + 4 * hi;
        bf16_t* op = (bf16_t*)(a.ws + WS_MIXED) + ((size_t)b * SEQ + T0 + tl) * DM + head * 64 + 4 * hi;
#pragma unroll
        for (int d0 = 0; d0 < 2; ++d0)
#pragma unroll
            for (int g = 0; g < 4; ++g) { const f32x4 a1 = *(const f32x4*)(p1 + 32 * d0 + 8 * g), a2 = *(const f32x4*)(p2 + 32 * d0 + 8 * g); float v[4];
#pragma unroll
                for (int j = 0; j < 4; ++j) v[j] = (w0 * o[d0][4 * g + j] + w1 * a1[j] + w2 * a2[j]) * rden;
                u32x2 w; w.x = cvtpk(v[0], v[1]); w.y = cvtpk(v[2], v[3]); *(u32x2*)(op + 32 * d0 + 8 * g) = w; }
    }
    __syncthreads();
}

__device__ __forceinline__ unsigned ordkey(float v) { const unsigned u = __float_as_uint(v); return u ^ ((u >> 31) ? 0xFFFFFFFFu : 0x80000000u); }
__device__ __forceinline__ float unordkey(unsigned k) { const unsigned u = (k & 0x80000000u) ? (k ^ 0x80000000u) : ~k; return __uint_as_float(u); }
__device__ __forceinline__ void p4_ln_router(const Frame& F, const Args& a) {
    const int lane = F_LANE, wid = F.wave, tid = F_TID;
    LAS float* Wr = (LAS float*)F.lds;
    LAS unsigned* misc = (LAS unsigned*)(F.lds + LX_MISC);
    LAS float* pc = (LAS float*)(F.lds + LX_TOK);
    for (int i = tid; i < DM * NE / 4; i += 512) ((LAS f32x4*)Wr)[i] = ((const f32x4*)a.w_router)[i] * a.ln1_g[i >> 3];
    if (tid < 64) misc[tid] = 0u;
    float* Z = (float*)(a.ws + WS_Z); bf16_t* X1B = (bf16_t*)(a.ws + WS_XB);
    const int r0 = (F.vcu * 8 + wid) * 16;
    const int rl = lane & 15, q = lane >> 4;
    float mym[4] = {0.f, 0.f, 0.f, 0.f}, myr[4] = {0.f, 0.f, 0.f, 0.f};
    {
        f32x4 gv[4], bv[4];
#pragma unroll
        for (int j = 0; j < 4; ++j) { gv[j] = ((const f32x4*)a.ln1_g)[lane + 64 * j]; bv[j] = ((const f32x4*)a.ln1_b)[lane + 64 * j]; }
        float* stats = (float*)(a.ws + WS_ROUTE + 4 * MiB);
#pragma unroll 4
        for (int rr = 0; rr < 16; ++rr) {
            const f32x4* zr = (const f32x4*)(Z + (size_t)(r0 + rr) * DM) + lane; f32x4 v[4]; float s = 0.f;
#pragma unroll
            for (int j = 0; j < 4; ++j) { v[j] = zr[64 * j]; s += (v[j][0] + v[j][1]) + (v[j][2] + v[j][3]); }
            const float mean = wave_sum(s) * (1.f / DM); float s2 = 0.f;
#pragma unroll
            for (int j = 0; j < 4; ++j) { v[j] = v[j] - mean; s2 += (v[j][0] * v[j][0] + v[j][1] * v[j][1]) + (v[j][2] * v[j][2] + v[j][3] * v[j][3]); }
            const float rstd = 1.f / sqrtf(wave_sum(s2) * (1.f / DM) + LN_EPS);
            unsigned* o8 = (unsigned*)((unsigned char*)X1B + (size_t)(r0 + rr) * DM) + lane;
#pragma unroll
            for (int j = 0; j < 4; ++j) { const f32x4 y = (v[j] * rstd * gv[j] + bv[j]) * 8.f; o8[64 * j] = cvt4_fp8(y[0], y[1], y[2], y[3]); }
            if (lane == 0) *(f32x2*)(stats + 2 * (r0 + rr)) = (f32x2){mean, rstd};
            if ((rr >> 2) == q) {
#pragma unroll
                for (int i = 0; i < 4; ++i) if ((rr & 3) == i) { mym[i] = mean; myr[i] = rstd; } }
        }
    }
    __syncthreads();
    {
        const int e = tid & 31, part = tid >> 5; float s0 = 0.f, s1 = 0.f;
        for (int k = part * 64; k < part * 64 + 64; ++k) { s0 += Wr[k * 32 + e]; s1 += a.ln1_b[k] * a.w_router[k * 32 + e]; }
        pc[part * 32 + e] = s0; pc[512 + part * 32 + e] = s1;
    }
    __syncthreads();
    if (tid < 64) { const int e = tid & 31, w = tid >> 5; float t = 0.f; for (int p = 0; p < 16; ++p) t += pc[w * 512 + p * 32 + e]; pc[1024 + tid] = t + (w ? a.b_router[e] : 0.f); }
    __syncthreads();
    f32x4 acc0 = (f32x4){0.f, 0.f, 0.f, 0.f}, acc1 = acc0;
    const float* xr = Z + (size_t)(r0 + rl) * DM + 4 * q;
#pragma unroll 4
    for (int cidx = 0; cidx < 64; ++cidx) {
        const f32x4 xv = *(const f32x4*)(xr + 16 * cidx);
#pragma unroll
        for (int j = 0; j < 4; ++j) { const int k = 16 * cidx + 4 * q + j;
            acc0 = __builtin_amdgcn_mfma_f32_16x16x4f32(xv[j], Wr[k * 32 + rl], acc0, 0, 0, 0);
            acc1 = __builtin_amdgcn_mfma_f32_16x16x4f32(xv[j], Wr[k * 32 + 16 + rl], acc1, 0, 0, 0); }
    }
    {   const float cs0 = pc[1024 + rl], cs1 = pc[1024 + 16 + rl], cb0 = pc[1024 + 32 + rl], cb1 = pc[1024 + 48 + rl];
#pragma unroll
        for (int i = 0; i < 4; ++i) { acc0[i] = myr[i] * (acc0[i] - mym[i] * cs0) + cb0; acc1[i] = myr[i] * (acc1[i] - mym[i] * cs1) + cb1; } }
    const float br0 = 0.f, br1 = 0.f;
    int* sel_e = (int*)(a.ws + WS_ROUTE); int* sel_pos = sel_e + NTOK * TOPK; float* sel_gate = (float*)(sel_pos + NTOK * TOPK);
    int my_e[4] = {0, 0, 0, 0}, my_lp[4] = {0, 0, 0, 0}; float my_g[4] = {0.f, 0.f, 0.f, 0.f};
#pragma unroll
    for (int i = 0; i < 4; ++i) {
        unsigned k0 = (ordkey(acc0[i] + br0) & ~31u) | (unsigned)(31 - rl), k1 = (ordkey(acc1[i] + br1) & ~31u) | (unsigned)(15 - rl);
        unsigned selk[4];
#pragma unroll
        for (int t = 0; t < 4; ++t) {
            unsigned m = k0 > k1 ? k0 : k1;
#pragma unroll
            for (int ofs = 1; ofs < 16; ofs <<= 1) { const unsigned other = (unsigned)__shfl_xor((int)m, ofs); m = other > m ? other : m; }
            selk[t] = m; if (k0 == m) k0 = 0u; if (k1 == m) k1 = 0u;
        }
        const float v0 = unordkey(selk[0] & ~31u), v1 = unordkey(selk[1] & ~31u), v2 = unordkey(selk[2] & ~31u), v3 = unordkey(selk[3] & ~31u);
        const float e1 = __expf(v1 - v0), e2 = __expf(v2 - v0), e3 = __expf(v3 - v0); const float rs = 1.0f / (1.0f + e1 + e2 + e3);
        if (rl < 4) { const unsigned sk = rl == 0 ? selk[0] : (rl == 1 ? selk[1] : (rl == 2 ? selk[2] : selk[3]));
            const float ge = rl == 0 ? 1.0f : (rl == 1 ? e1 : (rl == 2 ? e2 : e3));
            my_e[i] = 31 - (int)(sk & 31u); my_g[i] = ge * rs; my_lp[i] = (int)atomicAdd((unsigned*)&misc[my_e[i]], 1u); }
    }
    __syncthreads();
    unsigned* gcnt = (unsigned*)(a.ws + WS_CTL);
    if (F_TID < 32) misc[32 + F_TID] = atomicAdd(&gcnt[F_TID], misc[F_TID]);
    __syncthreads();
    if (rl < 4) {
#pragma unroll
        for (int i = 0; i < 4; ++i) { const int tok = r0 + 4 * q + i, idx = tok * 4 + rl; sel_e[idx] = my_e[i]; sel_pos[idx] = (int)misc[32 + my_e[i]] + my_lp[i]; sel_gate[idx] = my_g[i]; }
    }
}

__device__ __forceinline__ int build_tiles(const Frame& F, const Args& a) {
    LAS unsigned* misc = (LAS unsigned*)(F.lds + LX_MISC); LAS unsigned char* tile_e = F.lds + LX_TILE;
    const unsigned* gcnt = (const unsigned*)(a.ws + WS_CTL);
    if (F_TID < NE) misc[128 + F_TID] = (__hip_atomic_load(&gcnt[F_TID], __ATOMIC_RELAXED, __HIP_MEMORY_SCOPE_AGENT) + 255u) >> 8;
    __syncthreads();
    if (F_TID == 0) { unsigned acc = 0; for (int e = 0; e < NE; ++e) { misc[64 + e] = acc; acc += misc[128 + e]; } misc[64 + NE] = acc; }
    __syncthreads();
    const int nt = (int)misc[64 + NE];
    for (int e = 0; e < NE; ++e) { const int t0 = (int)misc[64 + e], t1 = (int)misc[65 + e]; for (int t = t0 + F_TID; t < t1; t += 512) tile_e[t] = (unsigned char)e; }
    __syncthreads();
    return nt;
}

#define XLAS __attribute__((address_space(3)))
#define XB_TMO      128
#define XB_XCNT(j)  (256  + 64 * (j))
#define XB_XSUB(j)  (1280 + 64 * (j))
#define XB_XGEN(j)  (2304 + 64 * (j))
#define XB_TOP      3328
#define XB_TOPGEN   3392
#define XCD_BAR_WORDS 3456
#define XB_SPIN_CAP (1u << 22)

__device__ __forceinline__ unsigned xb_ld(unsigned* p)              { return __hip_atomic_load(p, __ATOMIC_RELAXED, __HIP_MEMORY_SCOPE_AGENT); }
__device__ __forceinline__ unsigned xb_add(unsigned* p, unsigned v) { return __hip_atomic_fetch_add(p, v, __ATOMIC_RELAXED, __HIP_MEMORY_SCOPE_AGENT); }
__device__ __forceinline__ unsigned xb_xcc_id() { return (unsigned)__builtin_amdgcn_s_getreg((3 << 11) | 20) & 0xFu; }
#define XB_SPIN(cond, bar) do { unsigned _sp = 0; while (cond) { __builtin_amdgcn_s_sleep(1); \
    if ((++_sp & 255u) == 0u) { if (xb_ld(&(bar)[XB_TMO])) break; if (_sp > XB_SPIN_CAP) { atomicAdd(&(bar)[XB_TMO], 1u); break; } } } } while (0)

struct XcdBarrier {
    unsigned* bar; unsigned x;
    volatile XLAS unsigned* st;
};

__device__ __forceinline__ XcdBarrier xcd_barrier_post(unsigned* bar, volatile XLAS unsigned* st) {
    XcdBarrier b; b.bar = bar; b.x = xb_xcc_id(); b.st = st;
    if (threadIdx.x == 0) (void)xb_add(&bar[XB_XCNT(b.x)], 1u);
    return b;
}
__device__ __forceinline__ void xcd_barrier_complete(unsigned* bar, unsigned x, unsigned& nloc, unsigned& nx) {
    const unsigned G = gridDim.x * gridDim.y * gridDim.z;
    unsigned sum, cnt, mine, sp = 0u;
    for (;;) {
        sum = 0u; cnt = 0u; mine = 0u;
#pragma unroll
        for (unsigned j = 0; j < 16; ++j) { const unsigned c = xb_ld(&bar[XB_XCNT(j)]); sum += c; cnt += (c > 0u) ? 1u : 0u; mine = (j == x) ? c : mine; }
        if (sum == G) break;
        __builtin_amdgcn_s_sleep(1);
        if ((++sp & 255u) == 0u) { if (xb_ld(&bar[XB_TMO])) break; if (sp > XB_SPIN_CAP) { atomicAdd(&bar[XB_TMO], 1u); break; } }
    }
    nloc = mine > 0u ? mine : 1u; nx = cnt > 0u ? cnt : 1u;
}

__device__ __forceinline__ void xcd_barrier(const XcdBarrier& b, const int tid0) {
    asm volatile("s_waitcnt vmcnt(0)" ::: "memory");
    __syncthreads();
    if (tid0 == 0) {
        unsigned* bar = b.bar;
        __builtin_amdgcn_s_waitcnt(0);
        unsigned nloc = b.st[0], nx = b.st[1];
        if (nloc == 0u) { xcd_barrier_complete(bar, b.x, nloc, nx); b.st[0] = nloc; b.st[1] = nx; }
        const unsigned old = xb_add(&bar[XB_XSUB(b.x)], 1u);
        const unsigned gen = old / nloc;
        if (old + 1u == (gen + 1u) * nloc) {
            __builtin_amdgcn_fence(__ATOMIC_RELEASE, "agent");
            asm volatile("s_waitcnt vmcnt(0)" ::: "memory");
            const unsigned og = xb_add(&bar[XB_TOP], 1u);
            const unsigned tg = og / nx;
            if (og + 1u == (tg + 1u) * nx) xb_add(&bar[XB_TOPGEN], 1u);
            else XB_SPIN(xb_ld(&bar[XB_TOPGEN]) == tg, bar);
            __builtin_amdgcn_fence(__ATOMIC_ACQUIRE, "agent");
            xb_add(&bar[XB_XGEN(b.x)], 1u);
            asm volatile("s_waitcnt vmcnt(0)" ::: "memory");
        } else {
            XB_SPIN(xb_ld(&bar[XB_XGEN(b.x)]) == gen, bar);
            __builtin_amdgcn_fence(__ATOMIC_ACQUIRE, "agent");
            asm volatile("s_waitcnt vmcnt(0)" ::: "memory");
        }
    }
    __syncthreads();
}

__global__ void __launch_bounds__(512, 2) fwd_megakernel(Args a) {
    extern __shared__ __attribute__((aligned(16))) unsigned char lds_raw[];
    cg::grid_group grid = cg::this_grid();
    Frame F; F.lds = (LAS unsigned char*)lds_raw; F.wave = __builtin_amdgcn_readfirstlane((int)(threadIdx.x >> 6));
    F.G = gridDim.x; { const int bx = blockIdx.x; F.vcu = (F.G % 8 == 0) ? (bx % 8) * (F.G / 8) + bx / 8 : bx; }
    unsigned char* ws = a.ws;
    {   LAS unsigned* m0_ = (LAS unsigned*)(F.lds + LX_MISC); if (F_TID < 128) m0_[F_TID] = 0u; __syncthreads(); }
    XcdBarrier xbar = xcd_barrier_post((unsigned*)(ws + WS_CTL) + CW_BAR, (volatile LAS unsigned*)(F.lds + LX_MISC) + 120);
#define GRID_BAR() xcd_barrier(xbar, F_TID)
#ifdef PROBE_T1
    unsigned long long* stamps = (unsigned long long*)(ws + WS_CTL + 2048);
#define STAMP(k) do { if (blockIdx.x == 0 && F_TID == 0) stamps[k] = __builtin_amdgcn_s_memrealtime(); } while (0)
#else
#define STAMP(k) do {} while (0)
#endif
    STAMP(0);

    for (int rep = 0; rep < REP_P0; ++rep) p0_prologue(F, a);
    if (a.out == nullptr) grid.sync();
    GRID_BAR();
    STAMP(1);

    for (int rep = 0; rep < REP_P1; ++rep) {
        pg8::Gemm g{(const bf16_t*)(ws + WS_XB), (const bf16_t*)(ws + WS_WIN), NTOK, NPROJ, DM, 0, 0}; pg8::StaticOrder S; S.init(NTOK, NPROJ, F.G, (int)blockIdx.x);
        EpiProj E{(bf16_t*)(ws + WS_PROJ), (unsigned*)(ws + WS_CTL)};
        pg8::gemm_phase<EpiProj, pg8::StaticOrder, true, false, KREP_P1>(F.lds, g, S, E, F_TID);
    }
    GRID_BAR();
    STAMP(2);

    {
        float s1 = 0.f, s2 = 0.f;
        for (int i = 0; i < 64; ++i) { s1 += a.lq1[i] * a.lk1[i]; s2 += a.lq2[i] * a.lk2[i]; }
        const float lam = __expf(s1) - __expf(s2) + LAM_INIT;
        {
            LAS unsigned* misc = (LAS unsigned*)(F.lds + LX_MISC); unsigned* ctl = (unsigned*)(ws + WS_CTL);
            const int myx = (int)(xbar.x & 7u);
            for (;;) {
                __syncthreads();
                if (F_TID == 0) { int got = -1;
                    { const unsigned p = atomicAdd(ctl + CW_QUEUE + myx, 1u); if (p < 160u) got = myx * 256 + (int)p; }
                    for (int k = 1; k < 8 && got < 0; ++k) { const int qx = (myx + k) & 7;
                        if (__hip_atomic_load(ctl + CW_QUEUE + qx, __ATOMIC_RELAXED, __HIP_MEMORY_SCOPE_AGENT) < 160u) { const unsigned p = atomicAdd(ctl + CW_QUEUE + qx, 1u); if (p < 160u) got = qx * 256 + (int)p; } }
                    misc[100] = (unsigned)got; }
                __syncthreads();
                const int idx = __builtin_amdgcn_readfirstlane((int)misc[100]);
                if (idx < 0) break;
                const int qx = idx >> 8, p = idx & 255;
                if (p < 64 && (p & 1)) attnA_unit(F, a, qx * 32 + (p >> 1));
                else { const int h = p < 64 ? 3 : 2 - ((p - 64) >> 5), j = p < 64 ? (p >> 1) : (p & 31); attnB_item(F, a, h, qx >> 2, 32 * (qx & 3) + j, lam); }
            }
        }
    }
    GRID_BAR();
    STAMP(3);

    for (int rep = 0; rep < REP_P3; ++rep) {
        pg8::Gemm g{(const bf16_t*)(ws + WS_MIXED), (const bf16_t*)(ws + WS_WOUT), NTOK, DM, DM, 0, 0}; pg8::StaticOrder S; S.init(NTOK, DM, F.G, (int)blockIdx.x);
        EpiZ E{a.x, (float*)(ws + WS_Z)};
        pg8::gemm_phase<EpiZ, pg8::StaticOrder, true, false, KREP_P3>(F.lds, g, S, E, F_TID);
    }
    GRID_BAR();
    STAMP(4);

    if (F.G == 256) p4_ln_router(F, a);
    GRID_BAR();
    STAMP(5);

    int* sel_e = (int*)(ws + WS_ROUTE); int* sel_pos = sel_e + NTOK * TOPK; float* sel_gate = (float*)(sel_pos + NTOK * TOPK);
    int* inv = (int*)(sel_gate + NTOK * TOPK); int* row_tok = inv + NTOK * TOPK; float* row_gate = (float*)(row_tok + 262144);
    {
        const int ntl = build_tiles(F, a); (void)ntl;
        LAS unsigned* misc = (LAS unsigned*)(F.lds + LX_MISC);
        const unsigned* gcnt = (const unsigned*)(ws + WS_CTL);
        for (int idx = F.vcu * 512 + F_TID; idx < NTOK * TOPK; idx += F.G * 512) {
            const int e = sel_e[idx], dest = (int)misc[64 + e] * 256 + sel_pos[idx];
            row_tok[dest] = idx >> 2; row_gate[dest] = sel_gate[idx]; inv[idx] = dest;
        }
        for (int e = F.vcu; e < NE; e += F.G) {
            const int c = (int)__hip_atomic_load(&gcnt[e], __ATOMIC_RELAXED, __HIP_MEMORY_SCOPE_AGENT), base = (int)misc[64 + e] * 256, end = (int)misc[65 + e] * 256;
            for (int r = base + c + F_TID; r < end; r += 512) { row_tok[r] = 0; row_gate[r] = 0.f; }
        }
    }
    GRID_BAR();
    STAMP(6);

    for (int rep = 0; rep < REP_P6; ++rep) {
        const int ntl = build_tiles(F, a);
        MoeOrder S; S.so.init(ntl * 256, 2048, F.G, (int)blockIdx.x); S.tile_e = F.lds + LX_TILE; S.tok = (const LAS unsigned short*)(F.lds + LX_TOK); S.ncolt = 8;
        {
            LAS unsigned short* tk = (LAS unsigned short*)(F.lds + LX_TOK); pg8::Unit u;
            for (int i = F.wave; i < 24 && S.so.next(i, u); i += 8) { const int l_ = F_LANE;
#pragma unroll
                for (int j = 0; j < 4; ++j) tk[i * 256 + l_ + 64 * j] = (unsigned short)row_tok[u.pm * 256 + l_ + 64 * j]; }
            __syncthreads();
        }
        pg8::Gemm g{(const bf16_t*)(ws + WS_XB), (const bf16_t*)(ws + WS_WUP), ntl * 256, 2048, DM, 0x7C7C7C7C, 0x77777777};
        EpiUp E{(bf16_t*)(ws + WS_H), a.b_up};
        pg8::gemm_phase<EpiUp, MoeOrder, true, true, KREP_P6, true>(F.lds, g, S, E, F_TID);
    }
    GRID_BAR();
    STAMP(7);

    for (int rep = 0; rep < REP_P7; ++rep) {
        const int ntl = build_tiles(F, a);
        MoeOrder S; S.so.init(ntl * 256, 1024, F.G, (int)blockIdx.x, ORD_REV7); S.tile_e = F.lds + LX_TILE; S.tok = nullptr; S.ncolt = 4;
        pg8::Gemm g{(const bf16_t*)(ws + WS_H), (const bf16_t*)(ws + WS_WDN), ntl * 256, DM, DFF, 0x7D7D7D7D, 0x77777777};
        EpiDown E{(bf16_t*)(ws + WS_Y), a.b_down, row_gate};
        pg8::gemm_phase<EpiDown, MoeOrder, true, false, KREP_P7, true>(F.lds, g, S, E, F_TID);
    }
    GRID_BAR();
    STAMP(8);

    for (int rep = 0; rep < REP_P8; ++rep) {
        const int lane = F_LANE; const float* X1 = (const float*)(ws + WS_Z); const bf16_t* Y = (const bf16_t*)(ws + WS_Y); const float* stats = (const float*)(ws + WS_ROUTE + 4 * MiB);
        f32x4 gv[4], bv[4], g1[4], b1[4];
#pragma unroll
        for (int j = 0; j < 4; ++j) { gv[j] = ((const f32x4*)a.ln2_g)[lane + 64 * j]; bv[j] = ((const f32x4*)a.ln2_b)[lane + 64 * j]; g1[j] = ((const f32x4*)a.ln1_g)[lane + 64 * j] * ALPHA; b1[j] = ((const f32x4*)a.ln1_b)[lane + 64 * j] * ALPHA; }
        for (int m = F.vcu * 8 + F.wave; m < NTOK; m += F.G * 8) {
            const f32x4* xr = (const f32x4*)(X1 + (size_t)m * DM) + lane; f32x4 v[4]; const f32x2 st = *(const f32x2*)(stats + 2 * m);
#pragma unroll
            for (int j = 0; j < 4; ++j) v[j] = (xr[64 * j] - st[0]) * st[1] * g1[j] + b1[j];
#pragma unroll
            for (int t = 0; t < 4; ++t) { const int dest = inv[m * 4 + t]; const unsigned* yr = (const unsigned*)((const unsigned char*)Y + (size_t)dest * DM) + lane;
#pragma unroll
                for (int j = 0; j < 4; ++j) { const int w = (int)yr[64 * j];
                    v[j][0] += __builtin_amdgcn_cvt_f32_fp8(w, 0) * (1.f / 32.f); v[j][1] += __builtin_amdgcn_cvt_f32_fp8(w, 1) * (1.f / 32.f);
                    v[j][2] += __builtin_amdgcn_cvt_f32_fp8(w, 2) * (1.f / 32.f); v[j][3] += __builtin_amdgcn_cvt_f32_fp8(w, 3) * (1.f / 32.f); } }
            float s = 0.f;
#pragma unroll
            for (int j = 0; j < 4; ++j) s += (v[j][0] + v[j][1]) + (v[j][2] + v[j][3]);
            const float mean = wave_sum(s) * (1.f / DM); float s2 = 0.f;
#pragma unroll
            for (int j = 0; j < 4; ++j) { v[j] = v[j] - mean; s2 += (v[j][0] * v[j][0] + v[j][1] * v[j][1]) + (v[j][2] * v[j][2] + v[j][3] * v[j][3]); }
            const float rstd = 1.f / sqrtf(wave_sum(s2) * (1.f / DM) + LN_EPS);
            f32x4* orow = (f32x4*)(a.out + (size_t)m * DM) + lane;
#pragma unroll
            for (int j = 0; j < 4; ++j) orow[64 * j] = v[j] * rstd * gv[j] + bv[j];
        }
    }
#ifdef PROBE_T1
    STAMP(9);
    if (blockIdx.x == 0) {
        __syncthreads();
        const float t1 = (float)(stamps[PROBE_T1 + 1] - stamps[PROBE_T1]) * 0.01f, t2 = (float)(stamps[PROBE_T2 + 1] - stamps[PROBE_T2]) * 0.01f;
        for (int i = F_TID; i < (1 << 20); i += 512) a.out[1 + i] = t2;
        if (F_TID == 0) a.out[0] = t1 * 10.0f;
    }
#endif
}

extern "C" void kernel_launch(void* const* d_in, const int* in_sizes, int n_in, void* d_out, int out_size, void* d_ws, size_t ws_size, hipStream_t stream) {
    static int grid = 0;
    if (grid == 0) {
        if (n_in != 18 || in_sizes[0] != NTOK * DM || out_size != NTOK * DM || ws_size < WS_END) {
            fprintf(stderr, "kernel_launch: unexpected shapes (n_in %d, in0 %d, out %d, ws %zu need %zu); nothing launched\n", n_in, n_in > 0 ? in_sizes[0] : -1, out_size, ws_size, (size_t)WS_END); grid = -1; return; }
        int dev = 0, cus = 0, per_cu = 0;
        if (hipGetDevice(&dev) != hipSuccess || hipDeviceGetAttribute(&cus, hipDeviceAttributeMultiprocessorCount, dev) != hipSuccess) { grid = -1; return; }
        if (hipFuncSetAttribute((const void*)fwd_megakernel, hipFuncAttributeMaxDynamicSharedMemorySize, LDS_BYTES) != hipSuccess) { fprintf(stderr, "kernel_launch: hipFuncSetAttribute failed\n"); grid = -1; return; }
        if (hipOccupancyMaxActiveBlocksPerMultiprocessor(&per_cu, (const void*)fwd_megakernel, 512, LDS_BYTES) != hipSuccess || per_cu < 1) { fprintf(stderr, "kernel_launch: occupancy query says %d\n", per_cu); per_cu = 1; }
        (void)hipGetLastError();
        grid = cus * (per_cu > 1 ? 1 : per_cu);
        fprintf(stderr, "kernel_launch: grid %d (cus %d, per_cu %d)\n", grid, cus, per_cu);
    }
    if (grid < 0) return;
    if (hipMemsetAsync((char*)d_ws + WS_CTL, 0, CTL_ZERO_BYTES, stream) != hipSuccess) return;
    Args a{};
    const float* const* in = (const float* const*)d_in;
    a.x = in[0]; a.w_in = in[1]; a.w_out = in[2]; a.lq1 = in[3]; a.lk1 = in[4]; a.lq2 = in[5]; a.lk2 = in[6]; a.g_sub = in[7];
    a.ln1_g = in[8]; a.ln1_b = in[9]; a.w_router = in[10]; a.b_router = in[11]; a.w_up = in[12]; a.b_up = in[13]; a.w_down = in[14]; a.b_down = in[15];
    a.ln2_g = in[16]; a.ln2_b = in[17]; a.out = (float*)d_out; a.ws = (unsigned char*)d_ws;
    void* args[] = {&a};
    hipError_t e = hipLaunchCooperativeKernel((void*)fwd_megakernel, dim3(grid), dim3(512), args, LDS_BYTES, stream);
    if (e != hipSuccess) fprintf(stderr, "kernel_launch: cooperative launch failed: %s (grid %d)\n", hipGetErrorString(e), grid);
}
```

```cpp
#include <hip/hip_runtime.h>
#include <hip/hip_cooperative_groups.h>
#include <cstdio>
#include <cstdint>
namespace cg = cooperative_groups;
#ifndef KREP_P1
#define KREP_P1 1
#endif
#ifndef KREP_P3
#define KREP_P3 1
#endif
#ifndef KREP_P6
#define KREP_P6 1
#endif
#ifndef KREP_P7
#define KREP_P7 1
#endif
#ifndef ORD_SWZ
#define ORD_SWZ 0
#endif
#ifndef ORD_REV7
#define ORD_REV7 1
#endif
#ifndef REP_P0
#define REP_P0 1
#endif
#ifndef REP_P1
#define REP_P1 1
#endif
#ifndef REP_A
#define REP_A 1
#endif
#ifndef REP_B
#define REP_B 1
#endif
#ifndef REP_P3
#define REP_P3 1
#endif
#ifndef REP_P6
#define REP_P6 1
#endif
#ifndef REP_P7
#define REP_P7 1
#endif
#ifndef REP_P8
#define REP_P8 1
#endif

#define LAS __attribute__((address_space(3)))
typedef unsigned short bf16_t;
typedef short bf16x8 __attribute__((ext_vector_type(8)));
typedef short s16x4 __attribute__((ext_vector_type(4)));
typedef float f32x4 __attribute__((ext_vector_type(4)));
typedef float f32x2 __attribute__((ext_vector_type(2)));
typedef float f32x16 __attribute__((ext_vector_type(16)));
typedef unsigned u32x4 __attribute__((ext_vector_type(4)));
typedef unsigned u32x2 __attribute__((ext_vector_type(2)));
typedef __bf16 bf16x2_t __attribute__((ext_vector_type(2)));

constexpr int BATCH = 2, SEQ = 16384, DM = 1024, NTOK = BATCH * SEQ;
constexpr int NPROJ = 3072, NE = 32, TOPK = 4, DFF = 1024;
constexpr int NROWS_MAX = NTOK * TOPK + NE * 256;
constexpr float LN_EPS = 1e-5f;
constexpr float ALPHA = 1.189207115002721f;
constexpr float LOG2E = 1.4426950408889634f;
constexpr float C2 = 0.125f * LOG2E;
constexpr float LAM_INIT = 0.2f;
constexpr float NEG_BIG = -1e30f;

constexpr size_t MiB = 1u << 20;
constexpr size_t WS_CTL = 0, CTL_ZERO_BYTES = 65536;
constexpr int CW_QMAX = 64, CW_KMAX = 128, CW_KAMAX = 192, CW_QAMAX = 224, CW_QUEUE = 256, CW_BAR = 4096;
constexpr size_t WS_WIN = 2 * MiB, WS_WOUT = 8 * MiB, WS_WUP = 16 * MiB, WS_WDN = 144 * MiB;
constexpr size_t WS_XB = 208 * MiB;
constexpr size_t WS_PROJ = 272 * MiB;
constexpr size_t PROJ_STRIDE = (size_t)NTOK * 512;
constexpr size_t WS_MIXED = 464 * MiB;
constexpr size_t WS_Z = 272 * MiB;
constexpr size_t WS_H = 400 * MiB;
constexpr size_t WS_Y = 672 * MiB;
constexpr size_t WS_APART = 672 * MiB;
constexpr size_t APART_UNIT = 2 * 1024 * 64 * 4 + 2 * 1024 * 2 * 4;
constexpr size_t WS_ROUTE = 944 * MiB;
constexpr size_t WS_END = 952 * MiB;

constexpr int RING_BYTES = 131072;
constexpr int LX_TILE = 131072;
constexpr int LX_TOK = 132096;
constexpr int LX_MISC = 144384;
constexpr int LDS_BYTES = 147456;

__device__ __forceinline__ unsigned cvtpk(float lo, float hi) { f32x2 v = {lo, hi}; bf16x2_t b = __builtin_convertvector(v, bf16x2_t); return __builtin_bit_cast(unsigned, b); }
__device__ __forceinline__ unsigned cvt4_fp8(float a, float b, float c, float d) { int w = 0; w = __builtin_amdgcn_cvt_pk_fp8_f32(a, b, w, false); w = __builtin_amdgcn_cvt_pk_fp8_f32(c, d, w, true); return (unsigned)w; }
__device__ __forceinline__ float wave_sum(float v) {
#pragma unroll
    for (int o = 1; o < 64; o <<= 1) v += __shfl_xor(v, o);
    return v;
}

namespace pg8 {
constexpr int BM = 256, BK = 64, HALF = 128, HTB = HALF * BK * 2, STAGE_BYTES = 8 * HTB, NXCD = 8, WGM = 8;
__host__ __device__ __forceinline__ int lds_byte(int r, int c) { const int st = (r >> 4) * 2 + (c >> 5), rr = r & 15, cc = c & 31, ob = rr * 64 + cc * 2; return st * 1024 + (ob ^ (((ob >> 9) & 1) << 5)); }
__host__ __device__ __forceinline__ void stage_rc(int b, int& R, int& C) { const int st = b / 1024, sb = b % 1024, swz = sb ^ (((sb >> 9) & 1) << 5); R = (st >> 1) * 16 + swz / 64; C = (st & 1) * 32 + (swz % 64) / 2; }
__host__ __device__ __forceinline__ int perm32(int rho) { const int n = rho >> 4, i = rho & 15; return 8 * (i >> 2) + 4 * n + (i & 3); }

struct Unit { int pm, pn; };
struct Gemm { const bf16_t* A; const bf16_t* Bt; int M, N, K; int scale_a, scale_b; };
typedef int v4i_t __attribute__((ext_vector_type(4))); typedef int v8i_t __attribute__((ext_vector_type(8)));

struct StaticOrder {
    int nM, nN, nwg, G, c, rev, swz;
    __host__ __device__ void init(int M, int N, int G_, int c_, int rev_ = 0, int swz_ = ORD_SWZ) { nM = M / BM; nN = N / BM; nwg = nM * nN; G = G_; c = c_; rev = rev_; swz = swz_; }
    __host__ __device__ bool next(int i, Unit& u) const {
        const long L = (long)i * G + c; if (L >= nwg) return false;
        int wgid = (rev == 1) ? nwg - 1 - (int)L : (int)L;
        if (swz) { const int q = nwg / NXCD, r = nwg % NXCD, xcd = wgid % NXCD; int off = wgid / NXCD; const int len = xcd < r ? q + 1 : q;
            if (rev == 2) off = len - 1 - off;
            wgid = (xcd < r ? xcd * (q + 1) : r * (q + 1) + (xcd - r) * q) + off; }
        const int nig = WGM * nN, gid = wgid / nig, fm = gid * WGM, gsz = (nM - fm) < WGM ? (nM - fm) : WGM;
        u.pm = fm + ((wgid % nig) % gsz); u.pn = (wgid % nig) / gsz; return true;
    }
    __device__ __forceinline__ const LAS unsigned short* tok_table(int) const { return nullptr; }
};

template <class Epi, class Sched, bool ALIGN_EPI, bool GATHER, int KREP = 1, bool F8 = false>
__device__ __forceinline__ void gemm_phase(LAS unsigned char* lds, const Gemm g, const Sched& S, const Epi& E, const int tid) {
    const int wid = __builtin_amdgcn_readfirstlane(tid >> 6), lane = tid & 63, wr = wid >> 2, wc = wid & 3, fr = lane & 15, fq = lane >> 4;
    constexpr int ES = F8 ? 1 : 2;
    (void)g.scale_a; (void)g.scale_b;
    const int K = g.K, ntr = K * ES / (BK * 2), nt = ntr * KREP;
    unsigned voffA[2], voffB[2]; int rowA[2];
#pragma unroll
    for (int i = 0; i < 2; ++i) { int R, C; stage_rc(tid * 16 + i * 8192, R, C); const int Rb = Epi::PERM ? ((R & ~31) + perm32(R & 31)) : R;
        voffA[i] = GATHER ? (unsigned)(C * 2) : (unsigned)(R * K * ES + C * 2); voffB[i] = (unsigned)(Rb * K * ES + C * 2); rowA[i] = R; }
    const size_t kstep = (size_t)(BK * 2);
    const size_t hstep = (size_t)HALF * K * ES;
    const size_t tstep = 2 * hstep;
    const unsigned ldsw = (unsigned)wid * 1024u;
    const int aoff = lds_byte(wr * 64 + fr, fq * 8), boff = lds_byte(wc * 32 + fr, fq * 8);
    const int aoff8 = lds_byte(wr * 64 + fr, fq * 16), boff8 = lds_byte(wc * 32 + fr, fq * 16);
#define PG8_SA(b, h) (((b) * 2 + (h)) * HTB)
#define PG8_SB(b, h) ((4 + (b) * 2 + (h)) * HTB)
#define PG8_STAGE(bufoff, gbase, voff) do { _Pragma("unroll") for (int _i = 0; _i < 2; ++_i) \
        __builtin_amdgcn_global_load_lds((const unsigned*)((const char*)(gbase) + (voff)[_i]), (LAS unsigned*)(lds + (bufoff) + ldsw + _i * 8192), 16, 0, 0); } while (0)
#define PG8_STAGE_A(bufoff, NX, h, kb) do { if constexpr (GATHER) { const unsigned* _o = (NX) ? gN[h] : gC[h]; PG8_STAGE(bufoff, (const char*)g.A + (kb), _o); } \
        else { PG8_STAGE(bufoff, ((NX) ? nA : cA) + (h) * hstep + (kb), voffA); } } while (0)
#define PG8_LDA(dst, b, h) do { _Pragma("unroll") for (int m = 0; m < 4; ++m) _Pragma("unroll") for (int k = 0; k < 2; ++k) dst[m][k] = *(const LAS bf16x8*)(lds + PG8_SA(b, h) + (F8 ? aoff8 + k * 16 : aoff + k * 1024) + m * 2048); } while (0)
#define PG8_LDB(dst, b, h) do { _Pragma("unroll") for (int n = 0; n < 2; ++n) _Pragma("unroll") for (int k = 0; k < 2; ++k) dst[n][k] = *(const LAS bf16x8*)(lds + PG8_SB(b, h) + (F8 ? boff8 + k * 16 : boff + k * 1024) + n * 2048); } while (0)
#define PG8_F8OP(x) __builtin_shufflevector(__builtin_bit_cast(v4i_t, x[0]), __builtin_bit_cast(v4i_t, x[1]), 0, 1, 2, 3, 4, 5, 6, 7)
#define PG8_MMA(ai, bj, At, Bt) do { __builtin_amdgcn_s_setprio(1); _Pragma("unroll") for (int m = 0; m < 4; ++m) _Pragma("unroll") for (int n = 0; n < 2; ++n) { \
        if constexpr (F8) { const v8i_t _a = PG8_F8OP(Bt[n]), _b = PG8_F8OP(At[m]); asm volatile("v_mfma_f32_16x16x128_f8f6f4 %0, %1, %2, %0" : "+v"(acc[ai][bj][m][n]) : "v"(_a), "v"(_b)); } \
        else { _Pragma("unroll") for (int k = 0; k < 2; ++k) acc[ai][bj][m][n] = __builtin_amdgcn_mfma_f32_16x16x32_bf16(Bt[n][k], At[m][k], acc[ai][bj][m][n], 0, 0, 0); } } \
        __builtin_amdgcn_s_setprio(0); } while (0)
#define PG8_WAIT_V(n) asm volatile("s_waitcnt vmcnt(" #n ")" ::: "memory")
#define PG8_WAIT_L(n) asm volatile("s_waitcnt lgkmcnt(" #n ")" ::: "memory")
#define PG8_BAR __builtin_amdgcn_s_barrier()
#define PG8_SCHED __builtin_amdgcn_sched_barrier(0)
#define PG8_GOFF(dst, ui_) do { if constexpr (GATHER) { const LAS unsigned short* _t = S.tok_table(ui_); _Pragma("unroll") for (int _h = 0; _h < 2; ++_h) _Pragma("unroll") for (int _i = 0; _i < 2; ++_i) \
        dst[_h][_i] = (unsigned)_t[_h * HALF + rowA[_i]] * (unsigned)(K * ES) + voffA[_i]; } } while (0)
    Unit cur, nxt; int ui = 0;
    if (!S.next(0, cur)) return;
    f32x4 acc[2][2][4][2];
    E.init(acc, cur, wc, fq);
    bf16x8 At[4][2], B0[2][2], B1[2][2];
    unsigned gC[2][2] = {{0u, 0u}, {0u, 0u}}, gN[2][2] = {{0u, 0u}, {0u, 0u}};
    PG8_GOFF(gC, 0);
    const char* cA = (const char*)g.A + (GATHER ? (size_t)0 : (size_t)cur.pm * tstep); const char* cB = (const char*)g.Bt + (size_t)cur.pn * tstep;
    const char* nA = cA;
    {
        PG8_STAGE(PG8_SB(0, 0), cB, voffB); PG8_STAGE(PG8_SB(0, 1), cB + hstep, voffB); PG8_STAGE_A(PG8_SA(0, 0), false, 0, 0); PG8_STAGE_A(PG8_SA(0, 1), false, 1, 0);
        if (wr == 1) PG8_BAR;
        PG8_WAIT_V(2); PG8_BAR;
        PG8_STAGE(PG8_SB(1, 0), cB + kstep, voffB); PG8_STAGE_A(PG8_SA(1, 0), false, 0, kstep); PG8_STAGE(PG8_SB(1, 1), cB + hstep + kstep, voffB);
        PG8_WAIT_V(6); PG8_BAR;
    }
    for (;;) {
        const bool has_next = S.next(ui + 1, nxt);
        nA = has_next ? (const char*)g.A + (GATHER ? (size_t)0 : (size_t)nxt.pm * tstep) : cA; const char* nB = has_next ? (const char*)g.Bt + (size_t)nxt.pn * tstep : cB;
        if (has_next) { PG8_GOFF(gN, ui + 1); } else {
#pragma unroll
            for (int h = 0; h < 2; ++h)
#pragma unroll
                for (int i = 0; i < 2; ++i) gN[h][i] = gC[h][i]; }
#pragma unroll 1
        for (int t = 0; t < nt; t += 2) {
            const bool last = (t == nt - 2);
            const size_t k1 = (size_t)((t + 1) % ntr) * kstep;
            const size_t k2 = last ? (size_t)0 : (size_t)((t + 2) % ntr) * kstep, k3 = k2 + kstep;
            const char* b2 = last ? nB : cB + (size_t)((t + 2) % ntr) * kstep; const char* b3 = b2 + kstep;
            PG8_LDB(B0, 0, 0); PG8_LDB(B1, 0, 1); PG8_SCHED; PG8_LDA(At, 0, 0); PG8_STAGE_A(PG8_SA(1, 1), false, 1, k1);
            PG8_WAIT_V(8); PG8_WAIT_L(0); PG8_BAR; PG8_MMA(0, 0, At, B0); PG8_MMA(0, 1, At, B1); PG8_BAR; PG8_SCHED;
            PG8_LDA(At, 0, 1); PG8_STAGE(PG8_SB(0, 0), b2, voffB); PG8_STAGE(PG8_SB(0, 1), b2 + hstep, voffB); PG8_STAGE_A(PG8_SA(0, 0), last, 0, k2);
            PG8_WAIT_V(8); PG8_WAIT_L(0); PG8_BAR; PG8_MMA(1, 0, At, B0); PG8_MMA(1, 1, At, B1); PG8_BAR; PG8_SCHED;
            PG8_LDB(B0, 1, 0); PG8_LDB(B1, 1, 1); PG8_SCHED; PG8_LDA(At, 1, 0); PG8_STAGE_A(PG8_SA(0, 1), last, 1, k2);
            PG8_WAIT_V(8); PG8_WAIT_L(0); PG8_BAR; PG8_MMA(0, 0, At, B0); PG8_MMA(0, 1, At, B1); PG8_BAR; PG8_SCHED;
            PG8_LDA(At, 1, 1); PG8_STAGE(PG8_SB(1, 0), b3, voffB); PG8_STAGE(PG8_SB(1, 1), b3 + hstep, voffB); PG8_STAGE_A(PG8_SA(1, 0), last, 0, k3);
            PG8_WAIT_V(8); PG8_WAIT_L(0); PG8_BAR; PG8_MMA(1, 0, At, B0); PG8_MMA(1, 1, At, B1); PG8_BAR; PG8_SCHED;
        }
        if constexpr (ALIGN_EPI) { if (wr == 0) PG8_BAR; }
        if constexpr (F8) asm volatile("s_nop 15\n\ts_nop 15" ::: "memory");
        if constexpr (KREP > 1) {
_Pragma("unroll") for (int a_ = 0; a_ < 2; ++a_) _Pragma("unroll") for (int b_ = 0; b_ < 2; ++b_) _Pragma("unroll") for (int m_ = 0; m_ < 4; ++m_) _Pragma("unroll") for (int n_ = 0; n_ < 2; ++n_) acc[a_][b_][m_][n_] = acc[a_][b_][m_][n_] * (1.0f / KREP); }
        E(acc, cur, wr, wc, fr, fq);
        if (!has_next) break;
        E.init(acc, nxt, wc, fq);
        cur = nxt; cA = nA; cB = nB; ++ui;
#pragma unroll
        for (int h = 0; h < 2; ++h)
#pragma unroll
            for (int i = 0; i < 2; ++i) gC[h][i] = gN[h][i];
        if constexpr (ALIGN_EPI) { if (wr == 1) PG8_BAR; }
    }
    PG8_WAIT_V(0);
    if constexpr (!ALIGN_EPI) { if (wr == 0) PG8_BAR; }
    PG8_BAR;
#undef PG8_SA
#undef PG8_SB
#undef PG8_STAGE
#undef PG8_STAGE_A
#undef PG8_LDA
#undef PG8_LDB
#undef PG8_MMA
#undef PG8_F8OP
#undef PG8_WAIT_V
#undef PG8_WAIT_L
#undef PG8_BAR
#undef PG8_SCHED
#undef PG8_GOFF
}
}

struct Args {
    const float* x; const float* w_in; const float* w_out; const float* lq1; const float* lk1; const float* lq2; const float* lk2; const float* g_sub;
    const float* ln1_g; const float* ln1_b; const float* w_router; const float* b_router; const float* w_up; const float* b_up; const float* w_down; const float* b_down;
    const float* ln2_g; const float* ln2_b; float* out; unsigned char* ws;
};
struct Frame {
    LAS unsigned char* lds; int wave, vcu, G;
};
__device__ __forceinline__ int lane_now() { int l; asm volatile("v_mbcnt_lo_u32_b32 %0, -1, 0\n\tv_mbcnt_hi_u32_b32 %0, -1, %0" : "=v"(l)); return l; }
#define F_LANE lane_now()
#define F_TID (F.wave * 64 + lane_now())

struct EpiProj {
    static constexpr bool PERM = true;
    bf16_t* O; unsigned* ctl;
    __device__ __forceinline__ void init(f32x4 (&acc)[2][2][4][2], const pg8::Unit&, int, int) const {
#pragma unroll
        for (int a_ = 0; a_ < 2; ++a_)
#pragma unroll
            for (int b_ = 0; b_ < 2; ++b_)
#pragma unroll
                for (int m_ = 0; m_ < 4; ++m_)
#pragma unroll
                    for (int n_ = 0; n_ < 2; ++n_) acc[a_][b_][m_][n_] = (f32x4){0.f, 0.f, 0.f, 0.f};
    }
    __device__ __forceinline__ void operator()(const f32x4 (&acc)[2][2][4][2], const pg8::Unit& u, int wr, int wc, int fr, int fq) const {
        const int t = u.pn >> 1; const float sc = (t == 0 || t == 3) ? C2 : 1.f; const bool nrm = (t == 3 || t == 4 || t == 0 || t == 1);
        bf16_t* base = O + (size_t)t * PROJ_STRIDE; const int row0 = u.pm * 256 + wr * 64 + fr, col0 = (u.pn & 1) * 256 + wc * 32 + 8 * fq;
        float mx0 = 0.f, mx1 = 0.f;
#pragma unroll
        for (int ai = 0; ai < 2; ++ai)
#pragma unroll
            for (int m = 0; m < 4; ++m) { bf16_t* rowp = base + (size_t)(row0 + ai * 128 + m * 16) * 512 + col0;
#pragma unroll
                for (int bj = 0; bj < 2; ++bj) { const f32x4 v0 = acc[ai][bj][m][0] * sc, v1 = acc[ai][bj][m][1] * sc; u32x4 w;
                    w.x = cvtpk(v0[0], v0[1]); w.y = cvtpk(v0[2], v0[3]); w.z = cvtpk(v1[0], v1[1]); w.w = cvtpk(v1[2], v1[3]);
                    if (t >= 4) {
                        const int row = row0 + ai * 128 + m * 16, bb = row >> 14, sq = row & (SEQ - 1), key = sq & 63, hh = (u.pn & 1) * 2 + bj;
                        bf16_t* tb = O + 4 * PROJ_STRIDE + ((size_t)((bb * 4 + hh) * 256 + (sq >> 6))) * 16384;
                        if (t == 4) *(u32x4*)(tb + (4 * wc + fq) * 512 + key * 8) = w;
                        else *(u32x4*)(tb + 8192 + (wc * 4 + (key >> 4)) * 512 + (key & 15) * 32 + fq * 8) = w;
                    } else *(u32x4*)(rowp + bj * 128) = w;
                    if (nrm) { float ss = 0.f;
#pragma unroll
                        for (int j = 0; j < 4; ++j) { const float lo = __uint_as_float(w[j] << 16), hi = __uint_as_float(w[j] & 0xFFFF0000u); ss += lo * lo + hi * hi; }
                        ss += __shfl_xor(ss, 16); ss += __shfl_xor(ss, 32);
                        if (bj == 0) mx0 = fmaxf(mx0, ss); else mx1 = fmaxf(mx1, ss); } } }
        if (nrm) {
#pragma unroll
            for (int ofs = 1; ofs < 16; ofs <<= 1) { mx0 = fmaxf(mx0, __shfl_xor(mx0, ofs)); mx1 = fmaxf(mx1, __shfl_xor(mx1, ofs)); }
            if (fr == 0 && fq == 0) { const int b = u.pm >> 6, cw = (t == 3) ? CW_QMAX : (t == 4 ? CW_KMAX : (t == 1 ? CW_KAMAX : CW_QAMAX));
                atomicMax(ctl + cw + (((b * 4 + (u.pn & 1) * 2 + 0) * 2 + (wc >> 1)) * 2 + (wc & 1)), __float_as_uint(mx0));
                atomicMax(ctl + cw + (((b * 4 + (u.pn & 1) * 2 + 1) * 2 + (wc >> 1)) * 2 + (wc & 1)), __float_as_uint(mx1)); }
        }
    }
};
struct EpiZ {
    static constexpr bool PERM = false;
    const float* x; float* z;
    __device__ __forceinline__ void init(f32x4 (&acc)[2][2][4][2], const pg8::Unit&, int, int) const {
#pragma unroll
        for (int a_ = 0; a_ < 2; ++a_)
#pragma unroll
            for (int b_ = 0; b_ < 2; ++b_)
#pragma unroll
                for (int m_ = 0; m_ < 4; ++m_)
#pragma unroll
                    for (int n_ = 0; n_ < 2; ++n_) acc[a_][b_][m_][n_] = (f32x4){0.f, 0.f, 0.f, 0.f};
    }
    __device__ __forceinline__ void operator()(const f32x4 (&acc)[2][2][4][2], const pg8::Unit& u, int wr, int wc, int fr, int fq) const {
        const int col0 = u.pn * 256 + wc * 32 + 4 * fq;
#pragma unroll
        for (int ai = 0; ai < 2; ++ai)
#pragma unroll
            for (int m = 0; m < 4; ++m) { const size_t off = (size_t)(u.pm * 256 + ai * 128 + wr * 64 + m * 16 + fr) * DM + col0; f32x4 xv[2][2];
#pragma unroll
                for (int bj = 0; bj < 2; ++bj)
#pragma unroll
                    for (int n = 0; n < 2; ++n) xv[bj][n] = *(const f32x4*)(x + off + bj * 128 + n * 16);
#pragma unroll
                for (int bj = 0; bj < 2; ++bj)
#pragma unroll
                    for (int n = 0; n < 2; ++n) *(f32x4*)(z + off + bj * 128 + n * 16) = xv[bj][n] * ALPHA + acc[ai][bj][m][n]; }
    }
};
__device__ __forceinline__ f32x2 swiglu4_pk(f32x2 g, f32x2 u) {
    g = __builtin_elementwise_min(g, (f32x2){7.0f * 2048.f, 7.0f * 2048.f});
    u = __builtin_elementwise_min(__builtin_elementwise_max(u, (f32x2){-6.0f * 2048.f, -6.0f * 2048.f}), (f32x2){8.0f * 2048.f, 8.0f * 2048.f});
    const f32x2 a_ = g * (-1.702f * LOG2E / 2048.f) + 20.0f;
    f32x2 e_; e_.x = __builtin_amdgcn_exp2f(a_.x); e_.y = __builtin_amdgcn_exp2f(a_.y);
    const f32x2 d_ = e_ + 1048576.f;
    f32x2 s_; s_.x = __builtin_amdgcn_rcpf(d_.x); s_.y = __builtin_amdgcn_rcpf(d_.y);
    const f32x2 t_ = g * s_;
    return t_ * u;
}
struct EpiUp {
    static constexpr bool PERM = true;
    bf16_t* H; const float* b_up;
    __device__ __forceinline__ void init(f32x4 (&acc)[2][2][4][2], const pg8::Unit& u, int wc, int fq) const {
        const int e = u.pn >> 3, pnl = u.pn & 7, hcol0 = pnl * 128 + wc * 32 + 8 * fq;
        const float* bg = b_up + (size_t)e * 2048 + hcol0; const float* bu = bg + 1024;
        const f32x4 bg0 = *(const f32x4*)bg * 2048.f, bg1 = *(const f32x4*)(bg + 4) * 2048.f, bu0 = *(const f32x4*)bu * 2048.f + 2048.f, bu1 = *(const f32x4*)(bu + 4) * 2048.f + 2048.f;
#pragma unroll
        for (int a_ = 0; a_ < 2; ++a_)
#pragma unroll
            for (int m_ = 0; m_ < 4; ++m_) { acc[a_][0][m_][0] = bg0; acc[a_][0][m_][1] = bg1; acc[a_][1][m_][0] = bu0; acc[a_][1][m_][1] = bu1; }
    }
    __device__ __forceinline__ void operator()(const f32x4 (&acc)[2][2][4][2], const pg8::Unit& u, int wr, int wc, int fr, int fq) const {
        const int e = u.pn >> 3, pnl = u.pn & 7, hcol0 = pnl * 128 + wc * 32 + 8 * fq;
#pragma unroll
        for (int ai = 0; ai < 2; ++ai)
#pragma unroll
            for (int m = 0; m < 4; ++m) { const size_t row = (size_t)(u.pm * 256 + ai * 128 + wr * 64 + m * 16 + fr);
                const f32x4 g0 = acc[ai][0][m][0], g1 = acc[ai][0][m][1], u0 = acc[ai][1][m][0], u1 = acc[ai][1][m][1];
                const f32x2 r0 = swiglu4_pk((f32x2){g0[0], g0[1]}, (f32x2){u0[0], u0[1]}), r1 = swiglu4_pk((f32x2){g0[2], g0[3]}, (f32x2){u0[2], u0[3]});
                const f32x2 r2 = swiglu4_pk((f32x2){g1[0], g1[1]}, (f32x2){u1[0], u1[1]}), r3 = swiglu4_pk((f32x2){g1[2], g1[3]}, (f32x2){u1[2], u1[3]});
                u32x2 w8; w8.x = cvt4_fp8(r0.x, r0.y, r1.x, r1.y); w8.y = cvt4_fp8(r2.x, r2.y, r3.x, r3.y);
                *(u32x2*)((unsigned char*)H + row * DFF + hcol0) = w8; }
    }
};
struct EpiDown {
    static constexpr bool PERM = true;
    bf16_t* Y; const float* b_down; const float* row_gate;
    __device__ __forceinline__ void init(f32x4 (&acc)[2][2][4][2], const pg8::Unit& u, int wc, int fq) const {
        const int e = u.pn >> 2, pnl = u.pn & 3, col0 = pnl * 256 + wc * 32 + 8 * fq;
#pragma unroll
        for (int bj = 0; bj < 2; ++bj)
#pragma unroll
            for (int n = 0; n < 2; ++n) { const f32x4 bv = *(const f32x4*)(b_down + (size_t)e * DM + col0 + bj * 128 + 4 * n) * 1024.f;
#pragma unroll
                for (int a_ = 0; a_ < 2; ++a_)
#pragma unroll
                    for (int m_ = 0; m_ < 4; ++m_) acc[a_][bj][m_][n] = bv; }
    }
    __device__ __forceinline__ void operator()(const f32x4 (&acc)[2][2][4][2], const pg8::Unit& u, int wr, int wc, int fr, int fq) const {
        const int e = u.pn >> 2, pnl = u.pn & 3, col0 = pnl * 256 + wc * 32 + 8 * fq;
        float gts[2][4];
#pragma unroll
        for (int ai = 0; ai < 2; ++ai)
#pragma unroll
            for (int m = 0; m < 4; ++m) gts[ai][m] = row_gate[(size_t)(u.pm * 256 + ai * 128 + wr * 64 + m * 16 + fr)];
#pragma unroll
        for (int ai = 0; ai < 2; ++ai)
#pragma unroll
            for (int m = 0; m < 4; ++m) { const size_t row = (size_t)(u.pm * 256 + ai * 128 + wr * 64 + m * 16 + fr); const float gt = gts[ai][m];
#pragma unroll
                for (int bj = 0; bj < 2; ++bj) { const f32x4 v0 = acc[ai][bj][m][0] * (gt * (32.f / 1024.f)), v1 = acc[ai][bj][m][1] * (gt * (32.f / 1024.f)); u32x2 w;
                    w.x = cvt4_fp8(v0[0], v0[1], v0[2], v0[3]); w.y = cvt4_fp8(v1[0], v1[1], v1[2], v1[3]); *(u32x2*)((unsigned char*)Y + row * DM + col0 + bj * 128) = w; } }
    }
};
struct MoeOrder {
    pg8::StaticOrder so; const LAS unsigned char* tile_e; const LAS unsigned short* tok; int ncolt;
    __device__ __forceinline__ bool next(int i, pg8::Unit& u) const {
        if (!so.next(i, u)) return false;
        const int e = __builtin_amdgcn_readfirstlane((int)tile_e[u.pm]); u.pn = e * ncolt + u.pn; return true; }
    __device__ __forceinline__ const LAS unsigned short* tok_table(int ui) const { return tok + ui * 256; }
};

__device__ __forceinline__ void p0_transpose_item(const float* W, int K, int N, bf16_t* WT, int k0, int n0, int row0, LAS float* scr, int lane) {
#pragma unroll 8
    for (int i = 0; i < 32; ++i) { const int kk = 2 * i + (lane >> 5); scr[kk * 33 + (lane & 31)] = W[(size_t)(k0 + kk) * N + n0 + (lane & 31)]; }
    asm volatile("s_waitcnt lgkmcnt(0)" ::: "memory");
    const int c = lane & 7;
#pragma unroll
    for (int j = 0; j < 4; ++j) { const int n = (lane >> 3) + 8 * j; const LAS float* s = scr + (8 * c) * 33 + n;
        u32x4 o; o.x = cvtpk(s[0 * 33], s[1 * 33]); o.y = cvtpk(s[2 * 33], s[3 * 33]); o.z = cvtpk(s[4 * 33], s[5 * 33]); o.w = cvtpk(s[6 * 33], s[7 * 33]);
        *(u32x4*)(WT + (size_t)(row0 + n) * K + k0 + 8 * c) = o; }
    asm volatile("s_waitcnt lgkmcnt(0)" ::: "memory");
}
__device__ __forceinline__ void p0_transpose_item_f8(const float* W, int K, int N, unsigned char* WT, int k0, int n0, int row0, LAS float* scr, int lane) {
#pragma unroll 8
    for (int i = 0; i < 32; ++i) { const int kk = 2 * i + (lane >> 5); scr[kk * 33 + (lane & 31)] = W[(size_t)(k0 + kk) * N + n0 + (lane & 31)]; }
    asm volatile("s_waitcnt lgkmcnt(0)" ::: "memory");
    const int c = lane & 7;
#pragma unroll
    for (int j = 0; j < 4; ++j) { const int n = (lane >> 3) + 8 * j; const LAS float* s = scr + (8 * c) * 33 + n;
        u32x2 o; o.x = cvt4_fp8(256.f * s[0 * 33], 256.f * s[1 * 33], 256.f * s[2 * 33], 256.f * s[3 * 33]); o.y = cvt4_fp8(256.f * s[4 * 33], 256.f * s[5 * 33], 256.f * s[6 * 33], 256.f * s[7 * 33]);
        *(u32x2*)(WT + (size_t)(row0 + n) * K + k0 + 8 * c) = o; }
    asm volatile("s_waitcnt lgkmcnt(0)" ::: "memory");
}
__device__ __forceinline__ void p0_prologue(const Frame& F, const Args& a) {
    LAS float* scr = (LAS float*)(F.lds + F.wave * 16384);
    const int gw = F.vcu * 8 + F.wave, NGW = F.G * 8;
    bf16_t* WinT = (bf16_t*)(a.ws + WS_WIN); bf16_t* WoutT = (bf16_t*)(a.ws + WS_WOUT); bf16_t* WupT = (bf16_t*)(a.ws + WS_WUP); bf16_t* WdnT = (bf16_t*)(a.ws + WS_WDN);
    constexpr int I_IN = 16 * 96, I_OUT = 16 * 32, I_UP = 16 * 64, I_DN = 16 * 32;
    constexpr int NITEMS = I_IN + I_OUT;
    for (int it = gw; it < NITEMS; it += NGW) {
        int r = it;
        if (r < I_IN) { const int kb = r / 96, nb = r % 96; p0_transpose_item(a.w_in, DM, NPROJ, WinT, 64 * kb, 32 * nb, 32 * nb, scr, F_LANE); continue; } r -= I_IN;
        if (r < I_OUT) { const int kb = r / 32, nb = r % 32; p0_transpose_item(a.w_out, DM, DM, WoutT, 64 * kb, 32 * nb, 32 * nb, scr, F_LANE); continue; } r -= I_OUT;
        if (r < NE * I_UP) { const int e = r / I_UP, q = r % I_UP, kb = q / 64, nb = q % 64, n0 = 32 * nb;
            const int nn = n0 & 1023, row0 = (nn >> 7) * 256 + (n0 >> 10) * 128 + (nn & 127);
            p0_transpose_item_f8(a.w_up + (size_t)e * DM * 2048, DM, 2048, (unsigned char*)WupT + (size_t)e * 2048 * DM, 64 * kb, n0, row0, scr, F_LANE); continue; } r -= NE * I_UP;
        { const int e = r / I_DN, q = r % I_DN, kb = q / 32, nb = q % 32; p0_transpose_item_f8(a.w_down + (size_t)e * DFF * DM, DFF, DM, (unsigned char*)WdnT + (size_t)e * DM * DFF, 64 * kb, 32 * nb, 32 * nb, scr, F_LANE); }
    }
    bf16_t* XB = (bf16_t*)(a.ws + WS_XB);
    {
        f32x4 vn[4]; int m = gw;
        if (m < NTOK) { const f32x4* xr = (const f32x4*)(a.x + (size_t)m * DM) + F_LANE;
#pragma unroll
            for (int j = 0; j < 4; ++j) vn[j] = xr[64 * j]; }
        for (; m < NTOK; m += NGW) { f32x4 v[4];
#pragma unroll
            for (int j = 0; j < 4; ++j) v[j] = vn[j];
            if (m + NGW < NTOK) { const f32x4* xr = (const f32x4*)(a.x + (size_t)(m + NGW) * DM) + F_LANE;
#pragma unroll
                for (int j = 0; j < 4; ++j) vn[j] = xr[64 * j]; }
            unsigned long long* o8 = (unsigned long long*)(XB + (size_t)m * DM) + F_LANE;
#pragma unroll
            for (int j = 0; j < 4; ++j) o8[64 * j] = (unsigned long long)cvtpk(v[j][0], v[j][1]) | ((unsigned long long)cvtpk(v[j][2], v[j][3]) << 32); }
    }
}

__device__ __forceinline__ void glds16(const void* gsrc, unsigned lds_dst) { unsigned keep;
    asm volatile("s_mov_b32 %0, m0\n\ts_mov_b32 m0, %2\n\ts_nop 0\n\tglobal_load_lds_dwordx4 %1, off\n\ts_mov_b32 m0, %0" : "=&s"(keep) : "v"(gsrc), "s"(lds_dst) : "memory"); }
__device__ __forceinline__ int crow(int r, int hi) { return (r & 3) + 8 * (r >> 2) + 4 * hi; }
typedef LAS const char* lds_cptr;
typedef short v4i16_t __attribute__((ext_vector_type(4)));
__device__ __forceinline__ s16x4 vtr(lds_cptr p) { return __builtin_bit_cast(s16x4, __builtin_amdgcn_ds_read_tr16_b64_v4i16((LAS v4i16_t*)p)); }
#define MX3(a, b, c) __builtin_fmaxf(__builtin_fmaxf((a), (b)), (c))
__device__ __forceinline__ float rowmax(const f32x16& p0, const f32x16& p1) {
    float a = MX3(p0[0], p0[1], p1[0]), b = MX3(p0[2], p0[3], p1[1]); a = MX3(a, p1[2], p1[3]);
#pragma unroll
    for (int r = 4; r < 16; r += 4) { a = MX3(a, p0[r], p0[r + 1]); b = MX3(b, p0[r + 2], p0[r + 3]); a = MX3(a, p1[r], p1[r + 1]); b = MX3(b, p1[r + 2], p1[r + 3]); }
    float m = __builtin_fmaxf(a, b); auto rr = __builtin_amdgcn_permlane32_swap(__float_as_uint(m), __float_as_uint(m), false, false);
    return __builtin_fmaxf(__uint_as_float(rr[0]), __uint_as_float(rr[1]));
}
__device__ __forceinline__ float halfsum(float v) { auto rr = __builtin_amdgcn_permlane32_swap(__float_as_uint(v), __float_as_uint(v), false, false); return __uint_as_float(rr[0]) + __uint_as_float(rr[1]); }
#define MFMA32(a, b, c) __builtin_amdgcn_mfma_f32_32x32x16_bf16(a, b, c, 0, 0, 0)

template <int ND>
__device__ __forceinline__ void softmax_tile(f32x16& p0, f32x16& p1, float& mhat, float& lsum, f32x16 (&o)[ND], u32x4 (&pw)[4]) {
    const float rm = rowmax(p0, p1);
    const float mnew = __builtin_fmaxf(mhat, rm);
    if (__any(mnew != mhat)) {
        const float al = __builtin_amdgcn_exp2f(mhat - mnew); lsum *= al;
#pragma unroll
        for (int d = 0; d < ND; ++d)
#pragma unroll
            for (int r = 0; r < 16; ++r) o[d][r] *= al;
        mhat = mnew;
    }
    float s = 0.f;
#pragma unroll
    for (int r = 0; r < 16; ++r) { p0[r] = __builtin_amdgcn_exp2f(p0[r] - mhat); p1[r] = __builtin_amdgcn_exp2f(p1[r] - mhat); s += p0[r] + p1[r]; }
    lsum += s;
    pw[0] = (u32x4){cvtpk(p0[0], p0[1]), cvtpk(p0[2], p0[3]), cvtpk(p0[4], p0[5]), cvtpk(p0[6], p0[7])};
    pw[1] = (u32x4){cvtpk(p0[8], p0[9]), cvtpk(p0[10], p0[11]), cvtpk(p0[12], p0[13]), cvtpk(p0[14], p0[15])};
    pw[2] = (u32x4){cvtpk(p1[0], p1[1]), cvtpk(p1[2], p1[3]), cvtpk(p1[4], p1[5]), cvtpk(p1[6], p1[7])};
    pw[3] = (u32x4){cvtpk(p1[8], p1[9]), cvtpk(p1[10], p1[11]), cvtpk(p1[12], p1[13]), cvtpk(p1[14], p1[15])};
}
template <int ND>
__device__ __forceinline__ void pv_tile(f32x16 (&o)[ND], lds_cptr vbase, const u32x4 (&pw)[4]) {
#pragma unroll
    for (int d0 = 0; d0 < ND; ++d0)
#pragma unroll
        for (int ks = 0; ks < 4; ++ks) {
            const s16x4 lo = vtr(vbase + d0 * 4096 + ks * 1024), hi = vtr(vbase + d0 * 4096 + ks * 1024 + 512);
            const bf16x8 vf = (bf16x8){lo[0], lo[1], lo[2], lo[3], hi[0], hi[1], hi[2], hi[3]};
            o[d0] = MFMA32(vf, __builtin_bit_cast(bf16x8, pw[ks]), o[d0]);
        }
}

__device__ __forceinline__ unsigned bfb(float x) { return cvtpk(x, 0.f) & 0xFFFFu; }
__device__ __forceinline__ float bff(unsigned b) { return __uint_as_float(b << 16); }
__device__ __forceinline__ void bf_split3(float x, unsigned& h, unsigned& m, unsigned& l) { h = bfb(x); const float r1 = x - bff(h); m = bfb(r1); const float r2 = r1 - bff(m); l = bfb(r2); }
__device__ __forceinline__ void attnB_finish(const Frame& F, const Args& a, f32x16 (&o)[4], float lsum, float lam, size_t rowbase, int qpos, int h, int c, int qs, int r32, int hi) {
    LAS unsigned char* L = F.lds;
    const float inv = 1.0f / halfsum(lsum);
    LAS float* ex = (LAS float*)(L + 65536);
    __syncthreads();
    if (c == 1) {
#pragma unroll
        for (int d0 = 0; d0 < 4; ++d0)
#pragma unroll
            for (int r = 0; r < 16; ++r) ex[(qs * 128 + 32 * d0 + crow(r, hi)) * 32 + r32] = o[d0][r] * inv;
    }
    __syncthreads();
    if (c == 0) {
        float ss = 0.f;
#pragma unroll
        for (int d0 = 0; d0 < 4; ++d0)
#pragma unroll
            for (int r = 0; r < 16; ++r) { const float v = o[d0][r] * inv - lam * ex[(qs * 128 + 32 * d0 + crow(r, hi)) * 32 + r32]; o[d0][r] = v; ss += v * v; }
        ss = halfsum(ss);
        const float rs = __builtin_amdgcn_rsqf(ss * (1.0f / 128.0f) + LN_EPS) * (1.0f - LAM_INIT);
        bf16_t* op = (bf16_t*)(a.ws + WS_MIXED) + (rowbase + qpos) * DM + 512 + h * 128 + 4 * hi;
        f32x4 gsv[4][4];
#pragma unroll
        for (int d0 = 0; d0 < 4; ++d0)
#pragma unroll
            for (int g = 0; g < 4; ++g) gsv[d0][g] = *(const f32x4*)(a.g_sub + 32 * d0 + 8 * g + 4 * hi);
#pragma unroll
        for (int d0 = 0; d0 < 4; ++d0)
#pragma unroll
            for (int g = 0; g < 4; ++g) { const f32x4 gs = gsv[d0][g];
                u32x2 w; w.x = cvtpk(o[d0][4 * g] * rs * gs[0], o[d0][4 * g + 1] * rs * gs[1]); w.y = cvtpk(o[d0][4 * g + 2] * rs * gs[2], o[d0][4 * g + 3] * rs * gs[3]);
                *(u32x2*)(op + 32 * d0 + 8 * g) = w; }
    }
    __syncthreads();
}

template <bool FAST>
__device__ __forceinline__ void attnB_unit(const Frame& F, const Args& a, int b, int h, int qblk, float lam, int t_lo, int t_hi, float kn0, float kn1) {
    const int lane = F_LANE, r32 = lane & 31, hi = lane >> 5, wid = F.wave, c = wid >> 2, qs = wid & 3;
    const bf16_t* QD = (const bf16_t*)(a.ws + WS_PROJ) + 3 * PROJ_STRIDE; const bf16_t* KD = QD + PROJ_STRIDE; const bf16_t* VD = KD + PROJ_STRIDE;
    const size_t rowbase = (size_t)b * SEQ; const int q0 = qblk * 128, qpos = q0 + 32 * qs + r32;
    bf16x8 qr[4];
    { const bf16_t* Qp = QD + (rowbase + qpos) * 512 + h * 128 + c * 64 + 8 * hi;
#pragma unroll
      for (int d0 = 0; d0 < 4; ++d0) qr[d0] = *(const bf16x8*)(Qp + 16 * d0); }
    float ref = 0.f;
    { float qq = 0.f;
#pragma unroll
        for (int d0 = 0; d0 < 4; ++d0)
#pragma unroll
            for (int j = 0; j < 8; ++j) { const float v = __uint_as_float((unsigned)(unsigned short)qr[d0][j] << 16); qq += v * v; }
        qq = halfsum(qq); asm volatile("" : "+v"(qq));
        if (FAST) ref = sqrtf(qq) * (c ? kn1 : kn0) * 1.01f + 0.01f; }
    const float slope2 = __builtin_amdgcn_exp2f(-2.0f * (float)(h + 1)) * LOG2E;
    const bf16_t* tsrc = KD + (size_t)((b * 4 + h) * 256) * 16384 + wid * 2048 + lane * 8;
    LAS unsigned char* L = F.lds;
    const unsigned dbase = (unsigned)(uintptr_t)L + (unsigned)wid * 4096u;
#define B_DMA(tt, slot) do { const bf16_t* _k = tsrc + (size_t)(tt) * 16384; const unsigned _d = (unsigned)__builtin_amdgcn_readfirstlane((int)(dbase + (unsigned)(slot) * 32768u)); unsigned _keep; \
        asm volatile("s_mov_b32 %0, m0\n\ts_mov_b32 m0, %2\n\ts_nop 0\n\tglobal_load_lds_dwordx4 %1, off\n\tglobal_load_lds_dwordx4 %1, off offset:1024\n\tglobal_load_lds_dwordx4 %1, off offset:2048\n\tglobal_load_lds_dwordx4 %1, off offset:3072\n\ts_mov_b32 m0, %0" \
                     : "=&s"(_keep) : "v"(_k), "s"(_d) : "memory"); } while (0)
#define WAIT_BAR(N) asm volatile("s_waitcnt vmcnt(" #N ") lgkmcnt(0)\n\ts_barrier" ::: "memory")
#define SBAR() __builtin_amdgcn_sched_barrier(0)
#define PIN(x) asm volatile("" : "+v"(x))
#define VFRAG(dst, base, d0, ks) do { const s16x4 lo_ = vtr((base) + (d0) * 4096 + (ks) * 1024), hi_ = vtr((base) + (d0) * 4096 + (ks) * 1024 + 512); \
        dst = (bf16x8){lo_[0], lo_[1], lo_[2], lo_[3], hi_[0], hi_[1], hi_[2], hi_[3]}; } while (0)
#define GEN_C(tt) do { const float dq = (float)(qpos - (tt) * 64 - 4 * hi); \
        _Pragma("unroll") for (int r = 0; r < 16; ++r) { const float kk = (float)((r & 3) + 8 * (r >> 2)); C0[r] = -slope2 * __builtin_fabsf(dq - kk) - ref; C1[r] = -slope2 * __builtin_fabsf(dq - 32.f - kk) - ref; } } while (0)
    float mhat = NEG_BIG, lsum = 0.f; f32x16 o[4];
#pragma unroll
    for (int d = 0; d < 4; ++d) o[d] = (f32x16){};
    const int koff = (c * 8 + hi) * 1024 + r32 * 16;
    const int voff = 16384 + ((lane >> 4) & 1) * 32 + (lane & 3) * 8 + (4 * hi + ((lane & 15) >> 2)) * 64;
    const int tdiag = q0 >> 6;
    f32x16 C0, C1;
    u32x4 pw[4];
    const int NT = t_hi - t_lo + 1;
    GEN_C(t_lo);
    B_DMA(t_lo, 0); if (NT > 1) B_DMA(t_lo + 1, 1); if (NT > 2) B_DMA(t_lo + 2, 2);
    int sl = 0;
    for (int tau = 0; tau < NT; ++tau) {
        if (tau + 2 < NT) WAIT_BAR(8); else if (tau + 1 < NT) WAIT_BAR(4); else WAIT_BAR(0);
        if (tau + 3 < NT) B_DMA(t_lo + tau + 3, (sl + 3) & 3);
        const int t = t_lo + tau; const LAS unsigned char* buf = L + sl * 32768; const lds_cptr vbase = (lds_cptr)(buf + voff);
        bf16x8 kf[8];
#pragma unroll
        for (int d0 = 0; d0 < 4; ++d0) { kf[2 * d0] = *(const LAS bf16x8*)(buf + koff + d0 * 2048); kf[2 * d0 + 1] = *(const LAS bf16x8*)(buf + koff + d0 * 2048 + 512); }
        SBAR();
        f32x16 p0, p1;
        if constexpr (FAST) {
            bf16x8 vA[4], vB[4]; float sacc = 0.f;
#define EXPS(P, A, B) do { _Pragma("unroll") for (int r = (A); r < (B); ++r) { P[r] = __builtin_amdgcn_exp2f(P[r]); sacc += P[r]; } PIN(P); PIN(sacc); } while (0)
#define PK4(P, B) (u32x4){cvtpk(P[B], P[B + 1]), cvtpk(P[B + 2], P[B + 3]), cvtpk(P[B + 4], P[B + 5]), cvtpk(P[B + 6], P[B + 7])}
#define PWF(k) __builtin_bit_cast(bf16x8, pw[k])
            const float st = (t + 1 < tdiag) ? 64.f * slope2 : -64.f * slope2;
            p0 = MFMA32(kf[0], qr[0], C0); SBAR(); VFRAG(vA[0], vbase, 0, 0); SBAR();
            p0 = MFMA32(kf[2], qr[1], p0); SBAR(); VFRAG(vA[1], vbase, 1, 0); SBAR();
            p0 = MFMA32(kf[4], qr[2], p0); SBAR(); VFRAG(vA[2], vbase, 2, 0); SBAR();
            p0 = MFMA32(kf[6], qr[3], p0); SBAR(); VFRAG(vA[3], vbase, 3, 0); SBAR();
            p1 = MFMA32(kf[1], qr[0], C1); SBAR();
            p1 = MFMA32(kf[3], qr[1], p1); SBAR(); EXPS(p0, 0, 5); SBAR();
            p1 = MFMA32(kf[5], qr[2], p1); SBAR(); EXPS(p0, 5, 11); SBAR();
            p1 = MFMA32(kf[7], qr[3], p1); SBAR(); EXPS(p0, 11, 16); pw[0] = PK4(p0, 0); PIN(pw[0]); SBAR();
            o[0] = MFMA32(vA[0], PWF(0), o[0]); SBAR(); pw[1] = PK4(p0, 8); PIN(pw[1]); VFRAG(vB[0], vbase, 0, 1); SBAR();
            o[1] = MFMA32(vA[1], PWF(0), o[1]); SBAR(); EXPS(p1, 0, 3); VFRAG(vB[1], vbase, 1, 1); SBAR();
            o[2] = MFMA32(vA[2], PWF(0), o[2]); SBAR(); EXPS(p1, 3, 6); VFRAG(vB[2], vbase, 2, 1); SBAR();
            o[3] = MFMA32(vA[3], PWF(0), o[3]); SBAR(); EXPS(p1, 6, 8); VFRAG(vB[3], vbase, 3, 1); SBAR();
            o[0] = MFMA32(vB[0], PWF(1), o[0]); SBAR(); EXPS(p1, 8, 10); VFRAG(vA[0], vbase, 0, 2); SBAR();
            o[1] = MFMA32(vB[1], PWF(1), o[1]); SBAR(); EXPS(p1, 10, 12); VFRAG(vA[1], vbase, 1, 2); SBAR();
            o[2] = MFMA32(vB[2], PWF(1), o[2]); SBAR(); EXPS(p1, 12, 14); VFRAG(vA[2], vbase, 2, 2); SBAR();
            o[3] = MFMA32(vB[3], PWF(1), o[3]); SBAR(); EXPS(p1, 14, 16); VFRAG(vA[3], vbase, 3, 2); pw[2] = PK4(p1, 0); PIN(pw[2]); SBAR();
            o[0] = MFMA32(vA[0], PWF(2), o[0]); SBAR(); pw[3] = PK4(p1, 8); PIN(pw[3]); VFRAG(vB[0], vbase, 0, 3); SBAR();
            o[1] = MFMA32(vA[1], PWF(2), o[1]); SBAR(); VFRAG(vB[1], vbase, 1, 3);
#pragma unroll
            for (int r = 0; r < 8; ++r) C0[r] += st;
            PIN(C0); SBAR();
            o[2] = MFMA32(vA[2], PWF(2), o[2]); SBAR(); VFRAG(vB[2], vbase, 2, 3);
#pragma unroll
            for (int r = 8; r < 16; ++r) C0[r] += st;
            PIN(C0); SBAR();
            o[3] = MFMA32(vA[3], PWF(2), o[3]); SBAR(); VFRAG(vB[3], vbase, 3, 3);
#pragma unroll
            for (int r = 0; r < 8; ++r) C1[r] += st;
            PIN(C1); SBAR();
            o[0] = MFMA32(vB[0], PWF(3), o[0]); SBAR();
#pragma unroll
            for (int r = 8; r < 16; ++r) C1[r] += st;
            PIN(C1); SBAR();
            o[1] = MFMA32(vB[1], PWF(3), o[1]);
            o[2] = MFMA32(vB[2], PWF(3), o[2]);
            o[3] = MFMA32(vB[3], PWF(3), o[3]);
            lsum += sacc;
#undef EXPS
#undef PK4
#undef PWF
        } else {
            p0 = MFMA32(kf[0], qr[0], C0); p1 = MFMA32(kf[1], qr[0], C1);
#pragma unroll
            for (int d0 = 1; d0 < 4; ++d0) { p0 = MFMA32(kf[2 * d0], qr[d0], p0); p1 = MFMA32(kf[2 * d0 + 1], qr[d0], p1); }
            softmax_tile<4>(p0, p1, mhat, lsum, o, pw);
            pv_tile<4>(o, vbase, pw);
            const float st = (t + 1 < tdiag) ? 64.f * slope2 : -64.f * slope2; C0 = C0 + st; C1 = C1 + st;
        }
        if ((t + 1 >= tdiag && t + 1 <= tdiag + 2) || ((tau + 1) & 15) == 0) GEN_C(t + 1);
        sl = (sl + 1) & 3;
    }
#undef B_DMA
#undef WAIT_BAR
#undef VFRAG
#undef GEN_C
#undef SBAR
#undef PIN
    attnB_finish(F, a, o, lsum, lam, rowbase, qpos, h, c, qs, r32, hi);
}
__device__ __forceinline__ void attnB_fast(const Frame& F, const Args& a, int b, int h, int qblk, float lam, int t_lo, int t_hi, float kn0, float kn1) {
    const int lane = F_LANE, r32 = lane & 31, hi = lane >> 5, wid = F.wave, c = wid >> 2, qs = wid & 3;
    const bf16_t* QD = (const bf16_t*)(a.ws + WS_PROJ) + 3 * PROJ_STRIDE; const bf16_t* KD = QD + PROJ_STRIDE;
    const size_t rowbase = (size_t)b * SEQ; const int q0 = qblk * 128, qpos = q0 + 32 * qs + r32;
    bf16x8 qr[4], ks[4];
    { const bf16_t* Qp = QD + (rowbase + qpos) * 512 + h * 128 + c * 64 + 8 * hi;
      const bf16_t* Kp = KD + ((size_t)((b * 4 + h) * 256 + (qpos >> 6))) * 16384 + ((c * 8 + hi) * 64 + (qpos & 63)) * 8;
#pragma unroll
      for (int d0 = 0; d0 < 4; ++d0) { qr[d0] = *(const bf16x8*)(Qp + 16 * d0); ks[d0] = *(const bf16x8*)(Kp + d0 * 1024); } }
    const float slope2 = __builtin_amdgcn_exp2f(-2.0f * (float)(h + 1)) * LOG2E;
    float ref;
    { float qq = 0.f, sii = 0.f;
#pragma unroll
        for (int d0 = 0; d0 < 4; ++d0)
#pragma unroll
            for (int j = 0; j < 8; ++j) { const float v = __uint_as_float((unsigned)(unsigned short)qr[d0][j] << 16), kv = __uint_as_float((unsigned)(unsigned short)ks[d0][j] << 16); qq += v * v; sii += v * kv; }
        qq = halfsum(qq); sii = halfsum(sii); asm volatile("" : "+v"(qq));
        ref = sqrtf(qq) * (c ? kn1 : kn0) * 1.01f + 0.01f;
        float dd = (ref - sii + 72.02f) / slope2;
#pragma unroll
        for (int ofs = 1; ofs < 64; ofs <<= 1) dd = fmaxf(dd, __shfl_xor(dd, ofs));
        LAS float* red = (LAS float*)(F.lds + LX_MISC) + 104;
        if (lane == 0) red[wid] = dd;
        __syncthreads();
        float dm = red[0];
#pragma unroll
        for (int w_ = 1; w_ < 8; ++w_) dm = fmaxf(dm, red[w_]);
        const int Dd = dm < 40000.f ? (int)dm + 2 : 40000;
        int tl = (q0 - Dd) >> 6; if (q0 - Dd < 0) tl = 0;
        int th = (q0 + 127 + Dd) >> 6; if (th > SEQ / 64 - 1) th = SEQ / 64 - 1;
        t_lo = __builtin_amdgcn_readfirstlane(tl > t_lo ? tl : t_lo); t_hi = __builtin_amdgcn_readfirstlane(th < t_hi ? th : t_hi); }
    const bf16_t* tsrc = KD + (size_t)((b * 4 + h) * 256) * 16384 + wid * 2048 + lane * 8;
    LAS unsigned char* L = F.lds;
    const unsigned dbase = (unsigned)(uintptr_t)L + (unsigned)wid * 4096u;
#define B_DMA(tt, slot) do { const bf16_t* _k = tsrc + (size_t)(tt) * 16384; const unsigned _d = (unsigned)__builtin_amdgcn_readfirstlane((int)(dbase + (unsigned)(slot) * 32768u)); unsigned _keep; \
        asm volatile("s_mov_b32 %0, m0\n\ts_mov_b32 m0, %2\n\ts_nop 0\n\tglobal_load_lds_dwordx4 %1, off\n\tglobal_load_lds_dwordx4 %1, off offset:1024\n\tglobal_load_lds_dwordx4 %1, off offset:2048\n\tglobal_load_lds_dwordx4 %1, off offset:3072\n\ts_mov_b32 m0, %0" \
                     : "=&s"(_keep) : "v"(_k), "s"(_d) : "memory"); } while (0)
#define WAIT_BAR(N) asm volatile("s_waitcnt vmcnt(" #N ") lgkmcnt(0)\n\ts_barrier" : "+v"(p1), "+v"(sacc) :: "memory")
#define VFRAG(dst, base, d0, ks) do { const s16x4 lo_ = vtr((base) + (d0) * 4096 + (ks) * 1024), hi_ = vtr((base) + (d0) * 4096 + (ks) * 1024 + 512); \
        dst = (bf16x8){lo_[0], lo_[1], lo_[2], lo_[3], hi_[0], hi_[1], hi_[2], hi_[3]}; } while (0)
#define MF_ "v_mfma_f32_32x32x16_bf16 "
#define AMF(D, A, B)              asm volatile(MF_ "%0, %1, %2, %0" : "+v"(D) : "v"(A), "v"(B) : "memory")
#define AMF1(D, A, B, X)          asm volatile(MF_ "%0, %2, %3, %0" : "+v"(D), "+v"(X) : "v"(A), "v"(B) : "memory")
#define AMF2(D, A, B, X, Y)       asm volatile(MF_ "%0, %3, %4, %0" : "+v"(D), "+v"(X), "+v"(Y) : "v"(A), "v"(B) : "memory")
#define AMF3(D, A, B, X, Y, Z)    asm volatile(MF_ "%0, %4, %5, %0" : "+v"(D), "+v"(X), "+v"(Y), "+v"(Z) : "v"(A), "v"(B) : "memory")
#define AMF0(D, A, B)             asm volatile(MF_ "%0, %1, %2, 0" : "=&v"(D) : "v"(A), "v"(B) : "memory")
#define PK4(P, B) (u32x4){cvtpk(P[B], P[B + 1]), cvtpk(P[B + 2], P[B + 3]), cvtpk(P[B + 4], P[B + 5]), cvtpk(P[B + 6], P[B + 7])}
#define XE(P, r) { P[r] = __builtin_amdgcn_exp2f(P[r]); sacc += P[r]; }
#define XE2(P, r) do { XE(P, r) XE(P, (r) + 1) } while (0)
#define KLD(bk, i) kf[i] = *(const LAS bf16x8*)((bk) + koff + ((i) >> 1) * 2048 + ((i) & 1) * 512)
#define SET_KA(tn) do { const unsigned w_ = __builtin_amdgcn_perm(0u, __float_as_uint(tf), 0x03020302u); ka0[1] = w_; ka1[1] = w_; tf += tinc; if ((tn) == tdiag + 2) qa = qaR; } while (0)
#define BIAS_HALF(P, KA, e, tn) do { \
        if ((unsigned)((tn) - tdiag) < 2u) { const int kb_ = 2 * (tn) + (e); \
            if (kb_ == qb) { float dq_ = (float)(qpos - (tn) * 64 - 32 * (e) - 4 * hi), ns_ = -slope2, nr_ = -ref; asm volatile("" : "+v"(dq_), "+v"(ns_), "+v"(nr_)); \
                             _Pragma("unroll") for (int r = 0; r < 16; ++r) { const float kk_ = (float)((r & 3) + 8 * (r >> 2)); P[r] = __builtin_fmaf(ns_, __builtin_fabsf(dq_ - kk_), nr_); } \
                             asm volatile("s_nop 4" : "+v"(P) :: "memory"); } \
            else if (kb_ < qb) { AMF0(P, KA, qaL); } else { AMF0(P, KA, qaR); } } \
        else { AMF0(P, KA, qa); } } while (0)
    const int tdiag = q0 >> 6, qb = 4 * qblk + qs;
    const unsigned msk = hi ? 0u : 0xFFFFFFFFu;
    bf16x8 qaL, qaR, qa; u32x4 ka0, ka1;
    { const float S64 = 64.f * slope2;
        const unsigned sh = bfb(slope2), slo = bfb(slope2 - bff(sh)), Sh = bfb(S64), Slo = bfb(S64 - bff(Sh));
        unsigned ch, cm, cl, dh, dm, dl;
        bf_split3(slope2 * (float)(qpos - 64 * tdiag) - ref, ch, cm, cl);
        bf_split3(-slope2 * (float)(qpos - 64 * tdiag) - ref, dh, dm, dl);
        const u32x4 r_ = (u32x4){(((slo ^ 0x8000u) << 16) | (sh ^ 0x8000u)) & msk, (((Slo ^ 0x8000u) << 16) | (Sh ^ 0x8000u)) & msk, ((cm << 16) | ch) & msk, cl & msk};
        const u32x4 l_ = (u32x4){((slo << 16) | sh) & msk, ((Slo << 16) | Sh) & msk, ((dm << 16) | dh) & msk, dl & msk};
        qaR = __builtin_bit_cast(bf16x8, r_); qaL = __builtin_bit_cast(bf16x8, l_); qa = (t_lo < tdiag + 2) ? qaL : qaR;
        const unsigned j0 = bfb((float)r32), j1 = bfb((float)(32 + r32));
        ka0 = (u32x4){((j0 << 16) | j0) & msk, 0u, 0x3F803F80u & msk, 0x00003F80u & msk}; ka1 = ka0; ka1[0] = ((j1 << 16) | j1) & msk; }
    float tf = hi ? 0.f : (float)(t_lo - tdiag); const float tinc = hi ? 0.f : 1.f;
    f32x16 o[4], p0, p1; u32x4 pw[4]; bf16x8 kf[8], vA[4], vB[4]; float sacc = 0.f;
#pragma unroll
    for (int d = 0; d < 4; ++d) o[d] = (f32x16){};
    p1 = (f32x16){};
    const int koff = (c * 8 + hi) * 1024 + r32 * 16;
    const int voff = 16384 + ((lane >> 4) & 1) * 32 + (lane & 3) * 8 + (4 * hi + ((lane & 15) >> 2)) * 64;
    const int NT = t_hi - t_lo + 1;
    B_DMA(t_lo, 0); if (NT > 1) B_DMA(t_lo + 1, 1); if (NT > 2) B_DMA(t_lo + 2, 2);
    if (NT > 2) WAIT_BAR(8); else if (NT > 1) WAIT_BAR(4); else WAIT_BAR(0);
    {
        const LAS unsigned char* bk = L;
#pragma unroll
        for (int i = 0; i < 8; ++i) KLD(bk, i);
        SET_KA(t_lo);
        asm volatile("s_nop 1" : "+v"(ka0), "+v"(ka1), "+v"(qa) :: "memory");
        BIAS_HALF(p0, ka0, 0, t_lo);
        AMF(p0, kf[0], qr[0]); AMF(p0, kf[2], qr[1]); AMF(p0, kf[4], qr[2]); AMF(p0, kf[6], qr[3]);
        BIAS_HALF(p1, ka1, 1, t_lo);
        AMF(p1, kf[1], qr[0]); AMF(p1, kf[3], qr[1]); AMF(p1, kf[5], qr[2]); AMF(p1, kf[7], qr[3]);
        const lds_cptr vb0 = (lds_cptr)(bk + voff);
        VFRAG(vA[0], vb0, 0, 0); VFRAG(vA[1], vb0, 1, 0); VFRAG(vA[2], vb0, 2, 0); VFRAG(vA[3], vb0, 3, 0);
        asm volatile("s_nop 15\n\ts_nop 15" : "+v"(p0), "+v"(p1) :: "memory");
#pragma unroll
        for (int r = 0; r < 16; r += 2) XE2(p0, r);
#pragma unroll
        for (int r = 0; r < 16; r += 2) XE2(p1, r);
        pw[0] = PK4(p0, 0); pw[1] = PK4(p0, 8); pw[2] = PK4(p1, 0);
    }
    int sl = 0;
    for (int tau = 0; tau + 1 < NT; ++tau) {
        if (tau + 2 < NT) WAIT_BAR(4); else WAIT_BAR(0);
        if (tau + 3 < NT) B_DMA(t_lo + tau + 3, (sl + 3) & 3);
        const LAS unsigned char* buf = L + sl * 32768; const LAS unsigned char* bufn = L + ((sl + 1) & 3) * 32768;
        const lds_cptr vb = (lds_cptr)(buf + voff), vbn = (lds_cptr)(bufn + voff);
        const int tn = t_lo + tau + 1;
        SET_KA(tn);
        AMF(o[0], vA[0], pw[0]);            KLD(bufn, 0); KLD(bufn, 2);
        AMF1(o[1], vA[1], pw[0], p1);       KLD(bufn, 4); KLD(bufn, 6); pw[3] = PK4(p1, 8);
        AMF1(o[2], vA[2], pw[0], pw[3]);    KLD(bufn, 1); KLD(bufn, 3);
        AMF(o[3], vA[3], pw[0]);            KLD(bufn, 5); KLD(bufn, 7);
        BIAS_HALF(p0, ka0, 0, tn);          VFRAG(vB[0], vb, 0, 1);
        AMF(p0, kf[0], qr[0]);              VFRAG(vB[1], vb, 1, 1);
        AMF(p0, kf[2], qr[1]);              VFRAG(vB[2], vb, 2, 1);
        AMF(p0, kf[4], qr[2]);              VFRAG(vB[3], vb, 3, 1);
        AMF(p0, kf[6], qr[3]);
        BIAS_HALF(p1, ka1, 1, tn);
        AMF1(p1, kf[1], qr[0], p0);         XE2(p0, 0);
        AMF2(p1, kf[3], qr[1], p0, sacc);   XE2(p0, 2);
        AMF2(p1, kf[5], qr[2], p0, sacc);   XE2(p0, 4);
        AMF2(p1, kf[7], qr[3], p0, sacc);   XE2(p0, 6);
        AMF2(o[0], vB[0], pw[1], p0, sacc); XE2(p0, 8);  VFRAG(vA[0], vb, 0, 2);
        AMF2(o[1], vB[1], pw[1], p0, sacc); XE2(p0, 10); VFRAG(vA[1], vb, 1, 2);
        AMF2(o[2], vB[2], pw[1], p0, sacc); XE2(p0, 12); VFRAG(vA[2], vb, 2, 2);
        AMF2(o[3], vB[3], pw[1], p0, sacc); XE2(p0, 14); VFRAG(vA[3], vb, 3, 2);
        AMF3(o[0], vA[0], pw[2], p0, sacc, p1);     pw[0] = PK4(p0, 0); XE2(p1, 0); VFRAG(vB[0], vb, 0, 3);
        AMF3(o[1], vA[1], pw[2], p1, sacc, pw[0]);  XE2(p1, 2); VFRAG(vB[1], vb, 1, 3);
        AMF3(o[2], vA[2], pw[2], p1, sacc, p0);     pw[1] = PK4(p0, 8); XE2(p1, 4); VFRAG(vB[2], vb, 2, 3);
        AMF3(o[3], vA[3], pw[2], p1, sacc, pw[1]);  XE2(p1, 6); VFRAG(vB[3], vb, 3, 3);
        AMF2(o[0], vB[0], pw[3], p1, sacc); XE2(p1, 8);  VFRAG(vA[0], vbn, 0, 0);
        AMF2(o[1], vB[1], pw[3], p1, sacc); XE2(p1, 10); VFRAG(vA[1], vbn, 1, 0);
        AMF2(o[2], vB[2], pw[3], p1, sacc); pw[2] = PK4(p1, 0); XE2(p1, 12); VFRAG(vA[2], vbn, 2, 0);
        AMF3(o[3], vB[3], pw[3], p1, sacc, pw[2]);  XE2(p1, 14); VFRAG(vA[3], vbn, 3, 0);
        sl = (sl + 1) & 3;
    }
    {
        const lds_cptr vb = (lds_cptr)(L + sl * 32768 + voff);
        pw[3] = PK4(p1, 8);
        AMF3(o[0], vA[0], pw[0], p1, sacc, pw[3]); VFRAG(vB[0], vb, 0, 1);
        AMF(o[1], vA[1], pw[0]); VFRAG(vB[1], vb, 1, 1);
        AMF(o[2], vA[2], pw[0]); VFRAG(vB[2], vb, 2, 1);
        AMF(o[3], vA[3], pw[0]); VFRAG(vB[3], vb, 3, 1);
        AMF(o[0], vB[0], pw[1]); VFRAG(vA[0], vb, 0, 2);
        AMF(o[1], vB[1], pw[1]); VFRAG(vA[1], vb, 1, 2);
        AMF(o[2], vB[2], pw[1]); VFRAG(vA[2], vb, 2, 2);
        AMF(o[3], vB[3], pw[1]); VFRAG(vA[3], vb, 3, 2);
        AMF(o[0], vA[0], pw[2]); VFRAG(vB[0], vb, 0, 3);
        AMF(o[1], vA[1], pw[2]); VFRAG(vB[1], vb, 1, 3);
        AMF(o[2], vA[2], pw[2]); VFRAG(vB[2], vb, 2, 3);
        AMF(o[3], vA[3], pw[2]); VFRAG(vB[3], vb, 3, 3);
        AMF(o[0], vB[0], pw[3]); AMF(o[1], vB[1], pw[3]); AMF(o[2], vB[2], pw[3]); AMF(o[3], vB[3], pw[3]);
        asm volatile("s_nop 15\n\ts_nop 15" : "+v"(o[0]), "+v"(o[1]), "+v"(o[2]), "+v"(o[3]) :: "memory");
    }
#undef B_DMA
#undef WAIT_BAR
#undef VFRAG
#undef MF_
#undef AMF
#undef AMF1
#undef AMF2
#undef AMF3
#undef AMF0
#undef PK4
#undef XE
#undef XE2
#undef KLD
#undef SET_KA
#undef BIAS_HALF
    attnB_finish(F, a, o, sacc, lam, rowbase, qpos, h, c, qs, r32, hi);
}
__device__ __forceinline__ void attnB_item(const Frame& F, const Args& a, int h, int b, int qblk, float lam) {
    const int q0 = qblk * 128;
    const unsigned* ctl = (const unsigned*)(a.ws + WS_CTL); const int sl = (b * 4 + h) * 4;
    const float qn0 = sqrtf(__uint_as_float(ctl[CW_QMAX + sl]) + __uint_as_float(ctl[CW_QMAX + sl + 1])), qn1 = sqrtf(__uint_as_float(ctl[CW_QMAX + sl + 2]) + __uint_as_float(ctl[CW_QMAX + sl + 3]));
    const float kn0 = sqrtf(__uint_as_float(ctl[CW_KMAX + sl]) + __uint_as_float(ctl[CW_KMAX + sl + 1])), kn1 = sqrtf(__uint_as_float(ctl[CW_KMAX + sl + 2]) + __uint_as_float(ctl[CW_KMAX + sl + 3]));
    const float U = fmaxf(qn0 * kn0, qn1 * kn1) * 1.01f + 0.01f;
    const float slope2 = __builtin_amdgcn_exp2f(-2.0f * (float)(h + 1)) * LOG2E;
    const float Df = (2.0f * U + 72.0f) / slope2;
    const int Dd = Df < 40000.f ? (int)Df + 2 : 40000;
    int t_lo = (q0 - Dd) >> 6; if (q0 - Dd < 0) t_lo = 0;
    int t_hi = (q0 + 127 + Dd) >> 6; if (t_hi > SEQ / 64 - 1) t_hi = SEQ / 64 - 1;
    if (U <= 40.f) attnB_fast(F, a, b, h, qblk, lam, t_lo, t_hi, kn0, kn1);
    else attnB_unit<false>(F, a, b, h, qblk, lam, t_lo, t_hi, kn0, kn1);
}

__device__ __forceinline__ int a_kbase(int n0, int it) { return n0 - 64 + 64 * ((it == 0) ? 1 : (it == 1 ? 0 : 2)); }
__device__ __forceinline__ void a_load_k(const bf16_t* KA, size_t rowbase, int head, int d, int r, int L, int kbase, int r32, int hi, bf16x8 (&kf)[8]) {
#pragma unroll
    for (int kh = 0; kh < 2; ++kh) { int kn = kbase + 32 * kh + r32; kn = kn < 0 ? 0 : (kn >= L ? L - 1 : kn);
        const bf16_t* Kp = KA + (rowbase + (size_t)(d * kn + r)) * 512 + head * 64 + 8 * hi;
#pragma unroll
        for (int d0 = 0; d0 < 4; ++d0) kf[2 * d0 + kh] = *(const bf16x8*)(Kp + 16 * d0); }
}
__device__ __forceinline__ void attnA_task(const Frame& F, const Args& a, int b, int head, int d, int r, int n0, int L, LAS unsigned char* vw, f32x16 (&o)[2], float& mhat, float& ltot) {
    const int lane = F_LANE, r32 = lane & 31, hi = lane >> 5;
    const bf16_t* QA = (const bf16_t*)(a.ws + WS_PROJ); const bf16_t* KA = QA + PROJ_STRIDE; const bf16_t* VA = KA + PROJ_STRIDE;
    const size_t rowbase = (size_t)b * SEQ; const int qn = n0 + r32;
    bf16x8 qr[4], kf[8], kfn[8];
    { const bf16_t* Qp = QA + (rowbase + (size_t)(d * qn + r)) * 512 + head * 64 + 8 * hi;
#pragma unroll
      for (int d0 = 0; d0 < 4; ++d0) qr[d0] = *(const bf16x8*)(Qp + 16 * d0); }
    a_load_k(KA, rowbase, head, d, r, L, a_kbase(n0, 0), r32, hi, kf);
    const float sl = __builtin_amdgcn_exp2f(-(float)(head + 1)) * LOG2E * (float)d;
    mhat = NEG_BIG; float lsum = 0.f; o[0] = (f32x16){}; o[1] = (f32x16){};
    const int voff = ((lane >> 4) & 1) * 32 + (lane & 3) * 8 + (4 * hi + ((lane & 15) >> 2)) * 64;
#pragma unroll
    for (int it = 0; it < 3; ++it) {
        const int kbase = a_kbase(n0, it);
        u32x4 vv[8];
#pragma unroll
        for (int ks = 0; ks < 4; ++ks) { int kn = kbase + 16 * ks + (lane >> 2); kn = kn < 0 ? 0 : (kn >= L ? L - 1 : kn);
            const bf16_t* Vp = VA + (rowbase + (size_t)(d * kn + r)) * 512 + head * 64 + 8 * (lane & 3);
            vv[ks] = *(const u32x4*)Vp; vv[4 + ks] = *(const u32x4*)(Vp + 32); }
        if (it < 2) a_load_k(KA, rowbase, head, d, r, L, a_kbase(n0, it + 1), r32, hi, kfn);
        __builtin_amdgcn_sched_barrier(0);
        f32x16 p0, p1;
#pragma unroll
        for (int rr = 0; rr < 16; ++rr) { const int k0 = kbase + crow(rr, hi), k1 = k0 + 32; const int d0_ = k0 - qn, d1_ = k1 - qn;
            const bool v0 = (k0 >= 0) && (k0 < L) && (d0_ <= 64) && (d0_ >= -64), v1 = (k1 >= 0) && (k1 < L) && (d1_ <= 64) && (d1_ >= -64);
            p0[rr] = v0 ? -sl * __builtin_fabsf((float)d0_) : NEG_BIG; p1[rr] = v1 ? -sl * __builtin_fabsf((float)d1_) : NEG_BIG; }
#pragma unroll
        for (int d0 = 0; d0 < 4; ++d0) { p0 = MFMA32(kf[2 * d0], qr[d0], p0); p1 = MFMA32(kf[2 * d0 + 1], qr[d0], p1); }
        u32x4 pw[4];
        softmax_tile<2>(p0, p1, mhat, lsum, o, pw);
        __builtin_amdgcn_sched_barrier(0);
#pragma unroll
        for (int i = 0; i < 8; ++i) *(LAS u32x4*)(vw + i * 1024 + lane * 16) = vv[i];
        asm volatile("s_waitcnt lgkmcnt(0)" ::: "memory");
        pv_tile<2>(o, (lds_cptr)(vw + voff), pw);
        asm volatile("s_waitcnt lgkmcnt(0)" ::: "memory");
        if (it < 2) {
#pragma unroll
            for (int j = 0; j < 8; ++j) kf[j] = kfn[j];
        }
    }
    ltot = halfsum(lsum);
}
struct ACst { bf16x8 qaC, qaL, qaR; u32x4 ka0, ka1; float e0, nsl, nref; };
__device__ __forceinline__ void a_consts(int head, int d, int r32, int hi, float ref, ACst& c) {
    const float sl = __builtin_amdgcn_exp2f(-(float)(head + 1)) * LOG2E * (float)d; const unsigned msk = hi ? 0u : 0xFFFFFFFFu;
    const unsigned sh = bfb(sl), slo = bfb(sl - bff(sh)); unsigned h0, m0, l0;
    const unsigned pos = ((slo << 16) | sh) & msk, neg = (((slo ^ 0x8000u) << 16) | (sh ^ 0x8000u)) & msk;
    bf_split3(sl * (float)r32 - ref, h0, m0, l0);          { const u32x4 v = (u32x4){neg, 0u, ((m0 << 16) | h0) & msk, l0 & msk}; c.qaC = __builtin_bit_cast(bf16x8, v); }
    bf_split3(-sl * (float)(64 + r32) - ref, h0, m0, l0);  { const u32x4 v = (u32x4){pos, 0u, ((m0 << 16) | h0) & msk, l0 & msk}; c.qaL = __builtin_bit_cast(bf16x8, v); }
    bf_split3(sl * (float)(r32 - 64) - ref, h0, m0, l0);   { const u32x4 v = (u32x4){neg, 0u, ((m0 << 16) | h0) & msk, l0 & msk}; c.qaR = __builtin_bit_cast(bf16x8, v); }
    const unsigned j0 = bfb((float)r32), j1 = bfb((float)(32 + r32));
    c.ka0 = (u32x4){((j0 << 16) | j0) & msk, 0u, 0x3F803F80u & msk, 0x00003F80u & msk}; c.ka1 = c.ka0; c.ka1[0] = ((j1 << 16) | j1) & msk;
    c.e0 = (float)(4 * hi - r32); c.nsl = -sl; c.nref = -ref;
}
__device__ __forceinline__ void a_load_k_half(const bf16_t* KA, size_t rowbase, int head, int d, int r, int kbase, int r32, int hi, bf16x8 (&kf)[8]) {
    const bf16_t* Kp = KA + (rowbase + (size_t)(d * (kbase + r32) + r)) * 512 + head * 64 + 8 * hi;
#pragma unroll
    for (int d0 = 0; d0 < 4; ++d0) kf[2 * d0] = *(const bf16x8*)(Kp + 16 * d0);
}
__device__ __forceinline__ void softmax_half(f32x16& p0, float& mhat, float& lsum, f32x16 (&o)[2], u32x4 (&pw)[4]) {
    float a_ = MX3(p0[0], p0[1], p0[2]), b_ = MX3(p0[3], p0[4], p0[5]);
#pragma unroll
    for (int r = 6; r < 16; r += 2) { a_ = __builtin_fmaxf(a_, p0[r]); b_ = __builtin_fmaxf(b_, p0[r + 1]); }
    float m = __builtin_fmaxf(a_, b_); auto rr = __builtin_amdgcn_permlane32_swap(__float_as_uint(m), __float_as_uint(m), false, false);
    const float rm = __builtin_fmaxf(__uint_as_float(rr[0]), __uint_as_float(rr[1]));
    const float mnew = __builtin_fmaxf(mhat, rm);
    if (__any(mnew != mhat)) {
        const float al = __builtin_amdgcn_exp2f(mhat - mnew); lsum *= al;
#pragma unroll
        for (int d = 0; d < 2; ++d)
#pragma unroll
            for (int r = 0; r < 16; ++r) o[d][r] *= al;
        mhat = mnew;
    }
    float s = 0.f;
#pragma unroll
    for (int r = 0; r < 16; ++r) { p0[r] = __builtin_amdgcn_exp2f(p0[r] - mhat); s += p0[r]; }
    lsum += s;
    pw[0] = (u32x4){cvtpk(p0[0], p0[1]), cvtpk(p0[2], p0[3]), cvtpk(p0[4], p0[5]), cvtpk(p0[6], p0[7])};
    pw[1] = (u32x4){cvtpk(p0[8], p0[9]), cvtpk(p0[10], p0[11]), cvtpk(p0[12], p0[13]), cvtpk(p0[14], p0[15])};
}
template <bool H1>
__device__ __forceinline__ void softmax_fix(f32x16& p0, f32x16& p1, float& lsum, u32x4 (&pw)[4]) {
    float s = 0.f;
#pragma unroll
    for (int r = 0; r < 16; ++r) { p0[r] = __builtin_amdgcn_exp2f(p0[r]); s += p0[r]; if (H1) { p1[r] = __builtin_amdgcn_exp2f(p1[r]); s += p1[r]; } }
    lsum += s;
    pw[0] = (u32x4){cvtpk(p0[0], p0[1]), cvtpk(p0[2], p0[3]), cvtpk(p0[4], p0[5]), cvtpk(p0[6], p0[7])};
    pw[1] = (u32x4){cvtpk(p0[8], p0[9]), cvtpk(p0[10], p0[11]), cvtpk(p0[12], p0[13]), cvtpk(p0[14], p0[15])};
    if (H1) { pw[2] = (u32x4){cvtpk(p1[0], p1[1]), cvtpk(p1[2], p1[3]), cvtpk(p1[4], p1[5]), cvtpk(p1[6], p1[7])};
              pw[3] = (u32x4){cvtpk(p1[8], p1[9]), cvtpk(p1[10], p1[11]), cvtpk(p1[12], p1[13]), cvtpk(p1[14], p1[15])}; }
}
__device__ __forceinline__ void attnA_task_in(const Frame& F, const Args& a, float kn, int b, int head, int d, int r, int n0, LAS unsigned char* vw, f32x16 (&o)[2], float& mhat, float& ltot) {
    const int lane = F_LANE, r32 = lane & 31, hi = lane >> 5;
    const bf16_t* QA = (const bf16_t*)(a.ws + WS_PROJ); const bf16_t* KA = QA + PROJ_STRIDE; const bf16_t* VA = KA + PROJ_STRIDE;
    const size_t rowbase = (size_t)b * SEQ; const int qn = n0 + r32;
    bf16x8 qr[4], kf[8];
    { const bf16_t* Qp = QA + (rowbase + (size_t)(d * qn + r)) * 512 + head * 64 + 8 * hi;
#pragma unroll
      for (int d0 = 0; d0 < 4; ++d0) qr[d0] = *(const bf16x8*)(Qp + 16 * d0); }
    a_load_k(KA, rowbase, head, d, r, 1 << 30, n0, r32, hi, kf);
    float ref;
    { float qq = 0.f;
#pragma unroll
        for (int d0 = 0; d0 < 4; ++d0)
#pragma unroll
            for (int j = 0; j < 8; ++j) { const float v = __uint_as_float((unsigned)(unsigned short)qr[d0][j] << 16); qq += v * v; }
        qq = halfsum(qq); ref = sqrtf(qq) * kn * 1.01f + 0.01f; }
    ACst cs; a_consts(head, d, r32, hi, ref, cs);
    mhat = ref; float lsum = 0.f; o[0] = (f32x16){}; o[1] = (f32x16){};
    const int voff = ((lane >> 4) & 1) * 32 + (lane & 3) * 8 + (4 * hi + ((lane & 15) >> 2)) * 64;
    const int m_ = r32 - 4 * hi;
#define A_VLOAD(kb_, NKS) _Pragma("unroll") for (int ks = 0; ks < (NKS); ++ks) { const int kn = (kb_) + 16 * ks + (lane >> 2); \
            const bf16_t* Vp = VA + (rowbase + (size_t)(d * kn + r)) * 512 + head * 64 + 8 * (lane & 3); vv[ks] = *(const u32x4*)Vp; vv[4 + ks] = *(const u32x4*)(Vp + 32); }
    const f32x16 zero16 = (f32x16){};
    u32x4 vv[8], pw[4]; f32x16 p0, p1;
    A_VLOAD(n0, 4)
#pragma unroll
    for (int rr = 0; rr < 16; ++rr) p0[rr] = __builtin_fmaf(cs.nsl, __builtin_fabsf(cs.e0 + (float)((rr & 3) + 8 * (rr >> 2))), cs.nref);
    p1 = MFMA32(__builtin_bit_cast(bf16x8, cs.ka1), cs.qaC, zero16);
#pragma unroll
    for (int d0 = 0; d0 < 4; ++d0) { p0 = MFMA32(kf[2 * d0], qr[d0], p0); p1 = MFMA32(kf[2 * d0 + 1], qr[d0], p1); }
    a_load_k(KA, rowbase, head, d, r, 1 << 30, n0 - 64, r32, hi, kf);
    softmax_fix<true>(p0, p1, lsum, pw);
#pragma unroll
    for (int i = 0; i < 8; ++i) *(LAS u32x4*)(vw + i * 1024 + lane * 16) = vv[i];
    asm volatile("s_waitcnt lgkmcnt(0)" ::: "memory");
    pv_tile<2>(o, (lds_cptr)(vw + voff), pw);
    asm volatile("s_waitcnt lgkmcnt(0)" ::: "memory");
    A_VLOAD(n0 - 64, 4)
    p0 = MFMA32(__builtin_bit_cast(bf16x8, cs.ka0), cs.qaL, zero16); p1 = MFMA32(__builtin_bit_cast(bf16x8, cs.ka1), cs.qaL, zero16);
#pragma unroll
    for (int d0 = 0; d0 < 4; ++d0) { p0 = MFMA32(kf[2 * d0], qr[d0], p0); p1 = MFMA32(kf[2 * d0 + 1], qr[d0], p1); }
    a_load_k_half(KA, rowbase, head, d, r, n0 + 64, r32, hi, kf);
#pragma unroll
    for (int rr = 0; rr < 16; ++rr) p0[rr] = ((rr & 3) + 8 * (rr >> 2) >= m_) ? p0[rr] : NEG_BIG;
    softmax_fix<true>(p0, p1, lsum, pw);
#pragma unroll
    for (int i = 0; i < 8; ++i) *(LAS u32x4*)(vw + i * 1024 + lane * 16) = vv[i];
    asm volatile("s_waitcnt lgkmcnt(0)" ::: "memory");
    pv_tile<2>(o, (lds_cptr)(vw + voff), pw);
    asm volatile("s_waitcnt lgkmcnt(0)" ::: "memory");
    A_VLOAD(n0 + 64, 2)
    p0 = MFMA32(__builtin_bit_cast(bf16x8, cs.ka0), cs.qaR, zero16);
#pragma unroll
    for (int d0 = 0; d0 < 4; ++d0) p0 = MFMA32(kf[2 * d0], qr[d0], p0);
#pragma unroll
    for (int rr = 0; rr < 16; ++rr) p0[rr] = ((rr & 3) + 8 * (rr >> 2) <= m_) ? p0[rr] : NEG_BIG;
    softmax_fix<false>(p0, p1, lsum, pw);
#pragma unroll
    for (int ks = 0; ks < 2; ++ks) { *(LAS u32x4*)(vw + ks * 1024 + lane * 16) = vv[ks]; *(LAS u32x4*)(vw + (4 + ks) * 1024 + lane * 16) = vv[4 + ks]; }
    asm volatile("s_waitcnt lgkmcnt(0)" ::: "memory");
    {   const lds_cptr vbase = (lds_cptr)(vw + voff);
#pragma unroll
        for (int d0 = 0; d0 < 2; ++d0)
#pragma unroll
            for (int ks = 0; ks < 2; ++ks) {
                const s16x4 lo = vtr(vbase + d0 * 4096 + ks * 1024), hi_ = vtr(vbase + d0 * 4096 + ks * 1024 + 512);
                const bf16x8 vf = (bf16x8){lo[0], lo[1], lo[2], lo[3], hi_[0], hi_[1], hi_[2], hi_[3]};
                o[d0] = MFMA32(vf, __builtin_bit_cast(bf16x8, pw[ks]), o[d0]); } }
    asm volatile("s_waitcnt lgkmcnt(0)" ::: "memory");
#undef A_VLOAD
    ltot = halfsum(lsum);
}
__device__ __forceinline__ void attnA_unit(const Frame& F, const Args& a, int unit) {
    const int lane = F_LANE, r32 = lane & 31, hi = lane >> 5, wid = F.wave;
    const int b = unit >> 7, head = (unit >> 4) & 7, tb = unit & 15, T0 = tb * 1024;
    float* part = (float*)(a.ws + WS_APART + (size_t)unit * APART_UNIT); float* ml = part + 2 * 1024 * 64;
    LAS unsigned char* vw = F.lds + wid * 8192;
    const unsigned* ctlA = (const unsigned*)(a.ws + WS_CTL) + CW_KAMAX + b * 16 + head * 2; const unsigned* ctlQ = (const unsigned*)(a.ws + WS_CTL) + CW_QAMAX + b * 16 + head * 2;
    const float knA = sqrtf(__uint_as_float(ctlA[0]) + __uint_as_float(ctlA[1])), qnA = sqrtf(__uint_as_float(ctlQ[0]) + __uint_as_float(ctlQ[1]));
    const bool fixok = qnA * knA * 1.01f <= 40.f;
    {
#pragma unroll 1
    for (int task = wid; task < 64; task += 8) {
        int pat, d, r, n0, L;
        if (task < 32) { pat = 0; d = 16; r = task >> 1; n0 = T0 / 16 + 32 * (task & 1); L = SEQ / 16; }
        else { const int tt = task - 32; pat = 1; d = 4; r = tt >> 3; n0 = T0 / 4 + 32 * (tt & 7); L = SEQ / 4; }
        f32x16 o[2]; float mhat, ltot;
        if (fixok && n0 >= 64 && n0 + 128 <= L) attnA_task_in(F, a, knA, b, head, d, r, n0, vw, o, mhat, ltot);
        else attnA_task(F, a, b, head, d, r, n0, L, vw, o, mhat, ltot);
        const int tl = d * (n0 + r32) + r - T0;
        float* pp = part + ((size_t)pat * 1024 + tl) * 64 + 4 * hi;
#pragma unroll
        for (int d0 = 0; d0 < 2; ++d0)
#pragma unroll
            for (int g = 0; g < 4; ++g) *(f32x4*)(pp + 32 * d0 + 8 * g) = (f32x4){o[d0][4 * g], o[d0][4 * g + 1], o[d0][4 * g + 2], o[d0][4 * g + 3]};
        if (hi == 0) *(f32x2*)(ml + ((size_t)pat * 1024 + tl) * 2) = (f32x2){mhat, ltot};
    }
    }
    asm volatile("s_waitcnt vmcnt(0)" ::: "memory");
    __syncthreads();
    __builtin_amdgcn_fence(__ATOMIC_ACQUIRE, "agent");
    for (int task = wid; task < 32; task += 8) {
        const int n0 = T0 + 32 * task;
        f32x16 o[2]; float m0, l0;
        if (fixok && n0 >= 64 && n0 + 128 <= SEQ) attnA_task_in(F, a, knA, b, head, 1, 0, n0, vw, o, m0, l0);
        else attnA_task(F, a, b, head, 1, 0, n0, SEQ, vw, o, m0, l0);
        const int tl = 32 * task + r32;
        const f32x2 ml1 = *(const f32x2*)(ml + ((size_t)0 * 1024 + tl) * 2), ml2 = *(const f32x2*)(ml + ((size_t)1 * 1024 + tl) * 2);
        const float M = MX3(m0, ml1[0], ml2[0]);
        const float w0 = __builtin_amdgcn_exp2f(m0 - M), w1 = __builtin_amdgcn_exp2f(ml1[0] - M), w2 = __builtin_amdgcn_exp2f(ml2[0] - M);
        const float rden = 1.0f / (w0 * l0 + w1 * ml1[1] + w2 * ml2[1]);
        const float* p1 = part + ((size_t)0 * 1024 + tl) * 64 + 4 * hi; const float* p2 = part + ((size_t)1 * 1024 + tl) * 64 + 4 * hi;
        bf16_t* op = (bf16_t*)(a.ws + WS_MIXED) + ((size_t)b * SEQ + T0 + tl) * DM + head * 64 + 4 * hi;
        f32x4 a1v[2][4], a2v[2][4];
#pragma unroll
        for (int d0 = 0; d0 < 2; ++d0)
#pragma unroll
            for (int g = 0; g < 4; ++g) { a1v[d0][g] = *(const f32x4*)(p1 + 32 * d0 + 8 * g); a2v[d0][g] = *(const f32x4*)(p2 + 32 * d0 + 8 * g); }
#pragma unroll
        for (int d0 = 0; d0 < 2; ++d0)
#pragma unroll
            for (int g = 0; g < 4; ++g) { const f32x4 a1 = a1v[d0][g], a2 = a2v[d0][g]; float v[4];
#pragma unroll
                for (int j = 0; j < 4; ++j) v[j] = (w0 * o[d0][4 * g + j] + w1 * a1[j] + w2 * a2[j]) * rden;
                u32x2 w; w.x = cvtpk(v[0], v[1]); w.y = cvtpk(v[2], v[3]); *(u32x2*)(op + 32 * d0 + 8 * g) = w; }
    }
    __syncthreads();
}

struct CvItem { const float* W; unsigned char* WT; int K, N, k0, n0, row0; };
__device__ __forceinline__ CvItem cv_decode(const Args& a, int r) {
    constexpr int I_UP = 16 * 64, I_DN = 16 * 32; CvItem t;
    if (r < NE * I_UP) { const int e = r / I_UP, q = r % I_UP, kb = q / 64, nb = q % 64, n0 = 32 * nb, nn = n0 & 1023;
        t.W = a.w_up + (size_t)e * DM * 2048; t.WT = a.ws + WS_WUP + (size_t)e * 2048 * DM; t.K = DM; t.N = 2048; t.k0 = 64 * kb; t.n0 = n0; t.row0 = (nn >> 7) * 256 + (n0 >> 10) * 128 + (nn & 127); }
    else { r -= NE * I_UP; const int e = r / I_DN, q = r % I_DN, kb = q / 32, nb = q % 32;
        t.W = a.w_down + (size_t)e * DFF * DM; t.WT = a.ws + WS_WDN + (size_t)e * DM * DFF; t.K = DFF; t.N = DM; t.k0 = 64 * kb; t.n0 = 32 * nb; t.row0 = 32 * nb; }
    return t;
}
__device__ __forceinline__ void cv_load(const CvItem& t, int lane, f32x4 (&v)[8]) {
    const float* p = t.W + (size_t)(t.k0 + (lane >> 3)) * t.N + t.n0 + (lane & 7) * 4;
#pragma unroll
    for (int i = 0; i < 8; ++i) v[i] = *(const f32x4*)(p + (size_t)(8 * i) * t.N);
}
__device__ __forceinline__ void cv_store(const CvItem& t, int lane, const f32x4 (&v)[8], LAS float* scr) {
    { const int kr_ = lane >> 3, q4_ = (lane & 7) * 4;
#pragma unroll
      for (int i = 0; i < 8; ++i) { LAS float* d_ = scr + (kr_ + 8 * i) * 33 + q4_; d_[0] = v[i][0]; d_[1] = v[i][1]; d_[2] = v[i][2]; d_[3] = v[i][3]; } }
    asm volatile("s_waitcnt lgkmcnt(0)" ::: "memory");
    const int c = lane & 7;
#pragma unroll
    for (int j = 0; j < 4; ++j) { const int n = (lane >> 3) + 8 * j; const LAS float* s = scr + (8 * c) * 33 + n;
        u32x2 o; o.x = cvt4_fp8(256.f * s[0 * 33], 256.f * s[1 * 33], 256.f * s[2 * 33], 256.f * s[3 * 33]); o.y = cvt4_fp8(256.f * s[4 * 33], 256.f * s[5 * 33], 256.f * s[6 * 33], 256.f * s[7 * 33]);
        *(u32x2*)(t.WT + (size_t)(t.row0 + n) * t.K + t.k0 + 8 * c) = o; }
    asm volatile("s_waitcnt lgkmcnt(0)" ::: "memory");
}
__device__ __forceinline__ void cv_batch(const Frame& F, const Args& a, int bi) {
    LAS float* scr = (LAS float*)(F.lds + F.wave * 16384); const int lane = F_LANE;
    const int it0 = bi * 96 + F.wave;
    f32x4 vA[8], vB[8], vC[8];
    cv_load(cv_decode(a, it0), lane, vA); cv_load(cv_decode(a, it0 + 8), lane, vB);
#pragma unroll 1
    for (int j = 0; j < 12; j += 3) {
        cv_load(cv_decode(a, it0 + 8 * (j + 2)), lane, vC);
        cv_store(cv_decode(a, it0 + 8 * j), lane, vA, scr);
        cv_load(cv_decode(a, it0 + 8 * (j + 3 < 12 ? j + 3 : j)), lane, vA);
        cv_store(cv_decode(a, it0 + 8 * (j + 1)), lane, vB, scr);
        cv_load(cv_decode(a, it0 + 8 * (j + 4 < 12 ? j + 4 : j)), lane, vB);
        cv_store(cv_decode(a, it0 + 8 * (j + 2)), lane, vC, scr);
    }
    asm volatile("s_waitcnt vmcnt(0)" ::: "memory");
}

__device__ __forceinline__ unsigned ordkey(float v) { const unsigned u = __float_as_uint(v); return u ^ ((u >> 31) ? 0xFFFFFFFFu : 0x80000000u); }
__device__ __forceinline__ float unordkey(unsigned k) { const unsigned u = (k & 0x80000000u) ? (k ^ 0x80000000u) : ~k; return __uint_as_float(u); }
__device__ __forceinline__ void p4_ln_router(const Frame& F, const Args& a) {
    const int lane = F_LANE, wid = F.wave, tid = F_TID;
    LAS float* Wr = (LAS float*)F.lds;
    LAS unsigned* misc = (LAS unsigned*)(F.lds + LX_MISC);
    LAS float* pc = (LAS float*)(F.lds + LX_TOK);
    f32x4 wv_[16]; float gs_[16];
#pragma unroll
    for (int j = 0; j < 16; ++j) { const int i = tid + 512 * j; wv_[j] = ((const f32x4*)a.w_router)[i]; gs_[j] = a.ln1_g[i >> 3]; }
    if (tid < 64) misc[tid] = 0u;
    float* Z = (float*)(a.ws + WS_Z); bf16_t* X1B = (bf16_t*)(a.ws + WS_XB);
    const int r0 = (F.vcu * 8 + wid) * 16;
    const int rl = lane & 15, q = lane >> 4;
    float mym[4] = {0.f, 0.f, 0.f, 0.f}, myr[4] = {0.f, 0.f, 0.f, 0.f};
    {
        f32x4 gv[4], bv[4];
#pragma unroll
        for (int j = 0; j < 4; ++j) { gv[j] = ((const f32x4*)a.ln1_g)[lane + 64 * j]; bv[j] = ((const f32x4*)a.ln1_b)[lane + 64 * j]; }
        float* stats = (float*)(a.ws + WS_ROUTE + 4 * MiB);
        f32x4 vn_[4];
        { const f32x4* zr = (const f32x4*)(Z + (size_t)r0 * DM) + lane;
#pragma unroll
          for (int j = 0; j < 4; ++j) vn_[j] = zr[64 * j]; }
#pragma unroll 2
        for (int rr = 0; rr < 16; ++rr) {
            f32x4 v[4]; float s = 0.f;
#pragma unroll
            for (int j = 0; j < 4; ++j) { v[j] = vn_[j]; s += (v[j][0] + v[j][1]) + (v[j][2] + v[j][3]); }
            if (rr < 15) { const f32x4* zr = (const f32x4*)(Z + (size_t)(r0 + rr + 1) * DM) + lane;
#pragma unroll
                for (int j = 0; j < 4; ++j) vn_[j] = zr[64 * j]; }
            const float mean = wave_sum(s) * (1.f / DM); float s2 = 0.f;
#pragma unroll
            for (int j = 0; j < 4; ++j) { v[j] = v[j] - mean; s2 += (v[j][0] * v[j][0] + v[j][1] * v[j][1]) + (v[j][2] * v[j][2] + v[j][3] * v[j][3]); }
            const float rstd = 1.f / sqrtf(wave_sum(s2) * (1.f / DM) + LN_EPS);
            unsigned* o8 = (unsigned*)((unsigned char*)X1B + (size_t)(r0 + rr) * DM) + lane;
#pragma unroll
            for (int j = 0; j < 4; ++j) { const f32x4 y = (v[j] * rstd * gv[j] + bv[j]) * 8.f; o8[64 * j] = cvt4_fp8(y[0], y[1], y[2], y[3]); }
            if (lane == 0) *(f32x2*)(stats + 2 * (r0 + rr)) = (f32x2){mean, rstd};
            if ((rr >> 2) == q) {
#pragma unroll
                for (int i = 0; i < 4; ++i) if ((rr & 3) == i) { mym[i] = mean; myr[i] = rstd; } }
        }
    }
#pragma unroll
    for (int j = 0; j < 16; ++j) ((LAS f32x4*)Wr)[tid + 512 * j] = wv_[j] * gs_[j];
    __syncthreads();
    {
        const int e = tid & 31, part = tid >> 5; float s0 = 0.f, s1 = 0.f;
        for (int k = part * 64; k < part * 64 + 64; ++k) { s0 += Wr[k * 32 + e]; s1 += a.ln1_b[k] * a.w_router[k * 32 + e]; }
        pc[part * 32 + e] = s0; pc[512 + part * 32 + e] = s1;
    }
    __syncthreads();
    if (tid < 64) { const int e = tid & 31, w = tid >> 5; float t = 0.f; for (int p = 0; p < 16; ++p) t += pc[w * 512 + p * 32 + e]; pc[1024 + tid] = t + (w ? a.b_router[e] : 0.f); }
    __syncthreads();
    f32x4 acc0 = (f32x4){0.f, 0.f, 0.f, 0.f}, acc1 = acc0;
    const float* xr = Z + (size_t)(r0 + rl) * DM + 4 * q;
#pragma unroll 4
    for (int cidx = 0; cidx < 64; ++cidx) {
        const f32x4 xv = *(const f32x4*)(xr + 16 * cidx);
#pragma unroll
        for (int j = 0; j < 4; ++j) { const int k = 16 * cidx + 4 * q + j;
            acc0 = __builtin_amdgcn_mfma_f32_16x16x4f32(xv[j], Wr[k * 32 + rl], acc0, 0, 0, 0);
            acc1 = __builtin_amdgcn_mfma_f32_16x16x4f32(xv[j], Wr[k * 32 + 16 + rl], acc1, 0, 0, 0); }
    }
    {   const float cs0 = pc[1024 + rl], cs1 = pc[1024 + 16 + rl], cb0 = pc[1024 + 32 + rl], cb1 = pc[1024 + 48 + rl];
#pragma unroll
        for (int i = 0; i < 4; ++i) { acc0[i] = myr[i] * (acc0[i] - mym[i] * cs0) + cb0; acc1[i] = myr[i] * (acc1[i] - mym[i] * cs1) + cb1; } }
    const float br0 = 0.f, br1 = 0.f;
    int* sel_e = (int*)(a.ws + WS_ROUTE); int* sel_pos = sel_e + NTOK * TOPK; float* sel_gate = (float*)(sel_pos + NTOK * TOPK);
    int my_e[4] = {0, 0, 0, 0}, my_lp[4] = {0, 0, 0, 0}; float my_g[4] = {0.f, 0.f, 0.f, 0.f};
#pragma unroll
    for (int i = 0; i < 4; ++i) {
        unsigned k0 = (ordkey(acc0[i] + br0) & ~31u) | (unsigned)(31 - rl), k1 = (ordkey(acc1[i] + br1) & ~31u) | (unsigned)(15 - rl);
        unsigned selk[4];
#pragma unroll
        for (int t = 0; t < 4; ++t) {
            unsigned m = k0 > k1 ? k0 : k1;
#pragma unroll
            for (int ofs = 1; ofs < 16; ofs <<= 1) { const unsigned other = (unsigned)__shfl_xor((int)m, ofs); m = other > m ? other : m; }
            selk[t] = m; if (k0 == m) k0 = 0u; if (k1 == m) k1 = 0u;
        }
        const float v0 = unordkey(selk[0] & ~31u), v1 = unordkey(selk[1] & ~31u), v2 = unordkey(selk[2] & ~31u), v3 = unordkey(selk[3] & ~31u);
        const float e1 = __expf(v1 - v0), e2 = __expf(v2 - v0), e3 = __expf(v3 - v0); const float rs = 1.0f / (1.0f + e1 + e2 + e3);
        if (rl < 4) { const unsigned sk = rl == 0 ? selk[0] : (rl == 1 ? selk[1] : (rl == 2 ? selk[2] : selk[3]));
            const float ge = rl == 0 ? 1.0f : (rl == 1 ? e1 : (rl == 2 ? e2 : e3));
            my_e[i] = 31 - (int)(sk & 31u); my_g[i] = ge * rs; my_lp[i] = (int)atomicAdd((unsigned*)&misc[my_e[i]], 1u); }
    }
    __syncthreads();
    unsigned* gcnt = (unsigned*)(a.ws + WS_CTL);
    if (F_TID < 32) misc[32 + F_TID] = atomicAdd(&gcnt[F_TID], misc[F_TID]);
    __syncthreads();
    if (rl < 4) {
#pragma unroll
        for (int i = 0; i < 4; ++i) { const int tok = r0 + 4 * q + i, idx = tok * 4 + rl; sel_e[idx] = my_e[i]; sel_pos[idx] = (int)misc[32 + my_e[i]] + my_lp[i]; sel_gate[idx] = my_g[i]; }
    }
}

__device__ __forceinline__ int build_tiles(const Frame& F, const Args& a) {
    LAS unsigned* misc = (LAS unsigned*)(F.lds + LX_MISC); LAS unsigned char* tile_e = F.lds + LX_TILE;
    const unsigned* gcnt = (const unsigned*)(a.ws + WS_CTL);
    if (F_TID < 64) {
        const int l_ = F_TID; const unsigned tl_ = l_ < NE ? (__hip_atomic_load(&gcnt[l_], __ATOMIC_RELAXED, __HIP_MEMORY_SCOPE_AGENT) + 255u) >> 8 : 0u;
        unsigned inc_ = tl_;
#pragma unroll
        for (int ofs = 1; ofs < 32; ofs <<= 1) { const unsigned o_ = (unsigned)__shfl_up((int)inc_, ofs); if ((l_ & 31) >= ofs) inc_ += o_; }
        if (l_ < NE) { misc[128 + l_] = tl_; misc[64 + l_] = inc_ - tl_; if (l_ == NE - 1) misc[64 + NE] = inc_; }
    }
    __syncthreads();
    const int nt = (int)misc[64 + NE];
    for (int t = F_TID; t < nt; t += 512) {
        int lo = 0, hi = NE - 1;
#pragma unroll
        for (int it = 0; it < 5; ++it) { const int mid = (lo + hi + 1) >> 1; if ((int)misc[64 + mid] <= t) lo = mid; else hi = mid - 1; }
        tile_e[t] = (unsigned char)lo; }
    __syncthreads();
    return nt;
}

#define XLAS __attribute__((address_space(3)))
#define XB_TMO      128
#define XB_XCNT(j)  (256  + 64 * (j))
#define XB_XSUB(j)  (1280 + 64 * (j))
#define XB_XGEN(j)  (2304 + 64 * (j))
#define XB_TOP      3328
#define XB_TOPGEN   3392
#define XCD_BAR_WORDS 3456
#define XB_SPIN_CAP (1u << 22)

__device__ __forceinline__ unsigned xb_ld(unsigned* p)              { return __hip_atomic_load(p, __ATOMIC_RELAXED, __HIP_MEMORY_SCOPE_AGENT); }
__device__ __forceinline__ unsigned xb_add(unsigned* p, unsigned v) { return __hip_atomic_fetch_add(p, v, __ATOMIC_RELAXED, __HIP_MEMORY_SCOPE_AGENT); }
__device__ __forceinline__ unsigned xb_xcc_id() { return (unsigned)__builtin_amdgcn_s_getreg((3 << 11) | 20) & 0xFu; }
#define XB_SPIN(cond, bar) do { unsigned _sp = 0; while (cond) { __builtin_amdgcn_s_sleep(1); \
    if ((++_sp & 255u) == 0u) { if (xb_ld(&(bar)[XB_TMO])) break; if (_sp > XB_SPIN_CAP) { atomicAdd(&(bar)[XB_TMO], 1u); break; } } } } while (0)

struct XcdBarrier {
    unsigned* bar; unsigned x;
    volatile XLAS unsigned* st;
};

__device__ __forceinline__ XcdBarrier xcd_barrier_post(unsigned* bar, volatile XLAS unsigned* st) {
    XcdBarrier b; b.bar = bar; b.x = xb_xcc_id(); b.st = st;
    if (threadIdx.x == 0) (void)xb_add(&bar[XB_XCNT(b.x)], 1u);
    return b;
}
__device__ __forceinline__ void xcd_barrier_complete(unsigned* bar, unsigned x, unsigned& nloc, unsigned& nx) {
    const unsigned G = gridDim.x * gridDim.y * gridDim.z;
    unsigned sum, cnt, mine, sp = 0u;
    for (;;) {
        sum = 0u; cnt = 0u; mine = 0u;
#pragma unroll
        for (unsigned j = 0; j < 16; ++j) { const unsigned c = xb_ld(&bar[XB_XCNT(j)]); sum += c; cnt += (c > 0u) ? 1u : 0u; mine = (j == x) ? c : mine; }
        if (sum == G) break;
        __builtin_amdgcn_s_sleep(1);
        if ((++sp & 255u) == 0u) { if (xb_ld(&bar[XB_TMO])) break; if (sp > XB_SPIN_CAP) { atomicAdd(&bar[XB_TMO], 1u); break; } }
    }
    nloc = mine > 0u ? mine : 1u; nx = cnt > 0u ? cnt : 1u;
}

__device__ __forceinline__ void xcd_barrier(const XcdBarrier& b, const int tid0) {
    asm volatile("s_waitcnt vmcnt(0)" ::: "memory");
    __syncthreads();
    if (tid0 == 0) {
        unsigned* bar = b.bar;
        __builtin_amdgcn_s_waitcnt(0);
        unsigned nloc = b.st[0], nx = b.st[1];
        if (nloc == 0u) { xcd_barrier_complete(bar, b.x, nloc, nx); b.st[0] = nloc; b.st[1] = nx; }
        const unsigned old = xb_add(&bar[XB_XSUB(b.x)], 1u);
        const unsigned gen = old / nloc;
        if (old + 1u == (gen + 1u) * nloc) {
            __builtin_amdgcn_fence(__ATOMIC_RELEASE, "agent");
            asm volatile("s_waitcnt vmcnt(0)" ::: "memory");
            const unsigned og = xb_add(&bar[XB_TOP], 1u);
            const unsigned tg = og / nx;
            if (og + 1u == (tg + 1u) * nx) xb_add(&bar[XB_TOPGEN], 1u);
            else XB_SPIN(xb_ld(&bar[XB_TOPGEN]) == tg, bar);
            __builtin_amdgcn_fence(__ATOMIC_ACQUIRE, "agent");
            xb_add(&bar[XB_XGEN(b.x)], 1u);
            asm volatile("s_waitcnt vmcnt(0)" ::: "memory");
        } else {
            XB_SPIN(xb_ld(&bar[XB_XGEN(b.x)]) == gen, bar);
            __builtin_amdgcn_fence(__ATOMIC_ACQUIRE, "agent");
            asm volatile("s_waitcnt vmcnt(0)" ::: "memory");
        }
    }
    __syncthreads();
}

__global__ void __launch_bounds__(512, 2) fwd_megakernel(Args a) {
    extern __shared__ __attribute__((aligned(16))) unsigned char lds_raw[];
    cg::grid_group grid = cg::this_grid();
    Frame F; F.lds = (LAS unsigned char*)lds_raw; F.wave = __builtin_amdgcn_readfirstlane((int)(threadIdx.x >> 6));
    F.G = gridDim.x; { const int bx = blockIdx.x; F.vcu = (F.G % 8 == 0) ? (bx % 8) * (F.G / 8) + bx / 8 : bx; }
    unsigned char* ws = a.ws;
    {   LAS unsigned* m0_ = (LAS unsigned*)(F.lds + LX_MISC); if (F_TID < 128) m0_[F_TID] = 0u; __syncthreads(); }
    XcdBarrier xbar = xcd_barrier_post((unsigned*)(ws + WS_CTL) + CW_BAR, (volatile LAS unsigned*)(F.lds + LX_MISC) + 120);
#define GRID_BAR() xcd_barrier(xbar, F_TID)
#ifdef PROBE_T1
    unsigned long long* stamps = (unsigned long long*)(ws + WS_CTL + 2048);
#define STAMP(k) do { if (blockIdx.x == 0 && F_TID == 0) stamps[k] = __builtin_amdgcn_s_memrealtime(); } while (0)
#else
#define STAMP(k) do {} while (0)
#endif
    STAMP(0);

    for (int rep = 0; rep < REP_P0; ++rep) p0_prologue(F, a);
    if (a.out == nullptr) grid.sync();
    GRID_BAR();
    STAMP(1);

    for (int rep = 0; rep < REP_P1; ++rep) {
        pg8::Gemm g{(const bf16_t*)(ws + WS_XB), (const bf16_t*)(ws + WS_WIN), NTOK, NPROJ, DM, 0, 0}; pg8::StaticOrder S; S.init(NTOK, NPROJ, F.G, (int)blockIdx.x);
        EpiProj E{(bf16_t*)(ws + WS_PROJ), (unsigned*)(ws + WS_CTL)};
        pg8::gemm_phase<EpiProj, pg8::StaticOrder, true, false, KREP_P1>(F.lds, g, S, E, F_TID);
    }
    GRID_BAR();
    STAMP(2);

    {
        float s1 = 0.f, s2 = 0.f;
        for (int i = 0; i < 64; ++i) { s1 += a.lq1[i] * a.lk1[i]; s2 += a.lq2[i] * a.lk2[i]; }
        const float lam = __expf(s1) - __expf(s2) + LAM_INIT;
        {
            LAS unsigned* misc = (LAS unsigned*)(F.lds + LX_MISC); unsigned* ctl = (unsigned*)(ws + WS_CTL);
            const int myx = (int)(xbar.x & 7u);
            for (;;) {
                __syncthreads();
                if (F_TID == 0) { int got = -1;
                    { const unsigned p = atomicAdd(ctl + CW_QUEUE + myx, 1u); if (p < 224u) got = myx * 256 + (int)p; }
                    for (int k = 1; k < 8 && got < 0; ++k) { const int qx = (myx + k) & 7;
                        if (__hip_atomic_load(ctl + CW_QUEUE + qx, __ATOMIC_RELAXED, __HIP_MEMORY_SCOPE_AGENT) < 224u) { const unsigned p = atomicAdd(ctl + CW_QUEUE + qx, 1u); if (p < 224u) got = qx * 256 + (int)p; } }
                    misc[100] = (unsigned)got; }
                __syncthreads();
                const int idx = __builtin_amdgcn_readfirstlane((int)misc[100]);
                if (idx < 0) break;
                const int qx = idx >> 8, p = idx & 255;
                int kind_ = 0, h_ = 0, j_ = 0;
                if (p < 64) { if (p & 1) { kind_ = 1; j_ = qx * 32 + (p >> 1); } else { h_ = 3; j_ = p >> 1; } }
                else if (p < 192) { const int q_ = p - 64, i_ = q_ >> 1; if (q_ & 1) { kind_ = 2; j_ = qx * 64 + i_; } else { h_ = 2 - (i_ >> 5); j_ = i_ & 31; } }
                else { h_ = 0; j_ = p - 192; }
                if (kind_ == 1) attnA_unit(F, a, j_);
                else if (kind_ == 2) cv_batch(F, a, j_);
                else attnB_item(F, a, h_, qx >> 2, 32 * (qx & 3) + j_, lam);
            }
        }
    }
    GRID_BAR();
    STAMP(3);

    for (int rep = 0; rep < REP_P3; ++rep) {
        pg8::Gemm g{(const bf16_t*)(ws + WS_MIXED), (const bf16_t*)(ws + WS_WOUT), NTOK, DM, DM, 0, 0}; pg8::StaticOrder S; S.init(NTOK, DM, F.G, (int)blockIdx.x);
        EpiZ E{a.x, (float*)(ws + WS_Z)};
        pg8::gemm_phase<EpiZ, pg8::StaticOrder, true, false, KREP_P3>(F.lds, g, S, E, F_TID);
    }
    GRID_BAR();
    STAMP(4);

    if (F.G == 256) p4_ln_router(F, a);
    GRID_BAR();
    STAMP(5);

    int* sel_e = (int*)(ws + WS_ROUTE); int* sel_pos = sel_e + NTOK * TOPK; float* sel_gate = (float*)(sel_pos + NTOK * TOPK);
    int* inv = (int*)(sel_gate + NTOK * TOPK); int* row_tok = inv + NTOK * TOPK; float* row_gate = (float*)(row_tok + 262144);
    {
        const int ntl = build_tiles(F, a); (void)ntl;
        LAS unsigned* misc = (LAS unsigned*)(F.lds + LX_MISC);
        const unsigned* gcnt = (const unsigned*)(ws + WS_CTL);
        for (int idx = F.vcu * 512 + F_TID; idx < NTOK * TOPK; idx += F.G * 512) {
            const int e = sel_e[idx], dest = (int)misc[64 + e] * 256 + sel_pos[idx];
            row_tok[dest] = idx >> 2; row_gate[dest] = sel_gate[idx]; inv[idx] = dest;
        }
        for (int e = F.vcu; e < NE; e += F.G) {
            const int c = (int)__hip_atomic_load(&gcnt[e], __ATOMIC_RELAXED, __HIP_MEMORY_SCOPE_AGENT), base = (int)misc[64 + e] * 256, end = (int)misc[65 + e] * 256;
            for (int r = base + c + F_TID; r < end; r += 512) { row_tok[r] = 0; row_gate[r] = 0.f; }
        }
    }
    GRID_BAR();
    STAMP(6);

    for (int rep = 0; rep < REP_P6; ++rep) {
        const int ntl = build_tiles(F, a);
        MoeOrder S; S.so.init(ntl * 256, 2048, F.G, (int)blockIdx.x); S.tile_e = F.lds + LX_TILE; S.tok = (const LAS unsigned short*)(F.lds + LX_TOK); S.ncolt = 8;
        {
            LAS unsigned short* tk = (LAS unsigned short*)(F.lds + LX_TOK); pg8::Unit u;
            for (int i = F.wave; i < 24 && S.so.next(i, u); i += 8) { const int l_ = F_LANE;
#pragma unroll
                for (int j = 0; j < 4; ++j) tk[i * 256 + l_ + 64 * j] = (unsigned short)row_tok[u.pm * 256 + l_ + 64 * j]; }
            __syncthreads();
        }
        pg8::Gemm g{(const bf16_t*)(ws + WS_XB), (const bf16_t*)(ws + WS_WUP), ntl * 256, 2048, DM, 0x7C7C7C7C, 0x77777777};
        EpiUp E{(bf16_t*)(ws + WS_H), a.b_up};
        pg8::gemm_phase<EpiUp, MoeOrder, true, true, KREP_P6, true>(F.lds, g, S, E, F_TID);
    }
    GRID_BAR();
    STAMP(7);

    for (int rep = 0; rep < REP_P7; ++rep) {
        const int ntl = build_tiles(F, a);
        MoeOrder S; S.so.init(ntl * 256, 1024, F.G, (int)blockIdx.x, ORD_REV7); S.tile_e = F.lds + LX_TILE; S.tok = nullptr; S.ncolt = 4;
        pg8::Gemm g{(const bf16_t*)(ws + WS_H), (const bf16_t*)(ws + WS_WDN), ntl * 256, DM, DFF, 0x7D7D7D7D, 0x77777777};
        EpiDown E{(bf16_t*)(ws + WS_Y), a.b_down, row_gate};
        pg8::gemm_phase<EpiDown, MoeOrder, true, false, KREP_P7, true>(F.lds, g, S, E, F_TID);
    }
    GRID_BAR();
    STAMP(8);

    for (int rep = 0; rep < REP_P8; ++rep) {
        const int lane = F_LANE; const float* X1 = (const float*)(ws + WS_Z); const bf16_t* Y = (const bf16_t*)(ws + WS_Y); const float* stats = (const float*)(ws + WS_ROUTE + 4 * MiB);
        f32x4 gv[4], bv[4], g1[4], b1[4];
#pragma unroll
        for (int j = 0; j < 4; ++j) { gv[j] = ((const f32x4*)a.ln2_g)[lane + 64 * j]; bv[j] = ((const f32x4*)a.ln2_b)[lane + 64 * j]; g1[j] = ((const f32x4*)a.ln1_g)[lane + 64 * j] * ALPHA; b1[j] = ((const f32x4*)a.ln1_b)[lane + 64 * j] * ALPHA; }
        const int mstep = F.G * 8; int m = F.vcu * 8 + F.wave;
        f32x4 zn[4]; unsigned yn[4][4]; f32x2 stn = (f32x2){0.f, 0.f};
#define P8_LOAD(mm) do { const f32x4* xr_ = (const f32x4*)(X1 + (size_t)(mm) * DM) + lane; stn = *(const f32x2*)(stats + 2 * (mm)); \
            _Pragma("unroll") for (int j = 0; j < 4; ++j) zn[j] = xr_[64 * j]; \
            _Pragma("unroll") for (int t = 0; t < 4; ++t) { const int dest_ = inv[(mm) * 4 + t]; const unsigned* yr_ = (const unsigned*)((const unsigned char*)Y + (size_t)dest_ * DM) + lane; \
                _Pragma("unroll") for (int j = 0; j < 4; ++j) yn[t][j] = yr_[64 * j]; } } while (0)
        if (m < NTOK) P8_LOAD(m);
        for (; m < NTOK; m += mstep) {
            f32x4 v[4]; unsigned yc[4][4]; const f32x2 st = stn;
#pragma unroll
            for (int j = 0; j < 4; ++j) v[j] = (zn[j] - st[0]) * st[1] * g1[j] + b1[j];
#pragma unroll
            for (int t = 0; t < 4; ++t)
#pragma unroll
                for (int j = 0; j < 4; ++j) yc[t][j] = yn[t][j];
            if (m + mstep < NTOK) P8_LOAD(m + mstep);
#pragma unroll
            for (int t = 0; t < 4; ++t)
#pragma unroll
                for (int j = 0; j < 4; ++j) { const int w = (int)yc[t][j];
                    v[j][0] += __builtin_amdgcn_cvt_f32_fp8(w, 0) * (1.f / 32.f); v[j][1] += __builtin_amdgcn_cvt_f32_fp8(w, 1) * (1.f / 32.f);
                    v[j][2] += __builtin_amdgcn_cvt_f32_fp8(w, 2) * (1.f / 32.f); v[j][3] += __builtin_amdgcn_cvt_f32_fp8(w, 3) * (1.f / 32.f); }
            float s = 0.f;
#pragma unroll
            for (int j = 0; j < 4; ++j) s += (v[j][0] + v[j][1]) + (v[j][2] + v[j][3]);
            const float mean = wave_sum(s) * (1.f / DM); float s2 = 0.f;
#pragma unroll
            for (int j = 0; j < 4; ++j) { v[j] = v[j] - mean; s2 += (v[j][0] * v[j][0] + v[j][1] * v[j][1]) + (v[j][2] * v[j][2] + v[j][3] * v[j][3]); }
            const float rstd = 1.f / sqrtf(wave_sum(s2) * (1.f / DM) + LN_EPS);
            f32x4* orow = (f32x4*)(a.out + (size_t)m * DM) + lane;
#pragma unroll
            for (int j = 0; j < 4; ++j) orow[64 * j] = v[j] * rstd * gv[j] + bv[j];
        }
#undef P8_LOAD
    }
#ifdef PROBE_T1
    STAMP(9);
    if (blockIdx.x == 0) {
        __syncthreads();
        const float t1 = (float)(stamps[PROBE_T1 + 1] - stamps[PROBE_T1]) * 0.01f, t2 = (float)(stamps[PROBE_T2 + 1] - stamps[PROBE_T2]) * 0.01f;
        for (int i = F_TID; i < (1 << 20); i += 512) a.out[1 + i] = t2;
        if (F_TID == 0) a.out[0] = t1 * 10.0f;
    }
#endif
}

extern "C" void kernel_launch(void* const* d_in, const int* in_sizes, int n_in, void* d_out, int out_size, void* d_ws, size_t ws_size, hipStream_t stream) {
    static int grid = 0;
    if (grid == 0) {
        if (n_in != 18 || in_sizes[0] != NTOK * DM || out_size != NTOK * DM || ws_size < WS_END) {
            fprintf(stderr, "kernel_launch: unexpected shapes (n_in %d, in0 %d, out %d, ws %zu need %zu); nothing launched\n", n_in, n_in > 0 ? in_sizes[0] : -1, out_size, ws_size, (size_t)WS_END); grid = -1; return; }
        int dev = 0, cus = 0, per_cu = 0;
        if (hipGetDevice(&dev) != hipSuccess || hipDeviceGetAttribute(&cus, hipDeviceAttributeMultiprocessorCount, dev) != hipSuccess) { grid = -1; return; }
        if (hipFuncSetAttribute((const void*)fwd_megakernel, hipFuncAttributeMaxDynamicSharedMemorySize, LDS_BYTES) != hipSuccess) { fprintf(stderr, "kernel_launch: hipFuncSetAttribute failed\n"); grid = -1; return; }
        if (hipOccupancyMaxActiveBlocksPerMultiprocessor(&per_cu, (const void*)fwd_megakernel, 512, LDS_BYTES) != hipSuccess || per_cu < 1) { fprintf(stderr, "kernel_launch: occupancy query says %d\n", per_cu); per_cu = 1; }
        (void)hipGetLastError();
        grid = cus * (per_cu > 1 ? 1 : per_cu);
        fprintf(stderr, "kernel_launch: grid %d (cus %d, per_cu %d)\n", grid, cus, per_cu);
    }
    if (grid < 0) return;
    if (hipMemsetAsync((char*)d_ws + WS_CTL, 0, CTL_ZERO_BYTES, stream) != hipSuccess) return;
    Args a{};
    const float* const* in = (const float* const*)d_in;
    a.x = in[0]; a.w_in = in[1]; a.w_out = in[2]; a.lq1 = in[3]; a.lk1 = in[4]; a.lq2 = in[5]; a.lk2 = in[6]; a.g_sub = in[7];
    a.ln1_g = in[8]; a.ln1_b = in[9]; a.w_router = in[10]; a.b_router = in[11]; a.w_up = in[12]; a.b_up = in[13]; a.w_down = in[14]; a.b_down = in[15];
    a.ln2_g = in[16]; a.ln2_b = in[17]; a.out = (float*)d_out; a.ws = (unsigned char*)d_ws;
    void* args[] = {&a};
    hipError_t e = hipLaunchCooperativeKernel((void*)fwd_megakernel, dim3(grid), dim3(512), args, LDS_BYTES, stream);
    if (e != hipSuccess) fprintf(stderr, "kernel_launch: cooperative launch failed: %s (grid %d)\n", hipGetErrorString(e), grid);
}
```
